# Optimizing an MI355X kernel written in HIP

```python
import math
import numpy as np
import jax
import jax.numpy as jnp
from jax import lax

D_MODEL = 1024
BATCH = 2
SEQ = 8192
DEPTH = 2

GRID_W = 64
CTX_LEN = 256
ROPE_BASE = 10000.0
EPS = 1e-6
Q_BLOCK = 128

MLA_HEADS = 8
MLA_Q_RANK = 256
MLA_KV_RANK = 128
MLA_NOPE = 64
MLA_ROPE = 32
MLA_V = 64
GQA_HEADS = 4
GQA_KV_HEADS = 2
GQA_HEAD_DIM = 64
CONV_CH = 256
CONV_WIDTH = 31

MLA_WIDTH = MLA_HEADS * MLA_V
GQA_WIDTH = GQA_HEADS * GQA_HEAD_DIM
MIX_WIDTH = MLA_WIDTH + GQA_WIDTH + CONV_CH
IN_SIZES = (MLA_Q_RANK, MLA_KV_RANK, MLA_ROPE, GQA_HEADS * GQA_HEAD_DIM,
            GQA_KV_HEADS * GQA_HEAD_DIM, GQA_KV_HEADS * GQA_HEAD_DIM, 2 * CONV_CH)
IN_WIDTH = (MLA_Q_RANK + MLA_KV_RANK + MLA_ROPE
            + (GQA_HEADS + 2 * GQA_KV_HEADS) * GQA_HEAD_DIM + 2 * CONV_CH)
MLA_SCALE = 1.0 / math.sqrt(MLA_NOPE + MLA_ROPE)
GQA_SCALE = 1.0 / math.sqrt(GQA_HEAD_DIM)

N_EXPERTS = 16
EXPERT_FF = 2688
CAPACITY_FACTOR = 2

kernel_name = "hybrid_mla_gqa_conformer_ecmoe_diffusion"


def rmsnorm(x, g):
    xf = x.astype(jnp.float32)
    y = xf * lax.rsqrt(jnp.mean(xf * xf, axis=-1, keepdims=True) + EPS)
    return (y * g).astype(x.dtype)


def layernorm(x, g, b):
    xf = x.astype(jnp.float32)
    mu = jnp.mean(xf, axis=-1, keepdims=True)
    var = jnp.mean(jnp.square(xf - mu), axis=-1, keepdims=True)
    return ((xf - mu) * lax.rsqrt(var + EPS) * g + b).astype(x.dtype)


def modulate(h, shift, scale):
    return h * (1.0 + scale) + shift


def axial_rope_tables(n, d_rot):
    rows = n // GRID_W
    row = jnp.repeat(jnp.arange(rows), GRID_W).astype(jnp.float32)
    col = jnp.tile(jnp.arange(GRID_W), rows).astype(jnp.float32)
    d_axis = d_rot // 2
    inv = ROPE_BASE ** (-jnp.arange(0, d_axis, 2, dtype=jnp.float32) / d_axis)
    ang = jnp.concatenate([row[:, None] * inv, col[:, None] * inv], axis=-1)
    return (jnp.cos(ang), jnp.sin(ang))


def apply_rope(x, cos, sin):
    xf = x.astype(jnp.float32)
    half = x.shape[-1] // 2
    x1, x2 = xf[..., :half], xf[..., half:]
    cs, sn = cos[None, :, None, :], sin[None, :, None, :]
    return jnp.concatenate([x1 * cs - x2 * sn, x2 * cs + x1 * sn], axis=-1).astype(x.dtype)


def attend(q, k, v, scale):
    B, n, G, R, dk = q.shape
    nblk = n // Q_BLOCK
    qb = q.reshape(B, nblk, Q_BLOCK, G, R, dk).transpose(1, 0, 2, 3, 4, 5)

    def one_block(q_blk):
        s = jnp.einsum("bqgrd,bkgd->bgrqk", q_blk, k, preferred_element_type=jnp.float32) * scale
        pr = jax.nn.softmax(s, axis=-1).astype(v.dtype)
        return jnp.einsum("bgrqk,bkge->bqgre", pr, v)

    o = lax.map(one_block, qb)
    return o.transpose(1, 0, 2, 3, 4, 5).reshape(B, n, G, R, v.shape[-1])


def split_in(z):
    offsets = np.cumsum(IN_SIZES)[:-1].tolist()
    return jnp.split(z, offsets, axis=-1)


def project_side(h, p, tabs, with_queries):
    B, n, _ = h.shape
    cq, ckv, kr, zq, zk, zv, zc = split_in(h @ p["w_in"])
    kv = (rmsnorm(ckv, p["mla_kv_norm_g"]) @ p["mla_w_ukv"]).reshape(B, n, MLA_HEADS, MLA_NOPE + MLA_V)
    k_nope, v_mla = kv[..., :MLA_NOPE], kv[..., MLA_NOPE:]
    k_rope = kr[:, :, None, :]
    gk = rmsnorm(zk.reshape(B, n, GQA_KV_HEADS, GQA_HEAD_DIM), p["gqa_k_norm_g"])
    gv = zv.reshape(B, n, GQA_KV_HEADS, GQA_HEAD_DIM)
    if tabs is not None:
        cos_m, sin_m, cos_g, sin_g = tabs
        k_rope = apply_rope(k_rope, cos_m, sin_m)
        gk = apply_rope(gk, cos_g, sin_g)
    k_mla = jnp.concatenate([k_nope, jnp.broadcast_to(k_rope, (B, n, MLA_HEADS, MLA_ROPE))], axis=-1)
    out = {"k_mla": k_mla, "v_mla": v_mla, "k_gqa": gk, "v_gqa": gv}
    if with_queries:
        q = (rmsnorm(cq, p["mla_q_norm_g"]) @ p["mla_w_uq"]).reshape(B, n, MLA_HEADS, MLA_NOPE + MLA_ROPE)
        q_nope, q_rope = q[..., :MLA_NOPE], q[..., MLA_NOPE:]
        gq = rmsnorm(zq.reshape(B, n, GQA_HEADS, GQA_HEAD_DIM), p["gqa_q_norm_g"])
        if tabs is not None:
            q_rope = apply_rope(q_rope, cos_m, sin_m)
            gq = apply_rope(gq, cos_g, sin_g)
        out["q_mla"] = jnp.concatenate([q_nope, q_rope], axis=-1)[:, :, :, None, :]
        out["q_gqa"] = gq.reshape(B, n, GQA_KV_HEADS, GQA_HEADS // GQA_KV_HEADS, GQA_HEAD_DIM)
        out["conv_in"] = zc
    return out


def conformer_conv(zc, p):
    a, b = jnp.split(zc, 2, axis=-1)
    u = a * jax.nn.sigmoid(b)
    y = lax.conv_general_dilated(
        u, p["conv_dw_w"][:, None, :], window_strides=(1,),
        padding=[(CONV_WIDTH // 2, CONV_WIDTH // 2)],
        dimension_numbers=("NWC", "WIO", "NWC"), feature_group_count=CONV_CH) + p["conv_dw_b"]
    return jax.nn.silu(layernorm(y, p["conv_ln_g"], p["conv_ln_b"]))


def mix_side(side, k_mla, v_mla, k_gqa, v_gqa, p):
    B, n = side["q_mla"].shape[:2]
    o_mla = attend(side["q_mla"], k_mla, v_mla, MLA_SCALE).reshape(B, n, MLA_WIDTH)
    o_gqa = attend(side["q_gqa"], k_gqa, v_gqa, GQA_SCALE).reshape(B, n, GQA_WIDTH)
    o_conv = conformer_conv(side["conv_in"], p)
    g = p["mix_out_g"]
    cat = jnp.concatenate([
        rmsnorm(o_mla, g[:MLA_WIDTH]),
        rmsnorm(o_gqa, g[MLA_WIDTH:MLA_WIDTH + GQA_WIDTH]),
        rmsnorm(o_conv, g[MLA_WIDTH + GQA_WIDTH:]),
    ], axis=-1)
    return cat @ p["w_out"]


def expert_choice_ffn(h, p):
    B, n, D = h.shape
    cap = CAPACITY_FACTOR * n // N_EXPERTS
    aff = jax.nn.softmax(jnp.einsum("bnd,de->bne", h, p["router_w"], preferred_element_type=jnp.float32), axis=-1)
    gate, idx = lax.top_k(aff.transpose(0, 2, 1), cap)
    xg = jax.vmap(lambda hb, ib: hb[ib])(h, idx)
    hid = jax.nn.silu(jnp.einsum("becd,edf->becf", xg, p["exp_w1"])) * jnp.einsum("becd,edf->becf", xg, p["exp_w3"])
    y = jnp.einsum("becf,efd->becd", hid, p["exp_w2"]) * gate[..., None].astype(h.dtype)
    return jax.vmap(lambda ib, yb: jnp.zeros((n, D), yb.dtype).at[ib.reshape(-1)].add(yb.reshape(-1, D)))(idx, y)


def hybrid_layer(x, ctx, mod_lat, mod_ctx, p, tabs, need_ctx):
    sh1, sc1, g1, sh2, sc2, g2 = jnp.split(mod_lat, 6, axis=-1)
    csh1, csc1, cg1, csh2, csc2, cg2 = jnp.split(mod_ctx, 6, axis=-1)
    lat = project_side(modulate(rmsnorm(x, p["norm1_g"]), sh1, sc1), p, tabs, True)
    cx = project_side(modulate(rmsnorm(ctx, p["norm1_g"]), csh1, csc1), p, None, need_ctx)
    k_mla = jnp.concatenate([cx["k_mla"], lat["k_mla"]], axis=1)
    v_mla = jnp.concatenate([cx["v_mla"], lat["v_mla"]], axis=1)
    k_gqa = jnp.concatenate([cx["k_gqa"], lat["k_gqa"]], axis=1)
    v_gqa = jnp.concatenate([cx["v_gqa"], lat["v_gqa"]], axis=1)
    x = x + g1 * mix_side(lat, k_mla, v_mla, k_gqa, v_gqa, p)
    x = x + g2 * expert_choice_ffn(modulate(rmsnorm(x, p["norm2_g"]), sh2, sc2), p)
    if need_ctx:
        ctx = ctx + cg1 * mix_side(cx, cx["k_mla"], cx["v_mla"], cx["k_gqa"], cx["v_gqa"], p)
        ctx = ctx + cg2 * expert_choice_ffn(modulate(rmsnorm(ctx, p["norm2_g"]), csh2, csc2), p)
    return x, ctx


def setup_inputs(seed: int = 0) -> dict:
    key = jax.random.key(seed)
    ks = iter(jax.random.split(key, 32))

    def nrm(shape, scale):
        return jax.random.normal(next(ks), shape, jnp.float32) * scale

    def gain(shape):
        return 1.0 + nrm(shape, 0.05)

    L = DEPTH
    return {
        "x": nrm((BATCH, SEQ, D_MODEL), 1.0),
        "c": nrm((BATCH, D_MODEL), 1.0),
        "ctx": nrm((BATCH, CTX_LEN, D_MODEL), 1.0),
        "c_ctx": nrm((D_MODEL,), 1.0),
        "mod_w": nrm((L, D_MODEL, 6 * D_MODEL), 0.5 * D_MODEL ** -0.5),
        "mod_b": nrm((L, 6 * D_MODEL), 0.02),
        "norm1_g": gain((L, D_MODEL)),
        "w_in": nrm((L, D_MODEL, IN_WIDTH), D_MODEL ** -0.5),
        "mla_q_norm_g": gain((L, MLA_Q_RANK)),
        "mla_w_uq": nrm((L, MLA_Q_RANK, MLA_HEADS * (MLA_NOPE + MLA_ROPE)), MLA_Q_RANK ** -0.5),
        "mla_kv_norm_g": gain((L, MLA_KV_RANK)),
        "mla_w_ukv": nrm((L, MLA_KV_RANK, MLA_HEADS * (MLA_NOPE + MLA_V)), MLA_KV_RANK ** -0.5),
        "gqa_q_norm_g": gain((L, GQA_HEAD_DIM)),
        "gqa_k_norm_g": gain((L, GQA_HEAD_DIM)),
        "conv_dw_w": nrm((L, CONV_WIDTH, CONV_CH), CONV_WIDTH ** -0.5),
        "conv_dw_b": nrm((L, CONV_CH), 0.02),
        "conv_ln_g": gain((L, CONV_CH)),
        "conv_ln_b": nrm((L, CONV_CH), 0.02),
        "mix_out_g": gain((L, MIX_WIDTH)),
        "w_out": nrm((L, MIX_WIDTH, D_MODEL), MIX_WIDTH ** -0.5),
        "norm2_g": gain((L, D_MODEL)),
        "router_w": nrm((L, D_MODEL, N_EXPERTS), D_MODEL ** -0.5),
        "exp_w1": nrm((L, N_EXPERTS, D_MODEL, EXPERT_FF), D_MODEL ** -0.5),
        "exp_w3": nrm((L, N_EXPERTS, D_MODEL, EXPERT_FF), D_MODEL ** -0.5),
        "exp_w2": nrm((L, N_EXPERTS, EXPERT_FF, D_MODEL), EXPERT_FF ** -0.5),
        "final_g": gain((D_MODEL,)),
    }


def reference(x, c, ctx, c_ctx, mod_w, mod_b, norm1_g, w_in, mla_q_norm_g, mla_w_uq, mla_kv_norm_g,
              mla_w_ukv, gqa_q_norm_g, gqa_k_norm_g, conv_dw_w, conv_dw_b, conv_ln_g, conv_ln_b,
              mix_out_g, w_out, norm2_g, router_w, exp_w1, exp_w3, exp_w2, final_g):
    n = x.shape[1]
    tabs = axial_rope_tables(n, MLA_ROPE) + axial_rope_tables(n, GQA_HEAD_DIM)
    for l in range(DEPTH):
        p = {
            "norm1_g": norm1_g[l], "w_in": w_in[l],
            "mla_q_norm_g": mla_q_norm_g[l], "mla_w_uq": mla_w_uq[l],
            "mla_kv_norm_g": mla_kv_norm_g[l], "mla_w_ukv": mla_w_ukv[l],
            "gqa_q_norm_g": gqa_q_norm_g[l], "gqa_k_norm_g": gqa_k_norm_g[l],
            "conv_dw_w": conv_dw_w[l], "conv_dw_b": conv_dw_b[l],
            "conv_ln_g": conv_ln_g[l], "conv_ln_b": conv_ln_b[l],
            "mix_out_g": mix_out_g[l], "w_out": w_out[l], "norm2_g": norm2_g[l],
            "router_w": router_w[l], "exp_w1": exp_w1[l], "exp_w3": exp_w3[l], "exp_w2": exp_w2[l],
        }
        mod_lat = (jax.nn.silu(c) @ mod_w[l] + mod_b[l])[:, None, :]
        mod_ctx = jax.nn.silu(c_ctx) @ mod_w[l] + mod_b[l]
        x, ctx = hybrid_layer(x, ctx, mod_lat, mod_ctx, p, tabs, l < DEPTH - 1)
    return rmsnorm(x, final_g)
```

```cpp
#include <hip/hip_runtime.h>
#include <cstdio>
#include <cstdint>

#define GAS __attribute__((address_space(1)))
#define LAS __attribute__((address_space(3)))
typedef unsigned short bf16;
typedef unsigned v4u __attribute__((ext_vector_type(4)));
typedef unsigned v2u __attribute__((ext_vector_type(2)));
typedef float f32x4 __attribute__((ext_vector_type(4)));
typedef float f32x2 __attribute__((ext_vector_type(2)));
typedef short bf16x8 __attribute__((ext_vector_type(8)));
typedef short s16x4 __attribute__((ext_vector_type(4)));
typedef float f32x16 __attribute__((ext_vector_type(16)));
#define LDS_WAIT() asm volatile("s_waitcnt lgkmcnt(0)" ::: "memory")
#define VM_WAIT() asm volatile("s_waitcnt vmcnt(0)" ::: "memory")

constexpr int DM = 1024, SEQ = 8192, CTX = 256, NB = 2, SB = SEQ + CTX, M = NB * SB, NPM = M / 256, PPB = SB / 256;
constexpr int ZW = 1536, QW = 768, KVW = 1024, OW = 768, FF = 2688, NE = 16, RPE = 2304;
constexpr int ZQ = 0, ZKV = 256, ZKR = 384, ZGQ = 416, ZGK = 672, ZGV = 800, ZCA = 928, ZCB = 1184;
constexpr float EPS = 1e-6f;
constexpr float LOG2E = 1.4426950408889634f;
constexpr float C_MLA = 0.10206207261596575f * LOG2E, C_GQA = 0.125f * LOG2E;

__device__ __forceinline__ unsigned f2bf(float f) { unsigned u = __builtin_bit_cast(unsigned, f); return (u + 0x7fffu + ((u >> 16) & 1u)) >> 16; }
__device__ __forceinline__ unsigned pk2(float lo, float hi) { unsigned r; asm volatile("v_cvt_pk_bf16_f32 %0, %1, %2" : "=v"(r) : "v"(lo), "v"(hi)); return r; }
__device__ __forceinline__ float bf2f(unsigned short h) { return __builtin_bit_cast(float, (unsigned)h << 16); }
__device__ __forceinline__ float bflo(unsigned w) { return __builtin_bit_cast(float, w << 16); }
__device__ __forceinline__ float bfhi(unsigned w) { return __builtin_bit_cast(float, w & 0xffff0000u); }
#ifndef OLD_SX
#define OLD_SX 0
#endif
#ifndef OLD_SCAN
#define OLD_SCAN 0
#endif
template <int X> __device__ __forceinline__ float sx(float v) { if (OLD_SX) return __shfl_xor(v, X); return __builtin_bit_cast(float, __builtin_amdgcn_ds_swizzle(__builtin_bit_cast(int, v), (X << 10) | 0x1f)); }
#ifndef OLD_S32
#define OLD_S32 OLD_SX
#endif
__device__ __forceinline__ float sum32(float v) {
    if (OLD_S32) return v + __shfl_xor(v, 32);
    float a_ = v, b_ = v; asm volatile("s_nop 1\n\tv_permlane32_swap_b32 %0, %1" : "+v"(a_), "+v"(b_)); return a_ + b_; }
__device__ __forceinline__ float wave_sum(float v) { v += sx<1>(v); v += sx<2>(v); v += sx<4>(v); v += sx<8>(v); v += sx<16>(v); return sum32(v); }
__device__ __forceinline__ unsigned wave_scan_incl(unsigned v, int lane) {
    if (OLD_SCAN) { for (int o = 1; o < 64; o <<= 1) { const unsigned n = __shfl_up(v, o); if (lane >= o) v += n; } return v; }
    v += (unsigned)__builtin_amdgcn_update_dpp(0, (int)v, 0x111, 0xf, 0xf, false);
    v += (unsigned)__builtin_amdgcn_update_dpp(0, (int)v, 0x112, 0xf, 0xf, false);
    v += (unsigned)__builtin_amdgcn_update_dpp(0, (int)v, 0x114, 0xf, 0xf, false);
    v += (unsigned)__builtin_amdgcn_update_dpp(0, (int)v, 0x118, 0xf, 0xf, false);
    const unsigned s0 = __builtin_amdgcn_readlane(v, 15), s1 = __builtin_amdgcn_readlane(v, 31), s2 = __builtin_amdgcn_readlane(v, 47);
    return v + (lane >= 16 ? s0 : 0u) + (lane >= 32 ? s1 : 0u) + (lane >= 48 ? s2 : 0u);
}
__device__ __forceinline__ float sigmoidf_(float v) { return 1.f / (1.f + __expf(-v)); }

namespace pg8 {
#define PG8_LAS __attribute__((address_space(3)))
typedef unsigned short bf16_t;
typedef short bf16x8 __attribute__((ext_vector_type(8)));
typedef float f32x4 __attribute__((ext_vector_type(4)));
typedef unsigned u32x4 __attribute__((ext_vector_type(4)));
constexpr int BM = 256, BK = 64, HALF = 128, HTB = HALF * BK * 2  , STAGE_BYTES = 8 * HTB;

__host__ __device__ __forceinline__ int lds_byte(int r, int c) { const int st = (r >> 4) * 2 + (c >> 5), rr = r & 15, cc = c & 31, ob = rr * 64 + cc * 2; return st * 1024 + (ob ^ (((ob >> 9) & 1) << 5)); }
__host__ __device__ __forceinline__ void stage_rc(int b, int& R, int& C) { const int st = b / 1024, sb = b % 1024, swz = sb ^ (((sb >> 9) & 1) << 5); R = (st >> 1) * 16 + swz / 64; C = (st & 1) * 32 + (swz % 64) / 2; }
__host__ __device__ __forceinline__ int perm32(int rho) { const int n = rho >> 4, i = rho & 15; return 8 * (i >> 2) + 4 * n + (i & 3); }

struct Unit { int pm, pn; };
struct Gemm { const bf16_t* A; const bf16_t* Bt; int K, lda; const int* gidx; };


__device__ __forceinline__ void tile_of(int L, int nM, int nN, int& pm, int& pn) {
    const int nig = 8 * nN, gid = L / nig, fm = gid * 8, gsz = (nM - fm) < 8 ? (nM - fm) : 8, r = L % nig;
    pm = fm + r % gsz; pn = r / gsz;
}
struct RowOrder {
    int nM, nN, nwg, G, c; bool skip;
    __device__ __forceinline__ void init(int nN_, int G_, int c_, bool skip_ctx) { skip = skip_ctx; nM = skip_ctx ? 64 : 66; nN = nN_; nwg = nM * nN; G = G_; c = c_; }
    __device__ __forceinline__ bool next(int i, Unit& u) const {
        const int L = i * G + c; if (L >= nwg) return false;
        int pm, pn; tile_of(L, nM, nN, pm, pn);
        u.pm = skip ? pm + 1 + (pm >> 5) : pm; u.pn = pn; return true;
    }
    __device__ __forceinline__ void a_ready(const Unit&) const {}
    __device__ __forceinline__ void done(const Unit&) const {}
};
struct MoeOrder {
    int nMe, nNe, per, cpg, grp, j, epg;
    __device__ __forceinline__ void init(int nMe_, int nNe_, int G, int vcu) {
        nMe = nMe_; nNe = nNe_; per = nMe * nNe; const int ngrp = (G % 8 == 0) ? 8 : 1; cpg = G / ngrp; grp = vcu / cpg; j = vcu % cpg; epg = 16 / ngrp;
    }
    __device__ __forceinline__ bool next(int i, Unit& u) const {
        const int q = i * cpg + j; if (q >= epg * per) return false;
        const int e = grp * epg + q / per, r = q % per; u.pm = e * 9 + r % nMe; u.pn = e * nNe + r / nMe; return true;
    }
    __device__ __forceinline__ void a_ready(const Unit&) const {}
    __device__ __forceinline__ void done(const Unit&) const {}
};

struct EpiStore {
    static constexpr bool PERM = true, AFTER_DRAIN = false;
    bf16_t* O; int ldc; int nNloc;
    __device__ __forceinline__ void operator()(const f32x4 (&acc)[2][2][4][2], const Unit& u, int wr, int wc, int fr, int fq) const {
        const int row0 = u.pm * BM + wr * 64 + fr, col0 = (u.pn % nNloc) * BM + wc * 32 + 8 * fq;
#pragma unroll
        for (int ai = 0; ai < 2; ++ai)
#pragma unroll
            for (int m = 0; m < 4; ++m) { bf16_t* rowp = O + (size_t)(row0 + ai * HALF + m * 16) * ldc + col0;
#pragma unroll
                for (int bj = 0; bj < 2; ++bj) { const f32x4 v0 = acc[ai][bj][m][0], v1 = acc[ai][bj][m][1];
                    u32x4 w; w.x = pk2(v0[0], v0[1]); w.y = pk2(v0[2], v0[3]); w.z = pk2(v1[0], v1[1]); w.w = pk2(v1[2], v1[3]);
                    *(u32x4*)(rowp + bj * HALF) = w; } }
    }
};
struct EpiQ {
    static constexpr bool PERM = true, AFTER_DRAIN = false;
    bf16_t* O; const float* cosM; const float* sinM;
    __device__ __forceinline__ void operator()(const f32x4 (&acc)[2][2][4][2], const Unit& u, int wr, int wc, int fr, int fq) const {
        const int row0 = u.pm * BM + wr * 64 + fr, col0 = u.pn * BM + wc * 32 + 8 * fq;
        const int pb = u.pm % PPB; const bool lat = pb != 0; const int t0 = (pb - 1) * 256 + wr * 64 + fr;
#pragma unroll
        for (int ai = 0; ai < 2; ++ai)
#pragma unroll
            for (int m = 0; m < 4; ++m) { bf16_t* rowp = O + (size_t)(row0 + ai * HALF + m * 16) * QW + col0; const int t = t0 + ai * HALF + m * 16;
#pragma unroll
                for (int bj = 0; bj < 2; ++bj) { f32x4 v0 = acc[ai][bj][m][0], v1 = acc[ai][bj][m][1];
                    const int g32 = u.pn * 8 + bj * 4 + wc;
                    if (lat && (g32 % 3) == 2) {
                        const f32x4 c = *(const f32x4*)(cosM + (size_t)t * 16 + 4 * fq), s = *(const f32x4*)(sinM + (size_t)t * 16 + 4 * fq);
                        const f32x4 a0 = v0, a1 = v1;
                        v0[0] = a0[0] * c[0] - a0[1] * s[0]; v0[1] = a0[1] * c[0] + a0[0] * s[0]; v0[2] = a0[2] * c[1] - a0[3] * s[1]; v0[3] = a0[3] * c[1] + a0[2] * s[1];
                        v1[0] = a1[0] * c[2] - a1[1] * s[2]; v1[1] = a1[1] * c[2] + a1[0] * s[2]; v1[2] = a1[2] * c[3] - a1[3] * s[3]; v1[3] = a1[3] * c[3] + a1[2] * s[3];
                    }
                    u32x4 w; w.x = pk2(v0[0], v0[1]); w.y = pk2(v0[2], v0[3]); w.z = pk2(v1[0], v1[1]); w.w = pk2(v1[2], v1[3]);
                    *(u32x4*)(rowp + bj * HALF) = w; } }
    }
};
struct EpiRes {
    static constexpr bool PERM = true, AFTER_DRAIN = false;
    const float* xin; const float* cin; float* xres; const float* gate; int layer;
    __device__ __forceinline__ void operator()(const f32x4 (&acc)[2][2][4][2], const Unit& u, int wr, int wc, int fr, int fq) const {
        const int b = u.pm / PPB, pb = u.pm % PPB, mv = pb == 0 ? 2 : b;
        const int col0 = u.pn * BM + wc * 32 + 8 * fq; const float* gp = gate + mv * 6144 + col0;
        f32x4 gv[2][2];
#pragma unroll
        for (int bj = 0; bj < 2; ++bj)
#pragma unroll
            for (int n = 0; n < 2; ++n) gv[bj][n] = *(const f32x4*)(gp + bj * HALF + 4 * n);
#pragma unroll
        for (int ai = 0; ai < 2; ++ai)
#pragma unroll
            for (int m = 0; m < 4; ++m) { const int rl = ai * HALF + wr * 64 + m * 16 + fr; const size_t R = (size_t)u.pm * BM + rl;
                const float* sp = layer ? xres + R * DM : (pb == 0 ? cin + ((size_t)b * CTX + rl) * DM : xin + ((size_t)b * SEQ + (pb - 1) * 256 + rl) * DM);
                float* op = xres + R * DM + col0; sp += col0;
#pragma unroll
                for (int bj = 0; bj < 2; ++bj)
#pragma unroll
                    for (int n = 0; n < 2; ++n) { const f32x4 x0 = *(const f32x4*)(sp + bj * HALF + 4 * n); *(f32x4*)(op + bj * HALF + 4 * n) = x0 + gv[bj][n] * acc[ai][bj][m][n]; } }
    }
};
struct EpiSwiglu {
    static constexpr bool PERM = true, AFTER_DRAIN = false;
    bf16_t* H;
    __device__ __forceinline__ void operator()(const f32x4 (&acc)[2][2][4][2], const Unit& u, int wr, int wc, int fr, int fq) const {
        const int row0 = u.pm * BM + wr * 64 + fr, col0 = (u.pn % 21) * HALF + wc * 32 + 8 * fq;
#pragma unroll
        for (int ai = 0; ai < 2; ++ai)
#pragma unroll
            for (int m = 0; m < 4; ++m) { bf16_t* rowp = H + (size_t)(row0 + ai * HALF + m * 16) * FF + col0;
                float h[8];
#pragma unroll
                for (int n = 0; n < 2; ++n)
#pragma unroll
                    for (int i = 0; i < 4; ++i) { const float a = acc[ai][0][m][n][i], b = acc[ai][1][m][n][i]; h[n * 4 + i] = a * __builtin_amdgcn_rcpf(1.f + __builtin_amdgcn_exp2f(-a * LOG2E)) * b; }
                u32x4 w; w.x = pk2(h[0], h[1]); w.y = pk2(h[2], h[3]); w.z = pk2(h[4], h[5]); w.w = pk2(h[6], h[7]);
                *(u32x4*)rowp = w; }
    }
};

template <class Epi, class Sched, bool ALIGN_EPI = false, bool SP2 = false, bool GATHER = false>
__device__ __forceinline__ void gemm_phase(PG8_LAS unsigned char* lds, const Gemm g, const Sched& S, const Epi& E, const int tid_in) {
    int tid_ = tid_in; asm volatile("" : "+v"(tid_));
    const int tid = tid_, wid = __builtin_amdgcn_readfirstlane(tid >> 6), lane = tid & 63, wr = wid >> 2, wc = wid & 3, fr = lane & 15, fq = lane >> 4;
    int K_ = g.K; asm volatile("" : "+s"(K_));
    const int K = K_, nt = K / BK;
    unsigned voffA[2], voffB[2]; int gR[2]; unsigned gC[2];
#pragma unroll
    for (int i = 0; i < 2; ++i) { int R, C; stage_rc(tid * 16 + i * 8192, R, C); const int Rb = Epi::PERM ? ((R & ~31) + perm32(R & 31)) : R;
        voffA[i] = (unsigned)(R * g.lda + C) * 2u; voffB[i] = (unsigned)(Rb * K + C) * 2u; gR[i] = R; gC[i] = (unsigned)C * 2u; }
    unsigned vC[2][2], vN[2][2];
#define PG8_GIDX(dst, U) do { _Pragma("unroll") for (int h_ = 0; h_ < 2; ++h_) _Pragma("unroll") for (int i_ = 0; i_ < 2; ++i_) \
        dst[h_][i_] = (unsigned)g.gidx[(U).pm * BM + h_ * HALF + gR[i_]] * (unsigned)(g.lda * 2) + gC[i_]; } while (0)
#define PG8_STGA(bufoff, kptr, h, USEN) do { if constexpr (GATHER) { const unsigned vsel_[2] = {(USEN) ? vN[h][0] : vC[h][0], (USEN) ? vN[h][1] : vC[h][1]}; PG8_STAGE(bufoff, kptr, vsel_); } \
        else { PG8_STAGE(bufoff, (kptr) + (h) * hstepA, voffA); } } while (0)
    const size_t kstep = (size_t)(BK * 2);
    const size_t hstepA = (size_t)HALF * g.lda * 2, hstepB = (size_t)HALF * K * 2;
    const size_t tstepA = 2 * hstepA, tstepB = 2 * hstepB;
    const unsigned ldsw = (unsigned)wid * 1024u;
    const int aoff = lds_byte(wr * 64 + fr, fq * 8), boff = lds_byte(wc * 32 + fr, fq * 8);
#define PG8_SA(b, h) (((b) * 2 + (h)) * HTB)
#define PG8_SB(b, h) ((4 + (b) * 2 + (h)) * HTB)
#define PG8_STAGE(bufoff, gbase, voff) do { _Pragma("unroll") for (int _i = 0; _i < 2; ++_i) \
        __builtin_amdgcn_global_load_lds((const unsigned*)((const char*)(gbase) + (voff)[_i]), (PG8_LAS unsigned*)(lds + (bufoff) + ldsw + _i * 8192), 16, 0, 0); } while (0)
#define PG8_LDA(dst, b, h) do { _Pragma("unroll") for (int m = 0; m < 4; ++m) _Pragma("unroll") for (int k = 0; k < 2; ++k) dst[m][k] = *(const PG8_LAS bf16x8*)(lds + PG8_SA(b, h) + aoff + m * 2048 + k * 1024); } while (0)
#define PG8_LDB(dst, b, h) do { _Pragma("unroll") for (int n = 0; n < 2; ++n) _Pragma("unroll") for (int k = 0; k < 2; ++k) dst[n][k] = *(const PG8_LAS bf16x8*)(lds + PG8_SB(b, h) + boff + n * 2048 + k * 1024); } while (0)
#define PG8_MMA(ai, bj, At, Bt) do { __builtin_amdgcn_s_setprio(1); _Pragma("unroll") for (int m = 0; m < 4; ++m) _Pragma("unroll") for (int n = 0; n < 2; ++n) _Pragma("unroll") for (int k = 0; k < 2; ++k) \
        acc[ai][bj][m][n] = __builtin_amdgcn_mfma_f32_16x16x32_bf16(Bt[n][k], At[m][k], acc[ai][bj][m][n], 0, 0, 0); __builtin_amdgcn_s_setprio(0); } while (0)
#define PG8_WAIT_V(n) asm volatile("s_waitcnt vmcnt(" #n ")" ::: "memory")
#define PG8_WAIT_L(n) asm volatile("s_waitcnt lgkmcnt(" #n ")" ::: "memory")
#define PG8_BAR __builtin_amdgcn_s_barrier()
#define PG8_SCHED __builtin_amdgcn_sched_barrier(0)
    Unit cur, nxt; int ui = 0;
    if (!S.next(0, cur)) return;
    f32x4 acc[2][2][4][2];
#pragma unroll
    for (int a = 0; a < 2; ++a)
#pragma unroll
        for (int b = 0; b < 2; ++b)
#pragma unroll
            for (int m = 0; m < 4; ++m)
#pragma unroll
                for (int n = 0; n < 2; ++n) acc[a][b][m][n] = (f32x4){0.f, 0.f, 0.f, 0.f};
    bf16x8 At[4][2], B0[2][2], B1[2][2];
    const char* cA = (const char*)g.A + (GATHER ? (size_t)0 : (size_t)cur.pm * tstepA); const char* cB = (const char*)g.Bt + (size_t)cur.pn * tstepB;
    if constexpr (GATHER) { PG8_GIDX(vC, cur); }
    S.a_ready(cur);
    if constexpr (SP2) {
        PG8_STAGE(PG8_SB(0, 0), cB, voffB); PG8_STAGE(PG8_SB(0, 1), cB + hstepB, voffB); PG8_STGA(PG8_SA(0, 0), cA, 0, false); PG8_STGA(PG8_SA(0, 1), cA, 1, false);
        if (wr == 1) PG8_BAR;
        PG8_WAIT_V(2); PG8_BAR;
        PG8_STAGE(PG8_SB(1, 0), cB + kstep, voffB); PG8_STGA(PG8_SA(1, 0), cA + kstep, 0, false); PG8_STAGE(PG8_SB(1, 1), cB + hstepB + kstep, voffB);
        PG8_WAIT_V(6); PG8_BAR;
    } else {
        PG8_STAGE(PG8_SB(0, 0), cB, voffB); PG8_STAGE(PG8_SA(0, 0), cA, voffA); PG8_STAGE(PG8_SB(0, 1), cB + hstepB, voffB); PG8_STAGE(PG8_SA(0, 1), cA + hstepA, voffA);
        if (wr == 1) PG8_BAR;
        PG8_WAIT_V(4); PG8_BAR;
        PG8_STAGE(PG8_SB(1, 0), cB + kstep, voffB); PG8_STAGE(PG8_SA(1, 0), cA + kstep, voffA); PG8_STAGE(PG8_SB(1, 1), cB + hstepB + kstep, voffB);
        PG8_WAIT_V(6); PG8_BAR;
    }
    for (;;) {
        const bool has_next = S.next(ui + 1, nxt);
        const char* nA = (has_next && !GATHER) ? (const char*)g.A + (size_t)nxt.pm * tstepA : cA;
        if constexpr (GATHER) { if (has_next) { PG8_GIDX(vN, nxt); } else { _Pragma("unroll") for (int h_ = 0; h_ < 2; ++h_) { vN[h_][0] = vC[h_][0]; vN[h_][1] = vC[h_][1]; } } } const char* nB = has_next ? (const char*)g.Bt + (size_t)nxt.pn * tstepB : cB;
        for (int t = 0; t < nt; t += 2) {
            const bool last = (t == nt - 2);
            const char* a1 = cA + (size_t)(t + 1) * kstep;
            const char* a2 = last ? nA : cA + (size_t)(t + 2) * kstep; const char* b2 = last ? nB : cB + (size_t)(t + 2) * kstep;
            const char* a3 = a2 + kstep; const char* b3 = b2 + kstep;
            if (last && has_next) S.a_ready(nxt);
            if constexpr (SP2) {
            PG8_LDB(B0, 0, 0); PG8_LDB(B1, 0, 1); PG8_SCHED; PG8_LDA(At, 0, 0); PG8_STGA(PG8_SA(1, 1), a1, 1, false);
            PG8_WAIT_V(8); PG8_WAIT_L(0); PG8_BAR; PG8_MMA(0, 0, At, B0); PG8_MMA(0, 1, At, B1); PG8_BAR; PG8_SCHED;
            PG8_LDA(At, 0, 1); PG8_STAGE(PG8_SB(0, 0), b2, voffB); PG8_STAGE(PG8_SB(0, 1), b2 + hstepB, voffB); PG8_STGA(PG8_SA(0, 0), a2, 0, last);
            PG8_WAIT_V(8); PG8_WAIT_L(0); PG8_BAR; PG8_MMA(1, 0, At, B0); PG8_MMA(1, 1, At, B1); PG8_BAR; PG8_SCHED;
            PG8_LDB(B0, 1, 0); PG8_LDB(B1, 1, 1); PG8_SCHED; PG8_LDA(At, 1, 0); PG8_STGA(PG8_SA(0, 1), a2, 1, last);
            PG8_WAIT_V(8); PG8_WAIT_L(0); PG8_BAR; PG8_MMA(0, 0, At, B0); PG8_MMA(0, 1, At, B1); PG8_BAR; PG8_SCHED;
            PG8_LDA(At, 1, 1); PG8_STAGE(PG8_SB(1, 0), b3, voffB); PG8_STAGE(PG8_SB(1, 1), b3 + hstepB, voffB); PG8_STGA(PG8_SA(1, 0), a3, 0, last);
            PG8_WAIT_V(8); PG8_WAIT_L(0); PG8_BAR; PG8_MMA(1, 0, At, B0); PG8_MMA(1, 1, At, B1); PG8_BAR; PG8_SCHED;
            } else {
            PG8_LDB(B0, 0, 0); PG8_SCHED; PG8_LDA(At, 0, 0); PG8_STAGE(PG8_SA(1, 1), a1 + hstepA, voffA);
            PG8_WAIT_L(8); PG8_BAR; PG8_WAIT_L(0); PG8_MMA(0, 0, At, B0); PG8_BAR; PG8_SCHED;
            PG8_LDB(B1, 0, 1); PG8_STAGE(PG8_SB(0, 0), b2, voffB);
            PG8_BAR; PG8_WAIT_L(0); PG8_MMA(0, 1, At, B1); PG8_BAR;
            PG8_LDA(At, 0, 1); PG8_STAGE(PG8_SA(0, 0), a2, voffA);
            PG8_BAR; PG8_WAIT_L(0); PG8_MMA(1, 0, At, B0); PG8_BAR; PG8_SCHED;
            PG8_STAGE(PG8_SB(0, 1), b2 + hstepB, voffB);
            PG8_WAIT_V(6); PG8_BAR; PG8_MMA(1, 1, At, B1); PG8_BAR;
            PG8_LDB(B0, 1, 0); PG8_SCHED; PG8_LDA(At, 1, 0); PG8_STAGE(PG8_SA(0, 1), a2 + hstepA, voffA);
            PG8_WAIT_L(8); PG8_BAR; PG8_WAIT_L(0); PG8_MMA(0, 0, At, B0); PG8_BAR; PG8_SCHED;
            PG8_LDB(B1, 1, 1); PG8_STAGE(PG8_SB(1, 0), b3, voffB);
            PG8_BAR; PG8_WAIT_L(0); PG8_MMA(0, 1, At, B1); PG8_BAR;
            PG8_LDA(At, 1, 1); PG8_STAGE(PG8_SA(1, 0), a3, voffA);
            PG8_BAR; PG8_WAIT_L(0); PG8_MMA(1, 0, At, B0); PG8_BAR; PG8_SCHED;
            PG8_STAGE(PG8_SB(1, 1), b3 + hstepB, voffB);
            PG8_WAIT_V(6); PG8_BAR; PG8_MMA(1, 1, At, B1); PG8_BAR;
            }
        }
        if constexpr (ALIGN_EPI) { if (wr == 0) PG8_BAR; }
        if constexpr (!Epi::AFTER_DRAIN) { E(acc, cur, wr, wc, fr, fq); S.done(cur); }
        if (!has_next) break;
#pragma unroll
        for (int a = 0; a < 2; ++a)
#pragma unroll
            for (int b = 0; b < 2; ++b)
#pragma unroll
                for (int m = 0; m < 4; ++m)
#pragma unroll
                    for (int n = 0; n < 2; ++n) acc[a][b][m][n] = (f32x4){0.f, 0.f, 0.f, 0.f};
        cur = nxt; cA = nA; cB = nB; ++ui;
        if constexpr (GATHER) { _Pragma("unroll") for (int h_ = 0; h_ < 2; ++h_) { vC[h_][0] = vN[h_][0]; vC[h_][1] = vN[h_][1]; } }
        if constexpr (ALIGN_EPI) { if (wr == 1) PG8_BAR; }
    }
    PG8_WAIT_V(0);
    if constexpr (!ALIGN_EPI) { if (wr == 0) PG8_BAR; }
    PG8_BAR;
    if constexpr (Epi::AFTER_DRAIN) { E.fused(acc, cur, wr, wc, fr, fq, lds, wid, lane); S.done(cur); }
#undef PG8_SA
#undef PG8_SB
#undef PG8_STAGE
#undef PG8_STGA
#undef PG8_GIDX
#undef PG8_LDA
#undef PG8_LDB
#undef PG8_MMA
#undef PG8_WAIT_V
#undef PG8_WAIT_L
#undef PG8_BAR
#undef PG8_SCHED
}
}

namespace att {
#define SBAR() __builtin_amdgcn_sched_barrier(0)
__device__ __forceinline__ int crow(int r, int hi) { return (r & 3) + 8 * (r >> 2) + 4 * hi; }
__device__ __forceinline__ unsigned cvtpk(float lo, float hi) { unsigned r; asm volatile("v_cvt_pk_bf16_f32 %0, %1, %2" : "=v"(r) : "v"(lo), "v"(hi)); return r; }

__device__ __forceinline__ void partialSM(f32x16& p0, f32x16& p1, float& mhat, f32x16& negm, float& alpha, const bool first, const float thr) {
  float pmax = p0[0];
#pragma unroll
  for (int r = 1; r < 16; ++r) pmax = fmaxf(pmax, p0[r]);
#pragma unroll
  for (int r = 0; r < 16; ++r) pmax = fmaxf(pmax, p1[r]);
  { auto rr = __builtin_amdgcn_permlane32_swap(__float_as_uint(pmax), __float_as_uint(pmax), false, false);
    pmax = fmaxf(__uint_as_float(rr[0]), __uint_as_float(rr[1])); }
  alpha = 1.f;
  if (__builtin_expect(first || __any(pmax > thr), 0)) {
    const float dl = first ? pmax : fmaxf(pmax, 0.f); mhat += dl;
#pragma unroll
    for (int r = 0; r < 16; ++r) { p0[r] -= dl; p1[r] -= dl; }
#pragma unroll
    for (int r = 0; r < 16; ++r) negm[r] = -mhat;
    asm volatile("" : "+v"(negm));
    alpha = first ? 1.f : __builtin_amdgcn_exp2f(-dl);
  }
#pragma unroll
  for (int r = 0; r < 16; ++r) p0[r] = __builtin_amdgcn_exp2f(p0[r]);
}
__device__ __forceinline__ void finishSM(f32x16& p0, f32x16& p1, float alpha, float& l_reg, bf16x8& pa0, bf16x8& pa1, bf16x8& pa2, bf16x8& pa3) {
#pragma unroll
  for (int r = 0; r < 16; ++r) p1[r] = __builtin_amdgcn_exp2f(p1[r]);
  float ps = 0;
#pragma unroll
  for (int r = 0; r < 16; ++r) ps += p0[r];
#pragma unroll
  for (int r = 0; r < 16; ++r) ps += p1[r];
  { auto rr = __builtin_amdgcn_permlane32_swap(__float_as_uint(ps), __float_as_uint(ps), false, false);
    ps = __uint_as_float(rr[0]) + __uint_as_float(rr[1]); }
  l_reg = l_reg * alpha + ps;
#define PK4(P, BASE, OUT) do { unsigned a0 = cvtpk(P[BASE + 0], P[BASE + 1]), a1 = cvtpk(P[BASE + 2], P[BASE + 3]);   \
    unsigned b0 = cvtpk(P[BASE + 4], P[BASE + 5]), b1 = cvtpk(P[BASE + 6], P[BASE + 7]);                              \
    auto r0 = __builtin_amdgcn_permlane32_swap(a0, b0, false, false); auto r1 = __builtin_amdgcn_permlane32_swap(a1, b1, false, false); \
    v4u w = {r0[0], r1[0], r0[1], r1[1]}; OUT = __builtin_bit_cast(bf16x8, w); } while (0)
  PK4(p0, 0, pa0); PK4(p0, 8, pa1); PK4(p1, 0, pa2); PK4(p1, 8, pa3);
#undef PK4
}
template <int ND, int KS>
__device__ __forceinline__ void qkt(f32x16& p0, f32x16& p1, const char* Ks, const bf16x8* qr, const f32x16& negm, int r32, int hi) {
#pragma unroll
  for (int d0 = 0; d0 < ND; ++d0) { const int cb = (d0 * 16 + hi * 8) * 2;
    const bf16x8 b0 = *reinterpret_cast<const bf16x8*>(Ks + r32 * KS + cb);
    const bf16x8 b1 = *reinterpret_cast<const bf16x8*>(Ks + (32 + r32) * KS + cb);
    p0 = __builtin_amdgcn_mfma_f32_32x32x16_bf16(b0, qr[d0], d0 == 0 ? negm : p0, 0, 0, 0);
    p1 = __builtin_amdgcn_mfma_f32_32x32x16_bf16(b1, qr[d0], d0 == 0 ? negm : p1, 0, 0, 0); }
}
__device__ __forceinline__ int v_st(int k, int c) { const int kk = (k & ~0xC) | ((k & 4) << 1) | ((k & 8) >> 1); return ((kk >> 3) * 2 + (c >> 5)) * 512 + ((kk & 7) * 32 + (c & 31)) * 2; }
__device__ __forceinline__ int v_rd_base(int lane) { return ((lane & 3) << 3) | (((lane >> 2) & 3) << 6) | (((lane >> 4) & 1) << 5) | (((lane >> 5) & 1) << 8); }
constexpr int v_rd_off(int d0, int ks, int half) { return ((2 * ks + half) * 2 + d0) * 512; }
template <int OFF> __device__ __forceinline__ s16x4 tr_read(int vb) {
  s16x4 r; asm volatile("ds_read_b64_tr_b16 %0, %1 offset:%2" : "=&v"(r) : "v"(vb), "i"(OFF) : "memory"); return r;
}
template <int D0> __device__ __forceinline__ void pv_one(f32x16& od, int vb, bf16x8 pa0, bf16x8 pa1, bf16x8 pa2, bf16x8 pa3) {
  const s16x4 l0 = tr_read<v_rd_off(D0, 0, 0)>(vb), h0 = tr_read<v_rd_off(D0, 0, 1)>(vb), l1 = tr_read<v_rd_off(D0, 1, 0)>(vb), h1 = tr_read<v_rd_off(D0, 1, 1)>(vb);
  const s16x4 l2 = tr_read<v_rd_off(D0, 2, 0)>(vb), h2 = tr_read<v_rd_off(D0, 2, 1)>(vb), l3 = tr_read<v_rd_off(D0, 3, 0)>(vb), h3 = tr_read<v_rd_off(D0, 3, 1)>(vb);
  asm volatile("s_waitcnt lgkmcnt(0)" ::: "memory"); SBAR();
#define PK(L, H) (bf16x8){L[0], L[1], L[2], L[3], H[0], H[1], H[2], H[3]}
  od = __builtin_amdgcn_mfma_f32_32x32x16_bf16(pa0, PK(l0, h0), od, 0, 0, 0);
  od = __builtin_amdgcn_mfma_f32_32x32x16_bf16(pa1, PK(l1, h1), od, 0, 0, 0);
  od = __builtin_amdgcn_mfma_f32_32x32x16_bf16(pa2, PK(l2, h2), od, 0, 0, 0);
  od = __builtin_amdgcn_mfma_f32_32x32x16_bf16(pa3, PK(l3, h3), od, 0, 0, 0);
#undef PK
}
__device__ __forceinline__ void pv_d0(f32x16* o, int vb, bf16x8 pa0, bf16x8 pa1, bf16x8 pa2, bf16x8 pa3) {
  pv_one<0>(o[0], vb, pa0, pa1, pa2, pa3); pv_one<1>(o[1], vb, pa0, pa1, pa2, pa3);
}

template <int DK, int LDQ, int LDK1, int LDK2, int LDV>
__device__ __forceinline__ void attn_unit(const bf16* __restrict__ Qb, const bf16* __restrict__ K1, const bf16* __restrict__ K2, const bf16* __restrict__ Vb,
                                          bf16* __restrict__ Ob, const float* ropeq, const int nkeys, char* lds, const int tid_in) {
  constexpr int ND = DK / 16, KS = DK * 2 + 16, SHM_K = 64 * KS, SHM_V = 8192;
  int tid_ = tid_in; asm volatile("" : "+v"(tid_));
  const int tid = tid_, wid = tid >> 6, lane = tid & 63, r32 = lane & 31, hi = lane >> 5;
  char* V_lds = lds; char* K_lds = lds + 2 * SHM_V;
  float* ws = (float*)(lds + 2 * SHM_V + 2 * SHM_K) + wid * 64; float* li_l = ws; float* al_l = ws + 32;
  constexpr float THR = 8.f;
  float mhat = 0.f, l_reg = 0; f32x16 o[2] = {}; bf16x8 qr[ND]; f32x16 negm = {}; asm volatile("" : "+v"(negm));
  const bf16* Qw = Qb + (long)(wid * 32 + r32) * LDQ + hi * 8;
#pragma unroll
  for (int d0 = 0; d0 < ND; ++d0) qr[d0] = *reinterpret_cast<const bf16x8*>(Qw + d0 * 16);
  if (DK == 96 && ropeq != nullptr) {
    const float* cr = ropeq + (size_t)(wid * 32 + r32) * 16 + 4 * hi;
#pragma unroll
    for (int d0 = 4; d0 < ND; ++d0) { const f32x4 c = *(const f32x4*)(cr + (d0 - 4) * 8), s = *(const f32x4*)(cr + 8192 * 16 + (d0 - 4) * 8);
      const v4u w = __builtin_bit_cast(v4u, qr[d0]); v4u o;
      { const float a = bflo(w.x), b = bfhi(w.x); o.x = cvtpk(a * c.x - b * s.x, b * c.x + a * s.x); }
      { const float a = bflo(w.y), b = bfhi(w.y); o.y = cvtpk(a * c.y - b * s.y, b * c.y + a * s.y); }
      { const float a = bflo(w.z), b = bfhi(w.z); o.z = cvtpk(a * c.z - b * s.z, b * c.z + a * s.z); }
      { const float a = bflo(w.w), b = bfhi(w.w); o.w = cvtpk(a * c.w - b * s.w, b * c.w + a * s.w); }
      qr[d0] = __builtin_bit_cast(bf16x8, o); }
  }
  const int sr = tid >> 3, sc = (tid & 7) * 8, vst = v_st(sr, sc), kst = sr * KS + sc * 2;
  const int sr2 = tid >> 2, sc2 = (tid & 3) * 8, kst2 = sr2 * KS + 128 + sc2 * 2;
  const bool has2 = (DK == 96) && (tid < 256);
  const int vb0 = (int)(uintptr_t)V_lds + v_rd_base(lane);
  struct { bf16x8 v, k1, k2; } sr_[2];
#define SLOAD(i, k0) do { sr_[i].v = *reinterpret_cast<const bf16x8*>(&Vb[(long)((k0) + sr) * LDV + sc]); sr_[i].k1 = *reinterpret_cast<const bf16x8*>(&K1[(long)((k0) + sr) * LDK1 + sc]); \
    if (has2) sr_[i].k2 = *reinterpret_cast<const bf16x8*>(&K2[(long)((k0) + sr2) * LDK2 + sc2]); } while (0)
#define SWRITE(b, i) do { *(bf16x8*)(V_lds + (b) * SHM_V + vst) = sr_[i].v; *(bf16x8*)(K_lds + (b) * SHM_K + kst) = sr_[i].k1; \
    if (has2) *(bf16x8*)(K_lds + (b) * SHM_K + kst2) = sr_[i].k2; } while (0)
#define RESC(a) do { if (__any((a) < 1.f)) { if (hi == 0) al_l[r32] = (a); asm volatile("s_waitcnt lgkmcnt(0)" ::: "memory"); \
    _Pragma("unroll") for (int d = 0; d < 2; ++d) _Pragma("unroll") for (int r = 0; r < 16; ++r) o[d][r] *= al_l[crow(r, hi)]; } } while (0)
  f32x16 pA0, pA1, pB0, pB1; float alA, alB; bf16x8 pa0, pa1, pa2, pa3; const int NT = nkeys / 64;
  constexpr int SE = 0, SO = 1;
  SLOAD(SE, 0); asm volatile("s_waitcnt vmcnt(0)" ::: "memory"); SWRITE(0, SE); __syncthreads();
  qkt<ND, KS>(pA0, pA1, K_lds, qr, negm, r32, hi); partialSM(pA0, pA1, mhat, negm, alA, true, THR);
  SLOAD(SO, 64); if (2 < NT) SLOAD(SE, 128);
  SWRITE(1, SO); __syncthreads();
  for (int j = 1; j + 1 < NT; j += 2) {
    SBAR(); qkt<ND, KS>(pB0, pB1, K_lds + SHM_K, qr, negm, r32, hi);
    finishSM(pA0, pA1, alA, l_reg, pa0, pa1, pa2, pa3); SBAR();
    SLOAD(SO, (j + 2) * 64); SBAR();
    pv_d0(o, vb0, pa0, pa1, pa2, pa3); partialSM(pB0, pB1, mhat, negm, alB, false, THR);
    __syncthreads(); SWRITE(0, SE);
    RESC(alB); __syncthreads();
    SBAR(); qkt<ND, KS>(pA0, pA1, K_lds, qr, negm, r32, hi);
    finishSM(pB0, pB1, alB, l_reg, pa0, pa1, pa2, pa3); SBAR();
    if (j + 3 < NT) SLOAD(SE, (j + 3) * 64); SBAR();
    pv_d0(o, vb0 + SHM_V, pa0, pa1, pa2, pa3); partialSM(pA0, pA1, mhat, negm, alA, false, THR);
    __syncthreads(); SWRITE(1, SO);
    RESC(alA); __syncthreads();
  }
  SBAR(); qkt<ND, KS>(pB0, pB1, K_lds + SHM_K, qr, negm, r32, hi);
  finishSM(pA0, pA1, alA, l_reg, pa0, pa1, pa2, pa3); SBAR();
  pv_d0(o, vb0, pa0, pa1, pa2, pa3); partialSM(pB0, pB1, mhat, negm, alB, false, THR);
  __syncthreads(); RESC(alB);
  finishSM(pB0, pB1, alB, l_reg, pa0, pa1, pa2, pa3); SBAR();
  pv_d0(o, vb0 + SHM_V, pa0, pa1, pa2, pa3);
  if (hi == 0) li_l[r32] = l_reg; asm volatile("s_waitcnt lgkmcnt(0)" ::: "memory");
  float rli[16];
#pragma unroll
  for (int r = 0; r < 16; ++r) rli[r] = __builtin_amdgcn_rcpf(li_l[crow(r, hi)]);
  bf16* Ow = Ob + (long)(wid * 32) * OW;
#pragma unroll
  for (int r = 0; r < 16; ++r) { const int orow = crow(r, hi);
#pragma unroll
    for (int d0 = 0; d0 < 2; ++d0) Ow[(long)orow * OW + d0 * 32 + r32] = (bf16)f2bf(o[d0][r] * rli[r]); }
  __syncthreads();
#undef SLOAD
#undef SWRITE
#undef RESC
}
#undef SBAR
}

namespace att2 {
using u32x4 = v4u;
typedef __attribute__((address_space(3))) const char* lds_cptr;
typedef short v4i16_t __attribute__((ext_vector_type(4)));
typedef float f32x2_t __attribute__((ext_vector_type(2))); typedef __bf16 bf16x2_t __attribute__((ext_vector_type(2)));
#define SBAR() __builtin_amdgcn_sched_barrier(0)
__device__ __forceinline__ int crow(int r, int hi) { return (r & 3) + 8 * (r >> 2) + 4 * hi; }
__device__ __forceinline__ void glds16(const void* gbase, unsigned voff, unsigned lds_dst) { unsigned keep;
  asm volatile("s_mov_b32 %0, m0\n\ts_mov_b32 m0, %3\n\ts_nop 0\n\tglobal_load_lds_dwordx4 %1, %2\n\ts_mov_b32 m0, %0" : "=&s"(keep) : "v"(voff), "s"(gbase), "s"(lds_dst) : "memory"); }
__device__ __forceinline__ float max3f(float a, float b, float c) { float r; asm("v_max3_f32 %0, %1, %2, %3" : "=v"(r) : "v"(a), "v"(b), "v"(c)); return r; }
__device__ __forceinline__ float max2f(float a, float b) { float r; asm("v_max_f32_e32 %0, %1, %2" : "=v"(r) : "v"(a), "v"(b)); return r; }
__device__ __forceinline__ float fadd_s(float a, float b) { float r; asm("v_add_f32_e32 %0, %1, %2" : "=v"(r) : "v"(a), "v"(b)); return r; }
__device__ __forceinline__ float fsub_s(float a, float b) { float r; asm("v_sub_f32_e32 %0, %1, %2" : "=v"(r) : "v"(a), "v"(b)); return r; }
__device__ __forceinline__ unsigned cvtpk_s(float lo, float hi) { f32x2_t v = {lo, hi}; bf16x2_t b = __builtin_convertvector(v, bf16x2_t); return __builtin_bit_cast(unsigned, b); }
template <int N> __device__ __forceinline__ void wait_bar() { asm volatile("s_waitcnt vmcnt(%0) lgkmcnt(0)\n\ts_barrier" :: "n"(N) : "memory"); }
template <int ND> __device__ __forceinline__ void qkt(f32x16& p0, f32x16& p1, const char* Kslot, const bf16x8* qr, const f32x16& negm, int r32, int hi) {
  const char* kb = Kslot + hi * 1024 + r32 * 16;
#pragma unroll
  for (int d0 = 0; d0 < ND; ++d0) {
    const bf16x8 b0 = *reinterpret_cast<const bf16x8*>(kb + d0 * 2048);
    const bf16x8 b1 = *reinterpret_cast<const bf16x8*>(kb + d0 * 2048 + 512);
    if (d0 == 0) { p0 = __builtin_amdgcn_mfma_f32_32x32x16_bf16(b0, qr[0], negm, 0, 0, 0); p1 = __builtin_amdgcn_mfma_f32_32x32x16_bf16(b1, qr[0], negm, 0, 0, 0); }
    else { p0 = __builtin_amdgcn_mfma_f32_32x32x16_bf16(b0, qr[d0], p0, 0, 0, 0); p1 = __builtin_amdgcn_mfma_f32_32x32x16_bf16(b1, qr[d0], p1, 0, 0, 0); } }
}
__device__ __forceinline__ void kload2(bf16x8* kf, lds_cptr kp, int j) { kf[2 * j] = *(const LAS bf16x8*)(kp + j * 2048); kf[2 * j + 1] = *(const LAS bf16x8*)(kp + j * 2048 + 512); }
__device__ __forceinline__ s16x4 vtr(lds_cptr p) { return __builtin_bit_cast(s16x4, __builtin_amdgcn_ds_read_tr16_b64_v4i16((LAS v4i16_t*)p)); }
__device__ __forceinline__ float rowmax(const f32x16& p0, const f32x16& p1) {
  float a = max3f(p0[0], p0[1], p1[0]), b = max3f(p0[2], p0[3], p1[1]); a = max3f(a, p1[2], p1[3]);
#pragma unroll
  for (int r = 4; r < 16; r += 4) { a = max3f(a, p0[r], p0[r + 1]); b = max3f(b, p0[r + 2], p0[r + 3]); a = max3f(a, p1[r], p1[r + 1]); b = max3f(b, p1[r + 2], p1[r + 3]); }
  const float m = max2f(a, b);
  auto rr = __builtin_amdgcn_permlane32_swap(__float_as_uint(m), __float_as_uint(m), false, false);
  return max2f(__uint_as_float(rr[0]), __uint_as_float(rr[1]));
}
__device__ __forceinline__ void pv(f32x16* o, int vb, bf16x8 pa0, bf16x8 pa1, bf16x8 pa2, bf16x8 pa3) {
#pragma unroll
  for (int d0 = 0; d0 < 2; ++d0) { s16x4 lo[4], hi[4];
#pragma unroll
    for (int ks = 0; ks < 4; ++ks) {
      asm volatile("ds_read_b64_tr_b16 %0,%1 offset:%c2" : "=&v"(lo[ks]) : "v"(vb), "i"(d0 * 4096 + ks * 1024) : "memory");
      asm volatile("ds_read_b64_tr_b16 %0,%1 offset:%c2" : "=&v"(hi[ks]) : "v"(vb), "i"(d0 * 4096 + ks * 1024 + 512) : "memory"); }
    asm volatile("s_waitcnt lgkmcnt(0)" ::: "memory"); SBAR();
#define PK(k) (bf16x8){lo[k][0], lo[k][1], lo[k][2], lo[k][3], hi[k][0], hi[k][1], hi[k][2], hi[k][3]}
    o[d0] = __builtin_amdgcn_mfma_f32_32x32x16_bf16(pa0, PK(0), o[d0], 0, 0, 0);
    o[d0] = __builtin_amdgcn_mfma_f32_32x32x16_bf16(pa1, PK(1), o[d0], 0, 0, 0);
    o[d0] = __builtin_amdgcn_mfma_f32_32x32x16_bf16(pa2, PK(2), o[d0], 0, 0, 0);
    o[d0] = __builtin_amdgcn_mfma_f32_32x32x16_bf16(pa3, PK(3), o[d0], 0, 0, 0);
#undef PK
  }
}

template <int DK> struct Lay { static constexpr int ND = DK / 16, NC = DK / 8, SLOTK = NC * 1024, SLOTV = 8192, LDS_K = 0, LDS_V = 3 * SLOTK, LDS_WS = LDS_V + 3 * SLOTV, LDS_OST = LDS_WS + 8 * 256, LDS_BYTES = LDS_OST + 8 * 4096, KD = (DK == 96) ? 2 : 1; };

template <int DK, int LDQ, int LDK1, int LDK2, int LDV, int THRL>
__device__ __forceinline__ void attn_unit(const bf16* Qb, const bf16* __restrict__ K1, const bf16* __restrict__ K2, const bf16* __restrict__ Vh, bf16* Ob, const float* ropeq, const int NT, char* shm, const int tid_in) {
  using L = Lay<DK>; constexpr int ND = L::ND, SLOTK = L::SLOTK, SLOTV = L::SLOTV, LDS_K = L::LDS_K, LDS_V = L::LDS_V, LDS_WS = L::LDS_WS, LDS_OST = L::LDS_OST, KD = L::KD;
  int tid_ = tid_in; asm volatile("" : "+v"(tid_));
  const int tid = tid_, lane = tid & 63, r32 = lane & 31, hi = lane >> 5; const int wid = __builtin_amdgcn_readfirstlane(tid >> 6);
  const bf16* Qw = Qb + (long)(wid * 32) * LDQ;
  const unsigned lds0 = (unsigned)(uintptr_t)shm;
  float* wsf = (float*)(shm + LDS_WS) + wid * 64;
  const unsigned koff = (unsigned)(lane * LDK1 + wid * 8) * 2u;
  const unsigned koff2 = (unsigned)(lane * LDK2 + (wid & 3) * 8) * 2u;
  const unsigned voffv = (unsigned)((16 * (wid & 3) + (lane >> 2)) * LDV + (wid >> 2) * 32 + (lane & 3) * 8) * 2u;
  const unsigned kdst = lds0 + LDS_K + wid * 1024, kdst2 = lds0 + LDS_K + (8 + (wid & 3)) * 1024, vdst = lds0 + LDS_V + wid * 1024;
#define DMA_K(t, s) do { glds16(K1 + (long)(t) * 64 * LDK1, koff, (unsigned)__builtin_amdgcn_readfirstlane(kdst + (s) * SLOTK)); \
    if (DK == 96) glds16(K2 + (long)(t) * 64 * LDK2, koff2, (unsigned)__builtin_amdgcn_readfirstlane(kdst2 + (s) * SLOTK)); } while (0)
#define DMA_V(t, s) glds16(Vh + (long)(t) * 64 * LDV, voffv, (unsigned)__builtin_amdgcn_readfirstlane(vdst + (s) * SLOTV))
  const int vb0 = (int)(lds0 + LDS_V) + ((lane >> 4) & 1) * 32 + (lane & 3) * 8 + (4 * hi + ((lane & 15) >> 2)) * 64;
  const char* Kbase = shm + LDS_K; bf16x8 kf[12];
  const lds_cptr shm3 = (lds_cptr)shm; const lds_cptr kp0 = shm3 + LDS_K + hi * 1024 + r32 * 16; const lds_cptr vp0 = shm3 + LDS_V + ((lane >> 4) & 1) * 32 + (lane & 3) * 8 + (4 * hi + ((lane & 15) >> 2)) * 64;
  DMA_K(0, 0); DMA_V(0, 0); DMA_K(1, 1);
  bf16x8 qr[6];
#pragma unroll
  for (int d0 = 0; d0 < ND; ++d0) qr[d0] = *reinterpret_cast<const bf16x8*>(&Qw[(long)r32 * LDQ + d0 * 16 + hi * 8]);
  if (DK == 96 && ropeq != nullptr) {
    const float* cr = ropeq + (size_t)(wid * 32 + r32) * 16 + 4 * hi;
#pragma unroll
    for (int d0 = 4; d0 < ND; ++d0) { const f32x4 c = *(const f32x4*)(cr + (d0 - 4) * 8), s = *(const f32x4*)(cr + 8192 * 16 + (d0 - 4) * 8);
      const v4u w = __builtin_bit_cast(v4u, qr[d0]); v4u o;
      { const float a = bflo(w.x), b = bfhi(w.x); o.x = cvtpk_s(a * c.x - b * s.x, b * c.x + a * s.x); }
      { const float a = bflo(w.y), b = bfhi(w.y); o.y = cvtpk_s(a * c.y - b * s.y, b * c.y + a * s.y); }
      { const float a = bflo(w.z), b = bfhi(w.z); o.z = cvtpk_s(a * c.z - b * s.z, b * c.z + a * s.z); }
      { const float a = bflo(w.w), b = bfhi(w.w); o.w = cvtpk_s(a * c.w - b * s.w, b * c.w + a * s.w); }
      qr[d0] = __builtin_bit_cast(bf16x8, o); }
  }
  float mhat = 0.f, l_reg = 0.f; f32x16 o[2]; o[0] = f32x16{}; o[1] = f32x16{}; f32x16 negm = f32x16{}; asm volatile("" : "+v"(negm));
  bool resc = false;
#define START(P0, P1) do { const float rm = rowmax(P0, P1); resc = false; \
    { const float dl = rm; mhat = fadd_s(mhat, dl); \
      _Pragma("unroll") for (int r = 0; r < 16; ++r) { P0[r] = fsub_s(P0[r], dl); P1[r] = fsub_s(P1[r], dl); } \
      _Pragma("unroll") for (int r = 0; r < 16; ++r) negm[r] = -mhat; asm volatile("" : "+v"(negm)); } \
    _Pragma("unroll") for (int r = 0; r < 16; ++r) P0[r] = __builtin_amdgcn_exp2f(P0[r]); } while (0)
#define RESC() do { if (resc) { asm volatile("s_waitcnt lgkmcnt(0)" ::: "memory"); \
      _Pragma("unroll") for (int d_ = 0; d_ < 2; ++d_) _Pragma("unroll") for (int r = 0; r < 16; ++r) o[d_][r] *= wsf[crow(r, hi)]; } } while (0)
  f32x16 pA0, pA1, pB0, pB1;
  int sp = 0, sc = 0, sn = 1;
#define ROT() do { sp = sc; sc = sn; sn = (sn == 2) ? 0 : sn + 1; } while (0)
  DMA_K(2, 2);
  wait_bar<1 + 2 * KD>();
  qkt<ND>(pA0, pA1, Kbase, qr, negm, r32, hi); asm volatile("s_nop 15\n\ts_nop 7" : "+v"(pA0), "+v"(pA1));
  START(pA0, pA1);
  _Pragma("unroll") for (int r = 0; r < 16; ++r) pA1[r] = __builtin_amdgcn_exp2f(pA1[r]);
  wait_bar<0>();
  DMA_K(3, 0); DMA_V(1, 1);
  ROT();
#pragma unroll
  for (int j = 0; j < ND; ++j) kload2(kf, kp0 + sc * SLOTK, j);
  wait_bar<KD + 1>();
  s16x4 vlo[8], vhi[8]; u32x4 pw0, pw1, pw2, pw3;
#define PKW(P, B) cvtpk_s(P[B], P[B + 1])
#define PAF(k) __builtin_bit_cast(bf16x8, pw##k)
#define VFR(i) (bf16x8){vlo[i][0], vlo[i][1], vlo[i][2], vlo[i][3], vhi[i][0], vhi[i][1], vhi[i][2], vhi[i][3]}
#define PIN(x) asm volatile("" : "+v"(x))
#define MX3(a, b, c) __builtin_fmaxf(__builtin_fmaxf((a), (b)), (c))
#define EX(v) __builtin_amdgcn_exp2f(v)
#define GAPB(MF, X, B) do { MF; X[B] = EX(X[B]); X[B + 1] = EX(X[B + 1]); X[B + 2] = EX(X[B + 2]); X[B + 3] = EX(X[B + 3]); PIN(X); SBAR(); } while (0)
#define VRD(i) do { vlo[i] = vtr(vp_ + (((i) >> 2) * 4096 + ((i) & 3) * 1024)); vhi[i] = vtr(vp_ + (((i) >> 2) * 4096 + ((i) & 3) * 1024 + 512)); } while (0)
#define KRD(G, j) do { if (G) { kload2(kf, kp0 + sn * SLOTK, j); SBAR(); } } while (0)
#define MFQ(C, i, d, INIT) C = __builtin_amdgcn_mfma_f32_32x32x16_bf16(kf[i], qr[d], INIT, 0, 0, 0)
#define PHASE_A64(C0, C1, P0, P1) do { \
    VRD(0); SBAR(); float sacc = (P0[0] + P0[1]); \
    MFQ(C0, 0, 0, negm); sacc += P0[2]; sacc += P0[3]; sacc += P0[4]; sacc += P0[5]; PIN(sacc); pw0[0] = PKW(P0, 0); pw0[1] = PKW(P0, 2); PIN(pw0); SBAR(); \
    VRD(4); SBAR(); MFQ(C1, 1, 0, negm); sacc += P0[6]; sacc += P0[7]; sacc += P0[8]; sacc += P0[9]; PIN(sacc); pw0[2] = PKW(P0, 4); pw0[3] = PKW(P0, 6); PIN(pw0); SBAR(); \
    VRD(1); SBAR(); MFQ(C0, 2, 1, C0); sacc += P0[10]; sacc += P0[11]; sacc += P0[12]; sacc += P0[13]; PIN(sacc); pw1[0] = PKW(P0, 8); pw1[1] = PKW(P0, 10); PIN(pw1); SBAR(); \
    VRD(5); SBAR(); MFQ(C1, 3, 1, C1); sacc += P0[14]; sacc += P0[15]; sacc += P1[0]; sacc += P1[1]; PIN(sacc); pw1[2] = PKW(P0, 12); pw1[3] = PKW(P0, 14); PIN(pw1); SBAR(); \
    VRD(2); SBAR(); MFQ(C0, 4, 2, C0); sacc += P1[2]; sacc += P1[3]; sacc += P1[4]; sacc += P1[5]; PIN(sacc); pw2[0] = PKW(P1, 0); pw2[1] = PKW(P1, 2); PIN(pw2); SBAR(); \
    VRD(6); SBAR(); MFQ(C1, 5, 2, C1); sacc += P1[6]; sacc += P1[7]; sacc += P1[8]; sacc += P1[9]; PIN(sacc); pw2[2] = PKW(P1, 4); pw2[3] = PKW(P1, 6); PIN(pw2); SBAR(); \
    VRD(3); SBAR(); MFQ(C0, 6, 3, C0); sacc += P1[10]; sacc += P1[11]; sacc += P1[12]; sacc += P1[13]; PIN(sacc); pw3[0] = PKW(P1, 8); pw3[1] = PKW(P1, 10); PIN(pw3); SBAR(); \
    VRD(7); SBAR(); MFQ(C1, 7, 3, C1); sacc += P1[14]; sacc += P1[15]; PIN(sacc); pw3[2] = PKW(P1, 12); pw3[3] = PKW(P1, 14); PIN(pw3); SBAR(); \
    l_reg += sacc; } while (0)
#define PHASE_A96(C0, C1, P0, P1) do { \
    VRD(0); SBAR(); float sacc = (P0[0] + P0[1]); \
    MFQ(C0, 0, 0, negm); sacc += P0[2]; sacc += P0[3]; sacc += P0[4]; PIN(sacc); pw0[0] = PKW(P0, 0); PIN(pw0); SBAR(); \
    VRD(4); SBAR(); MFQ(C1, 1, 0, negm); sacc += P0[5]; sacc += P0[6]; sacc += P0[7]; PIN(sacc); pw0[1] = PKW(P0, 2); PIN(pw0); SBAR(); \
    VRD(1); SBAR(); MFQ(C0, 2, 1, C0); sacc += P0[8]; sacc += P0[9]; sacc += P0[10]; PIN(sacc); pw0[2] = PKW(P0, 4); PIN(pw0); SBAR(); \
    VRD(5); SBAR(); MFQ(C1, 3, 1, C1); sacc += P0[11]; sacc += P0[12]; sacc += P0[13]; PIN(sacc); pw0[3] = PKW(P0, 6); PIN(pw0); SBAR(); \
    VRD(2); SBAR(); MFQ(C0, 4, 2, C0); sacc += P0[14]; sacc += P0[15]; PIN(sacc); pw1[0] = PKW(P0, 8); PIN(pw1); SBAR(); \
    VRD(6); SBAR(); MFQ(C1, 5, 2, C1); sacc += P1[0]; sacc += P1[1]; PIN(sacc); pw1[1] = PKW(P0, 10); PIN(pw1); SBAR(); \
    VRD(3); SBAR(); MFQ(C0, 6, 3, C0); sacc += P1[2]; sacc += P1[3]; PIN(sacc); pw1[2] = PKW(P0, 12); PIN(pw1); SBAR(); \
    VRD(7); SBAR(); MFQ(C1, 7, 3, C1); sacc += P1[4]; sacc += P1[5]; PIN(sacc); pw1[3] = PKW(P0, 14); PIN(pw1); SBAR(); \
    MFQ(C0, 8, 4, C0); sacc += P1[6]; sacc += P1[7]; sacc += P1[8]; PIN(sacc); pw2[0] = PKW(P1, 0); pw2[1] = PKW(P1, 2); PIN(pw2); SBAR(); \
    MFQ(C1, 9, 4, C1); sacc += P1[9]; sacc += P1[10]; sacc += P1[11]; PIN(sacc); pw2[2] = PKW(P1, 4); pw2[3] = PKW(P1, 6); PIN(pw2); SBAR(); \
    MFQ(C0, 10, 5, C0); sacc += P1[12]; sacc += P1[13]; PIN(sacc); pw3[0] = PKW(P1, 8); pw3[1] = PKW(P1, 10); PIN(pw3); SBAR(); \
    MFQ(C1, 11, 5, C1); sacc += P1[14]; sacc += P1[15]; PIN(sacc); pw3[2] = PKW(P1, 12); pw3[3] = PKW(P1, 14); PIN(pw3); SBAR(); \
    l_reg += sacc; } while (0)
#define STEP(C0, C1, P0, P1, t, GK, GV, GL) do { SBAR(); \
    const lds_cptr vp_ = vp0 + sp * SLOTV; \
    if (DK == 96) PHASE_A96(C0, C1, P0, P1); else PHASE_A64(C0, C1, P0, P1); \
    if (GK) { DMA_K((t) + 3, sc); } if (GV) { DMA_V((t) + 1, sn); } \
    { float a = MX3(C0[0], C0[1], C1[0]), b = MX3(C0[2], C0[3], C1[1]); a = MX3(a, C1[2], C1[3]); \
      _Pragma("unroll") for (int r = 4; r < 16; r += 4) { a = MX3(a, C0[r], C0[r + 1]); b = MX3(b, C0[r + 2], C0[r + 3]); a = MX3(a, C1[r], C1[r + 1]); b = MX3(b, C1[r + 2], C1[r + 3]); } \
      float rm = __builtin_fmaxf(a, b); { auto rr = __builtin_amdgcn_permlane32_swap(__float_as_uint(rm), __float_as_uint(rm), false, false); rm = __builtin_fmaxf(__uint_as_float(rr[0]), __uint_as_float(rr[1])); } \
      resc = false; \
      if (__builtin_expect(__any(rm > (float)THRL), 0)) { const float dl = __builtin_fmaxf(rm, 0.f); mhat += dl; \
        _Pragma("unroll") for (int r = 0; r < 16; ++r) { C0[r] -= dl; C1[r] -= dl; } \
        _Pragma("unroll") for (int r = 0; r < 16; ++r) negm[r] = -mhat; asm volatile("" : "+v"(negm)); \
        const float f = __builtin_amdgcn_exp2f(-dl); l_reg *= f; if (hi == 0) wsf[r32] = f; resc = true; } } \
    SBAR(); \
    GAPB(o[0] = __builtin_amdgcn_mfma_f32_32x32x16_bf16(PAF(0), VFR(0), o[0], 0, 0, 0), C0, 0); \
    KRD(GL && ND == 6, 0); GAPB(o[1] = __builtin_amdgcn_mfma_f32_32x32x16_bf16(PAF(0), VFR(4), o[1], 0, 0, 0), C0, 4); \
    KRD(GL, ND == 6 ? 1 : 0); GAPB(o[0] = __builtin_amdgcn_mfma_f32_32x32x16_bf16(PAF(1), VFR(1), o[0], 0, 0, 0), C0, 8); \
    KRD(GL, ND == 6 ? 2 : 1); GAPB(o[1] = __builtin_amdgcn_mfma_f32_32x32x16_bf16(PAF(1), VFR(5), o[1], 0, 0, 0), C0, 12); \
    KRD(GL, ND == 6 ? 3 : 2); GAPB(o[0] = __builtin_amdgcn_mfma_f32_32x32x16_bf16(PAF(2), VFR(2), o[0], 0, 0, 0), C1, 0); \
    KRD(GL, ND == 6 ? 4 : 3); GAPB(o[1] = __builtin_amdgcn_mfma_f32_32x32x16_bf16(PAF(2), VFR(6), o[1], 0, 0, 0), C1, 4); \
    KRD(GL && ND == 6, 5); GAPB(o[0] = __builtin_amdgcn_mfma_f32_32x32x16_bf16(PAF(3), VFR(3), o[0], 0, 0, 0), C1, 8); \
    GAPB(o[1] = __builtin_amdgcn_mfma_f32_32x32x16_bf16(PAF(3), VFR(7), o[1], 0, 0, 0), C1, 12); \
  } while (0)
  int t = 1;
  for (; t + 5 < NT; t += 2) {
    STEP(pB0, pB1, pA0, pA1, t, true, true, true);     wait_bar<KD + 1>(); RESC(); ROT();
    STEP(pA0, pA1, pB0, pB1, t + 1, true, true, true); wait_bar<KD + 1>(); RESC(); ROT();
  }
#define ENDW(tt) do { if ((tt) + 3 < NT) { wait_bar<KD + 1>(); } else if ((tt) + 2 < NT) { wait_bar<1>(); } else { wait_bar<0>(); } } while (0)
  for (; t + 1 < NT; t += 2) {
    STEP(pB0, pB1, pA0, pA1, t, (t + 3 < NT), (t + 1 < NT), (t + 1 < NT));         ENDW(t);     RESC(); ROT();
    STEP(pA0, pA1, pB0, pB1, t + 1, (t + 4 < NT), (t + 2 < NT), (t + 2 < NT));     ENDW(t + 1); RESC(); ROT();
  }
  STEP(pB0, pB1, pA0, pA1, NT - 1, false, false, false); RESC();
  { float sacc = pB0[0] + pB0[1];
    _Pragma("unroll") for (int r = 2; r < 16; ++r) sacc += pB0[r];
    _Pragma("unroll") for (int r = 0; r < 16; ++r) sacc += pB1[r];
    l_reg += sacc;
    pw0 = (u32x4){PKW(pB0, 0), PKW(pB0, 2), PKW(pB0, 4), PKW(pB0, 6)}; pw1 = (u32x4){PKW(pB0, 8), PKW(pB0, 10), PKW(pB0, 12), PKW(pB0, 14)};
    pw2 = (u32x4){PKW(pB1, 0), PKW(pB1, 2), PKW(pB1, 4), PKW(pB1, 6)}; pw3 = (u32x4){PKW(pB1, 8), PKW(pB1, 10), PKW(pB1, 12), PKW(pB1, 14)};
    SBAR(); pv(o, vb0 + sc * SLOTV, PAF(0), PAF(1), PAF(2), PAF(3)); }
  { auto rr = __builtin_amdgcn_permlane32_swap(__float_as_uint(l_reg), __float_as_uint(l_reg), false, false); l_reg = __uint_as_float(rr[0]) + __uint_as_float(rr[1]); }
  if (hi == 0) wsf[32 + r32] = l_reg; asm volatile("s_waitcnt lgkmcnt(0)" ::: "memory");
  float rli[16];
#pragma unroll
  for (int r = 0; r < 16; ++r) rli[r] = __builtin_amdgcn_rcpf(wsf[32 + crow(r, hi)]);
  bf16* Ow = Ob + (long)(wid * 32) * OW;
  { bf16* stg = (bf16*)(shm + LDS_OST) + wid * 2048;
#pragma unroll
    for (int r = 0; r < 16; ++r) { const int orow = crow(r, hi);
#pragma unroll
      for (int d0 = 0; d0 < 2; ++d0) stg[orow * 64 + d0 * 32 + r32] = (bf16)f2bf(o[d0][r] * rli[r]); }
    asm volatile("s_waitcnt lgkmcnt(0)" ::: "memory");
#pragma unroll
    for (int i = 0; i < 4; ++i) { const int row = i * 8 + (lane >> 3), ch = lane & 7; const u32x4 v = *(const u32x4*)(stg + row * 64 + ch * 8); *(u32x4*)(Ow + (long)row * OW + ch * 8) = v; } }
  asm volatile("s_waitcnt lgkmcnt(0)\n\ts_barrier" ::: "memory");
#undef DMA_K
#undef DMA_V
#undef START
#undef RESC
#undef ROT
#undef PKW
#undef PAF
#undef VFR
#undef PIN
#undef MX3
#undef EX
#undef GAPB
#undef VRD
#undef KRD
#undef MFQ
#undef PHASE_A64
#undef PHASE_A96
#undef STEP
#undef ENDW
}
#undef SBAR
}

constexpr size_t MiB = 1u << 20;
constexpr size_t WS_CTL = 0, CTL_ZERO_BYTES = 1 * MiB;
constexpr size_t WS_MOD = 1 * MiB;
constexpr size_t WS_ROPE = 2 * MiB;
constexpr size_t WS_AFF = 5 * MiB;
constexpr size_t WS_INV = 8 * MiB;
constexpr size_t WS_ROWIDX = 10 * MiB;
constexpr size_t WS_WIN = 12 * MiB, WS_WUQ = 18 * MiB, WS_WUKV = 19 * MiB, WS_WOUT = 20 * MiB;
constexpr size_t WS_XRES = 24 * MiB;
constexpr size_t WS_H1 = 90 * MiB;
constexpr size_t WS_Z = 123 * MiB;
constexpr size_t WS_QM = 173 * MiB, WS_KVM = 198 * MiB, WS_O = 231 * MiB;
constexpr size_t WS_XG = 256 * MiB;
constexpr size_t WS_HID = 328 * MiB;
constexpr size_t WS_W13 = 520 * MiB, WS_W2 = 856 * MiB, WS_END = 1024 * MiB;
constexpr int CW_BAR = 4096;
constexpr int NPHASE = 28;
constexpr int LDS_BYTES = 147456, MISC_OFF = LDS_BYTES - 256;
constexpr int NWAVES = 8;

#define XB_TMO      128
#define XB_XCNT(j)  (256  + 64 * (j))
#define XB_XSUB(j)  (1280 + 64 * (j))
#define XB_XGEN(j)  (2304 + 64 * (j))
#define XB_TOP      3328
#define XB_TOPGEN   3392
#define XCD_BAR_WORDS 3456
#define XB_SPIN_CAP (1u << 18)

__device__ __forceinline__ unsigned xb_ld(unsigned* p)              { return __hip_atomic_load(p, __ATOMIC_RELAXED, __HIP_MEMORY_SCOPE_AGENT); }
__device__ __forceinline__ unsigned xb_add(unsigned* p, unsigned v) { return __hip_atomic_fetch_add(p, v, __ATOMIC_RELAXED, __HIP_MEMORY_SCOPE_AGENT); }
__device__ __forceinline__ unsigned xb_xcc_id() { return (unsigned)__builtin_amdgcn_s_getreg((3 << 11) | 20) & 0xFu; }
#define XB_SPIN(cond, bar) do { unsigned _sp = 0; while (cond) { __builtin_amdgcn_s_sleep(1); \
    if ((++_sp & 255u) == 0u) { if (xb_ld(&(bar)[XB_TMO])) break; if (_sp > XB_SPIN_CAP) { atomicAdd(&(bar)[XB_TMO], 1u); break; } } } } while (0)

struct XcdBarrier {
    unsigned* bar; unsigned x;
    volatile LAS unsigned* st;
};

__device__ __forceinline__ XcdBarrier xcd_barrier_post(unsigned* bar, volatile LAS unsigned* st) {
    XcdBarrier b; b.bar = bar; b.x = xb_xcc_id(); b.st = st;
    if (threadIdx.x == 0) (void)xb_add(&bar[XB_XCNT(b.x)], 1u);
    return b;
}
__device__ __forceinline__ void xcd_barrier_complete(unsigned* bar, unsigned x, unsigned& nloc, unsigned& nx) {
    const unsigned G = gridDim.x * gridDim.y * gridDim.z;
    unsigned sum, cnt, mine, sp = 0u;
    for (;;) {
        sum = 0u; cnt = 0u; mine = 0u;
#pragma unroll
        for (unsigned j = 0; j < 16; ++j) { const unsigned c = xb_ld(&bar[XB_XCNT(j)]); sum += c; cnt += (c > 0u) ? 1u : 0u; mine = (j == x) ? c : mine; }
        if (sum == G) break;
        __builtin_amdgcn_s_sleep(1);
        if ((++sp & 255u) == 0u) { if (xb_ld(&bar[XB_TMO])) break; if (sp > XB_SPIN_CAP) { atomicAdd(&bar[XB_TMO], 1u); break; } }
    }
    nloc = mine > 0u ? mine : 1u; nx = cnt > 0u ? cnt : 1u;
}

__device__ __forceinline__ void xcd_barrier(const XcdBarrier& b) {
    asm volatile("s_waitcnt vmcnt(0)" ::: "memory");
    __syncthreads();
    if (threadIdx.x == 0) {
        unsigned* bar = b.bar;
        __builtin_amdgcn_s_waitcnt(0);
        unsigned nloc = b.st[0], nx = b.st[1];
        if (nloc == 0u) { xcd_barrier_complete(bar, b.x, nloc, nx); b.st[0] = nloc; b.st[1] = nx; }
        const unsigned old = xb_add(&bar[XB_XSUB(b.x)], 1u);
        const unsigned gen = old / nloc;
        if (old + 1u == (gen + 1u) * nloc) {
            __builtin_amdgcn_fence(__ATOMIC_RELEASE, "agent");
            asm volatile("s_waitcnt vmcnt(0)" ::: "memory");
            const unsigned og = xb_add(&bar[XB_TOP], 1u);
            const unsigned tg = og / nx;
            if (og + 1u == (tg + 1u) * nx) xb_add(&bar[XB_TOPGEN], 1u);
            else XB_SPIN(xb_ld(&bar[XB_TOPGEN]) == tg, bar);
            __builtin_amdgcn_fence(__ATOMIC_ACQUIRE, "agent");
            xb_add(&bar[XB_XGEN(b.x)], 1u);
            asm volatile("s_waitcnt vmcnt(0)" ::: "memory");
        } else {
            XB_SPIN(xb_ld(&bar[XB_XGEN(b.x)]) == gen, bar);
            __builtin_amdgcn_fence(__ATOMIC_ACQUIRE, "agent");
            asm volatile("s_waitcnt vmcnt(0)" ::: "memory");
        }
    }
    __syncthreads();
}

struct Frame {
    LAS unsigned char* lds; volatile LAS unsigned* MISC; unsigned* ctl;
    int tid, lane, wave, vcu, G;
    const float* const* in; float* out; unsigned char* ws;
};
__device__ __forceinline__ const float* gin(const Frame& F, int i) { return (const float*)(const GAS float*)F.in[i]; }
enum { I_X = 0, I_C, I_CTX, I_CCTX, I_MODW, I_MODB, I_N1G, I_WIN, I_QNG, I_WUQ, I_KVNG, I_WUKV, I_GQG, I_GKG, I_CVW, I_CVB, I_LNG, I_LNB, I_MOG, I_WOUT, I_N2G, I_RW, I_W1, I_W3, I_W2, I_FG };

__device__ __forceinline__ void sincos_acc(float ang, float& s, float& c) {
    const double x = (double)ang; const double k = __builtin_rint(x * 0.63661977236758134);
    double r = __builtin_fma(-k, 1.5707963267948966, x); r = __builtin_fma(-k, 6.123233995736766e-17, r);
    const double r2 = r * r;
    const double sp = r * (1.0 + r2 * (-1.0 / 6 + r2 * (1.0 / 120 + r2 * (-1.0 / 5040 + r2 * (1.0 / 362880 + r2 * (-1.0 / 39916800 + r2 * (1.0 / 6227020800.0)))))));
    const double cp = 1.0 + r2 * (-0.5 + r2 * (1.0 / 24 + r2 * (-1.0 / 720 + r2 * (1.0 / 40320 + r2 * (-1.0 / 3628800 + r2 * (1.0 / 479001600.0 + r2 * (-1.0 / 87178291200.0)))))));
    const int q = (int)k & 3;
    const double sv = (q == 0) ? sp : (q == 1) ? cp : (q == 2) ? -sp : -cp;
    const double cv = (q == 0) ? cp : (q == 1) ? -sp : (q == 2) ? -cp : sp;
    s = (float)sv; c = (float)cv;
}
template <int NW, class RowMap>
__device__ __forceinline__ void tr_item(const float* W, int N, int k0, int n0, bf16* WT, int ldwt, RowMap rowmap, LAS float* scr, int lane, const float vs = 1.f) {
    constexpr int LPR = NW / 4, RPI = 64 / LPR, NI = 64 / RPI, NO = NW * 8 / 64;
    const int r = lane / LPR, c4 = lane % LPR;
    f32x4 v[NI];
#pragma unroll
    for (int i = 0; i < NI; ++i) v[i] = *(const GAS f32x4*)(W + (size_t)(k0 + i * RPI + r) * N + n0 + 4 * c4);
#pragma unroll
    for (int i = 0; i < NI; ++i) { const int k = i * RPI + r;
#pragma unroll
        for (int j = 0; j < 4; ++j) scr[(4 * c4 + j) * 65 + k] = v[i][j]; }
    LDS_WAIT(); asm volatile("" ::: "memory");
#pragma unroll
    for (int j = 0; j < NO; ++j) { const int n = (lane >> 3) + 8 * j, c = lane & 7; const LAS float* s = scr + n * 65 + 8 * c;
        v4u o; o.x = pk2(s[0] * vs, s[1] * vs); o.y = pk2(s[2] * vs, s[3] * vs); o.z = pk2(s[4] * vs, s[5] * vs); o.w = pk2(s[6] * vs, s[7] * vs);
        *(GAS v4u*)(WT + (size_t)rowmap(n0 + n) * ldwt + k0 + 8 * c) = o; }
    LDS_WAIT(); asm volatile("" ::: "memory");
}
constexpr int NLI = 32256, NMI = 10752;
struct XItem { const float* W; bf16* WT; int N, ldwt, k0, n0, radd; bool tiled; };
__device__ __forceinline__ void xitem_desc(Frame& F, int l, int x, XItem& d) {
    const int mat = x / NMI, r = x - mat * NMI, e = r / 672, q = r - e * 672, le = l * 16 + e;
    if (mat < 2) { d.W = (mat == 0 ? gin(F, I_W1) : gin(F, I_W3)) + (size_t)le * 1024 * FF; d.N = FF; d.k0 = (q / 42) * 64; d.n0 = (q % 42) * 64;
        d.WT = (bf16*)(F.ws + WS_W13) + (size_t)le * 5376 * 1024; d.ldwt = 1024; d.radd = mat * 128; d.tiled = true; }
    else { d.W = gin(F, I_W2) + (size_t)le * FF * 1024; d.N = 1024; d.k0 = (q / 16) * 64; d.n0 = (q % 16) * 64;
        d.WT = (bf16*)(F.ws + WS_W2) + (size_t)le * 1024 * FF; d.ldwt = FF; d.radd = 0; d.tiled = false; }
}
__device__ __forceinline__ void xitem_load(const XItem& d, f32x4 (&v)[16], int lane) {
    const int r = lane >> 4, c4 = lane & 15; const float* p = d.W + (size_t)(d.k0 + r) * d.N + d.n0 + 4 * c4;
#pragma unroll
    for (int i = 0; i < 16; ++i) v[i] = *(const GAS f32x4*)(p + (size_t)(4 * i) * d.N);
}
__device__ __forceinline__ void xitem_store(const XItem& d, const f32x4 (&v)[16], LAS float* scr, int lane) {
    const int r = lane >> 4, c4 = lane & 15;
#pragma unroll
    for (int i = 0; i < 16; ++i) { const int k = i * 4 + r;
#pragma unroll
        for (int j = 0; j < 4; ++j) scr[(4 * c4 + j) * 65 + k] = v[i][j]; }
    LDS_WAIT(); asm volatile("" ::: "memory");
#pragma unroll
    for (int j = 0; j < 8; ++j) { const int nn = (lane >> 3) + 8 * j, c = lane & 7; const LAS float* s = scr + nn * 65 + 8 * c; const int n = d.n0 + nn;
        const int row = d.tiled ? (n >> 7) * 256 + d.radd + (n & 127) : n;
        v4u o; o.x = pk2(s[0], s[1]); o.y = pk2(s[2], s[3]); o.z = pk2(s[4], s[5]); o.w = pk2(s[6], s[7]);
        *(GAS v4u*)(d.WT + (size_t)row * d.ldwt + d.k0 + 8 * c) = o; }
    LDS_WAIT(); asm volatile("" ::: "memory");
}
template <class IdxFn>
__device__ __forceinline__ void conv_stream(Frame& F, int n, IdxFn idx, LAS float* scr, int lane) {
    XItem da, db; f32x4 va[16], vb[16]; int l_, x_;
    if (n > 0) { idx(0, l_, x_); xitem_desc(F, l_, x_, da); xitem_load(da, va, lane); }
    for (int j = 0; j < n; j += 2) {
        const bool hb = j + 1 < n;
        if (hb) { idx(j + 1, l_, x_); xitem_desc(F, l_, x_, db); xitem_load(db, vb, lane); }
        xitem_store(da, va, scr, lane);
        if (hb) { if (j + 2 < n) { idx(j + 2, l_, x_); xitem_desc(F, l_, x_, da); xitem_load(da, va, lane); }
            xitem_store(db, vb, scr, lane); }
    }
}
constexpr int WIN_IN_NB = 116, WIN_IN_IPW = 3, WIN_OUT_NB = 248, WIN_OUT_IPW = 3, WIN_TK0_NB = 192, WIN_TK1_NB = 224, WIN_TK_IPW = 2, WIN_M2_NB = 192, WIN_M2_IPW = 8;
constexpr int N_WIN_IN = WIN_IN_NB * 8 * WIN_IN_IPW, N_WIN_OUT = WIN_OUT_NB * 8 * WIN_OUT_IPW, N_WIN_TK0 = WIN_TK0_NB * 8 * WIN_TK_IPW, N_WIN_TK1 = WIN_TK1_NB * 8 * WIN_TK_IPW, N_WIN_M2 = WIN_M2_NB * 8 * WIN_M2_IPW;
constexpr int PRO_L0 = NLI - N_WIN_IN - N_WIN_OUT - N_WIN_TK0;
constexpr int PRO_L1 = NLI - N_WIN_M2 - N_WIN_IN - N_WIN_TK1;
constexpr int BASE_IN0 = PRO_L0, BASE_OUT0 = BASE_IN0 + N_WIN_IN, BASE_TK0 = BASE_OUT0 + N_WIN_OUT;
constexpr int BASE_M2 = PRO_L1, BASE_IN1 = BASE_M2 + N_WIN_M2, BASE_TK1 = BASE_IN1 + N_WIN_IN;
static_assert(BASE_TK0 + N_WIN_TK0 == NLI && BASE_TK1 + N_WIN_TK1 == NLI && PRO_L0 > 0 && PRO_L1 > 0, "window partition");
__device__ __forceinline__ void conv_window(Frame& F, int l, int base, int rank, int nblk, int ipw) {
    LAS float* scr = (LAS float*)(F.lds + F.wave * 16640); const int w0 = base + rank * 8 + F.wave, st = nblk * 8;
    conv_stream(F, ipw, [=](int j, int& ll, int& xx) { ll = l; xx = w0 + j * st; }, scr, F.lane);
}
__device__ __forceinline__ void ph0(Frame& F) {
    const int tid = F.tid, lane = F.lane;
    const int gw = F.vcu * NWAVES + F.wave, NGW = F.G * NWAVES;
    const int gt = blockIdx.x * 512 + tid, NGT = F.G * 512;
    float* cosM = (float*)(F.ws + WS_ROPE); float* sinM = cosM + 8192 * 16; float* cosG = sinM + 8192 * 16; float* sinG = cosG + 8192 * 32;
    for (int i = gt; i < 8192 * 16; i += NGT) { const int t = i >> 4, p = i & 15; const float pos = (p < 8) ? (float)(t >> 6) : (float)(t & 63);
        const float inv = exp2f(-(float)(p & 7) * (13.287712379549449f / 8.f)); float s, c; sincos_acc(pos * inv, s, c); cosM[i] = c; sinM[i] = s; }
    for (int i = gt; i < 8192 * 32; i += NGT) { const int t = i >> 5, p = i & 31; const float pos = (p < 16) ? (float)(t >> 6) : (float)(t & 63);
        const float inv = exp2f(-(float)(p & 15) * (13.287712379549449f / 16.f)); float s, c; sincos_acc(pos * inv, s, c); cosG[i] = c; sinG[i] = s; }
    { bf16* wt = (bf16*)(F.ws + WS_WIN);
      for (int i = gt; i < 2 * 96 * 128; i += NGT) { const int l = i / (96 * 128), r = i % (96 * 128); *(v4u*)(wt + ((size_t)l * 1536 + 1440) * 1024 + (size_t)r * 8) = (v4u){0u, 0u, 0u, 0u}; } }
    { LAS float* sv = (LAS float*)F.lds; LAS f32x4* part = (LAS f32x4*)(F.lds + 12288);
      float* modv = (float*)(F.ws + WS_MOD);
      for (int job = blockIdx.x; job < 256; job += F.G) {
          const int l = job >> 7, grp = job & 127;
          for (int i = tid; i < 3072; i += 512) { const int mv = i >> 10, k = i & 1023; const float v = (mv < 2) ? gin(F, I_C)[mv * 1024 + k] : gin(F, I_CCTX)[k]; sv[i] = v * sigmoidf_(v); }
          __syncthreads();
          if (tid < 384) { const int kq = tid / 12, cq = tid % 12, col = grp * 48 + cq * 4;
              f32x4 a0 = {0.f, 0.f, 0.f, 0.f}, a1 = a0, a2 = a0;
              const float* wp = gin(F, I_MODW) + ((size_t)l * 1024 + kq * 32) * 6144 + col;
#pragma unroll 8
              for (int kk = 0; kk < 32; ++kk) { const f32x4 w = *(const f32x4*)(wp + (size_t)kk * 6144); const int k = kq * 32 + kk; a0 += sv[k] * w; a1 += sv[1024 + k] * w; a2 += sv[2048 + k] * w; }
              part[(kq * 12 + cq) * 3 + 0] = a0; part[(kq * 12 + cq) * 3 + 1] = a1; part[(kq * 12 + cq) * 3 + 2] = a2; }
          __syncthreads();
          if (tid < 36) { const int cq = tid % 12, mv = tid / 12, col = grp * 48 + cq * 4; f32x4 s = *(const f32x4*)(gin(F, I_MODB) + l * 6144 + col);
              for (int kq = 0; kq < 32; ++kq) s += part[(kq * 12 + cq) * 3 + mv];
              *(f32x4*)(modv + (size_t)(l * 3 + mv) * 6144 + col) = s; }
          __syncthreads();
      } }
    LAS float* scr = (LAS float*)(F.lds + F.wave * 16640);
    constexpr int N_WIN = 2 * 16 * 45, N_WUQ = 2 * 4 * 12, N_WUKV = 2 * 2 * 16, N_WOUT = 2 * 16 * 16;
#ifndef USE_WIN
#define USE_WIN 1
#endif
    const bool win = USE_WIN && (F.G == 256);
    const int n0 = win ? PRO_L0 : NLI, n1 = win ? PRO_L1 : NLI;
    const int NITEMS = n0 + n1 + N_WIN + N_WUQ + N_WUKV + N_WOUT;
    { const int nx = n0 + n1, cnt = (nx - gw + NGW - 1) / NGW;
      conv_stream(F, cnt > 0 ? cnt : 0, [=](int j, int& ll, int& xx) { const int r = gw + j * NGW; ll = r >= n0 ? 1 : 0; xx = r >= n0 ? r - n0 : r; }, scr, lane); }
    for (int it = gw; it < NITEMS - (n0 + n1); it += NGW) {
        int r = it;
        if (r < N_WIN) { const int l = r / 720, q = r % 720, kb = q / 45, nb = q % 45;
            tr_item<32>(gin(F, I_WIN) + (size_t)l * 1024 * 1440, 1440, kb * 64, nb * 32, (bf16*)(F.ws + WS_WIN) + (size_t)l * 1536 * 1024, 1024, [](int n) { return n; }, scr, lane); continue; } r -= N_WIN;
        if (r < N_WOUT) { const int l = r / 256, q = r % 256, kb = q / 16, nb = q % 16;
            tr_item<64>(gin(F, I_WOUT) + (size_t)l * 1024 * 1024, 1024, kb * 64, nb * 64, (bf16*)(F.ws + WS_WOUT) + (size_t)l * 1024 * 1024, 1024, [](int n) { return n; }, scr, lane); continue; } r -= N_WOUT;
        if (r < N_WUQ) { const int l = r / 48, q = r % 48, kb = q / 12, nb = q % 12;
            tr_item<64>(gin(F, I_WUQ) + (size_t)l * 256 * 768, 768, kb * 64, nb * 64, (bf16*)(F.ws + WS_WUQ) + (size_t)l * 768 * 256, 256,
                        [](int n) { const int h = n / 96, j = n % 96; return j < 64 ? n : (j < 80 ? h * 96 + 64 + 2 * (j - 64) : h * 96 + 64 + 2 * (j - 80) + 1); }, scr, lane, C_MLA); continue; } r -= N_WUQ;
        { const int l = r / 32, q = r % 32, kb = q / 16, nb = q % 16;
            tr_item<64>(gin(F, I_WUKV) + (size_t)l * 128 * 1024, 1024, kb * 64, nb * 64, (bf16*)(F.ws + WS_WUKV) + (size_t)l * 1024 * 128, 128, [](int n) { return n; }, scr, lane); }
    }
}

template <int MODE>
__device__ __forceinline__ void norm_phase(Frame& F) {
    const int lane = F.lane, gw = F.vcu * NWAVES + F.wave, NGW = F.G * NWAVES;
    float* xres = (float*)(F.ws + WS_XRES); bf16* h1 = (bf16*)(F.ws + WS_H1);
    const float* modv = (const float*)(F.ws + WS_MOD); const float* aff = (const float*)(F.ws + WS_AFF); const int* inv = (const int*)(F.ws + WS_INV); const bf16* ybuf = (const bf16*)(F.ws + WS_XG);
    const float* xin = gin(F, I_X); const float* cin = gin(F, I_CTX);
    f32x4 nv[4]; int nslot = -1; float ngate = 0.f;
#define NP_LOAD(R_) do { const int b_ = (R_) / SB, s_ = (R_) - b_ * SB; \
        const float* src_ = (MODE == 0) ? (s_ < CTX ? cin + ((size_t)b_ * CTX + s_) * DM : xin + ((size_t)b_ * SEQ + (s_ - CTX)) * DM) : xres + (size_t)(R_) * DM; \
        _Pragma("unroll") for (int j = 0; j < 4; ++j) nv[j] = *(const f32x4*)(src_ + 4 * lane + 256 * j); \
        if (MODE >= 1) { nslot = (lane < 16) ? inv[(size_t)(R_) * 16 + lane] : -1; ngate = (lane < 16) ? aff[(size_t)(R_) * 16 + lane] : 0.f; } } while (0)
    int R = gw;
    if (R < M) NP_LOAD(R);
    for (; R < M; R += NGW) {
        f32x4 v[4]; const int slotv = nslot; const float gatev = ngate;
#pragma unroll
        for (int j = 0; j < 4; ++j) v[j] = nv[j];
        if (R + NGW < M) NP_LOAD(R + NGW);
        const int b = R / SB, s = R - b * SB; const bool isctx = s < CTX; const int mv = isctx ? 2 : b;
        if (MODE == 2 && isctx) continue;
        if (MODE >= 1) {
            const float* g2 = modv + (size_t)((MODE - 1) * 3 + mv) * 6144 + 5120;
            f32x4 acc[4];
#pragma unroll
            for (int j = 0; j < 4; ++j) acc[j] = (f32x4){0.f, 0.f, 0.f, 0.f};
            unsigned long long mask = __ballot(slotv >= 0);
            while (mask) {
                const int e0 = __builtin_ctzll(mask); mask &= mask - 1; const bool two = mask != 0; const int e1 = two ? __builtin_ctzll(mask) : e0; if (two) mask &= mask - 1;
                const int s0 = __builtin_amdgcn_readlane(slotv, e0), s1 = __builtin_amdgcn_readlane(slotv, e1);
                const float g0 = __builtin_bit_cast(float, __builtin_amdgcn_readlane(__builtin_bit_cast(int, gatev), e0)), g1 = two ? __builtin_bit_cast(float, __builtin_amdgcn_readlane(__builtin_bit_cast(int, gatev), e1)) : 0.f;
                const bf16* y0 = ybuf + ((size_t)e0 * RPE + s0) * DM + 4 * lane; const bf16* y1 = ybuf + ((size_t)e1 * RPE + s1) * DM + 4 * lane;
                v2u r0[4], r1[4];
#pragma unroll
                for (int j = 0; j < 4; ++j) { r0[j] = *(const v2u*)(y0 + 256 * j); r1[j] = *(const v2u*)(y1 + 256 * j); }
#pragma unroll
                for (int j = 0; j < 4; ++j) { acc[j] += g0 * (f32x4){bflo(r0[j].x), bfhi(r0[j].x), bflo(r0[j].y), bfhi(r0[j].y)}; acc[j] += g1 * (f32x4){bflo(r1[j].x), bfhi(r1[j].x), bflo(r1[j].y), bfhi(r1[j].y)}; }
            }
#pragma unroll
            for (int j = 0; j < 4; ++j) v[j] += *(const f32x4*)(g2 + 4 * lane + 256 * j) * acc[j];
            if (MODE == 1) {
#pragma unroll
                for (int j = 0; j < 4; ++j) *(f32x4*)(xres + (size_t)R * DM + 4 * lane + 256 * j) = v[j]; }
        }
        float ss = 0.f;
#pragma unroll
        for (int j = 0; j < 4; ++j) ss += (v[j].x * v[j].x + v[j].y * v[j].y) + (v[j].z * v[j].z + v[j].w * v[j].w);
        const float rs = rsqrtf(wave_sum(ss) * (1.f / DM) + EPS);
        if (MODE == 2) {
            float* op = F.out + ((size_t)b * SEQ + (s - CTX)) * DM;
#pragma unroll
            for (int j = 0; j < 4; ++j) *(f32x4*)(op + 4 * lane + 256 * j) = v[j] * rs * *(const f32x4*)(gin(F, I_FG) + 4 * lane + 256 * j);
        } else {
            constexpr int l = MODE; const float* mp = modv + (size_t)(l * 3 + mv) * 6144; const float* ng = gin(F, I_N1G) + l * DM;
#pragma unroll
            for (int j = 0; j < 4; ++j) { const int c = 4 * lane + 256 * j; const f32x4 g = *(const f32x4*)(ng + c), sh = *(const f32x4*)(mp + c), sc = *(const f32x4*)(mp + 1024 + c);
                const f32x4 h = v[j] * rs * g * (1.f + sc) + sh; v2u o; o.x = pk2(h.x, h.y); o.y = pk2(h.z, h.w); *(v2u*)(h1 + (size_t)R * DM + c) = o; }
        }
    }
#undef NP_LOAD
}

struct PrepIn { v2u q; unsigned kv; float kr1, kr2, h1[3], h2[3]; float cm, sm, cg, sg; };
__device__ __forceinline__ void prep_load(Frame& F, int R, PrepIn& I) {
    const bf16* zr = (const bf16*)(F.ws + WS_Z) + (size_t)R * ZW; const int lane = F.lane;
    const int s = R % SB; const bool lat = s >= CTX; const int t = lat ? s - CTX : 0;
    const float* cosM = (const float*)(F.ws + WS_ROPE); const float* sinM = cosM + 8192 * 16; const float* cosG = sinM + 8192 * 16; const float* sinG = cosG + 8192 * 32;
    I.q = *(const v2u*)(zr + ZQ + 4 * lane); I.kv = *(const unsigned*)(zr + ZKV + 2 * lane);
    I.kr1 = bf2f(zr[ZKR + (lane & 15)]); I.kr2 = bf2f(zr[ZKR + 16 + (lane & 15)]);
#pragma unroll
    for (int p = 0; p < 3; ++p) { const bf16* hp = zr + ZGQ + (2 * p + (lane >> 5)) * 64; I.h1[p] = bf2f(hp[lane & 31]); I.h2[p] = bf2f(hp[(lane & 31) + 32]); }
    I.cm = cosM[(size_t)t * 16 + (lane & 15)]; I.sm = sinM[(size_t)t * 16 + (lane & 15)]; I.cg = cosG[(size_t)t * 32 + (lane & 31)]; I.sg = sinG[(size_t)t * 32 + (lane & 31)];
}
__device__ __forceinline__ void prep_store(Frame& F, int l, int R, const PrepIn& I) {
    bf16* zr = (bf16*)(F.ws + WS_Z) + (size_t)R * ZW; const int lane = F.lane;
    const bool lat = (R % SB) >= CTX;
    {
        const float x0 = bflo(I.q.x), x1 = bfhi(I.q.x), x2 = bflo(I.q.y), x3 = bfhi(I.q.y);
        const float rs = rsqrtf(wave_sum((x0 * x0 + x1 * x1) + (x2 * x2 + x3 * x3)) * (1.f / 256) + EPS);
        const f32x4 g = *(const f32x4*)(gin(F, I_QNG) + l * 256 + 4 * lane);
        v2u o; o.x = pk2(x0 * rs * g.x, x1 * rs * g.y); o.y = pk2(x2 * rs * g.z, x3 * rs * g.w); *(v2u*)(zr + ZQ + 4 * lane) = o; }
    {
        const float x0 = bflo(I.kv), x1 = bfhi(I.kv);
        const float rs = rsqrtf(wave_sum(x0 * x0 + x1 * x1) * (1.f / 128) + EPS);
        const f32x2 g = *(const f32x2*)(gin(F, I_KVNG) + l * 128 + 2 * lane);
        *(unsigned*)(zr + ZKV + 2 * lane) = pk2(x0 * rs * g.x, x1 * rs * g.y); }
    {
        const int i = lane & 15; float o1 = I.kr1, o2 = I.kr2;
        if (lat) { o1 = I.kr1 * I.cm - I.kr2 * I.sm; o2 = I.kr2 * I.cm + I.kr1 * I.sm; }
        const unsigned w = pk2(o1, o2);
        if (lane < 16) *(unsigned*)(zr + ZKR + 2 * i) = w; }
#pragma unroll
    for (int p = 0; p < 3; ++p) { const int hh = 2 * p + (lane >> 5), i = lane & 31; bf16* hp = zr + ZGQ + hh * 64;
        const float x1 = I.h1[p], x2 = I.h2[p];
        float ss = x1 * x1 + x2 * x2;
        ss += sx<1>(ss); ss += sx<2>(ss); ss += sx<4>(ss); ss += sx<8>(ss); ss += sx<16>(ss);
        const float rs = rsqrtf(ss * (1.f / 64) + EPS);
        const float* g = (p < 2 ? gin(F, I_GQG) : gin(F, I_GKG)) + l * 64;
        const float qs = (p < 2) ? C_GQA : 1.f;
        float y1 = x1 * rs * g[i] * qs, y2 = x2 * rs * g[i + 32] * qs;
        if (lat) { const float a = y1 * I.cg - y2 * I.sg, bb = y2 * I.cg + y1 * I.sg; y1 = a; y2 = bb; }
        hp[i] = (bf16)f2bf(y1); hp[i + 32] = (bf16)f2bf(y2); }
}
__device__ __forceinline__ void conv_tile(Frame& F, int l, int tile) {
    const int tid = F.tid, lane = F.lane, wave = F.wave; const int R0 = tile * 32;
    const int b = R0 / SB, s0 = R0 - b * SB; const bool isctx = s0 < CTX;
    const int seq_lo = b * SB + (isctx ? 0 : CTX), seq_hi = b * SB + (isctx ? CTX : SB);
    LAS float* U = (LAS float*)F.lds; LAS float* Y = U + 62 * 256;
    const bf16* z = (const bf16*)(F.ws + WS_Z);
    for (int it = tid; it < 62 * 32; it += 512) { const int rr = it >> 5, c8 = (it & 31) * 8; const int R = R0 - 15 + rr;
        f32x4 u0 = {0.f, 0.f, 0.f, 0.f}, u1 = u0;
        if (R >= seq_lo && R < seq_hi) { const v4u a = *(const v4u*)(z + (size_t)R * ZW + ZCA + c8), g = *(const v4u*)(z + (size_t)R * ZW + ZCB + c8);
            u0.x = bflo(a.x) * sigmoidf_(bflo(g.x)); u0.y = bfhi(a.x) * sigmoidf_(bfhi(g.x)); u0.z = bflo(a.y) * sigmoidf_(bflo(g.y)); u0.w = bfhi(a.y) * sigmoidf_(bfhi(g.y));
            u1.x = bflo(a.z) * sigmoidf_(bflo(g.z)); u1.y = bfhi(a.z) * sigmoidf_(bfhi(g.z)); u1.z = bflo(a.w) * sigmoidf_(bflo(g.w)); u1.w = bfhi(a.w) * sigmoidf_(bfhi(g.w)); }
        *(LAS f32x4*)(U + rr * 256 + c8) = u0; *(LAS f32x4*)(U + rr * 256 + c8 + 4) = u1; }
    __syncthreads();
    { const int c = tid & 255, hf = tid >> 8; const float* wp = gin(F, I_CVW) + (size_t)l * 31 * 256 + c; const float bias = gin(F, I_CVB)[l * 256 + c];
      float w[31];
#pragma unroll
      for (int j = 0; j < 31; ++j) w[j] = wp[j * 256];
#pragma unroll
      for (int ch = 0; ch < 2; ++ch) { const int r0 = hf * 16 + ch * 8; float win[38];
#pragma unroll
          for (int q = 0; q < 38; ++q) win[q] = U[(r0 + q) * 256 + c];
#pragma unroll
          for (int o = 0; o < 8; ++o) { float y = bias;
#pragma unroll
              for (int j = 0; j < 31; ++j) y = fmaf(win[o + j], w[j], y);
              Y[(r0 + o) * 256 + c] = y; } } }
    __syncthreads();
    { const float* lg = gin(F, I_LNG) + l * 256; const float* lb = gin(F, I_LNB) + l * 256; const float* mg = gin(F, I_MOG) + l * 1024 + 768; bf16* cat = (bf16*)(F.ws + WS_H1);
#pragma unroll
      for (int rr = 0; rr < 4; ++rr) { const int row = wave * 4 + rr; float y[4], sm = 0.f;
#pragma unroll
          for (int q = 0; q < 4; ++q) { y[q] = Y[row * 256 + lane + 64 * q]; sm += y[q]; }
          const float mean = wave_sum(sm) * (1.f / 256); float vs = 0.f;
#pragma unroll
          for (int q = 0; q < 4; ++q) { y[q] -= mean; vs += y[q] * y[q]; }
          const float rstd = rsqrtf(wave_sum(vs) * (1.f / 256) + EPS); float s2 = 0.f;
#pragma unroll
          for (int q = 0; q < 4; ++q) { const int c = lane + 64 * q; const float v = y[q] * rstd * lg[c] + lb[c]; y[q] = v * sigmoidf_(v); s2 += y[q] * y[q]; }
          const float rs = rsqrtf(wave_sum(s2) * (1.f / 256) + EPS);
#pragma unroll
          for (int q = 0; q < 4; ++q) { const int c = lane + 64 * q; cat[(size_t)(R0 + row) * DM + 768 + c] = (bf16)f2bf(y[q] * rs * mg[c]); } } }
    __syncthreads();
}
__device__ __forceinline__ void prep_phase(Frame& F, int l) {
    const int gw = F.vcu * NWAVES + F.wave, NGW = F.G * NWAVES;
    for (int R = gw; R < M; R += 2 * NGW) { PrepIn A, B; const bool two = R + NGW < M; prep_load(F, R, A); if (two) prep_load(F, R + NGW, B); prep_store(F, l, R, A); if (two) prep_store(F, l, R + NGW, B); }
#ifndef CONV_REP
#define CONV_REP 1
#endif
    for (int rep = 0; rep < CONV_REP; ++rep)
    for (int tile = F.vcu; tile < M / 32; tile += F.G) conv_tile(F, l, tile);
}

#ifndef ATT_TUNED
#define ATT_TUNED 1
#endif
__device__ __forceinline__ void attn_phase(Frame& F, int l, char* ldsg) {
    const bf16* z = (const bf16*)(F.ws + WS_Z); const bf16* qm = (const bf16*)(F.ws + WS_QM); const bf16* kvm = (const bf16*)(F.ws + WS_KVM); bf16* ob = (bf16*)(F.ws + WS_O);
    const float* cosM = (const float*)(F.ws + WS_ROPE);
    const int nctx = (l == 0) ? 16 : 0;
    for (int u = F.vcu; u < 512 + nctx; u += F.G) {
        int b, h; size_t rq, rk; int nk;
        if (u < 512) { const int bh = u >> 5, qb = u & 31; b = bh >> 3; h = bh & 7; rk = (size_t)b * SB; rq = rk + CTX + (size_t)qb * 256; nk = SB; }
        else { const int v = u - 512; b = v >> 3; h = v & 7; rk = (size_t)b * SB; rq = rk; nk = CTX; }
#if ATT_TUNED
        att2::attn_unit<96, QW, KVW, ZW, KVW, 8>(qm + rq * QW + 96 * h, kvm + rk * KVW + 128 * h, z + rk * ZW + ZKR, kvm + rk * KVW + 128 * h + 64, ob + rq * OW + 64 * h, (u < 512) ? cosM + (size_t)(u & 31) * 256 * 16 : nullptr, nk / 64, ldsg, F.tid);
#else
        att::attn_unit<96, QW, KVW, ZW, KVW>(qm + rq * QW + 96 * h, kvm + rk * KVW + 128 * h, z + rk * ZW + ZKR, kvm + rk * KVW + 128 * h + 64, ob + rq * OW + 64 * h, (u < 512) ? cosM + (size_t)(u & 31) * 256 * 16 : nullptr, nk, ldsg, F.tid);
#endif
    }
    const int nctx2 = (l == 0) ? 8 : 0;
    for (int u = F.vcu; u < 256 + nctx2; u += F.G) {
        int b, h; size_t rq, rk; int nk;
        if (u < 256) { const int bh = u >> 5, qb = u & 31; b = bh >> 2; h = bh & 3; rk = (size_t)b * SB; rq = rk + CTX + (size_t)qb * 256; nk = SB; }
        else { const int v = u - 256; b = v >> 2; h = v & 3; rk = (size_t)b * SB; rq = rk; nk = CTX; }
#if ATT_TUNED
        att2::attn_unit<64, ZW, ZW, ZW, ZW, 8>(z + rq * ZW + ZGQ + 64 * h, z + rk * ZW + ZGK + 64 * (h >> 1), nullptr, z + rk * ZW + ZGV + 64 * (h >> 1), ob + rq * OW + 512 + 64 * h, nullptr, nk / 64, ldsg, F.tid);
#else
        att::attn_unit<64, ZW, ZW, ZW, ZW>(z + rq * ZW + ZGQ + 64 * h, z + rk * ZW + ZGK + 64 * (h >> 1), nullptr, z + rk * ZW + ZGV + 64 * (h >> 1), ob + rq * OW + 512 + 64 * h, nullptr, nk, ldsg, F.tid);
#endif
    }
}

__device__ __forceinline__ void gnorm_phase(Frame& F, int l) {
    const int lane = F.lane, gw = F.vcu * NWAVES + F.wave, NGW = F.G * NWAVES;
    const bf16* ob = (const bf16*)(F.ws + WS_O); bf16* cat = (bf16*)(F.ws + WS_H1); const float* mg = gin(F, I_MOG) + l * 1024;
    const f32x4 g0 = *(const f32x4*)(mg + 8 * lane), g1 = *(const f32x4*)(mg + 8 * lane + 4), g2 = *(const f32x4*)(mg + 512 + 4 * lane);
    const int nrow = (l == 1) ? NB * SEQ : M;
#define GN_ROW(i_) ((l == 1) ? ((i_) / SEQ) * SB + CTX + ((i_) % SEQ) : (i_))
    for (int i = gw; i < nrow; i += 4 * NGW) {
        v4u a[4]; v2u c[4]; int R[4]; bool ok[4];
#pragma unroll
        for (int u = 0; u < 4; ++u) { const int ii = i + u * NGW; ok[u] = ii < nrow; R[u] = GN_ROW(ok[u] ? ii : i); a[u] = *(const v4u*)(ob + (size_t)R[u] * OW + 8 * lane); c[u] = *(const v2u*)(ob + (size_t)R[u] * OW + 512 + 4 * lane); }
#pragma unroll
        for (int u = 0; u < 4; ++u) { if (!ok[u]) continue;
            float x[8] = {bflo(a[u].x), bfhi(a[u].x), bflo(a[u].y), bfhi(a[u].y), bflo(a[u].z), bfhi(a[u].z), bflo(a[u].w), bfhi(a[u].w)}; float y[4] = {bflo(c[u].x), bfhi(c[u].x), bflo(c[u].y), bfhi(c[u].y)};
            float s1 = 0.f, s2 = 0.f;
#pragma unroll
            for (int k = 0; k < 8; ++k) s1 += x[k] * x[k];
#pragma unroll
            for (int k = 0; k < 4; ++k) s2 += y[k] * y[k];
            const float r1 = rsqrtf(wave_sum(s1) * (1.f / 512) + EPS), r2 = rsqrtf(wave_sum(s2) * (1.f / 256) + EPS);
            v4u o; o.x = pk2(x[0] * r1 * g0.x, x[1] * r1 * g0.y); o.y = pk2(x[2] * r1 * g0.z, x[3] * r1 * g0.w); o.z = pk2(x[4] * r1 * g1.x, x[5] * r1 * g1.y); o.w = pk2(x[6] * r1 * g1.z, x[7] * r1 * g1.w);
            *(v4u*)(cat + (size_t)R[u] * DM + 8 * lane) = o;
            v2u p; p.x = pk2(y[0] * r2 * g2.x, y[1] * r2 * g2.y); p.y = pk2(y[2] * r2 * g2.z, y[3] * r2 * g2.w);
            *(v2u*)(cat + (size_t)R[u] * DM + 512 + 4 * lane) = p; }
    }
#undef GN_ROW
}

#ifndef RT_ROWS
#define RT_ROWS 1
#endif
__device__ __forceinline__ void router_phase(Frame& F, int l) {
    constexpr int RT = RT_ROWS;
    const int tid = F.tid, lane = F.lane, gw = F.vcu * NWAVES + F.wave, NGW = F.G * NWAVES;
    LAS float* W = (LAS float*)F.lds; LAS float* G2 = W + 1024 * 20; LAS float* S2 = G2 + 3072;
    const float* rw = gin(F, I_RW) + (size_t)l * 1024 * 16; const float* n2 = gin(F, I_N2G) + l * DM; const float* modl = (const float*)(F.ws + WS_MOD) + (size_t)l * 3 * 6144;
    const float* xres = (const float*)(F.ws + WS_XRES); bf16* h2 = (bf16*)(F.ws + WS_H1); float* aff = (float*)(F.ws + WS_AFF);
    for (int i = tid; i < 4096; i += 512) *(LAS f32x4*)(W + (i >> 2) * 20 + (i & 3) * 4) = *(const f32x4*)(rw + 4 * i);
    for (int i = tid; i < 3072; i += 512) { const int mv = i >> 10, k = i & 1023; G2[i] = n2[k] * (1.f + modl[mv * 6144 + 4096 + k]); S2[i] = modl[mv * 6144 + 3072 + k]; }
    __syncthreads();
    const int ngrp = ((l == 1) ? NB * SEQ : M) / RT;
    for (int gi = gw; gi < ngrp; gi += NGW) {
        const int i0 = gi * RT; const int R0 = (l == 1) ? (i0 / SEQ) * SB + CTX + (i0 % SEQ) : i0;
        const int b = R0 / SB, s = R0 - b * SB; const int mv = (s < CTX) ? 2 : b;
        const float* xl = xres + (size_t)R0 * DM + lane; bf16* hl = h2 + (size_t)R0 * DM + lane;
        float x[RT][16]; float ss[RT];
#pragma unroll
        for (int u = 0; u < RT; ++u)
#pragma unroll
            for (int q = 0; q < 16; ++q) x[u][q] = xl[u * DM + 64 * q];
        float rs[RT];
#pragma unroll
        for (int u = 0; u < RT; ++u) {
            ss[u] = 0.f;
#pragma unroll
            for (int q = 0; q < 16; ++q) ss[u] += x[u][q] * x[u][q];
            asm volatile("" : "+v"(ss[u]));
            rs[u] = rsqrtf(wave_sum(ss[u]) * (1.f / DM) + EPS); }
        float acc[RT][16];
#pragma unroll
        for (int u = 0; u < RT; ++u)
#pragma unroll
            for (int e = 0; e < 16; ++e) acc[u][e] = 0.f;
#pragma unroll
        for (int q = 0; q < 16; ++q) { const int k = lane + 64 * q; const float g = G2[mv * 1024 + k], sh = S2[mv * 1024 + k];
            const LAS f32x4* wp = (const LAS f32x4*)(W + k * 20); const f32x4 w0 = wp[0], w1 = wp[1], w2 = wp[2], w3 = wp[3];
#pragma unroll
            for (int u = 0; u < RT; ++u) { float h = x[u][q] * rs[u] * g + sh; asm volatile("" : "+v"(h));
                hl[u * DM + 64 * q] = (bf16)f2bf(h);
#define RFMA(A_, W_) asm("v_fmac_f32_e32 %0, %1, %2" : "+v"(A_) : "v"(h), "v"(W_))
                RFMA(acc[u][0], w0.x); RFMA(acc[u][1], w0.y); RFMA(acc[u][2], w0.z); RFMA(acc[u][3], w0.w);
                RFMA(acc[u][4], w1.x); RFMA(acc[u][5], w1.y); RFMA(acc[u][6], w1.z); RFMA(acc[u][7], w1.w);
                RFMA(acc[u][8], w2.x); RFMA(acc[u][9], w2.y); RFMA(acc[u][10], w2.z); RFMA(acc[u][11], w2.w);
                RFMA(acc[u][12], w3.x); RFMA(acc[u][13], w3.y); RFMA(acc[u][14], w3.z); RFMA(acc[u][15], w3.w); }
#undef RFMA
            __builtin_amdgcn_sched_barrier(0); }
        const int e = ((lane & 1) << 3) | ((lane & 2) << 1) | ((lane & 4) >> 1) | ((lane & 8) >> 3);
#pragma unroll
        for (int u = 0; u < RT; ++u) {
#define RT_STAGE(ST) do { constexpr int half_ = 8 >> (ST); const bool up = (lane >> (ST)) & 1; \
                _Pragma("unroll") for (int j = 0; j < half_; ++j) { const float a = acc[u][j], c = acc[u][j + half_]; const float mine = up ? c : a, other = up ? a : c; acc[u][j] = mine + sx<(1 << (ST))>(other); } } while (0)
            RT_STAGE(0); RT_STAGE(1); RT_STAGE(2); RT_STAGE(3);
#undef RT_STAGE
            float lg = acc[u][0]; lg += sx<16>(lg); lg = sum32(lg);
            float mx = lg;
            mx = fmaxf(mx, sx<1>(mx)); mx = fmaxf(mx, sx<2>(mx)); mx = fmaxf(mx, sx<4>(mx)); mx = fmaxf(mx, sx<8>(mx));
            const float p = __expf(lg - mx); float sum = p;
            sum += sx<1>(sum); sum += sx<2>(sum); sum += sx<4>(sum); sum += sx<8>(sum);
            if (lane < 16) aff[(size_t)(R0 + u) * 16 + e] = p / sum; }
    }
}

template <int N, int KSEL>
__device__ __forceinline__ void topk_list(Frame& F, int R0, int e, int slot0) {
    constexpr int EPT = N >= 512 ? N / 512 : 1;
    LAS unsigned* keys = (LAS unsigned*)F.lds; LAS unsigned* hist = keys + 8192; LAS unsigned* wtot = hist + 256; LAS unsigned* sel = wtot + 16;
    const float* aff = (const float*)(F.ws + WS_AFF); int* inv = (int*)(F.ws + WS_INV); int* rowidx = (int*)(F.ws + WS_ROWIDX);
    const int tid = F.tid, lane = F.lane, wave = F.wave;
    for (int i = tid; i < N; i += 512) keys[i] = __float_as_uint(aff[(size_t)(R0 + i) * 16 + e]);
    unsigned prefix = 0u; unsigned kneed = KSEL;
    for (int pass = 0; pass < 4; ++pass) {
        const int shift = 24 - 8 * pass;
        if (tid < 256) hist[tid] = 0u;
        __syncthreads();
        if (pass == 0) {
            for (int i = tid; i < N; i += 512) { const unsigned d = keys[i] >> 24; unsigned long long todo = __ballot(1);
                while (todo) { const int ln = __builtin_ctzll(todo); const unsigned d0 = __builtin_amdgcn_readlane(d, ln); const unsigned long long m = __ballot(d == d0) & todo;
                    if (lane == ln) (void)__hip_atomic_fetch_add(&hist[d0], (unsigned)__builtin_popcountll(m), __ATOMIC_RELAXED, __HIP_MEMORY_SCOPE_WORKGROUP); todo &= ~m; } }
        } else {
        for (int i = tid; i < N; i += 512) { const unsigned k = keys[i]; const unsigned hiq = (unsigned)((unsigned long long)k >> (shift + 8));
            if (hiq == prefix) (void)__hip_atomic_fetch_add(&hist[(k >> shift) & 255u], 1u, __ATOMIC_RELAXED, __HIP_MEMORY_SCOPE_WORKGROUP); }
        }
        __syncthreads();
        unsigned v = 0u, incl = 0u;
        if (tid < 256) { v = hist[255 - tid]; incl = v;
            incl = wave_scan_incl(incl, lane);
            if (lane == 63) wtot[wave] = incl; }
        __syncthreads();
        if (tid < 256) { unsigned off = 0u; for (int w = 0; w < wave; ++w) off += wtot[w]; incl += off; const unsigned excl = incl - v;
            if (incl >= kneed && excl < kneed) { sel[0] = 255u - (unsigned)tid; sel[1] = kneed - excl; } }
        __syncthreads();
        prefix = (prefix << 8) | sel[0]; kneed = sel[1];
        __syncthreads();
    }
    const unsigned T = prefix; const int cgt = KSEL - (int)kneed;
    unsigned cnt = 0u; const int base = tid * EPT;
    if (base < N) {
#pragma unroll
        for (int q = 0; q < EPT; ++q) { const unsigned k = keys[base + q]; cnt += (k > T) ? 1u : 0u; cnt += (k == T) ? 0x10000u : 0u; } }
    unsigned incl = wave_scan_incl(cnt, lane);
    if (lane == 63) wtot[wave] = incl;
    __syncthreads();
    { unsigned off = 0u; for (int w = 0; w < wave; ++w) off += wtot[w]; incl += off; }
    const unsigned excl = incl - cnt; int pg = (int)(excl & 0xffffu), pe = (int)(excl >> 16);
    if (base < N) {
#pragma unroll
        for (int q = 0; q < EPT; ++q) { const unsigned k = keys[base + q]; int slot = -1;
            if (k > T) slot = pg++; else if (k == T) { if (pe < (int)kneed) slot = cgt + pe; ++pe; }
            const int R = R0 + base + q; inv[(size_t)R * 16 + e] = slot < 0 ? -1 : slot0 + slot;
            if (slot >= 0) rowidx[e * RPE + slot0 + slot] = R; } }
    __syncthreads();
}
__device__ __forceinline__ void topk_phase(Frame& F, int l) {
    if (l == 0) { int* rowidx = (int*)(F.ws + WS_ROWIDX);
        if (blockIdx.x < 6) { const int i = blockIdx.x * 512 + F.tid; rowidx[(i / 192) * RPE + 2112 + (i % 192)] = 0; } }
    const int njobs = (l == 0) ? 64 : 32;
    for (int job = blockIdx.x; job < njobs; job += F.G) {
        if (job < 32) { const int b = job >> 4, e = job & 15; topk_list<SEQ, 1024>(F, b * SB + CTX, e, b * 1024); }
        else { const int j = job - 32, b = j >> 4, e = j & 15; topk_list<CTX, 32>(F, b * SB, e, 2048 + b * 32); }
    }
}
__device__ __forceinline__ void gather_phase(Frame& F, int l) {
    const int lane = F.lane, gw = F.vcu * NWAVES + F.wave, NGW = F.G * NWAVES; const int nrows = (l == 0) ? 2112 : 2048;
    const int* rowidx = (const int*)(F.ws + WS_ROWIDX); const bf16* h2 = (const bf16*)(F.ws + WS_H1); bf16* xg = (bf16*)(F.ws + WS_XG);
    for (int g = gw; g < NE * nrows; g += NGW) { const int e = g / nrows, slot = g - e * nrows; const int R = rowidx[e * RPE + slot];
        const v4u* src = (const v4u*)(h2 + (size_t)R * DM); v4u* dst = (v4u*)(xg + ((size_t)e * RPE + slot) * DM);
        const v4u a = src[lane], c = src[64 + lane]; dst[lane] = a; dst[64 + lane] = c; }
}

struct Args { const float* in[26]; float* out; unsigned char* ws; int ph_lo, ph_hi, li, pad; };
__global__ void __launch_bounds__(NWAVES * 64, 2) fwd(Args args) {
    extern __shared__ __attribute__((aligned(16))) unsigned char lds[];
    Frame F;
    F.lds = (LAS unsigned char*)lds; F.MISC = (volatile LAS unsigned*)(F.lds + MISC_OFF);
    F.tid = threadIdx.x; F.lane = F.tid & 63; F.wave = __builtin_amdgcn_readfirstlane(F.tid >> 6);
    const int wv0 = F.wave;
    F.G = gridDim.x; { const int bx = blockIdx.x; F.vcu = (F.G % 8 == 0) ? (bx % 8) * (F.G / 8) + bx / 8 : bx; }
    const int vcu0 = F.vcu;
    F.ws = (unsigned char*)(GAS unsigned char*)args.ws; F.out = (float*)(GAS float*)args.out; F.ctl = (unsigned*)(GAS unsigned*)(args.ws + WS_CTL);
    F.in = args.in;
    if (F.tid < 64) F.MISC[F.tid] = 0u;
    __syncthreads();
    XcdBarrier bar = xcd_barrier_post(F.ctl + CW_BAR + args.li * XCD_BAR_WORDS, F.MISC + 8);
    const int lo = args.ph_lo, hi = args.ph_hi;
#ifndef PH_EN
#define PH_EN 0xFFFF
#endif
#define IN(k) (lo <= (k) && (k) < hi)
#define INT(k, t) ((((PH_EN) >> (t)) & 1) && IN(k))
#ifndef REP_MASK
#define REP_MASK 0
#endif
#define REPS(t) (1 + (((REP_MASK) >> (t)) & 1))
#define RETID() do { int wq_ = wv0; asm volatile("" : "+s"(wq_)); int ln_; asm volatile("v_mbcnt_lo_u32_b32 %0, -1, 0\n\tv_mbcnt_hi_u32_b32 %0, -1, %0" : "=v"(ln_)); int t_ = wq_ * 64 + ln_; F.tid = t_; F.lane = t_ & 63; F.wave = __builtin_amdgcn_readfirstlane(t_ >> 6); unsigned long long w_ = (unsigned long long)args.ws; asm volatile("" : "+s"(w_)); F.ws = (unsigned char*)(GAS unsigned char*)w_; int v_ = vcu0; asm volatile("" : "+s"(v_)); F.vcu = v_; } while (0)
#ifndef BAR_REP
#define BAR_REP 1
#endif
#define SEAM(k) do { if (IN(k) && IN((k) + 1)) { for (int br = 0; br < BAR_REP; ++br) xcd_barrier(bar); } } while (0)
#define h1 ((bf16*)(F.ws + WS_H1))
#define z ((bf16*)(F.ws + WS_Z))
#define xg ((bf16*)(F.ws + WS_XG))
#define hid ((bf16*)(F.ws + WS_HID))

    if (INT(0, 0)) { for (int rep = 0; rep < REPS(0); ++rep) { RETID(); ph0(F); if (REPS(0) > 1) __syncthreads(); } SEAM(0); }
    for (int l = 0; l < 2; ++l) {
        const int pb = 1 + 13 * l;
        if (INT(pb + 0, 1)) { for (int rep = 0; rep < REPS(1); ++rep) { RETID(); if (l == 0) norm_phase<0>(F); else norm_phase<1>(F); } SEAM(pb + 0); }
        if (INT(pb + 1, 2)) { for (int rep = 0; rep < REPS(2); ++rep) { RETID();
            pg8::Gemm g{h1, (const bf16*)(F.ws + WS_WIN) + (size_t)l * 1536 * 1024, 1024, 1024, nullptr}; pg8::RowOrder S; S.init(6, F.G, F.vcu, false);
            pg8::EpiStore E{z, ZW, 6};
            pg8::gemm_phase<pg8::EpiStore, pg8::RowOrder, true, true>(F.lds, g, S, E, F.tid);
            if (USE_WIN && rep == 0 && F.G == 256 && F.vcu >= 140) { RETID(); conv_window(F, l, l == 0 ? BASE_IN0 : BASE_IN1, F.vcu - 140, WIN_IN_NB, WIN_IN_IPW); }
            } SEAM(pb + 1); }
        if (INT(pb + 2, 3)) { for (int rep = 0; rep < REPS(3); ++rep) { RETID(); prep_phase(F, l); } SEAM(pb + 2); }
        if (INT(pb + 3, 4)) { for (int rep = 0; rep < REPS(4); ++rep) { RETID();
            { pg8::Gemm g{z + ZQ, (const bf16*)(F.ws + WS_WUQ) + (size_t)l * 768 * 256, 256, ZW, nullptr}; pg8::RowOrder S; S.init(3, F.G, F.vcu, false);
              pg8::EpiStore E{(bf16*)(F.ws + WS_QM), QW, 3};
              pg8::gemm_phase<pg8::EpiStore, pg8::RowOrder, true, true>(F.lds, g, S, E, F.tid); }
            RETID();
            { pg8::Gemm g{z + ZKV, (const bf16*)(F.ws + WS_WUKV) + (size_t)l * 1024 * 128, 128, ZW, nullptr}; pg8::RowOrder S; S.init(4, F.G, F.vcu, false);
              pg8::EpiStore E{(bf16*)(F.ws + WS_KVM), KVW, 4};
              pg8::gemm_phase<pg8::EpiStore, pg8::RowOrder, true, true>(F.lds, g, S, E, F.tid); }
            } if (IN(pb + 3) && IN(pb + 5)) xcd_barrier(bar); }
        if (INT(pb + 5, 6)) { for (int rep = 0; rep < REPS(6); ++rep) { RETID(); attn_phase(F, l, (char*)lds); } SEAM(pb + 5); }
        if (INT(pb + 6, 7)) { for (int rep = 0; rep < REPS(7); ++rep) { RETID(); gnorm_phase(F, l); } SEAM(pb + 6); }
        if (INT(pb + 7, 8)) { for (int rep = 0; rep < REPS(8); ++rep) { RETID();
            pg8::Gemm g{h1, (const bf16*)(F.ws + WS_WOUT) + (size_t)l * 1024 * 1024, 1024, 1024, nullptr}; pg8::RowOrder S; S.init(4, F.G, F.vcu, l == 1);
            pg8::EpiRes E{gin(F, I_X), gin(F, I_CTX), (float*)(F.ws + WS_XRES), (const float*)(F.ws + WS_MOD) + (size_t)l * 3 * 6144 + 2048, l};
            pg8::gemm_phase<pg8::EpiRes, pg8::RowOrder, true, true>(F.lds, g, S, E, F.tid);
            if (USE_WIN && rep == 0 && l == 0 && F.G == 256 && F.vcu >= 8) { RETID(); conv_window(F, 0, BASE_OUT0, F.vcu - 8, WIN_OUT_NB, WIN_OUT_IPW); }
            } SEAM(pb + 7); }
        if (INT(pb + 8, 9)) { for (int rep = 0; rep < REPS(9); ++rep) { RETID(); router_phase(F, l); } SEAM(pb + 8); }
        if (INT(pb + 9, 10)) { for (int rep = 0; rep < REPS(10); ++rep) { RETID(); topk_phase(F, l);
            if (USE_WIN && rep == 0 && F.G == 256) { const int nj = (l == 0) ? 64 : 32; if ((int)blockIdx.x >= nj) conv_window(F, l, l == 0 ? BASE_TK0 : BASE_TK1, (int)blockIdx.x - nj, 256 - nj, WIN_TK_IPW); }
            } if (IN(pb + 9) && IN(pb + 11)) xcd_barrier(bar); }
        if (INT(pb + 11, 12)) { for (int rep = 0; rep < REPS(12); ++rep) { RETID();
            pg8::Gemm g{h1, (const bf16*)(F.ws + WS_W13) + (size_t)l * 16 * 5376 * 1024, 1024, 1024, (const int*)(F.ws + WS_ROWIDX)};     pg8::MoeOrder S; S.init(l == 0 ? 9 : 8, 21, F.G, F.vcu);
            pg8::EpiSwiglu E{hid};
            pg8::gemm_phase<pg8::EpiSwiglu, pg8::MoeOrder, false, true, true>(F.lds, g, S, E, F.tid);
            } SEAM(pb + 11); }
        if (INT(pb + 12, 13)) { for (int rep = 0; rep < REPS(13); ++rep) { RETID();
            pg8::Gemm g{hid, (const bf16*)(F.ws + WS_W2) + (size_t)l * 16 * 1024 * FF, FF, FF, nullptr}; pg8::MoeOrder S; S.init(l == 0 ? 9 : 8, 4, F.G, F.vcu);
            pg8::EpiStore E{xg, DM, 4};
            pg8::gemm_phase<pg8::EpiStore, pg8::MoeOrder, true, true>(F.lds, g, S, E, F.tid);
            if (USE_WIN && rep == 0 && l == 0 && F.G == 256 && (F.vcu & 31) >= 8) { RETID(); conv_window(F, 1, BASE_M2, (F.vcu >> 5) * 24 + (F.vcu & 31) - 8, WIN_M2_NB, WIN_M2_IPW); }
            } SEAM(pb + 12); }
    }
    if (INT(27, 14)) { for (int rep = 0; rep < REPS(14); ++rep) { RETID(); norm_phase<2>(F); } }
#undef h1
#undef z
#undef xg
#undef hid
#undef IN
#undef INT
#undef REPS
#undef SEAM
}

#ifndef MK_MULTI
#define MK_MULTI 0
#endif
extern "C" void kernel_launch(void* const* d_in, const int* in_sizes, int n_in, void* d_out, int out_size, void* d_ws, size_t ws_size, hipStream_t stream) {
    static int grid = 0;
    if (grid == 0) {
        if (n_in != 26 || in_sizes[0] != NB * SEQ * DM || out_size != NB * SEQ * DM || ws_size < WS_END) { fprintf(stderr, "kernel_launch: shape / workspace mismatch (n_in %d, ws %zu)\n", n_in, ws_size); grid = -1; return; }
        int dev = 0, cus = 0, per_cu = 0;
        if (hipGetDevice(&dev) != hipSuccess || hipDeviceGetAttribute(&cus, hipDeviceAttributeMultiprocessorCount, dev) != hipSuccess) { grid = -1; return; }
        if (hipFuncSetAttribute((const void*)fwd, hipFuncAttributeMaxDynamicSharedMemorySize, LDS_BYTES) != hipSuccess) { fprintf(stderr, "kernel_launch: hipFuncSetAttribute failed\n"); grid = -1; return; }
        if (hipOccupancyMaxActiveBlocksPerMultiprocessor(&per_cu, (const void*)fwd, NWAVES * 64, LDS_BYTES) != hipSuccess || per_cu < 1) { fprintf(stderr, "kernel_launch: occupancy query reports %d\n", per_cu); (void)hipGetLastError(); per_cu = 1; }
        grid = cus;
    }
    if (grid < 0) return;
    if (hipMemsetAsync((char*)d_ws + WS_CTL, 0, CTL_ZERO_BYTES, stream) != hipSuccess) return;
    Args a{};
    for (int i = 0; i < 26; ++i) a.in[i] = (const float*)d_in[i];
    a.out = (float*)d_out; a.ws = (unsigned char*)d_ws; a.pad = 0;
#if MK_MULTI
    for (int p = 0; p < NPHASE; ++p) { a.ph_lo = p; a.ph_hi = p + 1; a.li = p; hipLaunchKernelGGL(fwd, dim3(grid), dim3(NWAVES * 64), LDS_BYTES, stream, a); }
#else
    a.ph_lo = 0; a.ph_hi = NPHASE; a.li = 0;
    hipLaunchKernelGGL(fwd, dim3(grid), dim3(NWAVES * 64), LDS_BYTES, stream, a);
#endif
    const hipError_t le = hipPeekAtLastError();
    if (le != hipSuccess) fprintf(stderr, "kernel_launch: launch failed: %s\n", hipGetErrorName(le));
}
```

```cpp
#include <hip/hip_runtime.h>
#include <cstdio>
#include <cstdint>

#define GAS __attribute__((address_space(1)))
#define LAS __attribute__((address_space(3)))
typedef unsigned short bf16;
typedef unsigned v4u __attribute__((ext_vector_type(4)));
typedef unsigned v2u __attribute__((ext_vector_type(2)));
typedef float f32x4 __attribute__((ext_vector_type(4)));
typedef float f32x2 __attribute__((ext_vector_type(2)));
typedef short bf16x8 __attribute__((ext_vector_type(8)));
typedef short s16x4 __attribute__((ext_vector_type(4)));
typedef float f32x16 __attribute__((ext_vector_type(16)));
#define LDS_WAIT() asm volatile("s_waitcnt lgkmcnt(0)" ::: "memory")
#define VM_WAIT() asm volatile("s_waitcnt vmcnt(0)" ::: "memory")

constexpr int DM = 1024, SEQ = 8192, CTX = 256, NB = 2, SB = SEQ + CTX, M = NB * SB, NPM = M / 256, PPB = SB / 256;
constexpr int ZW = 1536, QW = 768, KVW = 1024, OW = 768, FF = 2688, NE = 16, RPE = 2304;
#ifndef HIDP
#define HIDP 2688
#endif
#ifndef W2P
#define W2P 2688
#endif
constexpr int ZQ = 0, ZKV = 256, ZKR = 384, ZGQ = 416, ZGK = 672, ZGV = 800, ZCA = 928, ZCB = 1184;
constexpr float EPS = 1e-6f;
constexpr float LOG2E = 1.4426950408889634f;
constexpr float C_MLA = 0.10206207261596575f * LOG2E, C_GQA = 0.125f * LOG2E;

__device__ __forceinline__ unsigned f2bf(float f) { unsigned u = __builtin_bit_cast(unsigned, f); return (u + 0x7fffu + ((u >> 16) & 1u)) >> 16; }
__device__ __forceinline__ unsigned pk2(float lo, float hi) { unsigned r; asm volatile("v_cvt_pk_bf16_f32 %0, %1, %2" : "=v"(r) : "v"(lo), "v"(hi)); return r; }
__device__ __forceinline__ float bf2f(unsigned short h) { return __builtin_bit_cast(float, (unsigned)h << 16); }
__device__ __forceinline__ float bflo(unsigned w) { return __builtin_bit_cast(float, w << 16); }
__device__ __forceinline__ float bfhi(unsigned w) { return __builtin_bit_cast(float, w & 0xffff0000u); }
#ifndef OLD_SX
#define OLD_SX 0
#endif
#ifndef OLD_SCAN
#define OLD_SCAN 0
#endif
template <int X> __device__ __forceinline__ float sx(float v) { if (OLD_SX) return __shfl_xor(v, X); return __builtin_bit_cast(float, __builtin_amdgcn_ds_swizzle(__builtin_bit_cast(int, v), (X << 10) | 0x1f)); }
#ifndef OLD_S32
#define OLD_S32 OLD_SX
#endif
__device__ __forceinline__ float sum32(float v) {
    if (OLD_S32) return v + __shfl_xor(v, 32);
    float a_ = v, b_ = v; asm volatile("s_nop 1\n\tv_permlane32_swap_b32 %0, %1" : "+v"(a_), "+v"(b_)); return a_ + b_; }
__device__ __forceinline__ float wave_sum(float v) { v += sx<1>(v); v += sx<2>(v); v += sx<4>(v); v += sx<8>(v); v += sx<16>(v); return sum32(v); }
template <int N> __device__ __forceinline__ void wave_sum_n(float (&v)[N]) {
    float t[N];
#define WS_STEP(X) _Pragma("unroll") for (int i = 0; i < N; ++i) t[i] = sx<X>(v[i]); _Pragma("unroll") for (int i = 0; i < N; ++i) v[i] += t[i];
    WS_STEP(1) WS_STEP(2) WS_STEP(4) WS_STEP(8) WS_STEP(16)
#undef WS_STEP
#pragma unroll
    for (int i = 0; i < N; ++i) v[i] = sum32(v[i]);
}
template <int N> __device__ __forceinline__ void half_sum_n(float (&v)[N]) {
    float t[N];
#define WS_STEP(X) _Pragma("unroll") for (int i = 0; i < N; ++i) t[i] = sx<X>(v[i]); _Pragma("unroll") for (int i = 0; i < N; ++i) v[i] += t[i];
    WS_STEP(1) WS_STEP(2) WS_STEP(4) WS_STEP(8) WS_STEP(16)
#undef WS_STEP
}
__device__ __forceinline__ unsigned wave_scan_incl(unsigned v, int lane) {
    if (OLD_SCAN) { for (int o = 1; o < 64; o <<= 1) { const unsigned n = __shfl_up(v, o); if (lane >= o) v += n; } return v; }
    v += (unsigned)__builtin_amdgcn_update_dpp(0, (int)v, 0x111, 0xf, 0xf, false);
    v += (unsigned)__builtin_amdgcn_update_dpp(0, (int)v, 0x112, 0xf, 0xf, false);
    v += (unsigned)__builtin_amdgcn_update_dpp(0, (int)v, 0x114, 0xf, 0xf, false);
    v += (unsigned)__builtin_amdgcn_update_dpp(0, (int)v, 0x118, 0xf, 0xf, false);
    const unsigned s0 = __builtin_amdgcn_readlane(v, 15), s1 = __builtin_amdgcn_readlane(v, 31), s2 = __builtin_amdgcn_readlane(v, 47);
    return v + (lane >= 16 ? s0 : 0u) + (lane >= 32 ? s1 : 0u) + (lane >= 48 ? s2 : 0u);
}
__device__ __forceinline__ float sigmoidf_(float v) { return 1.f / (1.f + __expf(-v)); }

namespace pg8 {
#define PG8_LAS __attribute__((address_space(3)))
typedef unsigned short bf16_t;
typedef short bf16x8 __attribute__((ext_vector_type(8)));
typedef float f32x4 __attribute__((ext_vector_type(4)));
typedef unsigned u32x4 __attribute__((ext_vector_type(4)));
constexpr int BM = 256, BK = 64, HALF = 128, HTB = HALF * BK * 2  , STAGE_BYTES = 8 * HTB;

__host__ __device__ __forceinline__ int lds_byte(int r, int c) { const int st = (r >> 4) * 2 + (c >> 5), rr = r & 15, cc = c & 31, ob = rr * 64 + cc * 2; return st * 1024 + (ob ^ (((ob >> 9) & 1) << 5)); }
__host__ __device__ __forceinline__ void stage_rc(int b, int& R, int& C) { const int st = b / 1024, sb = b % 1024, swz = sb ^ (((sb >> 9) & 1) << 5); R = (st >> 1) * 16 + swz / 64; C = (st & 1) * 32 + (swz % 64) / 2; }
__host__ __device__ __forceinline__ int perm32(int rho) { const int n = rho >> 4, i = rho & 15; return 8 * (i >> 2) + 4 * n + (i & 3); }

struct Unit { int pm, pn; };
struct Gemm { const bf16_t* A; const bf16_t* Bt; int K, lda; const int* gidx; int ldb = 0;   };


__device__ __forceinline__ void tile_of(int L, int nM, int nN, int& pm, int& pn) {
    const int nig = 8 * nN, gid = L / nig, fm = gid * 8, gsz = (nM - fm) < 8 ? (nM - fm) : 8, r = L % nig;
    pm = fm + r % gsz; pn = r / gsz;
}
struct RowOrder {
    int nM, nN, nwg, G, c; bool skip;
    __device__ __forceinline__ void init(int nN_, int G_, int c_, bool skip_ctx) { skip = skip_ctx; nM = skip_ctx ? 64 : 66; nN = nN_; nwg = nM * nN; G = G_; c = c_; }
    __device__ __forceinline__ bool next(int i, Unit& u) const {
        const int L = i * G + c; if (L >= nwg) return false;
        int pm, pn; tile_of(L, nM, nN, pm, pn);
        u.pm = skip ? pm + 1 + (pm >> 5) : pm; u.pn = pn; return true;
    }
    __device__ __forceinline__ void a_ready(const Unit&) const {}
    __device__ __forceinline__ void done(const Unit&) const {}
};
struct GroupOrder {
    int p0, np, nN, cpg, j; bool skip;
    __device__ __forceinline__ void init(int nN_, int p0_, int np_, int cpg_, int j_, bool skip_ctx) { nN = nN_; p0 = p0_; np = np_; cpg = cpg_; j = j_; skip = skip_ctx; }
    __device__ __forceinline__ bool next(int i, Unit& u) const {
        const int q = i * cpg + j; if (q >= np * nN || j >= cpg) return false;
        const int lp = p0 + q % np; u.pm = skip ? lp + 1 + (lp >> 5) : lp; u.pn = q / np; return true;
    }
    __device__ __forceinline__ void a_ready(const Unit&) const {}
    __device__ __forceinline__ void done(const Unit&) const {}
};
struct MoeOrder {
    int nMe, nNe, per, cpg, grp, j, epg;
    __device__ __forceinline__ void init(int nMe_, int nNe_, int G, int vcu) {
        nMe = nMe_; nNe = nNe_; per = nMe * nNe; const int ngrp = (G % 8 == 0) ? 8 : 1; cpg = G / ngrp; grp = vcu / cpg; j = vcu % cpg; epg = 16 / ngrp;
    }
    __device__ __forceinline__ bool next(int i, Unit& u) const {
        const int q = i * cpg + j; if (q >= epg * per) return false;
        const int e = grp * epg + q / per, r = q % per; u.pm = e * 9 + r % nMe; u.pn = e * nNe + r / nMe; return true;
    }
    __device__ __forceinline__ void a_ready(const Unit&) const {}
    __device__ __forceinline__ void done(const Unit&) const {}
};

#ifndef WT_STORES
#define WT_STORES 0
#endif
__device__ __forceinline__ void st16(void* p, u32x4 v) {
    if (WT_STORES == 1) asm volatile("global_store_dwordx4 %0, %1, off sc1\n\ts_nop 1" :: "v"(p), "v"(v) : "memory");     else if (WT_STORES == 2) __builtin_nontemporal_store(v, (u32x4*)p); else *(u32x4*)p = v; }
struct EpiStore {
    static constexpr bool PERM = true, AFTER_DRAIN = false;
    bf16_t* O; int ldc; int nNloc;
    __device__ __forceinline__ void operator()(const f32x4 (&acc)[2][2][4][2], const Unit& u, int wr, int wc, int fr, int fq) const {
        const int row0 = u.pm * BM + wr * 64 + fr, col0 = (u.pn % nNloc) * BM + wc * 32 + 8 * fq;
#pragma unroll
        for (int ai = 0; ai < 2; ++ai)
#pragma unroll
            for (int m = 0; m < 4; ++m) { bf16_t* rowp = O + (size_t)(row0 + ai * HALF + m * 16) * ldc + col0;
#pragma unroll
                for (int bj = 0; bj < 2; ++bj) { const f32x4 v0 = acc[ai][bj][m][0], v1 = acc[ai][bj][m][1];
                    u32x4 w; w.x = pk2(v0[0], v0[1]); w.y = pk2(v0[2], v0[3]); w.z = pk2(v1[0], v1[1]); w.w = pk2(v1[2], v1[3]);
                    st16(rowp + bj * HALF, w); } }
    }
};
struct EpiQ {
    static constexpr bool PERM = true, AFTER_DRAIN = false;
    bf16_t* O; const float* cosM; const float* sinM;
    __device__ __forceinline__ void operator()(const f32x4 (&acc)[2][2][4][2], const Unit& u, int wr, int wc, int fr, int fq) const {
        const int row0 = u.pm * BM + wr * 64 + fr, col0 = u.pn * BM + wc * 32 + 8 * fq;
        const int pb = u.pm % PPB; const bool lat = pb != 0; const int t0 = (pb - 1) * 256 + wr * 64 + fr;
#pragma unroll
        for (int ai = 0; ai < 2; ++ai)
#pragma unroll
            for (int m = 0; m < 4; ++m) { bf16_t* rowp = O + (size_t)(row0 + ai * HALF + m * 16) * QW + col0; const int t = t0 + ai * HALF + m * 16;
#pragma unroll
                for (int bj = 0; bj < 2; ++bj) { f32x4 v0 = acc[ai][bj][m][0], v1 = acc[ai][bj][m][1];
                    const int g32 = u.pn * 8 + bj * 4 + wc;
                    if (lat && (g32 % 3) == 2) {
                        const f32x4 c = *(const f32x4*)(cosM + (size_t)t * 16 + 4 * fq), s = *(const f32x4*)(sinM + (size_t)t * 16 + 4 * fq);
                        const f32x4 a0 = v0, a1 = v1;
                        v0[0] = a0[0] * c[0] - a0[1] * s[0]; v0[1] = a0[1] * c[0] + a0[0] * s[0]; v0[2] = a0[2] * c[1] - a0[3] * s[1]; v0[3] = a0[3] * c[1] + a0[2] * s[1];
                        v1[0] = a1[0] * c[2] - a1[1] * s[2]; v1[1] = a1[1] * c[2] + a1[0] * s[2]; v1[2] = a1[2] * c[3] - a1[3] * s[3]; v1[3] = a1[3] * c[3] + a1[2] * s[3];
                    }
                    u32x4 w; w.x = pk2(v0[0], v0[1]); w.y = pk2(v0[2], v0[3]); w.z = pk2(v1[0], v1[1]); w.w = pk2(v1[2], v1[3]);
                    *(u32x4*)(rowp + bj * HALF) = w; } }
    }
};
#ifndef XRES_BF16
#define XRES_BF16 1
#endif
struct EpiRes {
    static constexpr bool PERM = true, AFTER_DRAIN = false;
    const float* xin; const float* cin; void* xres; const float* gate; int layer;
    __device__ __forceinline__ void operator()(const f32x4 (&acc)[2][2][4][2], const Unit& u, int wr, int wc, int fr, int fq) const {
        const int b = u.pm / PPB, pb = u.pm % PPB, mv = pb == 0 ? 2 : b;
        const int col0 = u.pn * BM + wc * 32 + 8 * fq; const float* gp = gate + mv * 6144 + col0;
        f32x4 gv[2][2];
#pragma unroll
        for (int bj = 0; bj < 2; ++bj)
#pragma unroll
            for (int n = 0; n < 2; ++n) gv[bj][n] = *(const f32x4*)(gp + bj * HALF + 4 * n);
#pragma unroll
        for (int ai = 0; ai < 2; ++ai)
#pragma unroll
            for (int m = 0; m < 4; ++m) { const int rl = ai * HALF + wr * 64 + m * 16 + fr; const size_t R = (size_t)u.pm * BM + rl;
                const float* sp = (pb == 0 ? cin + ((size_t)b * CTX + rl) * DM : xin + ((size_t)b * SEQ + (pb - 1) * 256 + rl) * DM) + col0;
#pragma unroll
                for (int bj = 0; bj < 2; ++bj) { f32x4 x0, x1;
                    if (layer == 0) { x0 = *(const f32x4*)(sp + bj * HALF); x1 = *(const f32x4*)(sp + bj * HALF + 4); }
                    else if (XRES_BF16) { const u32x4 w = *(const u32x4*)((const bf16_t*)xres + R * DM + col0 + bj * HALF);
                        x0 = (f32x4){bflo(w.x), bfhi(w.x), bflo(w.y), bfhi(w.y)}; x1 = (f32x4){bflo(w.z), bfhi(w.z), bflo(w.w), bfhi(w.w)}; }
                    else { const float* xp = (const float*)xres + R * DM + col0 + bj * HALF; x0 = *(const f32x4*)xp; x1 = *(const f32x4*)(xp + 4); }
                    const f32x4 o0 = x0 + gv[bj][0] * acc[ai][bj][m][0], o1 = x1 + gv[bj][1] * acc[ai][bj][m][1];
                    if (XRES_BF16) { u32x4 w; w.x = pk2(o0[0], o0[1]); w.y = pk2(o0[2], o0[3]); w.z = pk2(o1[0], o1[1]); w.w = pk2(o1[2], o1[3]); *(u32x4*)((bf16_t*)xres + R * DM + col0 + bj * HALF) = w; }
                    else { float* op = (float*)xres + R * DM + col0 + bj * HALF; *(f32x4*)op = o0; *(f32x4*)(op + 4) = o1; } } }
    }
};
struct EpiSwiglu {
    static constexpr bool PERM = true, AFTER_DRAIN = false;
    bf16_t* H;
    __device__ __forceinline__ void operator()(const f32x4 (&acc)[2][2][4][2], const Unit& u, int wr, int wc, int fr, int fq) const {
        const int row0 = u.pm * BM + wr * 64 + fr, col0 = (u.pn % 21) * HALF + wc * 32 + 8 * fq;
#pragma unroll
        for (int ai = 0; ai < 2; ++ai)
#pragma unroll
            for (int m = 0; m < 4; ++m) { bf16_t* rowp = H + (size_t)(row0 + ai * HALF + m * 16) * HIDP + col0;
                float h[8];
#pragma unroll
                for (int n = 0; n < 2; ++n)
#pragma unroll
                    for (int i = 0; i < 4; i += 2) { const f32x2 a = {acc[ai][0][m][n][i], acc[ai][0][m][n][i + 1]}, b = {acc[ai][1][m][n][i], acc[ai][1][m][n][i + 1]};
                        const f32x2 t = a * (-LOG2E); f32x2 d = {__builtin_amdgcn_exp2f(t.x), __builtin_amdgcn_exp2f(t.y)}; d = d + 1.0f;
                        const f32x2 r = {__builtin_amdgcn_rcpf(d.x), __builtin_amdgcn_rcpf(d.y)}; const f32x2 o = (a * b) * r; h[n * 4 + i] = o.x; h[n * 4 + i + 1] = o.y; }
                u32x4 w; w.x = pk2(h[0], h[1]); w.y = pk2(h[2], h[3]); w.z = pk2(h[4], h[5]); w.w = pk2(h[6], h[7]);
                st16(rowp, w); }
    }
};

template <class Epi, class Sched, bool ALIGN_EPI = false, bool SP2 = false, bool GATHER = false, int BAUX = 0>
__device__ __forceinline__ void gemm_phase(PG8_LAS unsigned char* lds, const Gemm g, const Sched& S, const Epi& E, const int tid_in) {
    int tid_ = tid_in; asm volatile("" : "+v"(tid_));
    const int tid = tid_, wid = __builtin_amdgcn_readfirstlane(tid >> 6), lane = tid & 63, wr = wid >> 2, wc = wid & 3, fr = lane & 15, fq = lane >> 4;
    int K_ = g.K; asm volatile("" : "+s"(K_));
    const int K = K_, nt = K / BK; int ldb_ = g.ldb ? g.ldb : K_; asm volatile("" : "+s"(ldb_)); const int LDB = ldb_;
    unsigned voffA[2], voffB[2]; int gR[2]; unsigned gC[2];
#pragma unroll
    for (int i = 0; i < 2; ++i) { int R, C; stage_rc(tid * 16 + i * 8192, R, C); const int Rb = Epi::PERM ? ((R & ~31) + perm32(R & 31)) : R;
        voffA[i] = (unsigned)(R * g.lda + C) * 2u; voffB[i] = (unsigned)(Rb * LDB + C) * 2u; gR[i] = R; gC[i] = (unsigned)C * 2u; }
    unsigned vC[2][2], vN[2][2];
#define PG8_GIDX(dst, U) do { _Pragma("unroll") for (int h_ = 0; h_ < 2; ++h_) _Pragma("unroll") for (int i_ = 0; i_ < 2; ++i_) \
        dst[h_][i_] = (unsigned)g.gidx[(U).pm * BM + h_ * HALF + gR[i_]] * (unsigned)(g.lda * 2) + gC[i_]; } while (0)
#define PG8_STGA(bufoff, kptr, h, USEN) do { if constexpr (GATHER) { const unsigned vsel_[2] = {(USEN) ? vN[h][0] : vC[h][0], (USEN) ? vN[h][1] : vC[h][1]}; PG8_STAGE(bufoff, kptr, vsel_); } \
        else { PG8_STAGE(bufoff, (kptr) + (h) * hstepA, voffA); } } while (0)
    const size_t kstep = (size_t)(BK * 2);
    const size_t hstepA = (size_t)HALF * g.lda * 2, hstepB = (size_t)HALF * LDB * 2;
    const size_t tstepA = 2 * hstepA, tstepB = 2 * hstepB;
    const unsigned ldsw = (unsigned)wid * 1024u;
    const int aoff = lds_byte(wr * 64 + fr, fq * 8), boff = lds_byte(wc * 32 + fr, fq * 8);
#define PG8_SA(b, h) (((b) * 2 + (h)) * HTB)
#define PG8_SB(b, h) ((4 + (b) * 2 + (h)) * HTB)
#define PG8_STAGE(bufoff, gbase, voff) do { _Pragma("unroll") for (int _i = 0; _i < 2; ++_i) \
        __builtin_amdgcn_global_load_lds((const unsigned*)((const char*)(gbase) + (voff)[_i]), (PG8_LAS unsigned*)(lds + (bufoff) + ldsw + _i * 8192), 16, 0, 0); } while (0)
#define PG8_STAGEB(bufoff, gbase, voff) do { _Pragma("unroll") for (int _i = 0; _i < 2; ++_i) \
        __builtin_amdgcn_global_load_lds((const unsigned*)((const char*)(gbase) + (voff)[_i]), (PG8_LAS unsigned*)(lds + (bufoff) + ldsw + _i * 8192), 16, 0, BAUX); } while (0)
#define PG8_LDA(dst, b, h) do { _Pragma("unroll") for (int m = 0; m < 4; ++m) _Pragma("unroll") for (int k = 0; k < 2; ++k) dst[m][k] = *(const PG8_LAS bf16x8*)(lds + PG8_SA(b, h) + aoff + m * 2048 + k * 1024); } while (0)
#define PG8_LDB(dst, b, h) do { _Pragma("unroll") for (int n = 0; n < 2; ++n) _Pragma("unroll") for (int k = 0; k < 2; ++k) dst[n][k] = *(const PG8_LAS bf16x8*)(lds + PG8_SB(b, h) + boff + n * 2048 + k * 1024); } while (0)
#define PG8_MMA(ai, bj, At, Bt) do { __builtin_amdgcn_s_setprio(1); _Pragma("unroll") for (int m = 0; m < 4; ++m) _Pragma("unroll") for (int n = 0; n < 2; ++n) _Pragma("unroll") for (int k = 0; k < 2; ++k) \
        acc[ai][bj][m][n] = __builtin_amdgcn_mfma_f32_16x16x32_bf16(Bt[n][k], At[m][k], acc[ai][bj][m][n], 0, 0, 0); __builtin_amdgcn_s_setprio(0); } while (0)
#define PG8_WAIT_V(n) asm volatile("s_waitcnt vmcnt(" #n ")" ::: "memory")
#define PG8_WAIT_L(n) asm volatile("s_waitcnt lgkmcnt(" #n ")" ::: "memory")
#define PG8_BAR __builtin_amdgcn_s_barrier()
#define PG8_SCHED __builtin_amdgcn_sched_barrier(0)
    Unit cur, nxt; int ui = 0;
    if (!S.next(0, cur)) return;
    f32x4 acc[2][2][4][2];
#pragma unroll
    for (int a = 0; a < 2; ++a)
#pragma unroll
        for (int b = 0; b < 2; ++b)
#pragma unroll
            for (int m = 0; m < 4; ++m)
#pragma unroll
                for (int n = 0; n < 2; ++n) acc[a][b][m][n] = (f32x4){0.f, 0.f, 0.f, 0.f};
    bf16x8 At[4][2], B0[2][2], B1[2][2];
    const char* cA = (const char*)g.A + (GATHER ? (size_t)0 : (size_t)cur.pm * tstepA); const char* cB = (const char*)g.Bt + (size_t)cur.pn * tstepB;
    if constexpr (GATHER) { PG8_GIDX(vC, cur); }
    S.a_ready(cur);
    if constexpr (SP2) {
        PG8_STAGEB(PG8_SB(0, 0), cB, voffB); PG8_STAGEB(PG8_SB(0, 1), cB + hstepB, voffB); PG8_STGA(PG8_SA(0, 0), cA, 0, false); PG8_STGA(PG8_SA(0, 1), cA, 1, false);
        if (wr == 1) PG8_BAR;
        PG8_WAIT_V(2); PG8_BAR;
        PG8_STAGEB(PG8_SB(1, 0), cB + kstep, voffB); PG8_STGA(PG8_SA(1, 0), cA + kstep, 0, false); PG8_STAGEB(PG8_SB(1, 1), cB + hstepB + kstep, voffB);
        PG8_WAIT_V(6); PG8_BAR;
    } else {
        PG8_STAGEB(PG8_SB(0, 0), cB, voffB); PG8_STAGE(PG8_SA(0, 0), cA, voffA); PG8_STAGEB(PG8_SB(0, 1), cB + hstepB, voffB); PG8_STAGE(PG8_SA(0, 1), cA + hstepA, voffA);
        if (wr == 1) PG8_BAR;
        PG8_WAIT_V(4); PG8_BAR;
        PG8_STAGEB(PG8_SB(1, 0), cB + kstep, voffB); PG8_STAGE(PG8_SA(1, 0), cA + kstep, voffA); PG8_STAGEB(PG8_SB(1, 1), cB + hstepB + kstep, voffB);
        PG8_WAIT_V(6); PG8_BAR;
    }
    for (;;) {
        const bool has_next = S.next(ui + 1, nxt);
        const char* nA = (has_next && !GATHER) ? (const char*)g.A + (size_t)nxt.pm * tstepA : cA;
        if constexpr (GATHER) { if (has_next) { PG8_GIDX(vN, nxt); } else { _Pragma("unroll") for (int h_ = 0; h_ < 2; ++h_) { vN[h_][0] = vC[h_][0]; vN[h_][1] = vC[h_][1]; } } } const char* nB = has_next ? (const char*)g.Bt + (size_t)nxt.pn * tstepB : cB;
        for (int t = 0; t < nt; t += 2) {
            const bool last = (t == nt - 2);
            const char* a1 = cA + (size_t)(t + 1) * kstep;
            const char* a2 = last ? nA : cA + (size_t)(t + 2) * kstep; const char* b2 = last ? nB : cB + (size_t)(t + 2) * kstep;
            const char* a3 = a2 + kstep; const char* b3 = b2 + kstep;
            if (last && has_next) S.a_ready(nxt);
            if constexpr (SP2) {
            PG8_LDB(B0, 0, 0); PG8_LDB(B1, 0, 1); PG8_SCHED; PG8_LDA(At, 0, 0); PG8_STGA(PG8_SA(1, 1), a1, 1, false);
            PG8_WAIT_V(8); PG8_WAIT_L(0); PG8_BAR; PG8_MMA(0, 0, At, B0); PG8_MMA(0, 1, At, B1); PG8_BAR; PG8_SCHED;
            PG8_LDA(At, 0, 1); PG8_STAGEB(PG8_SB(0, 0), b2, voffB); PG8_STAGEB(PG8_SB(0, 1), b2 + hstepB, voffB); PG8_STGA(PG8_SA(0, 0), a2, 0, last);
            PG8_WAIT_V(8); PG8_WAIT_L(0); PG8_BAR; PG8_MMA(1, 0, At, B0); PG8_MMA(1, 1, At, B1); PG8_BAR; PG8_SCHED;
            PG8_LDB(B0, 1, 0); PG8_LDB(B1, 1, 1); PG8_SCHED; PG8_LDA(At, 1, 0); PG8_STGA(PG8_SA(0, 1), a2, 1, last);
            PG8_WAIT_V(8); PG8_WAIT_L(0); PG8_BAR; PG8_MMA(0, 0, At, B0); PG8_MMA(0, 1, At, B1); PG8_BAR; PG8_SCHED;
            PG8_LDA(At, 1, 1); PG8_STAGEB(PG8_SB(1, 0), b3, voffB); PG8_STAGEB(PG8_SB(1, 1), b3 + hstepB, voffB); PG8_STGA(PG8_SA(1, 0), a3, 0, last);
            PG8_WAIT_V(8); PG8_WAIT_L(0); PG8_BAR; PG8_MMA(1, 0, At, B0); PG8_MMA(1, 1, At, B1); PG8_BAR; PG8_SCHED;
            } else {
            PG8_LDB(B0, 0, 0); PG8_SCHED; PG8_LDA(At, 0, 0); PG8_STAGE(PG8_SA(1, 1), a1 + hstepA, voffA);
            PG8_WAIT_L(8); PG8_BAR; PG8_WAIT_L(0); PG8_MMA(0, 0, At, B0); PG8_BAR; PG8_SCHED;
            PG8_LDB(B1, 0, 1); PG8_STAGEB(PG8_SB(0, 0), b2, voffB);
            PG8_BAR; PG8_WAIT_L(0); PG8_MMA(0, 1, At, B1); PG8_BAR;
            PG8_LDA(At, 0, 1); PG8_STAGE(PG8_SA(0, 0), a2, voffA);
            PG8_BAR; PG8_WAIT_L(0); PG8_MMA(1, 0, At, B0); PG8_BAR; PG8_SCHED;
            PG8_STAGEB(PG8_SB(0, 1), b2 + hstepB, voffB);
            PG8_WAIT_V(6); PG8_BAR; PG8_MMA(1, 1, At, B1); PG8_BAR;
            PG8_LDB(B0, 1, 0); PG8_SCHED; PG8_LDA(At, 1, 0); PG8_STAGE(PG8_SA(0, 1), a2 + hstepA, voffA);
            PG8_WAIT_L(8); PG8_BAR; PG8_WAIT_L(0); PG8_MMA(0, 0, At, B0); PG8_BAR; PG8_SCHED;
            PG8_LDB(B1, 1, 1); PG8_STAGEB(PG8_SB(1, 0), b3, voffB);
            PG8_BAR; PG8_WAIT_L(0); PG8_MMA(0, 1, At, B1); PG8_BAR;
            PG8_LDA(At, 1, 1); PG8_STAGE(PG8_SA(1, 0), a3, voffA);
            PG8_BAR; PG8_WAIT_L(0); PG8_MMA(1, 0, At, B0); PG8_BAR; PG8_SCHED;
            PG8_STAGEB(PG8_SB(1, 1), b3 + hstepB, voffB);
            PG8_WAIT_V(6); PG8_BAR; PG8_MMA(1, 1, At, B1); PG8_BAR;
            }
        }
        if constexpr (ALIGN_EPI) { if (wr == 0) PG8_BAR; }
        if constexpr (!Epi::AFTER_DRAIN) { E(acc, cur, wr, wc, fr, fq); S.done(cur); }
        if (!has_next) break;
#pragma unroll
        for (int a = 0; a < 2; ++a)
#pragma unroll
            for (int b = 0; b < 2; ++b)
#pragma unroll
                for (int m = 0; m < 4; ++m)
#pragma unroll
                    for (int n = 0; n < 2; ++n) acc[a][b][m][n] = (f32x4){0.f, 0.f, 0.f, 0.f};
        cur = nxt; cA = nA; cB = nB; ++ui;
        if constexpr (GATHER) { _Pragma("unroll") for (int h_ = 0; h_ < 2; ++h_) { vC[h_][0] = vN[h_][0]; vC[h_][1] = vN[h_][1]; } }
        if constexpr (ALIGN_EPI) { if (wr == 1) PG8_BAR; }
    }
    PG8_WAIT_V(0);
    if constexpr (!ALIGN_EPI) { if (wr == 0) PG8_BAR; }
    PG8_BAR;
    if constexpr (Epi::AFTER_DRAIN) { E.fused(acc, cur, wr, wc, fr, fq, lds, wid, lane); S.done(cur); }
#undef PG8_SA
#undef PG8_SB
#undef PG8_STAGE
#undef PG8_STAGEB
#undef PG8_STGA
#undef PG8_GIDX
#undef PG8_LDA
#undef PG8_LDB
#undef PG8_MMA
#undef PG8_WAIT_V
#undef PG8_WAIT_L
#undef PG8_BAR
#undef PG8_SCHED
}
}

namespace att {
#define SBAR() __builtin_amdgcn_sched_barrier(0)
__device__ __forceinline__ int crow(int r, int hi) { return (r & 3) + 8 * (r >> 2) + 4 * hi; }
__device__ __forceinline__ unsigned cvtpk(float lo, float hi) { unsigned r; asm volatile("v_cvt_pk_bf16_f32 %0, %1, %2" : "=v"(r) : "v"(lo), "v"(hi)); return r; }

__device__ __forceinline__ void partialSM(f32x16& p0, f32x16& p1, float& mhat, f32x16& negm, float& alpha, const bool first, const float thr) {
  float pmax = p0[0];
#pragma unroll
  for (int r = 1; r < 16; ++r) pmax = fmaxf(pmax, p0[r]);
#pragma unroll
  for (int r = 0; r < 16; ++r) pmax = fmaxf(pmax, p1[r]);
  { auto rr = __builtin_amdgcn_permlane32_swap(__float_as_uint(pmax), __float_as_uint(pmax), false, false);
    pmax = fmaxf(__uint_as_float(rr[0]), __uint_as_float(rr[1])); }
  alpha = 1.f;
  if (__builtin_expect(first || __any(pmax > thr), 0)) {
    const float dl = first ? pmax : fmaxf(pmax, 0.f); mhat += dl;
#pragma unroll
    for (int r = 0; r < 16; ++r) { p0[r] -= dl; p1[r] -= dl; }
#pragma unroll
    for (int r = 0; r < 16; ++r) negm[r] = -mhat;
    asm volatile("" : "+v"(negm));
    alpha = first ? 1.f : __builtin_amdgcn_exp2f(-dl);
  }
#pragma unroll
  for (int r = 0; r < 16; ++r) p0[r] = __builtin_amdgcn_exp2f(p0[r]);
}
__device__ __forceinline__ void finishSM(f32x16& p0, f32x16& p1, float alpha, float& l_reg, bf16x8& pa0, bf16x8& pa1, bf16x8& pa2, bf16x8& pa3) {
#pragma unroll
  for (int r = 0; r < 16; ++r) p1[r] = __builtin_amdgcn_exp2f(p1[r]);
  float ps = 0;
#pragma unroll
  for (int r = 0; r < 16; ++r) ps += p0[r];
#pragma unroll
  for (int r = 0; r < 16; ++r) ps += p1[r];
  { auto rr = __builtin_amdgcn_permlane32_swap(__float_as_uint(ps), __float_as_uint(ps), false, false);
    ps = __uint_as_float(rr[0]) + __uint_as_float(rr[1]); }
  l_reg = l_reg * alpha + ps;
#define PK4(P, BASE, OUT) do { unsigned a0 = cvtpk(P[BASE + 0], P[BASE + 1]), a1 = cvtpk(P[BASE + 2], P[BASE + 3]);   \
    unsigned b0 = cvtpk(P[BASE + 4], P[BASE + 5]), b1 = cvtpk(P[BASE + 6], P[BASE + 7]);                              \
    auto r0 = __builtin_amdgcn_permlane32_swap(a0, b0, false, false); auto r1 = __builtin_amdgcn_permlane32_swap(a1, b1, false, false); \
    v4u w = {r0[0], r1[0], r0[1], r1[1]}; OUT = __builtin_bit_cast(bf16x8, w); } while (0)
  PK4(p0, 0, pa0); PK4(p0, 8, pa1); PK4(p1, 0, pa2); PK4(p1, 8, pa3);
#undef PK4
}
template <int ND, int KS>
__device__ __forceinline__ void qkt(f32x16& p0, f32x16& p1, const char* Ks, const bf16x8* qr, const f32x16& negm, int r32, int hi) {
#pragma unroll
  for (int d0 = 0; d0 < ND; ++d0) { const int cb = (d0 * 16 + hi * 8) * 2;
    const bf16x8 b0 = *reinterpret_cast<const bf16x8*>(Ks + r32 * KS + cb);
    const bf16x8 b1 = *reinterpret_cast<const bf16x8*>(Ks + (32 + r32) * KS + cb);
    p0 = __builtin_amdgcn_mfma_f32_32x32x16_bf16(b0, qr[d0], d0 == 0 ? negm : p0, 0, 0, 0);
    p1 = __builtin_amdgcn_mfma_f32_32x32x16_bf16(b1, qr[d0], d0 == 0 ? negm : p1, 0, 0, 0); }
}
__device__ __forceinline__ int v_st(int k, int c) { const int kk = (k & ~0xC) | ((k & 4) << 1) | ((k & 8) >> 1); return ((kk >> 3) * 2 + (c >> 5)) * 512 + ((kk & 7) * 32 + (c & 31)) * 2; }
__device__ __forceinline__ int v_rd_base(int lane) { return ((lane & 3) << 3) | (((lane >> 2) & 3) << 6) | (((lane >> 4) & 1) << 5) | (((lane >> 5) & 1) << 8); }
constexpr int v_rd_off(int d0, int ks, int half) { return ((2 * ks + half) * 2 + d0) * 512; }
template <int OFF> __device__ __forceinline__ s16x4 tr_read(int vb) {
  s16x4 r; asm volatile("ds_read_b64_tr_b16 %0, %1 offset:%2" : "=&v"(r) : "v"(vb), "i"(OFF) : "memory"); return r;
}
template <int D0> __device__ __forceinline__ void pv_one(f32x16& od, int vb, bf16x8 pa0, bf16x8 pa1, bf16x8 pa2, bf16x8 pa3) {
  const s16x4 l0 = tr_read<v_rd_off(D0, 0, 0)>(vb), h0 = tr_read<v_rd_off(D0, 0, 1)>(vb), l1 = tr_read<v_rd_off(D0, 1, 0)>(vb), h1 = tr_read<v_rd_off(D0, 1, 1)>(vb);
  const s16x4 l2 = tr_read<v_rd_off(D0, 2, 0)>(vb), h2 = tr_read<v_rd_off(D0, 2, 1)>(vb), l3 = tr_read<v_rd_off(D0, 3, 0)>(vb), h3 = tr_read<v_rd_off(D0, 3, 1)>(vb);
  asm volatile("s_waitcnt lgkmcnt(0)" ::: "memory"); SBAR();
#define PK(L, H) (bf16x8){L[0], L[1], L[2], L[3], H[0], H[1], H[2], H[3]}
  od = __builtin_amdgcn_mfma_f32_32x32x16_bf16(pa0, PK(l0, h0), od, 0, 0, 0);
  od = __builtin_amdgcn_mfma_f32_32x32x16_bf16(pa1, PK(l1, h1), od, 0, 0, 0);
  od = __builtin_amdgcn_mfma_f32_32x32x16_bf16(pa2, PK(l2, h2), od, 0, 0, 0);
  od = __builtin_amdgcn_mfma_f32_32x32x16_bf16(pa3, PK(l3, h3), od, 0, 0, 0);
#undef PK
}
__device__ __forceinline__ void pv_d0(f32x16* o, int vb, bf16x8 pa0, bf16x8 pa1, bf16x8 pa2, bf16x8 pa3) {
  pv_one<0>(o[0], vb, pa0, pa1, pa2, pa3); pv_one<1>(o[1], vb, pa0, pa1, pa2, pa3);
}

template <int DK, int LDQ, int LDK1, int LDK2, int LDV>
__device__ __forceinline__ void attn_unit(const bf16* __restrict__ Qb, const bf16* __restrict__ K1, const bf16* __restrict__ K2, const bf16* __restrict__ Vb,
                                          bf16* __restrict__ Ob, const float* ropeq, const int nkeys, char* lds, const int tid_in) {
  constexpr int ND = DK / 16, KS = DK * 2 + 16, SHM_K = 64 * KS, SHM_V = 8192;
  int tid_ = tid_in; asm volatile("" : "+v"(tid_));
  const int tid = tid_, wid = tid >> 6, lane = tid & 63, r32 = lane & 31, hi = lane >> 5;
  char* V_lds = lds; char* K_lds = lds + 2 * SHM_V;
  float* ws = (float*)(lds + 2 * SHM_V + 2 * SHM_K) + wid * 64; float* li_l = ws; float* al_l = ws + 32;
  constexpr float THR = 8.f;
  float mhat = 0.f, l_reg = 0; f32x16 o[2] = {}; bf16x8 qr[ND]; f32x16 negm = {}; asm volatile("" : "+v"(negm));
  const bf16* Qw = Qb + (long)(wid * 32 + r32) * LDQ + hi * 8;
#pragma unroll
  for (int d0 = 0; d0 < ND; ++d0) qr[d0] = *reinterpret_cast<const bf16x8*>(Qw + d0 * 16);
  if (DK == 96 && ropeq != nullptr) {
    const float* cr = ropeq + (size_t)(wid * 32 + r32) * 16 + 4 * hi;
#pragma unroll
    for (int d0 = 4; d0 < ND; ++d0) { const f32x4 c = *(const f32x4*)(cr + (d0 - 4) * 8), s = *(const f32x4*)(cr + 8192 * 16 + (d0 - 4) * 8);
      const v4u w = __builtin_bit_cast(v4u, qr[d0]); v4u o;
      { const float a = bflo(w.x), b = bfhi(w.x); o.x = cvtpk(a * c.x - b * s.x, b * c.x + a * s.x); }
      { const float a = bflo(w.y), b = bfhi(w.y); o.y = cvtpk(a * c.y - b * s.y, b * c.y + a * s.y); }
      { const float a = bflo(w.z), b = bfhi(w.z); o.z = cvtpk(a * c.z - b * s.z, b * c.z + a * s.z); }
      { const float a = bflo(w.w), b = bfhi(w.w); o.w = cvtpk(a * c.w - b * s.w, b * c.w + a * s.w); }
      qr[d0] = __builtin_bit_cast(bf16x8, o); }
  }
  const int sr = tid >> 3, sc = (tid & 7) * 8, vst = v_st(sr, sc), kst = sr * KS + sc * 2;
  const int sr2 = tid >> 2, sc2 = (tid & 3) * 8, kst2 = sr2 * KS + 128 + sc2 * 2;
  const bool has2 = (DK == 96) && (tid < 256);
  const int vb0 = (int)(uintptr_t)V_lds + v_rd_base(lane);
  struct { bf16x8 v, k1, k2; } sr_[2];
#define SLOAD(i, k0) do { sr_[i].v = *reinterpret_cast<const bf16x8*>(&Vb[(long)((k0) + sr) * LDV + sc]); sr_[i].k1 = *reinterpret_cast<const bf16x8*>(&K1[(long)((k0) + sr) * LDK1 + sc]); \
    if (has2) sr_[i].k2 = *reinterpret_cast<const bf16x8*>(&K2[(long)((k0) + sr2) * LDK2 + sc2]); } while (0)
#define SWRITE(b, i) do { *(bf16x8*)(V_lds + (b) * SHM_V + vst) = sr_[i].v; *(bf16x8*)(K_lds + (b) * SHM_K + kst) = sr_[i].k1; \
    if (has2) *(bf16x8*)(K_lds + (b) * SHM_K + kst2) = sr_[i].k2; } while (0)
#define RESC(a) do { if (__any((a) < 1.f)) { if (hi == 0) al_l[r32] = (a); asm volatile("s_waitcnt lgkmcnt(0)" ::: "memory"); \
    _Pragma("unroll") for (int d = 0; d < 2; ++d) _Pragma("unroll") for (int r = 0; r < 16; ++r) o[d][r] *= al_l[crow(r, hi)]; } } while (0)
  f32x16 pA0, pA1, pB0, pB1; float alA, alB; bf16x8 pa0, pa1, pa2, pa3; const int NT = nkeys / 64;
  constexpr int SE = 0, SO = 1;
  SLOAD(SE, 0); asm volatile("s_waitcnt vmcnt(0)" ::: "memory"); SWRITE(0, SE); __syncthreads();
  qkt<ND, KS>(pA0, pA1, K_lds, qr, negm, r32, hi); partialSM(pA0, pA1, mhat, negm, alA, true, THR);
  SLOAD(SO, 64); if (2 < NT) SLOAD(SE, 128);
  SWRITE(1, SO); __syncthreads();
  for (int j = 1; j + 1 < NT; j += 2) {
    SBAR(); qkt<ND, KS>(pB0, pB1, K_lds + SHM_K, qr, negm, r32, hi);
    finishSM(pA0, pA1, alA, l_reg, pa0, pa1, pa2, pa3); SBAR();
    SLOAD(SO, (j + 2) * 64); SBAR();
    pv_d0(o, vb0, pa0, pa1, pa2, pa3); partialSM(pB0, pB1, mhat, negm, alB, false, THR);
    __syncthreads(); SWRITE(0, SE);
    RESC(alB); __syncthreads();
    SBAR(); qkt<ND, KS>(pA0, pA1, K_lds, qr, negm, r32, hi);
    finishSM(pB0, pB1, alB, l_reg, pa0, pa1, pa2, pa3); SBAR();
    if (j + 3 < NT) SLOAD(SE, (j + 3) * 64); SBAR();
    pv_d0(o, vb0 + SHM_V, pa0, pa1, pa2, pa3); partialSM(pA0, pA1, mhat, negm, alA, false, THR);
    __syncthreads(); SWRITE(1, SO);
    RESC(alA); __syncthreads();
  }
  SBAR(); qkt<ND, KS>(pB0, pB1, K_lds + SHM_K, qr, negm, r32, hi);
  finishSM(pA0, pA1, alA, l_reg, pa0, pa1, pa2, pa3); SBAR();
  pv_d0(o, vb0, pa0, pa1, pa2, pa3); partialSM(pB0, pB1, mhat, negm, alB, false, THR);
  __syncthreads(); RESC(alB);
  finishSM(pB0, pB1, alB, l_reg, pa0, pa1, pa2, pa3); SBAR();
  pv_d0(o, vb0 + SHM_V, pa0, pa1, pa2, pa3);
  if (hi == 0) li_l[r32] = l_reg; asm volatile("s_waitcnt lgkmcnt(0)" ::: "memory");
  float rli[16];
#pragma unroll
  for (int r = 0; r < 16; ++r) rli[r] = __builtin_amdgcn_rcpf(li_l[crow(r, hi)]);
  bf16* Ow = Ob + (long)(wid * 32) * OW;
#pragma unroll
  for (int r = 0; r < 16; ++r) { const int orow = crow(r, hi);
#pragma unroll
    for (int d0 = 0; d0 < 2; ++d0) Ow[(long)orow * OW + d0 * 32 + r32] = (bf16)f2bf(o[d0][r] * rli[r]); }
  __syncthreads();
#undef SLOAD
#undef SWRITE
#undef RESC
}
#undef SBAR
}

namespace att2 {
using u32x4 = v4u;
typedef __attribute__((address_space(3))) const char* lds_cptr;
typedef short v4i16_t __attribute__((ext_vector_type(4)));
typedef float f32x2_t __attribute__((ext_vector_type(2))); typedef __bf16 bf16x2_t __attribute__((ext_vector_type(2)));
#define SBAR() __builtin_amdgcn_sched_barrier(0)
__device__ __forceinline__ int crow(int r, int hi) { return (r & 3) + 8 * (r >> 2) + 4 * hi; }
__device__ __forceinline__ void glds16(const void* gbase, unsigned voff, unsigned lds_dst) { unsigned keep;
  asm volatile("s_mov_b32 %0, m0\n\ts_mov_b32 m0, %3\n\ts_nop 0\n\tglobal_load_lds_dwordx4 %1, %2\n\ts_mov_b32 m0, %0" : "=&s"(keep) : "v"(voff), "s"(gbase), "s"(lds_dst) : "memory"); }
__device__ __forceinline__ float max3f(float a, float b, float c) { float r; asm("v_max3_f32 %0, %1, %2, %3" : "=v"(r) : "v"(a), "v"(b), "v"(c)); return r; }
__device__ __forceinline__ float max2f(float a, float b) { float r; asm("v_max_f32_e32 %0, %1, %2" : "=v"(r) : "v"(a), "v"(b)); return r; }
__device__ __forceinline__ float fadd_s(float a, float b) { float r; asm("v_add_f32_e32 %0, %1, %2" : "=v"(r) : "v"(a), "v"(b)); return r; }
__device__ __forceinline__ float fsub_s(float a, float b) { float r; asm("v_sub_f32_e32 %0, %1, %2" : "=v"(r) : "v"(a), "v"(b)); return r; }
__device__ __forceinline__ unsigned cvtpk_s(float lo, float hi) { f32x2_t v = {lo, hi}; bf16x2_t b = __builtin_convertvector(v, bf16x2_t); return __builtin_bit_cast(unsigned, b); }
template <int N> __device__ __forceinline__ void wait_bar() { asm volatile("s_waitcnt vmcnt(%0) lgkmcnt(0)\n\ts_barrier" :: "n"(N) : "memory"); }
template <int ND> __device__ __forceinline__ void qkt(f32x16& p0, f32x16& p1, const char* Kslot, const bf16x8* qr, const f32x16& negm, int r32, int hi) {
  const char* kb = Kslot + hi * 1024 + r32 * 16;
#pragma unroll
  for (int d0 = 0; d0 < ND; ++d0) {
    const bf16x8 b0 = *reinterpret_cast<const bf16x8*>(kb + d0 * 2048);
    const bf16x8 b1 = *reinterpret_cast<const bf16x8*>(kb + d0 * 2048 + 512);
    if (d0 == 0) { p0 = __builtin_amdgcn_mfma_f32_32x32x16_bf16(b0, qr[0], negm, 0, 0, 0); p1 = __builtin_amdgcn_mfma_f32_32x32x16_bf16(b1, qr[0], negm, 0, 0, 0); }
    else { p0 = __builtin_amdgcn_mfma_f32_32x32x16_bf16(b0, qr[d0], p0, 0, 0, 0); p1 = __builtin_amdgcn_mfma_f32_32x32x16_bf16(b1, qr[d0], p1, 0, 0, 0); } }
}
__device__ __forceinline__ void kload2(bf16x8* kf, lds_cptr kp, int j) { kf[2 * j] = *(const LAS bf16x8*)(kp + j * 2048); kf[2 * j + 1] = *(const LAS bf16x8*)(kp + j * 2048 + 512); }
__device__ __forceinline__ s16x4 vtr(lds_cptr p) { return __builtin_bit_cast(s16x4, __builtin_amdgcn_ds_read_tr16_b64_v4i16((LAS v4i16_t*)p)); }
__device__ __forceinline__ float rowmax(const f32x16& p0, const f32x16& p1) {
  float a = max3f(p0[0], p0[1], p1[0]), b = max3f(p0[2], p0[3], p1[1]); a = max3f(a, p1[2], p1[3]);
#pragma unroll
  for (int r = 4; r < 16; r += 4) { a = max3f(a, p0[r], p0[r + 1]); b = max3f(b, p0[r + 2], p0[r + 3]); a = max3f(a, p1[r], p1[r + 1]); b = max3f(b, p1[r + 2], p1[r + 3]); }
  const float m = max2f(a, b);
  auto rr = __builtin_amdgcn_permlane32_swap(__float_as_uint(m), __float_as_uint(m), false, false);
  return max2f(__uint_as_float(rr[0]), __uint_as_float(rr[1]));
}
__device__ __forceinline__ void pv(f32x16* o, int vb, bf16x8 pa0, bf16x8 pa1, bf16x8 pa2, bf16x8 pa3) {
#pragma unroll
  for (int d0 = 0; d0 < 2; ++d0) { s16x4 lo[4], hi[4];
#pragma unroll
    for (int ks = 0; ks < 4; ++ks) {
      asm volatile("ds_read_b64_tr_b16 %0,%1 offset:%c2" : "=&v"(lo[ks]) : "v"(vb), "i"(d0 * 4096 + ks * 1024) : "memory");
      asm volatile("ds_read_b64_tr_b16 %0,%1 offset:%c2" : "=&v"(hi[ks]) : "v"(vb), "i"(d0 * 4096 + ks * 1024 + 512) : "memory"); }
    asm volatile("s_waitcnt lgkmcnt(0)" ::: "memory"); SBAR();
#define PK(k) (bf16x8){lo[k][0], lo[k][1], lo[k][2], lo[k][3], hi[k][0], hi[k][1], hi[k][2], hi[k][3]}
    o[d0] = __builtin_amdgcn_mfma_f32_32x32x16_bf16(pa0, PK(0), o[d0], 0, 0, 0);
    o[d0] = __builtin_amdgcn_mfma_f32_32x32x16_bf16(pa1, PK(1), o[d0], 0, 0, 0);
    o[d0] = __builtin_amdgcn_mfma_f32_32x32x16_bf16(pa2, PK(2), o[d0], 0, 0, 0);
    o[d0] = __builtin_amdgcn_mfma_f32_32x32x16_bf16(pa3, PK(3), o[d0], 0, 0, 0);
#undef PK
  }
}

template <int DK> struct Lay { static constexpr int ND = DK / 16, NC = DK / 8, SLOTK = NC * 1024, SLOTV = 8192, LDS_K = 0, LDS_V = 3 * SLOTK, LDS_WS = LDS_V + 3 * SLOTV, LDS_OST = LDS_WS + 8 * 256, LDS_BYTES = LDS_OST + 8 * 4096, KD = (DK == 96) ? 2 : 1; };

template <int DK, int LDQ, int LDK1, int LDK2, int LDV, int THRL>
__device__ __forceinline__ void attn_unit(const bf16* Qb, const bf16* __restrict__ K1, const bf16* __restrict__ K2, const bf16* __restrict__ Vh, bf16* Ob, const float* ropeq, const int NT, char* shm, const int tid_in) {
  using L = Lay<DK>; constexpr int ND = L::ND, SLOTK = L::SLOTK, SLOTV = L::SLOTV, LDS_K = L::LDS_K, LDS_V = L::LDS_V, LDS_WS = L::LDS_WS, LDS_OST = L::LDS_OST, KD = L::KD;
  int tid_ = tid_in; asm volatile("" : "+v"(tid_));
  const int tid = tid_, lane = tid & 63, r32 = lane & 31, hi = lane >> 5; const int wid = __builtin_amdgcn_readfirstlane(tid >> 6);
  const bf16* Qw = Qb + (long)(wid * 32) * LDQ;
  const unsigned lds0 = (unsigned)(uintptr_t)shm;
  float* wsf = (float*)(shm + LDS_WS) + wid * 64;
  const unsigned koff = (unsigned)(lane * LDK1 + wid * 8) * 2u;
  const unsigned koff2 = (unsigned)(lane * LDK2 + (wid & 3) * 8) * 2u;
  const unsigned voffv = (unsigned)((16 * (wid & 3) + (lane >> 2)) * LDV + (wid >> 2) * 32 + (lane & 3) * 8) * 2u;
  const unsigned kdst = lds0 + LDS_K + wid * 1024, kdst2 = lds0 + LDS_K + (8 + (wid & 3)) * 1024, vdst = lds0 + LDS_V + wid * 1024;
#define DMA_K(t, s) do { glds16(K1 + (long)(t) * 64 * LDK1, koff, (unsigned)__builtin_amdgcn_readfirstlane(kdst + (s) * SLOTK)); \
    if (DK == 96) glds16(K2 + (long)(t) * 64 * LDK2, koff2, (unsigned)__builtin_amdgcn_readfirstlane(kdst2 + (s) * SLOTK)); } while (0)
#define DMA_V(t, s) glds16(Vh + (long)(t) * 64 * LDV, voffv, (unsigned)__builtin_amdgcn_readfirstlane(vdst + (s) * SLOTV))
  const int vb0 = (int)(lds0 + LDS_V) + ((lane >> 4) & 1) * 32 + (lane & 3) * 8 + (4 * hi + ((lane & 15) >> 2)) * 64;
  const char* Kbase = shm + LDS_K; bf16x8 kf[12];
  const lds_cptr shm3 = (lds_cptr)shm; const lds_cptr kp0 = shm3 + LDS_K + hi * 1024 + r32 * 16; const lds_cptr vp0 = shm3 + LDS_V + ((lane >> 4) & 1) * 32 + (lane & 3) * 8 + (4 * hi + ((lane & 15) >> 2)) * 64;
  DMA_K(0, 0); DMA_V(0, 0); DMA_K(1, 1);
  bf16x8 qr[6];
#pragma unroll
  for (int d0 = 0; d0 < ND; ++d0) qr[d0] = *reinterpret_cast<const bf16x8*>(&Qw[(long)r32 * LDQ + d0 * 16 + hi * 8]);
  if (DK == 96 && ropeq != nullptr) {
    const float* cr = ropeq + (size_t)(wid * 32 + r32) * 16 + 4 * hi;
#pragma unroll
    for (int d0 = 4; d0 < ND; ++d0) { const f32x4 c = *(const f32x4*)(cr + (d0 - 4) * 8), s = *(const f32x4*)(cr + 8192 * 16 + (d0 - 4) * 8);
      const v4u w = __builtin_bit_cast(v4u, qr[d0]); v4u o;
      { const float a = bflo(w.x), b = bfhi(w.x); o.x = cvtpk_s(a * c.x - b * s.x, b * c.x + a * s.x); }
      { const float a = bflo(w.y), b = bfhi(w.y); o.y = cvtpk_s(a * c.y - b * s.y, b * c.y + a * s.y); }
      { const float a = bflo(w.z), b = bfhi(w.z); o.z = cvtpk_s(a * c.z - b * s.z, b * c.z + a * s.z); }
      { const float a = bflo(w.w), b = bfhi(w.w); o.w = cvtpk_s(a * c.w - b * s.w, b * c.w + a * s.w); }
      qr[d0] = __builtin_bit_cast(bf16x8, o); }
  }
  float mhat = 0.f, l_reg = 0.f; f32x16 o[2]; o[0] = f32x16{}; o[1] = f32x16{}; f32x16 negm = f32x16{}; asm volatile("" : "+v"(negm));
  bool resc = false;
#define START(P0, P1) do { const float rm = rowmax(P0, P1); resc = false; \
    { const float dl = rm; mhat = fadd_s(mhat, dl); \
      _Pragma("unroll") for (int r = 0; r < 16; ++r) { P0[r] = fsub_s(P0[r], dl); P1[r] = fsub_s(P1[r], dl); } \
      _Pragma("unroll") for (int r = 0; r < 16; ++r) negm[r] = -mhat; asm volatile("" : "+v"(negm)); } \
    _Pragma("unroll") for (int r = 0; r < 16; ++r) P0[r] = __builtin_amdgcn_exp2f(P0[r]); } while (0)
#define RESC() do { if (resc) { asm volatile("s_waitcnt lgkmcnt(0)" ::: "memory"); \
      _Pragma("unroll") for (int d_ = 0; d_ < 2; ++d_) _Pragma("unroll") for (int r = 0; r < 16; ++r) o[d_][r] *= wsf[crow(r, hi)]; } } while (0)
  f32x16 pA0, pA1, pB0, pB1;
  int sp = 0, sc = 0, sn = 1;
#define ROT() do { sp = sc; sc = sn; sn = (sn == 2) ? 0 : sn + 1; } while (0)
  DMA_K(2, 2);
  wait_bar<1 + 2 * KD>();
  qkt<ND>(pA0, pA1, Kbase, qr, negm, r32, hi); asm volatile("s_nop 15\n\ts_nop 7" : "+v"(pA0), "+v"(pA1));
  START(pA0, pA1);
  _Pragma("unroll") for (int r = 0; r < 16; ++r) pA1[r] = __builtin_amdgcn_exp2f(pA1[r]);
  wait_bar<0>();
  DMA_K(3, 0); DMA_V(1, 1);
  ROT();
#pragma unroll
  for (int j = 0; j < ND; ++j) kload2(kf, kp0 + sc * SLOTK, j);
  wait_bar<KD + 1>();
  s16x4 vlo[8], vhi[8]; u32x4 pw0, pw1, pw2, pw3;
#define PKW(P, B) cvtpk_s(P[B], P[B + 1])
#define PAF(k) __builtin_bit_cast(bf16x8, pw##k)
#define VFR(i) (bf16x8){vlo[i][0], vlo[i][1], vlo[i][2], vlo[i][3], vhi[i][0], vhi[i][1], vhi[i][2], vhi[i][3]}
#define PIN(x) asm volatile("" : "+v"(x))
#define MX3(a, b, c) __builtin_fmaxf(__builtin_fmaxf((a), (b)), (c))
#define EX(v) __builtin_amdgcn_exp2f(v)
#define GAPB(MF, X, B) do { MF; X[B] = EX(X[B]); X[B + 1] = EX(X[B + 1]); X[B + 2] = EX(X[B + 2]); X[B + 3] = EX(X[B + 3]); PIN(X); SBAR(); } while (0)
#define VRD(i) do { vlo[i] = vtr(vp_ + (((i) >> 2) * 4096 + ((i) & 3) * 1024)); vhi[i] = vtr(vp_ + (((i) >> 2) * 4096 + ((i) & 3) * 1024 + 512)); } while (0)
#define KRD(G, j) do { if (G) { kload2(kf, kp0 + sn * SLOTK, j); SBAR(); } } while (0)
#define MFQ(C, i, d, INIT) C = __builtin_amdgcn_mfma_f32_32x32x16_bf16(kf[i], qr[d], INIT, 0, 0, 0)
#define PHASE_A64(C0, C1, P0, P1) do { \
    VRD(0); SBAR(); float sacc = (P0[0] + P0[1]); \
    MFQ(C0, 0, 0, negm); sacc += P0[2]; sacc += P0[3]; sacc += P0[4]; sacc += P0[5]; PIN(sacc); pw0[0] = PKW(P0, 0); pw0[1] = PKW(P0, 2); PIN(pw0); SBAR(); \
    VRD(4); SBAR(); MFQ(C1, 1, 0, negm); sacc += P0[6]; sacc += P0[7]; sacc += P0[8]; sacc += P0[9]; PIN(sacc); pw0[2] = PKW(P0, 4); pw0[3] = PKW(P0, 6); PIN(pw0); SBAR(); \
    VRD(1); SBAR(); MFQ(C0, 2, 1, C0); sacc += P0[10]; sacc += P0[11]; sacc += P0[12]; sacc += P0[13]; PIN(sacc); pw1[0] = PKW(P0, 8); pw1[1] = PKW(P0, 10); PIN(pw1); SBAR(); \
    VRD(5); SBAR(); MFQ(C1, 3, 1, C1); sacc += P0[14]; sacc += P0[15]; sacc += P1[0]; sacc += P1[1]; PIN(sacc); pw1[2] = PKW(P0, 12); pw1[3] = PKW(P0, 14); PIN(pw1); SBAR(); \
    VRD(2); SBAR(); MFQ(C0, 4, 2, C0); sacc += P1[2]; sacc += P1[3]; sacc += P1[4]; sacc += P1[5]; PIN(sacc); pw2[0] = PKW(P1, 0); pw2[1] = PKW(P1, 2); PIN(pw2); SBAR(); \
    VRD(6); SBAR(); MFQ(C1, 5, 2, C1); sacc += P1[6]; sacc += P1[7]; sacc += P1[8]; sacc += P1[9]; PIN(sacc); pw2[2] = PKW(P1, 4); pw2[3] = PKW(P1, 6); PIN(pw2); SBAR(); \
    VRD(3); SBAR(); MFQ(C0, 6, 3, C0); sacc += P1[10]; sacc += P1[11]; sacc += P1[12]; sacc += P1[13]; PIN(sacc); pw3[0] = PKW(P1, 8); pw3[1] = PKW(P1, 10); PIN(pw3); SBAR(); \
    VRD(7); SBAR(); MFQ(C1, 7, 3, C1); sacc += P1[14]; sacc += P1[15]; PIN(sacc); pw3[2] = PKW(P1, 12); pw3[3] = PKW(P1, 14); PIN(pw3); SBAR(); \
    l_reg += sacc; } while (0)
#define PHASE_A96(C0, C1, P0, P1) do { \
    VRD(0); SBAR(); float sacc = (P0[0] + P0[1]); \
    MFQ(C0, 0, 0, negm); sacc += P0[2]; sacc += P0[3]; sacc += P0[4]; PIN(sacc); pw0[0] = PKW(P0, 0); PIN(pw0); SBAR(); \
    VRD(4); SBAR(); MFQ(C1, 1, 0, negm); sacc += P0[5]; sacc += P0[6]; sacc += P0[7]; PIN(sacc); pw0[1] = PKW(P0, 2); PIN(pw0); SBAR(); \
    VRD(1); SBAR(); MFQ(C0, 2, 1, C0); sacc += P0[8]; sacc += P0[9]; sacc += P0[10]; PIN(sacc); pw0[2] = PKW(P0, 4); PIN(pw0); SBAR(); \
    VRD(5); SBAR(); MFQ(C1, 3, 1, C1); sacc += P0[11]; sacc += P0[12]; sacc += P0[13]; PIN(sacc); pw0[3] = PKW(P0, 6); PIN(pw0); SBAR(); \
    VRD(2); SBAR(); MFQ(C0, 4, 2, C0); sacc += P0[14]; sacc += P0[15]; PIN(sacc); pw1[0] = PKW(P0, 8); PIN(pw1); SBAR(); \
    VRD(6); SBAR(); MFQ(C1, 5, 2, C1); sacc += P1[0]; sacc += P1[1]; PIN(sacc); pw1[1] = PKW(P0, 10); PIN(pw1); SBAR(); \
    VRD(3); SBAR(); MFQ(C0, 6, 3, C0); sacc += P1[2]; sacc += P1[3]; PIN(sacc); pw1[2] = PKW(P0, 12); PIN(pw1); SBAR(); \
    VRD(7); SBAR(); MFQ(C1, 7, 3, C1); sacc += P1[4]; sacc += P1[5]; PIN(sacc); pw1[3] = PKW(P0, 14); PIN(pw1); SBAR(); \
    MFQ(C0, 8, 4, C0); sacc += P1[6]; sacc += P1[7]; sacc += P1[8]; PIN(sacc); pw2[0] = PKW(P1, 0); pw2[1] = PKW(P1, 2); PIN(pw2); SBAR(); \
    MFQ(C1, 9, 4, C1); sacc += P1[9]; sacc += P1[10]; sacc += P1[11]; PIN(sacc); pw2[2] = PKW(P1, 4); pw2[3] = PKW(P1, 6); PIN(pw2); SBAR(); \
    MFQ(C0, 10, 5, C0); sacc += P1[12]; sacc += P1[13]; PIN(sacc); pw3[0] = PKW(P1, 8); pw3[1] = PKW(P1, 10); PIN(pw3); SBAR(); \
    MFQ(C1, 11, 5, C1); sacc += P1[14]; sacc += P1[15]; PIN(sacc); pw3[2] = PKW(P1, 12); pw3[3] = PKW(P1, 14); PIN(pw3); SBAR(); \
    l_reg += sacc; } while (0)
#define STEP(C0, C1, P0, P1, t, GK, GV, GL) do { SBAR(); \
    const lds_cptr vp_ = vp0 + sp * SLOTV; \
    if (DK == 96) PHASE_A96(C0, C1, P0, P1); else PHASE_A64(C0, C1, P0, P1); \
    if (GK) { DMA_K((t) + 3, sc); } if (GV) { DMA_V((t) + 1, sn); } \
    { float a = MX3(C0[0], C0[1], C1[0]), b = MX3(C0[2], C0[3], C1[1]); a = MX3(a, C1[2], C1[3]); \
      _Pragma("unroll") for (int r = 4; r < 16; r += 4) { a = MX3(a, C0[r], C0[r + 1]); b = MX3(b, C0[r + 2], C0[r + 3]); a = MX3(a, C1[r], C1[r + 1]); b = MX3(b, C1[r + 2], C1[r + 3]); } \
      float rm = __builtin_fmaxf(a, b); { auto rr = __builtin_amdgcn_permlane32_swap(__float_as_uint(rm), __float_as_uint(rm), false, false); rm = __builtin_fmaxf(__uint_as_float(rr[0]), __uint_as_float(rr[1])); } \
      resc = false; \
      if (__builtin_expect(__any(rm > (float)THRL), 0)) { const float dl = __builtin_fmaxf(rm, 0.f); mhat += dl; \
        _Pragma("unroll") for (int r = 0; r < 16; ++r) { C0[r] -= dl; C1[r] -= dl; } \
        _Pragma("unroll") for (int r = 0; r < 16; ++r) negm[r] = -mhat; asm volatile("" : "+v"(negm)); \
        const float f = __builtin_amdgcn_exp2f(-dl); l_reg *= f; if (hi == 0) wsf[r32] = f; resc = true; } } \
    SBAR(); \
    GAPB(o[0] = __builtin_amdgcn_mfma_f32_32x32x16_bf16(PAF(0), VFR(0), o[0], 0, 0, 0), C0, 0); \
    KRD(GL && ND == 6, 0); GAPB(o[1] = __builtin_amdgcn_mfma_f32_32x32x16_bf16(PAF(0), VFR(4), o[1], 0, 0, 0), C0, 4); \
    KRD(GL, ND == 6 ? 1 : 0); GAPB(o[0] = __builtin_amdgcn_mfma_f32_32x32x16_bf16(PAF(1), VFR(1), o[0], 0, 0, 0), C0, 8); \
    KRD(GL, ND == 6 ? 2 : 1); GAPB(o[1] = __builtin_amdgcn_mfma_f32_32x32x16_bf16(PAF(1), VFR(5), o[1], 0, 0, 0), C0, 12); \
    KRD(GL, ND == 6 ? 3 : 2); GAPB(o[0] = __builtin_amdgcn_mfma_f32_32x32x16_bf16(PAF(2), VFR(2), o[0], 0, 0, 0), C1, 0); \
    KRD(GL, ND == 6 ? 4 : 3); GAPB(o[1] = __builtin_amdgcn_mfma_f32_32x32x16_bf16(PAF(2), VFR(6), o[1], 0, 0, 0), C1, 4); \
    KRD(GL && ND == 6, 5); GAPB(o[0] = __builtin_amdgcn_mfma_f32_32x32x16_bf16(PAF(3), VFR(3), o[0], 0, 0, 0), C1, 8); \
    GAPB(o[1] = __builtin_amdgcn_mfma_f32_32x32x16_bf16(PAF(3), VFR(7), o[1], 0, 0, 0), C1, 12); \
  } while (0)
  int t = 1;
  for (; t + 5 < NT; t += 2) {
    STEP(pB0, pB1, pA0, pA1, t, true, true, true);     wait_bar<KD + 1>(); RESC(); ROT();
    STEP(pA0, pA1, pB0, pB1, t + 1, true, true, true); wait_bar<KD + 1>(); RESC(); ROT();
  }
#define ENDW(tt) do { if ((tt) + 3 < NT) { wait_bar<KD + 1>(); } else if ((tt) + 2 < NT) { wait_bar<1>(); } else { wait_bar<0>(); } } while (0)
  for (; t + 1 < NT; t += 2) {
    STEP(pB0, pB1, pA0, pA1, t, (t + 3 < NT), (t + 1 < NT), (t + 1 < NT));         ENDW(t);     RESC(); ROT();
    STEP(pA0, pA1, pB0, pB1, t + 1, (t + 4 < NT), (t + 2 < NT), (t + 2 < NT));     ENDW(t + 1); RESC(); ROT();
  }
  STEP(pB0, pB1, pA0, pA1, NT - 1, false, false, false); RESC();
  { float sacc = pB0[0] + pB0[1];
    _Pragma("unroll") for (int r = 2; r < 16; ++r) sacc += pB0[r];
    _Pragma("unroll") for (int r = 0; r < 16; ++r) sacc += pB1[r];
    l_reg += sacc;
    pw0 = (u32x4){PKW(pB0, 0), PKW(pB0, 2), PKW(pB0, 4), PKW(pB0, 6)}; pw1 = (u32x4){PKW(pB0, 8), PKW(pB0, 10), PKW(pB0, 12), PKW(pB0, 14)};
    pw2 = (u32x4){PKW(pB1, 0), PKW(pB1, 2), PKW(pB1, 4), PKW(pB1, 6)}; pw3 = (u32x4){PKW(pB1, 8), PKW(pB1, 10), PKW(pB1, 12), PKW(pB1, 14)};
    SBAR(); pv(o, vb0 + sc * SLOTV, PAF(0), PAF(1), PAF(2), PAF(3)); }
  { auto rr = __builtin_amdgcn_permlane32_swap(__float_as_uint(l_reg), __float_as_uint(l_reg), false, false); l_reg = __uint_as_float(rr[0]) + __uint_as_float(rr[1]); }
  if (hi == 0) wsf[32 + r32] = l_reg; asm volatile("s_waitcnt lgkmcnt(0)" ::: "memory");
  float rli[16];
#pragma unroll
  for (int r = 0; r < 16; ++r) rli[r] = __builtin_amdgcn_rcpf(wsf[32 + crow(r, hi)]);
  bf16* Ow = Ob + (long)(wid * 32) * OW;
  { bf16* stg = (bf16*)(shm + LDS_OST) + wid * 2048;
#pragma unroll
    for (int r = 0; r < 16; ++r) { const int orow = crow(r, hi);
#pragma unroll
      for (int d0 = 0; d0 < 2; ++d0) stg[orow * 64 + d0 * 32 + r32] = (bf16)f2bf(o[d0][r] * rli[r]); }
    asm volatile("s_waitcnt lgkmcnt(0)" ::: "memory");
#pragma unroll
    for (int i = 0; i < 4; ++i) { const int row = i * 8 + (lane >> 3), ch = lane & 7; const u32x4 v = *(const u32x4*)(stg + row * 64 + ch * 8); *(u32x4*)(Ow + (long)row * OW + ch * 8) = v; } }
  asm volatile("s_waitcnt lgkmcnt(0)\n\ts_barrier" ::: "memory");
#undef DMA_K
#undef DMA_V
#undef START
#undef RESC
#undef ROT
#undef PKW
#undef PAF
#undef VFR
#undef PIN
#undef MX3
#undef EX
#undef GAPB
#undef VRD
#undef KRD
#undef MFQ
#undef PHASE_A64
#undef PHASE_A96
#undef STEP
#undef ENDW
}
#undef SBAR
}

constexpr size_t MiB = 1u << 20;
constexpr size_t WS_CTL = 0, CTL_ZERO_BYTES = 1 * MiB;
constexpr size_t WS_MOD = 1 * MiB;
constexpr size_t WS_ROPE = 2 * MiB;
constexpr size_t WS_AFF = 5 * MiB;
constexpr size_t WS_INV = 8 * MiB;
constexpr size_t WS_ROWIDX = 10 * MiB;
constexpr size_t WS_WIN = 12 * MiB, WS_WUQ = 18 * MiB, WS_WUKV = 19 * MiB, WS_WOUT = 20 * MiB;
constexpr size_t WS_XRES = 24 * MiB;
constexpr size_t WS_H1 = 90 * MiB;
constexpr size_t WS_Z = 123 * MiB;
constexpr size_t WS_QM = 173 * MiB, WS_KVM = 198 * MiB, WS_O = 231 * MiB;
constexpr size_t WS_XG = 256 * MiB;
constexpr size_t WS_HID = 328 * MiB;
constexpr size_t WS_W13 = 520 * MiB, WS_W2 = 856 * MiB, WS_END = 1024 * MiB;
constexpr int CW_BAR = 4096;
constexpr int NPHASE = 28;
constexpr int LDS_BYTES = 147456, MISC_OFF = LDS_BYTES - 256;
constexpr int NWAVES = 8;

#define XB_TMO      128
#define XB_XCNT(j)  (256  + 64 * (j))
#define XB_XSUB(j)  (1280 + 64 * (j))
#define XB_XGEN(j)  (2304 + 64 * (j))
#define XB_TOP      3328
#define XB_TOPGEN   3392
#define XB_LSUB(j)  (3456 + 64 * (j))
#define XB_LGEN(j)  (4480 + 64 * (j))
#define XCD_BAR_WORDS 5504
#define XB_SPIN_CAP (1u << 18)

__device__ __forceinline__ unsigned xb_ld(unsigned* p)              { return __hip_atomic_load(p, __ATOMIC_RELAXED, __HIP_MEMORY_SCOPE_AGENT); }
__device__ __forceinline__ unsigned xb_add(unsigned* p, unsigned v) { return __hip_atomic_fetch_add(p, v, __ATOMIC_RELAXED, __HIP_MEMORY_SCOPE_AGENT); }
__device__ __forceinline__ unsigned xb_xcc_id() { return (unsigned)__builtin_amdgcn_s_getreg((3 << 11) | 20) & 0xFu; }
#define XB_SPIN(cond, bar) do { unsigned _sp = 0; while (cond) { __builtin_amdgcn_s_sleep(1); \
    if ((++_sp & 255u) == 0u) { if (xb_ld(&(bar)[XB_TMO])) break; if (_sp > XB_SPIN_CAP) { atomicAdd(&(bar)[XB_TMO], 1u); break; } } } } while (0)

struct XcdBarrier {
    unsigned* bar; unsigned x;
    volatile LAS unsigned* st;
};

__device__ __forceinline__ XcdBarrier xcd_barrier_post(unsigned* bar, volatile LAS unsigned* st) {
    XcdBarrier b; b.bar = bar; b.x = xb_xcc_id(); b.st = st;
    if (threadIdx.x == 0) st[2] = xb_add(&bar[XB_XCNT(b.x)], 1u);
    return b;
}
__device__ __forceinline__ void xcd_barrier_complete(unsigned* bar, unsigned x, unsigned& nloc, unsigned& nx) {
    const unsigned G = gridDim.x * gridDim.y * gridDim.z;
    unsigned sum, cnt, mine, sp = 0u;
    for (;;) {
        sum = 0u; cnt = 0u; mine = 0u;
#pragma unroll
        for (unsigned j = 0; j < 16; ++j) { const unsigned c = xb_ld(&bar[XB_XCNT(j)]); sum += c; cnt += (c > 0u) ? 1u : 0u; mine = (j == x) ? c : mine; }
        if (sum == G) break;
        __builtin_amdgcn_s_sleep(1);
        if ((++sp & 255u) == 0u) { if (xb_ld(&bar[XB_TMO])) break; if (sp > XB_SPIN_CAP) { atomicAdd(&bar[XB_TMO], 1u); break; } }
    }
    nloc = mine > 0u ? mine : 1u; nx = cnt > 0u ? cnt : 1u;
}

__device__ __forceinline__ void xcd_barrier(const XcdBarrier& b) {
    asm volatile("s_waitcnt vmcnt(0)" ::: "memory");
    __syncthreads();
    if (threadIdx.x == 0) {
        unsigned* bar = b.bar;
        __builtin_amdgcn_s_waitcnt(0);
        unsigned nloc = b.st[0], nx = b.st[1];
        if (nloc == 0u) { xcd_barrier_complete(bar, b.x, nloc, nx); b.st[0] = nloc; b.st[1] = nx; }
        const unsigned old = xb_add(&bar[XB_XSUB(b.x)], 1u);
        const unsigned gen = old / nloc;
        if (old + 1u == (gen + 1u) * nloc) {
            __builtin_amdgcn_fence(__ATOMIC_RELEASE, "agent");
            asm volatile("s_waitcnt vmcnt(0)" ::: "memory");
            const unsigned og = xb_add(&bar[XB_TOP], 1u);
            const unsigned tg = og / nx;
            if (og + 1u == (tg + 1u) * nx) xb_add(&bar[XB_TOPGEN], 1u);
            else XB_SPIN(xb_ld(&bar[XB_TOPGEN]) == tg, bar);
            __builtin_amdgcn_fence(__ATOMIC_ACQUIRE, "agent");
            xb_add(&bar[XB_XGEN(b.x)], 1u);
            asm volatile("s_waitcnt vmcnt(0)" ::: "memory");
        } else {
            XB_SPIN(xb_ld(&bar[XB_XGEN(b.x)]) == gen, bar);
            __builtin_amdgcn_fence(__ATOMIC_ACQUIRE, "agent");
            asm volatile("s_waitcnt vmcnt(0)" ::: "memory");
        }
    }
    __syncthreads();
}

__device__ __forceinline__ bool xcd_grid_regular(const XcdBarrier& b) {
    unsigned n32 = 0u, nz = 0u;
#pragma unroll
    for (unsigned j = 0; j < 16; ++j) { const unsigned c = xb_ld(&b.bar[XB_XCNT(j)]); n32 += (c == 32u) ? 1u : 0u; nz += (c > 0u) ? 1u : 0u; }
    return n32 == 8u && nz == 8u && b.x < 8u;
}
__device__ __forceinline__ void xcd_local_barrier(const XcdBarrier& b) {
    asm volatile("s_waitcnt vmcnt(0)" ::: "memory");
    __syncthreads();
    if (threadIdx.x == 0) {
        unsigned* bar = b.bar;
        __builtin_amdgcn_s_waitcnt(0);
        const unsigned nloc = b.st[0];
        const unsigned old = xb_add(&bar[XB_LSUB(b.x)], 1u);
        const unsigned gen = old / nloc;
        if (old + 1u == (gen + 1u) * nloc) xb_add(&bar[XB_LGEN(b.x)], 1u);
        else XB_SPIN(xb_ld(&bar[XB_LGEN(b.x)]) == gen, bar);
        __builtin_amdgcn_fence(__ATOMIC_ACQUIRE, "agent");
        asm volatile("s_waitcnt vmcnt(0)" ::: "memory");
    }
    __syncthreads();
}

struct Frame {
    LAS unsigned char* lds; volatile LAS unsigned* MISC; unsigned* ctl;
    int tid, lane, wave, vcu, G;
    int reg;
    const float* const* in; float* out; unsigned char* ws;
};
__device__ __forceinline__ const float* gin(const Frame& F, int i) { return (const float*)(const GAS float*)F.in[i]; }
struct Span { int lo, hi, step; };
__device__ __forceinline__ int grp_p0(int g) { return 8 * g + (g < 2 ? g : 2); }
__device__ __forceinline__ int grp_np(int g) { return g < 2 ? 9 : 8; }
__device__ __forceinline__ Span row_span(const Frame& F, bool latent_only) {
    Span s;
    if (F.reg) { const int g = F.vcu >> 5, j = F.vcu & 31; const int lo = latent_only ? 2048 * g : 256 * grp_p0(g); s.hi = latent_only ? lo + 2048 : lo + 256 * grp_np(g); s.lo = lo + j * NWAVES + F.wave; s.step = 32 * NWAVES; }
    else { s.lo = F.vcu * NWAVES + F.wave; s.hi = latent_only ? NB * SEQ : M; s.step = F.G * NWAVES; }
    return s;
}
enum { I_X = 0, I_C, I_CTX, I_CCTX, I_MODW, I_MODB, I_N1G, I_WIN, I_QNG, I_WUQ, I_KVNG, I_WUKV, I_GQG, I_GKG, I_CVW, I_CVB, I_LNG, I_LNB, I_MOG, I_WOUT, I_N2G, I_RW, I_W1, I_W3, I_W2, I_FG };

__device__ __forceinline__ void sincos_acc(float ang, float& s, float& c) {
    const double x = (double)ang; const double k = __builtin_rint(x * 0.63661977236758134);
    double r = __builtin_fma(-k, 1.5707963267948966, x); r = __builtin_fma(-k, 6.123233995736766e-17, r);
    const double r2 = r * r;
    const double sp = r * (1.0 + r2 * (-1.0 / 6 + r2 * (1.0 / 120 + r2 * (-1.0 / 5040 + r2 * (1.0 / 362880 + r2 * (-1.0 / 39916800 + r2 * (1.0 / 6227020800.0)))))));
    const double cp = 1.0 + r2 * (-0.5 + r2 * (1.0 / 24 + r2 * (-1.0 / 720 + r2 * (1.0 / 40320 + r2 * (-1.0 / 3628800 + r2 * (1.0 / 479001600.0 + r2 * (-1.0 / 87178291200.0)))))));
    const int q = (int)k & 3;
    const double sv = (q == 0) ? sp : (q == 1) ? cp : (q == 2) ? -sp : -cp;
    const double cv = (q == 0) ? cp : (q == 1) ? -sp : (q == 2) ? -cp : sp;
    s = (float)sv; c = (float)cv;
}
template <int NW, class RowMap>
__device__ __forceinline__ void tr_item(const float* W, int N, int k0, int n0, bf16* WT, int ldwt, RowMap rowmap, LAS float* scr, int lane, const float vs = 1.f) {
    constexpr int LPR = NW / 4, RPI = 64 / LPR, NI = 64 / RPI, NO = NW * 8 / 64;
    const int r = lane / LPR, c4 = lane % LPR;
    f32x4 v[NI];
#pragma unroll
    for (int i = 0; i < NI; ++i) v[i] = *(const GAS f32x4*)(W + (size_t)(k0 + i * RPI + r) * N + n0 + 4 * c4);
#pragma unroll
    for (int i = 0; i < NI; ++i) { const int k = i * RPI + r;
#pragma unroll
        for (int j = 0; j < 4; ++j) scr[(4 * c4 + j) * 65 + k] = v[i][j]; }
    LDS_WAIT(); asm volatile("" ::: "memory");
#pragma unroll
    for (int j = 0; j < NO; ++j) { const int n = (lane >> 3) + 8 * j, c = lane & 7; const LAS float* s = scr + n * 65 + 8 * c;
        v4u o; o.x = pk2(s[0] * vs, s[1] * vs); o.y = pk2(s[2] * vs, s[3] * vs); o.z = pk2(s[4] * vs, s[5] * vs); o.w = pk2(s[6] * vs, s[7] * vs);
        *(GAS v4u*)(WT + (size_t)rowmap(n0 + n) * ldwt + k0 + 8 * c) = o; }
    LDS_WAIT(); asm volatile("" ::: "memory");
}
constexpr int NLI = 32256, NMI = 10752;
constexpr int WIN_IN_NB = 116, WIN_IN_IPW = 5, WIN_OUT_NB = 248, WIN_OUT_IPW = 5, WIN_TK0_NB = 192, WIN_TK1_NB = 224, WIN_TK_IPW = 4, WIN_M2_NB = 192, WIN_M2_IPW = 10;
constexpr int N_WIN_IN = WIN_IN_NB * 8 * WIN_IN_IPW, N_WIN_OUT = WIN_OUT_NB * 8 * WIN_OUT_IPW, N_WIN_TK0 = WIN_TK0_NB * 8 * WIN_TK_IPW, N_WIN_TK1 = WIN_TK1_NB * 8 * WIN_TK_IPW, N_WIN_M2 = WIN_M2_NB * 8 * WIN_M2_IPW;
constexpr int WIN_M10_NB = 48, WIN_M11_NB = 128, WIN_M1_IPW = 3, N_WIN_M10 = WIN_M10_NB * 8 * WIN_M1_IPW, N_WIN_M11 = WIN_M11_NB * 8 * WIN_M1_IPW;
constexpr int WIN_AT_NB = 240, WIN_AT_IPW = 1, N_WIN_AT = WIN_AT_NB * 8 * WIN_AT_IPW;
constexpr int PRO_L0 = NLI - N_WIN_IN - N_WIN_AT - N_WIN_OUT - N_WIN_TK0 - N_WIN_M10;
constexpr int PRO_L1 = NLI - N_WIN_M2 - N_WIN_IN - N_WIN_TK1 - N_WIN_M11;
constexpr int BASE_IN0 = PRO_L0, BASE_AT0 = BASE_IN0 + N_WIN_IN, BASE_OUT0 = BASE_AT0 + N_WIN_AT, BASE_TK0 = BASE_OUT0 + N_WIN_OUT, BASE_M10 = BASE_TK0 + N_WIN_TK0;
constexpr int BASE_M2 = PRO_L1, BASE_IN1 = BASE_M2 + N_WIN_M2, BASE_TK1 = BASE_IN1 + N_WIN_IN, BASE_M11 = BASE_TK1 + N_WIN_TK1;
static_assert(BASE_M10 + N_WIN_M10 == NLI && BASE_M11 + N_WIN_M11 == NLI && PRO_L0 > 0 && PRO_L1 > 0 && BASE_M10 >= 2 * NMI && BASE_M11 >= 2 * NMI, "window partition (the MOE1 windows hold w2 tiles only)");
#ifndef XNT
#define XNT 1
#endif
struct XItem { const float* W; bf16* WT; int N, ldwt, k0, n0, radd; bool tiled; };
__device__ __forceinline__ void xitem_desc(Frame& F, int l, int x, XItem& d) {
    const int mat = x / NMI; int r = x - mat * NMI;
    if (mat == 2) {
        const int T8 = (l == 0 ? N_WIN_M10 : N_WIN_M11) / 8, H = 1344 - T8; int g, idx;
        if (r < 8 * H) { g = r / H; idx = r - g * H; } else { const int t = r - 8 * H; g = t / T8; idx = H + t - g * T8; }
        r = g * 1344 + idx; }
    const int e = r / 672, q = r - e * 672, le = l * 16 + e;
    if (mat < 2) { d.W = (mat == 0 ? gin(F, I_W1) : gin(F, I_W3)) + (size_t)le * 1024 * FF; d.N = FF; d.k0 = (q / 42) * 64; d.n0 = (q % 42) * 64;
        d.WT = (bf16*)(F.ws + WS_W13) + (size_t)le * 5376 * 1024; d.ldwt = 1024; d.radd = mat * 128; d.tiled = true; }
    else { d.W = gin(F, I_W2) + (size_t)le * FF * 1024; d.N = 1024; d.k0 = (q / 16) * 64; d.n0 = (q % 16) * 64;
        d.WT = (bf16*)(F.ws + WS_W2) + (size_t)le * 1024 * W2P; d.ldwt = W2P; d.radd = 0; d.tiled = false; }
}
__device__ __forceinline__ void xitem_load(const XItem& d, f32x4 (&v)[16], int lane) {
    const int r = lane >> 4, c4 = lane & 15; const float* p = d.W + (size_t)(d.k0 + r) * d.N + d.n0 + 4 * c4;
#pragma unroll
    for (int i = 0; i < 16; ++i) v[i] = XNT ? __builtin_nontemporal_load((const GAS f32x4*)(p + (size_t)(4 * i) * d.N)) : *(const GAS f32x4*)(p + (size_t)(4 * i) * d.N);
}
__device__ __forceinline__ void xitem_store(const XItem& d, const f32x4 (&v)[16], LAS float* scr, int lane) {
    const int r = lane >> 4, c4 = lane & 15;
#pragma unroll
    for (int i = 0; i < 16; ++i) { const int k = i * 4 + r;
#pragma unroll
        for (int j = 0; j < 4; ++j) scr[(4 * c4 + j) * 65 + k] = v[i][j]; }
    LDS_WAIT(); asm volatile("" ::: "memory");
#pragma unroll
    for (int j = 0; j < 8; ++j) { const int nn = (lane >> 3) + 8 * j, c = lane & 7; const LAS float* s = scr + nn * 65 + 8 * c; const int n = d.n0 + nn;
        const int row = d.tiled ? (n >> 7) * 256 + d.radd + (n & 127) : n;
        v4u o; o.x = pk2(s[0], s[1]); o.y = pk2(s[2], s[3]); o.z = pk2(s[4], s[5]); o.w = pk2(s[6], s[7]);
        if (XNT == 1) __builtin_nontemporal_store(o, (GAS v4u*)(d.WT + (size_t)row * d.ldwt + d.k0 + 8 * c)); else *(GAS v4u*)(d.WT + (size_t)row * d.ldwt + d.k0 + 8 * c) = o; }
    LDS_WAIT(); asm volatile("" ::: "memory");
}
template <class IdxFn>
__device__ __forceinline__ void conv_stream(Frame& F, int n, IdxFn idx, LAS float* scr, int lane) {
    XItem da, db; f32x4 va[16], vb[16]; int l_, x_;
    if (n > 0) { idx(0, l_, x_); xitem_desc(F, l_, x_, da); xitem_load(da, va, lane); }
    for (int j = 0; j < n; j += 2) {
        const bool hb = j + 1 < n;
        if (hb) { idx(j + 1, l_, x_); xitem_desc(F, l_, x_, db); xitem_load(db, vb, lane); }
        xitem_store(da, va, scr, lane);
        if (hb) { if (j + 2 < n) { idx(j + 2, l_, x_); xitem_desc(F, l_, x_, da); xitem_load(da, va, lane); }
            xitem_store(db, vb, scr, lane); }
    }
}
__device__ __forceinline__ void conv_window_blocked(Frame& F, int l, int base, int rank, int ipw) {
    LAS float* scr = (LAS float*)(F.lds + F.wave * 16640); const int w0 = base + rank * ipw * 8 + F.wave;
    conv_stream(F, ipw, [=](int j, int& ll, int& xx) { ll = l; xx = w0 + j * 8; }, scr, F.lane);
}
__device__ __forceinline__ void conv_window(Frame& F, int l, int base, int rank, int nblk, int ipw) {
    LAS float* scr = (LAS float*)(F.lds + F.wave * 16640); const int w0 = base + rank * 8 + F.wave, st = nblk * 8;
    conv_stream(F, ipw, [=](int j, int& ll, int& xx) { ll = l; xx = w0 + j * st; }, scr, F.lane);
}
__device__ __forceinline__ void ph0(Frame& F) {
    const int tid = F.tid, lane = F.lane;
    const int gw = F.vcu * NWAVES + F.wave, NGW = F.G * NWAVES;
    const int gt = blockIdx.x * 512 + tid, NGT = F.G * 512;
    float* cosM = (float*)(F.ws + WS_ROPE); float* sinM = cosM + 8192 * 16; float* cosG = sinM + 8192 * 16; float* sinG = cosG + 8192 * 32;
    for (int i = gt; i < 8192 * 16; i += NGT) { const int t = i >> 4, p = i & 15; const float pos = (p < 8) ? (float)(t >> 6) : (float)(t & 63);
        const float inv = exp2f(-(float)(p & 7) * (13.287712379549449f / 8.f)); float s, c; sincos_acc(pos * inv, s, c); cosM[i] = c; sinM[i] = s; }
    for (int i = gt; i < 8192 * 32; i += NGT) { const int t = i >> 5, p = i & 31; const float pos = (p < 16) ? (float)(t >> 6) : (float)(t & 63);
        const float inv = exp2f(-(float)(p & 15) * (13.287712379549449f / 16.f)); float s, c; sincos_acc(pos * inv, s, c); cosG[i] = c; sinG[i] = s; }
    { bf16* wt = (bf16*)(F.ws + WS_WIN);
      for (int i = gt; i < 2 * 96 * 128; i += NGT) { const int l = i / (96 * 128), r = i % (96 * 128); *(v4u*)(wt + ((size_t)l * 1536 + 1440) * 1024 + (size_t)r * 8) = (v4u){0u, 0u, 0u, 0u}; } }
    { LAS float* sv = (LAS float*)F.lds; LAS f32x4* part = (LAS f32x4*)(F.lds + 12288);
      float* modv = (float*)(F.ws + WS_MOD);
      for (int job = blockIdx.x; job < 256; job += F.G) {
          const int l = job >> 7, grp = job & 127;
          for (int i = tid; i < 3072; i += 512) { const int mv = i >> 10, k = i & 1023; const float v = (mv < 2) ? gin(F, I_C)[mv * 1024 + k] : gin(F, I_CCTX)[k]; sv[i] = v * sigmoidf_(v); }
          __syncthreads();
          if (tid < 384) { const int kq = tid / 12, cq = tid % 12, col = grp * 48 + cq * 4;
              f32x4 a0 = {0.f, 0.f, 0.f, 0.f}, a1 = a0, a2 = a0;
              const float* wp = gin(F, I_MODW) + ((size_t)l * 1024 + kq * 32) * 6144 + col;
#pragma unroll 8
              for (int kk = 0; kk < 32; ++kk) { const f32x4 w = *(const f32x4*)(wp + (size_t)kk * 6144); const int k = kq * 32 + kk; a0 += sv[k] * w; a1 += sv[1024 + k] * w; a2 += sv[2048 + k] * w; }
              part[(kq * 12 + cq) * 3 + 0] = a0; part[(kq * 12 + cq) * 3 + 1] = a1; part[(kq * 12 + cq) * 3 + 2] = a2; }
          __syncthreads();
          if (tid < 36) { const int cq = tid % 12, mv = tid / 12, col = grp * 48 + cq * 4; f32x4 s = *(const f32x4*)(gin(F, I_MODB) + l * 6144 + col);
              for (int kq = 0; kq < 32; ++kq) s += part[(kq * 12 + cq) * 3 + mv];
              *(f32x4*)(modv + (size_t)(l * 3 + mv) * 6144 + col) = s; }
          __syncthreads();
      } }
    LAS float* scr = (LAS float*)(F.lds + F.wave * 16640);
    constexpr int N_WIN = 2 * 16 * 45, N_WUQ = 2 * 4 * 12, N_WUKV = 2 * 2 * 16, N_WOUT = 2 * 16 * 16;
#ifndef USE_WIN
#define USE_WIN 1
#endif
    const bool win = USE_WIN && (F.G == 256);
    const int n0 = win ? PRO_L0 : NLI, n1 = win ? PRO_L1 : NLI;
    const int NITEMS = n0 + n1 + N_WIN + N_WUQ + N_WUKV + N_WOUT;
    { const int nx = n0 + n1, cnt = (nx - gw + NGW - 1) / NGW;
      conv_stream(F, cnt > 0 ? cnt : 0, [=](int j, int& ll, int& xx) { const int r = gw + j * NGW; ll = r >= n0 ? 1 : 0; xx = r >= n0 ? r - n0 : r; }, scr, lane); }
    for (int it = gw; it < NITEMS - (n0 + n1); it += NGW) {
        int r = it;
        if (r < N_WIN) { const int l = r / 720, q = r % 720, kb = q / 45, nb = q % 45;
            tr_item<32>(gin(F, I_WIN) + (size_t)l * 1024 * 1440, 1440, kb * 64, nb * 32, (bf16*)(F.ws + WS_WIN) + (size_t)l * 1536 * 1024, 1024, [](int n) { return n; }, scr, lane); continue; } r -= N_WIN;
        if (r < N_WOUT) { const int l = r / 256, q = r % 256, kb = q / 16, nb = q % 16;
            tr_item<64>(gin(F, I_WOUT) + (size_t)l * 1024 * 1024, 1024, kb * 64, nb * 64, (bf16*)(F.ws + WS_WOUT) + (size_t)l * 1024 * 1024, 1024, [](int n) { return n; }, scr, lane); continue; } r -= N_WOUT;
        if (r < N_WUQ) { const int l = r / 48, q = r % 48, kb = q / 12, nb = q % 12;
            tr_item<64>(gin(F, I_WUQ) + (size_t)l * 256 * 768, 768, kb * 64, nb * 64, (bf16*)(F.ws + WS_WUQ) + (size_t)l * 768 * 256, 256,
                        [](int n) { const int h = n / 96, j = n % 96; return j < 64 ? n : (j < 80 ? h * 96 + 64 + 2 * (j - 64) : h * 96 + 64 + 2 * (j - 80) + 1); }, scr, lane, C_MLA); continue; } r -= N_WUQ;
        { const int l = r / 32, q = r % 32, kb = q / 16, nb = q % 16;
            tr_item<64>(gin(F, I_WUKV) + (size_t)l * 128 * 1024, 1024, kb * 64, nb * 64, (bf16*)(F.ws + WS_WUKV) + (size_t)l * 1024 * 128, 128, [](int n) { return n; }, scr, lane); }
    }
}

template <int MODE>
__device__ __forceinline__ void norm_phase(Frame& F) {
    const int lane = F.lane; Span sp_; if (MODE == 2) { sp_.lo = F.vcu * NWAVES + F.wave; sp_.hi = M; sp_.step = F.G * NWAVES; } else sp_ = row_span(F, false);
    const int gw = sp_.lo, NGW = sp_.step, MH = sp_.hi;
    float* xres = (float*)(F.ws + WS_XRES); bf16* xrb = (bf16*)(F.ws + WS_XRES); bf16* h1 = (bf16*)(F.ws + WS_H1);
    const float* modv = (const float*)(F.ws + WS_MOD); const float* aff = (const float*)(F.ws + WS_AFF); const int* inv = (const int*)(F.ws + WS_INV); const bf16* ybuf = (const bf16*)(F.ws + WS_XG);
    const float* xin = gin(F, I_X); const float* cin = gin(F, I_CTX);
#define NP_LOAD(R_, V_, S_, G_) do { const int b_ = (R_) / SB, s_ = (R_) - b_ * SB; \
        const float* src_ = (MODE == 0) ? (s_ < CTX ? cin + ((size_t)b_ * CTX + s_) * DM : xin + ((size_t)b_ * SEQ + (s_ - CTX)) * DM) : xres + (size_t)(R_) * DM; \
        _Pragma("unroll") for (int j = 0; j < 4; ++j) { if (MODE == 0) V_[j] = __builtin_nontemporal_load((const f32x4*)(src_ + 4 * lane + 256 * j)); \
            else if (XRES_BF16) { const v2u w_ = *(const v2u*)(xrb + (size_t)(R_) * DM + 4 * lane + 256 * j); V_[j] = (f32x4){bflo(w_.x), bfhi(w_.x), bflo(w_.y), bfhi(w_.y)}; } \
            else V_[j] = *(const f32x4*)(src_ + 4 * lane + 256 * j); } \
        if (MODE >= 1) { S_ = (lane < 16) ? inv[(size_t)(R_) * 16 + lane] : -1; G_ = (lane < 16) ? aff[(size_t)(R_) * 16 + lane] : 0.f; } } while (0)
#define NP_YREQ(S_, G_, P0_, P1_, PG0_, PG1_, REST_) do { unsigned long long m_ = __ballot((S_) >= 0); PG0_ = 0.f; PG1_ = 0.f; \
        if (m_) { const int e_ = __builtin_ctzll(m_); m_ &= m_ - 1; const int s_ = __builtin_amdgcn_readlane((S_), e_); PG0_ = __builtin_bit_cast(float, __builtin_amdgcn_readlane(__builtin_bit_cast(int, (G_)), e_)); \
            const bf16* y_ = ybuf + ((size_t)e_ * RPE + s_) * DM + 4 * lane; _Pragma("unroll") for (int j = 0; j < 4; ++j) P0_[j] = *(const v2u*)(y_ + 256 * j); } \
        else { _Pragma("unroll") for (int j = 0; j < 4; ++j) P0_[j] = (v2u){0u, 0u}; } \
        if (m_) { const int e_ = __builtin_ctzll(m_); m_ &= m_ - 1; const int s_ = __builtin_amdgcn_readlane((S_), e_); PG1_ = __builtin_bit_cast(float, __builtin_amdgcn_readlane(__builtin_bit_cast(int, (G_)), e_)); \
            const bf16* y_ = ybuf + ((size_t)e_ * RPE + s_) * DM + 4 * lane; _Pragma("unroll") for (int j = 0; j < 4; ++j) P1_[j] = *(const v2u*)(y_ + 256 * j); } \
        else { _Pragma("unroll") for (int j = 0; j < 4; ++j) P1_[j] = (v2u){0u, 0u}; } \
        REST_ = m_; } while (0)
    f32x4 cv[4], n1v[4], n2v[4]; int cs = -1, n1s = -1, n2s = -1; float cg = 0.f, n1g = 0.f, n2g = 0.f;
    v2u cp0[4], cp1[4], np0[4], np1[4]; float cpg0 = 0.f, cpg1 = 0.f, npg0 = 0.f, npg1 = 0.f; unsigned long long crest = 0ull, nrest = 0ull;
    int R = gw;
    if (R < MH) NP_LOAD(R, cv, cs, cg);
    if (R + NGW < MH) NP_LOAD(R + NGW, n1v, n1s, n1g);
    if (MODE >= 1 && R < MH) NP_YREQ(cs, cg, cp0, cp1, cpg0, cpg1, crest);
    for (; R < MH; R += NGW) {
        if (R + 2 * NGW < MH) NP_LOAD(R + 2 * NGW, n2v, n2s, n2g);
        if (MODE >= 1 && R + NGW < MH) NP_YREQ(n1s, n1g, np0, np1, npg0, npg1, nrest);
        const int b = R / SB, s = R - b * SB; const bool isctx = s < CTX; const int mv = isctx ? 2 : b;
        if (!(MODE == 2 && isctx)) {
        f32x4 v[4];
#pragma unroll
        for (int j = 0; j < 4; ++j) v[j] = cv[j];
        if (MODE >= 1) {
            const float* g2 = modv + (size_t)((MODE - 1) * 3 + mv) * 6144 + 5120;
            f32x4 acc[4];
#pragma unroll
            for (int j = 0; j < 4; ++j) { acc[j] = cpg0 * (f32x4){bflo(cp0[j].x), bfhi(cp0[j].x), bflo(cp0[j].y), bfhi(cp0[j].y)}; acc[j] += cpg1 * (f32x4){bflo(cp1[j].x), bfhi(cp1[j].x), bflo(cp1[j].y), bfhi(cp1[j].y)}; }
            unsigned long long mask = crest;
            while (mask) {
                const int e0 = __builtin_ctzll(mask); mask &= mask - 1; const bool two = mask != 0; const int e1 = two ? __builtin_ctzll(mask) : e0; if (two) mask &= mask - 1;
                const int s0 = __builtin_amdgcn_readlane(cs, e0), s1 = __builtin_amdgcn_readlane(cs, e1);
                const float g0 = __builtin_bit_cast(float, __builtin_amdgcn_readlane(__builtin_bit_cast(int, cg), e0)), g1 = two ? __builtin_bit_cast(float, __builtin_amdgcn_readlane(__builtin_bit_cast(int, cg), e1)) : 0.f;
                const bf16* y0 = ybuf + ((size_t)e0 * RPE + s0) * DM + 4 * lane; const bf16* y1 = ybuf + ((size_t)e1 * RPE + s1) * DM + 4 * lane;
                v2u r0[4], r1[4];
#pragma unroll
                for (int j = 0; j < 4; ++j) { r0[j] = *(const v2u*)(y0 + 256 * j); r1[j] = *(const v2u*)(y1 + 256 * j); }
#pragma unroll
                for (int j = 0; j < 4; ++j) { acc[j] += g0 * (f32x4){bflo(r0[j].x), bfhi(r0[j].x), bflo(r0[j].y), bfhi(r0[j].y)}; acc[j] += g1 * (f32x4){bflo(r1[j].x), bfhi(r1[j].x), bflo(r1[j].y), bfhi(r1[j].y)}; }
            }
#pragma unroll
            for (int j = 0; j < 4; ++j) v[j] += *(const f32x4*)(g2 + 4 * lane + 256 * j) * acc[j];
            if (MODE == 1) {
#pragma unroll
                for (int j = 0; j < 4; ++j) { if (XRES_BF16) { v2u w_; w_.x = pk2(v[j].x, v[j].y); w_.y = pk2(v[j].z, v[j].w); *(v2u*)(xrb + (size_t)R * DM + 4 * lane + 256 * j) = w_; } else *(f32x4*)(xres + (size_t)R * DM + 4 * lane + 256 * j) = v[j]; } }
        }
        float ss = 0.f;
#pragma unroll
        for (int j = 0; j < 4; ++j) ss += (v[j].x * v[j].x + v[j].y * v[j].y) + (v[j].z * v[j].z + v[j].w * v[j].w);
        const float rs = rsqrtf(wave_sum(ss) * (1.f / DM) + EPS);
        if (MODE == 2) {
            float* op = F.out + ((size_t)b * SEQ + (s - CTX)) * DM;
#pragma unroll
            for (int j = 0; j < 4; ++j) __builtin_nontemporal_store(v[j] * rs * *(const f32x4*)(gin(F, I_FG) + 4 * lane + 256 * j), (f32x4*)(op + 4 * lane + 256 * j));
        } else {
            constexpr int l = MODE; const float* mp = modv + (size_t)(l * 3 + mv) * 6144; const float* ng = gin(F, I_N1G) + l * DM;
#pragma unroll
            for (int j = 0; j < 4; ++j) { const int c = 4 * lane + 256 * j; const f32x4 g = *(const f32x4*)(ng + c), sh = *(const f32x4*)(mp + c), sc = *(const f32x4*)(mp + 1024 + c);
                const f32x4 h = v[j] * rs * g * (1.f + sc) + sh; v2u o; o.x = pk2(h.x, h.y); o.y = pk2(h.z, h.w); *(v2u*)(h1 + (size_t)R * DM + c) = o; }
        }
        }
#pragma unroll
        for (int j = 0; j < 4; ++j) { cv[j] = n1v[j]; n1v[j] = n2v[j]; cp0[j] = np0[j]; cp1[j] = np1[j]; }
        cs = n1s; cg = n1g; n1s = n2s; n1g = n2g; cpg0 = npg0; cpg1 = npg1; crest = nrest;
    }
#undef NP_LOAD
#undef NP_YREQ
}

struct PrepIn { v2u q; unsigned kv; float kr1, kr2, h1[3], h2[3]; float cm, sm, cg, sg; };
__device__ __forceinline__ void prep_load(Frame& F, int R, PrepIn& I) {
    const bf16* zr = (const bf16*)(F.ws + WS_Z) + (size_t)R * ZW; const int lane = F.lane;
    const int s = R % SB; const bool lat = s >= CTX; const int t = lat ? s - CTX : 0;
    const float* cosM = (const float*)(F.ws + WS_ROPE); const float* sinM = cosM + 8192 * 16; const float* cosG = sinM + 8192 * 16; const float* sinG = cosG + 8192 * 32;
    I.q = *(const v2u*)(zr + ZQ + 4 * lane); I.kv = *(const unsigned*)(zr + ZKV + 2 * lane);
    I.kr1 = bf2f(zr[ZKR + (lane & 15)]); I.kr2 = bf2f(zr[ZKR + 16 + (lane & 15)]);
#pragma unroll
    for (int p = 0; p < 3; ++p) { const bf16* hp = zr + ZGQ + (2 * p + (lane >> 5)) * 64; I.h1[p] = bf2f(hp[lane & 31]); I.h2[p] = bf2f(hp[(lane & 31) + 32]); }
    I.cm = cosM[(size_t)t * 16 + (lane & 15)]; I.sm = sinM[(size_t)t * 16 + (lane & 15)]; I.cg = cosG[(size_t)t * 32 + (lane & 31)]; I.sg = sinG[(size_t)t * 32 + (lane & 31)];
}
__device__ __forceinline__ void prep_store(Frame& F, int l, int R, const PrepIn& I, const float ssq, const float sskv, const float (&ssh)[3]) {
    bf16* zr = (bf16*)(F.ws + WS_Z) + (size_t)R * ZW; const int lane = F.lane;
    const bool lat = (R % SB) >= CTX;
    {
        const float x0 = bflo(I.q.x), x1 = bfhi(I.q.x), x2 = bflo(I.q.y), x3 = bfhi(I.q.y);
        const float rs = rsqrtf(ssq * (1.f / 256) + EPS);
        const f32x4 g = *(const f32x4*)(gin(F, I_QNG) + l * 256 + 4 * lane);
        v2u o; o.x = pk2(x0 * rs * g.x, x1 * rs * g.y); o.y = pk2(x2 * rs * g.z, x3 * rs * g.w); *(v2u*)(zr + ZQ + 4 * lane) = o; }
    {
        const float x0 = bflo(I.kv), x1 = bfhi(I.kv);
        const float rs = rsqrtf(sskv * (1.f / 128) + EPS);
        const f32x2 g = *(const f32x2*)(gin(F, I_KVNG) + l * 128 + 2 * lane);
        *(unsigned*)(zr + ZKV + 2 * lane) = pk2(x0 * rs * g.x, x1 * rs * g.y); }
    {
        const int i = lane & 15; float o1 = I.kr1, o2 = I.kr2;
        if (lat) { o1 = I.kr1 * I.cm - I.kr2 * I.sm; o2 = I.kr2 * I.cm + I.kr1 * I.sm; }
        const unsigned w = pk2(o1, o2);
        if (lane < 16) *(unsigned*)(zr + ZKR + 2 * i) = w; }
#pragma unroll
    for (int p = 0; p < 3; ++p) { const int hh = 2 * p + (lane >> 5), i = lane & 31; bf16* hp = zr + ZGQ + hh * 64;
        const float x1 = I.h1[p], x2 = I.h2[p];
        const float rs = rsqrtf(ssh[p] * (1.f / 64) + EPS);
        const float* g = (p < 2 ? gin(F, I_GQG) : gin(F, I_GKG)) + l * 64;
        const float qs = (p < 2) ? C_GQA : 1.f;
        float y1 = x1 * rs * g[i] * qs, y2 = x2 * rs * g[i + 32] * qs;
        if (lat) { const float a = y1 * I.cg - y2 * I.sg, bb = y2 * I.cg + y1 * I.sg; y1 = a; y2 = bb; }
        hp[i] = (bf16)f2bf(y1); hp[i + 32] = (bf16)f2bf(y2); }
}
__device__ __forceinline__ void prep_quad(Frame& F, int l, int R0, int NGW, int MH) {
    PrepIn I[4]; int R[4]; bool ok[4];
#pragma unroll
    for (int u = 0; u < 4; ++u) { R[u] = R0 + u * NGW; ok[u] = R[u] < MH; if (!ok[u]) R[u] = R0; prep_load(F, R[u], I[u]); }
    float w[8], h[12];
#pragma unroll
    for (int u = 0; u < 4; ++u) { const float a0 = bflo(I[u].q.x), a1 = bfhi(I[u].q.x), a2 = bflo(I[u].q.y), a3 = bfhi(I[u].q.y); w[2 * u] = (a0 * a0 + a1 * a1) + (a2 * a2 + a3 * a3);
        const float k0 = bflo(I[u].kv), k1 = bfhi(I[u].kv); w[2 * u + 1] = k0 * k0 + k1 * k1;
#pragma unroll
        for (int p = 0; p < 3; ++p) h[3 * u + p] = I[u].h1[p] * I[u].h1[p] + I[u].h2[p] * I[u].h2[p]; }
    wave_sum_n<8>(w); half_sum_n<12>(h);
#pragma unroll
    for (int u = 0; u < 4; ++u) if (ok[u]) { const float sa[3] = {h[3 * u], h[3 * u + 1], h[3 * u + 2]}; prep_store(F, l, R[u], I[u], w[2 * u], w[2 * u + 1], sa); }
}
struct ConvIn { v4u av[4], gv[4]; bool ok[4]; };
__device__ __forceinline__ void conv_load(Frame& F, int tile, ConvIn& I) {
    const int tid = F.tid; const int R0 = tile * 32; const int b = R0 / SB, s0 = R0 - b * SB; const bool isctx = s0 < CTX;
    const int seq_lo = b * SB + (isctx ? 0 : CTX), seq_hi = b * SB + (isctx ? CTX : SB);
    const bf16* z = (const bf16*)(F.ws + WS_Z);
#pragma unroll
    for (int j = 0; j < 4; ++j) { const int it = tid + 512 * j; const int rr = it >> 5, c8 = (it & 31) * 8; const int R = R0 - 15 + rr;
        I.ok[j] = (it < 62 * 32) && R >= seq_lo && R < seq_hi; const size_t ro = (size_t)(I.ok[j] ? R : R0) * ZW;
        I.av[j] = *(const v4u*)(z + ro + ZCA + c8); I.gv[j] = *(const v4u*)(z + ro + ZCB + c8); }
}
__device__ __forceinline__ void conv_tile(Frame& F, int l, int tile, const ConvIn& I, int next_tile, ConvIn& N) {
    const int tid = F.tid, lane = F.lane, wave = F.wave; const int R0 = tile * 32;
    LAS float* U = (LAS float*)F.lds; LAS float* Y = U + 62 * 256;
#pragma unroll
    for (int j = 0; j < 4; ++j) { const int it = tid + 512 * j; if (it < 62 * 32) { const int rr = it >> 5, c8 = (it & 31) * 8;
        f32x4 u0 = {0.f, 0.f, 0.f, 0.f}, u1 = u0;
        if (I.ok[j]) { const v4u a = I.av[j], g = I.gv[j];
            u0.x = bflo(a.x) * sigmoidf_(bflo(g.x)); u0.y = bfhi(a.x) * sigmoidf_(bfhi(g.x)); u0.z = bflo(a.y) * sigmoidf_(bflo(g.y)); u0.w = bfhi(a.y) * sigmoidf_(bfhi(g.y));
            u1.x = bflo(a.z) * sigmoidf_(bflo(g.z)); u1.y = bfhi(a.z) * sigmoidf_(bfhi(g.z)); u1.z = bflo(a.w) * sigmoidf_(bflo(g.w)); u1.w = bfhi(a.w) * sigmoidf_(bfhi(g.w)); }
        *(LAS f32x4*)(U + rr * 256 + c8) = u0; *(LAS f32x4*)(U + rr * 256 + c8 + 4) = u1; } }
    if (next_tile >= 0) conv_load(F, next_tile, N);
    __syncthreads();
    { const int c = tid & 255, hf = tid >> 8; const float* wp = gin(F, I_CVW) + (size_t)l * 31 * 256 + c; const float bias = gin(F, I_CVB)[l * 256 + c];
      float w[31];
#pragma unroll
      for (int j = 0; j < 31; ++j) w[j] = wp[j * 256];
#pragma unroll
      for (int ch = 0; ch < 2; ++ch) { const int r0 = hf * 16 + ch * 8; float win[38];
#pragma unroll
          for (int q = 0; q < 38; ++q) win[q] = U[(r0 + q) * 256 + c];
#pragma unroll
          for (int o = 0; o < 8; ++o) { float y = bias;
#pragma unroll
              for (int j = 0; j < 31; ++j) y = fmaf(win[o + j], w[j], y);
              Y[(r0 + o) * 256 + c] = y; } } }
    __syncthreads();
    { const float* lg = gin(F, I_LNG) + l * 256; const float* lb = gin(F, I_LNB) + l * 256; const float* mg = gin(F, I_MOG) + l * 1024 + 768; bf16* cat = (bf16*)(F.ws + WS_H1);
      float y[4][4], red[8];
#pragma unroll
      for (int rr = 0; rr < 4; ++rr) { const int row = wave * 4 + rr; float sm = 0.f, sq = 0.f;
#pragma unroll
          for (int q = 0; q < 4; ++q) { y[rr][q] = Y[row * 256 + lane + 64 * q]; sm += y[rr][q]; sq += y[rr][q] * y[rr][q]; }
          red[rr] = sm; red[4 + rr] = sq; }
      wave_sum_n<8>(red);
      float r2[4];
#pragma unroll
      for (int rr = 0; rr < 4; ++rr) { const float mean = red[rr] * (1.f / 256), var = fmaxf(red[4 + rr] * (1.f / 256) - mean * mean, 0.f); const float rstd = rsqrtf(var + EPS); float s2 = 0.f;
#pragma unroll
          for (int q = 0; q < 4; ++q) { const int c = lane + 64 * q; const float v = (y[rr][q] - mean) * rstd * lg[c] + lb[c]; y[rr][q] = v * sigmoidf_(v); s2 += y[rr][q] * y[rr][q]; }
          r2[rr] = s2; }
      wave_sum_n<4>(r2);
#pragma unroll
      for (int rr = 0; rr < 4; ++rr) { const int row = wave * 4 + rr; const float rs = rsqrtf(r2[rr] * (1.f / 256) + EPS);
#pragma unroll
          for (int q = 0; q < 4; ++q) { const int c = lane + 64 * q; cat[(size_t)(R0 + row) * DM + 768 + c] = (bf16)f2bf(y[rr][q] * rs * mg[c]); } } }
    __syncthreads();
}
__device__ __forceinline__ void prep_phase(Frame& F, int l) {
    const Span sp = row_span(F, false);
    for (int R = sp.lo; R < sp.hi; R += 4 * sp.step) prep_quad(F, l, R, sp.step, sp.hi);
}
__device__ __forceinline__ void convmix_phase(Frame& F, int l) {
    const int ntile = (l == 1) ? NB * SEQ / 32 : M / 32;
#define CV_TILE(ti_) ((l == 1) ? ((ti_) / (SEQ / 32)) * (SB / 32) + CTX / 32 + ((ti_) % (SEQ / 32)) : (ti_))
    const int t0 = F.vcu, t1 = t0 + F.G, t2r = 2 * F.G + (F.G - 1 - F.vcu); const int t2 = (t1 < ntile && t2r < ntile) ? t2r : ntile;
    ConvIn A, B;
    if (t0 < ntile) { conv_load(F, CV_TILE(t0), A);
        conv_tile(F, l, CV_TILE(t0), A, t1 < ntile ? CV_TILE(t1) : -1, B);
        if (t1 < ntile) { conv_tile(F, l, CV_TILE(t1), B, t2 < ntile ? CV_TILE(t2) : -1, A);
            if (t2 < ntile) conv_tile(F, l, CV_TILE(t2), A, -1, B); } }
    for (int t = 3 * F.G + F.vcu; t < ntile; t += F.G) { conv_load(F, CV_TILE(t), A); conv_tile(F, l, CV_TILE(t), A, -1, B); }
#undef CV_TILE
}
#ifndef ATT_TUNED
#define ATT_TUNED 1
#endif
__device__ __forceinline__ void attn_phase(Frame& F, int l, char* ldsg) {
    const bf16* z = (const bf16*)(F.ws + WS_Z); const bf16* qm = (const bf16*)(F.ws + WS_QM); const bf16* kvm = (const bf16*)(F.ws + WS_KVM); bf16* ob = (bf16*)(F.ws + WS_O);
    const float* cosM = (const float*)(F.ws + WS_ROPE);
    const int nctx = (l == 0) ? 16 : 0;
    for (int u = F.vcu; u < 512 + nctx; u += F.G) {
        int b, h; size_t rq, rk; int nk;
        if (u < 512) { const int bh = u >> 5, qb = u & 31; b = bh >> 3; h = bh & 7; rk = (size_t)b * SB; rq = rk + CTX + (size_t)qb * 256; nk = SB; }
        else { const int v = u - 512; b = v >> 3; h = v & 7; rk = (size_t)b * SB; rq = rk; nk = CTX; }
#if ATT_TUNED
        att2::attn_unit<96, QW, KVW, ZW, KVW, 8>(qm + rq * QW + 96 * h, kvm + rk * KVW + 128 * h, z + rk * ZW + ZKR, kvm + rk * KVW + 128 * h + 64, ob + rq * OW + 64 * h, (u < 512) ? cosM + (size_t)(u & 31) * 256 * 16 : nullptr, nk / 64, ldsg, F.tid);
#else
        att::attn_unit<96, QW, KVW, ZW, KVW>(qm + rq * QW + 96 * h, kvm + rk * KVW + 128 * h, z + rk * ZW + ZKR, kvm + rk * KVW + 128 * h + 64, ob + rq * OW + 64 * h, (u < 512) ? cosM + (size_t)(u & 31) * 256 * 16 : nullptr, nk, ldsg, F.tid);
#endif
    }
    const int nctx2 = (l == 0) ? 8 : 0;
    for (int u = F.vcu; u < 256 + nctx2; u += F.G) {
        int b, h; size_t rq, rk; int nk;
        if (u < 256) { const int bh = u >> 5, qb = u & 31; b = bh >> 2; h = bh & 3; rk = (size_t)b * SB; rq = rk + CTX + (size_t)qb * 256; nk = SB; }
        else { const int v = u - 256; b = v >> 2; h = v & 3; rk = (size_t)b * SB; rq = rk; nk = CTX; }
#if ATT_TUNED
        att2::attn_unit<64, ZW, ZW, ZW, ZW, 8>(z + rq * ZW + ZGQ + 64 * h, z + rk * ZW + ZGK + 64 * (h >> 1), nullptr, z + rk * ZW + ZGV + 64 * (h >> 1), ob + rq * OW + 512 + 64 * h, nullptr, nk / 64, ldsg, F.tid);
#else
        att::attn_unit<64, ZW, ZW, ZW, ZW>(z + rq * ZW + ZGQ + 64 * h, z + rk * ZW + ZGK + 64 * (h >> 1), nullptr, z + rk * ZW + ZGV + 64 * (h >> 1), ob + rq * OW + 512 + 64 * h, nullptr, nk, ldsg, F.tid);
#endif
    }
}

__device__ __forceinline__ void gnorm_phase(Frame& F, int l) {
    const int lane = F.lane; const Span sp = row_span(F, l == 1); const int gw = sp.lo, NGW = sp.step;
    const bf16* ob = (const bf16*)(F.ws + WS_O); bf16* cat = (bf16*)(F.ws + WS_H1); const float* mg = gin(F, I_MOG) + l * 1024;
    const f32x4 g0 = *(const f32x4*)(mg + 8 * lane), g1 = *(const f32x4*)(mg + 8 * lane + 4), g2 = *(const f32x4*)(mg + 512 + 4 * lane);
    const int nrow = sp.hi;
#define GN_ROW(i_) ((l == 1) ? ((i_) / SEQ) * SB + CTX + ((i_) % SEQ) : (i_))
    for (int i = gw; i < nrow; i += 4 * NGW) {
        v4u a[4]; v2u c[4]; int R[4]; bool ok[4];
#pragma unroll
        for (int u = 0; u < 4; ++u) { const int ii = i + u * NGW; ok[u] = ii < nrow; R[u] = GN_ROW(ok[u] ? ii : i); a[u] = *(const v4u*)(ob + (size_t)R[u] * OW + 8 * lane); c[u] = *(const v2u*)(ob + (size_t)R[u] * OW + 512 + 4 * lane); }
#pragma unroll
        for (int u = 0; u < 4; ++u) { if (!ok[u]) continue;
            float x[8] = {bflo(a[u].x), bfhi(a[u].x), bflo(a[u].y), bfhi(a[u].y), bflo(a[u].z), bfhi(a[u].z), bflo(a[u].w), bfhi(a[u].w)}; float y[4] = {bflo(c[u].x), bfhi(c[u].x), bflo(c[u].y), bfhi(c[u].y)};
            float s1 = 0.f, s2 = 0.f;
#pragma unroll
            for (int k = 0; k < 8; ++k) s1 += x[k] * x[k];
#pragma unroll
            for (int k = 0; k < 4; ++k) s2 += y[k] * y[k];
            const float r1 = rsqrtf(wave_sum(s1) * (1.f / 512) + EPS), r2 = rsqrtf(wave_sum(s2) * (1.f / 256) + EPS);
            v4u o; o.x = pk2(x[0] * r1 * g0.x, x[1] * r1 * g0.y); o.y = pk2(x[2] * r1 * g0.z, x[3] * r1 * g0.w); o.z = pk2(x[4] * r1 * g1.x, x[5] * r1 * g1.y); o.w = pk2(x[6] * r1 * g1.z, x[7] * r1 * g1.w);
            *(v4u*)(cat + (size_t)R[u] * DM + 8 * lane) = o;
            v2u p; p.x = pk2(y[0] * r2 * g2.x, y[1] * r2 * g2.y); p.y = pk2(y[2] * r2 * g2.z, y[3] * r2 * g2.w);
            *(v2u*)(cat + (size_t)R[u] * DM + 512 + 4 * lane) = p; }
    }
#undef GN_ROW
}

#ifndef RT_ROWS
#define RT_ROWS 2
#endif
__device__ __forceinline__ void router_phase(Frame& F, int l) {
    constexpr int RT = RT_ROWS;
    const int tid = F.tid, lane = F.lane; const Span sp = row_span(F, l == 1);
    LAS float* W = (LAS float*)F.lds; LAS float* G2 = W + 1024 * 20; LAS float* S2 = G2 + 3072;
    const float* rw = gin(F, I_RW) + (size_t)l * 1024 * 16; const float* n2 = gin(F, I_N2G) + l * DM; const float* modl = (const float*)(F.ws + WS_MOD) + (size_t)l * 3 * 6144;
    const float* xres = (const float*)(F.ws + WS_XRES); bf16* h2 = (bf16*)(F.ws + WS_H1); float* aff = (float*)(F.ws + WS_AFF);
    for (int i = tid; i < 4096; i += 512) *(LAS f32x4*)(W + (i >> 2) * 20 + (i & 3) * 4) = *(const f32x4*)(rw + 4 * i);
    for (int i = tid; i < 3072; i += 512) { const int mv = i >> 10, k = i & 1023; G2[i] = n2[k] * (1.f + modl[mv * 6144 + 4096 + k]); S2[i] = modl[mv * 6144 + 3072 + k]; }
    __syncthreads();
    const int gbase = (sp.lo - (sp.lo % sp.step)) , gw = sp.lo % sp.step;
    for (int gi = gw; gbase + gi * RT < sp.hi; gi += sp.step) {
        const int i0 = gbase + gi * RT; const int R0 = (l == 1) ? (i0 / SEQ) * SB + CTX + (i0 % SEQ) : i0;
        const int b = R0 / SB, s = R0 - b * SB; const int mv = (s < CTX) ? 2 : b;
        const float* xl = xres + (size_t)R0 * DM + lane; const bf16* xlb = (const bf16*)(F.ws + WS_XRES) + (size_t)R0 * DM + lane; bf16* hl = h2 + (size_t)R0 * DM + lane;
        float x[RT][16]; float ss[RT];
#pragma unroll
        for (int u = 0; u < RT; ++u)
#pragma unroll
            for (int q = 0; q < 16; ++q) x[u][q] = XRES_BF16 ? bf2f(xlb[u * DM + 64 * q]) : xl[u * DM + 64 * q];
        float rs[RT];
#pragma unroll
        for (int u = 0; u < RT; ++u) {
            ss[u] = 0.f;
#pragma unroll
            for (int q = 0; q < 16; ++q) ss[u] += x[u][q] * x[u][q];
            asm volatile("" : "+v"(ss[u]));
            rs[u] = rsqrtf(wave_sum(ss[u]) * (1.f / DM) + EPS); }
        float acc[RT][16];
#pragma unroll
        for (int u = 0; u < RT; ++u)
#pragma unroll
            for (int e = 0; e < 16; ++e) acc[u][e] = 0.f;
        f32x4 cw0, cw1, cw2, cw3; float cg, csh;
#define RT_LD(q_, A0, A1, A2, A3, G_, S_) do { const int k_ = lane + 64 * (q_); const LAS f32x4* wp_ = (const LAS f32x4*)(W + k_ * 20); A0 = wp_[0]; A1 = wp_[1]; A2 = wp_[2]; A3 = wp_[3]; G_ = G2[mv * 1024 + k_]; S_ = S2[mv * 1024 + k_]; } while (0)
        RT_LD(0, cw0, cw1, cw2, cw3, cg, csh);
#pragma unroll
        for (int q = 0; q < 16; ++q) { f32x4 nw0 = cw0, nw1 = cw1, nw2 = cw2, nw3 = cw3; float ng = cg, nsh = csh;
            if (q < 15) RT_LD(q + 1, nw0, nw1, nw2, nw3, ng, nsh);
#pragma unroll
            for (int u = 0; u < RT; ++u) { float h = x[u][q] * rs[u] * cg + csh; asm volatile("" : "+v"(h));
                hl[u * DM + 64 * q] = (bf16)f2bf(h);
#define RFMA(A_, W_) asm("v_fmac_f32_e32 %0, %1, %2" : "+v"(A_) : "v"(h), "v"(W_))
                RFMA(acc[u][0], cw0.x); RFMA(acc[u][1], cw0.y); RFMA(acc[u][2], cw0.z); RFMA(acc[u][3], cw0.w);
                RFMA(acc[u][4], cw1.x); RFMA(acc[u][5], cw1.y); RFMA(acc[u][6], cw1.z); RFMA(acc[u][7], cw1.w);
                RFMA(acc[u][8], cw2.x); RFMA(acc[u][9], cw2.y); RFMA(acc[u][10], cw2.z); RFMA(acc[u][11], cw2.w);
                RFMA(acc[u][12], cw3.x); RFMA(acc[u][13], cw3.y); RFMA(acc[u][14], cw3.z); RFMA(acc[u][15], cw3.w); }
#undef RFMA
            cw0 = nw0; cw1 = nw1; cw2 = nw2; cw3 = nw3; cg = ng; csh = nsh;
            __builtin_amdgcn_sched_barrier(0); }
#undef RT_LD
        const int e = ((lane & 1) << 3) | ((lane & 2) << 1) | ((lane & 4) >> 1) | ((lane & 8) >> 3);
#pragma unroll
        for (int u = 0; u < RT; ++u) {
#define RT_STAGE(ST) do { constexpr int half_ = 8 >> (ST); const bool up = (lane >> (ST)) & 1; \
                _Pragma("unroll") for (int j = 0; j < half_; ++j) { const float a = acc[u][j], c = acc[u][j + half_]; const float mine = up ? c : a, other = up ? a : c; acc[u][j] = mine + sx<(1 << (ST))>(other); } } while (0)
            RT_STAGE(0); RT_STAGE(1); RT_STAGE(2); RT_STAGE(3);
#undef RT_STAGE
            float lg = acc[u][0]; lg += sx<16>(lg); lg = sum32(lg);
            float mx = lg;
            mx = fmaxf(mx, sx<1>(mx)); mx = fmaxf(mx, sx<2>(mx)); mx = fmaxf(mx, sx<4>(mx)); mx = fmaxf(mx, sx<8>(mx));
            const float p = __expf(lg - mx); float sum = p;
            sum += sx<1>(sum); sum += sx<2>(sum); sum += sx<4>(sum); sum += sx<8>(sum);
            if (lane < 16) aff[(size_t)(R0 + u) * 16 + e] = p / sum; }
    }
}

template <int N, int KSEL>
__device__ __forceinline__ void topk_list(Frame& F, int R0, int e, int slot0) {
    constexpr int EPT = N >= 512 ? N / 512 : 1;
    LAS unsigned* keys = (LAS unsigned*)F.lds; LAS unsigned* hist = keys + 8192; LAS unsigned* wtot = hist + 256; LAS unsigned* sel = wtot + 16;
    const float* aff = (const float*)(F.ws + WS_AFF); int* inv = (int*)(F.ws + WS_INV); int* rowidx = (int*)(F.ws + WS_ROWIDX);
    const int tid = F.tid, lane = F.lane, wave = F.wave;
    for (int i = tid; i < N; i += 512) keys[i] = __float_as_uint(aff[(size_t)(R0 + i) * 16 + e]);
    unsigned prefix = 0u; unsigned kneed = KSEL;
    for (int pass = 0; pass < 4; ++pass) {
        const int shift = 24 - 8 * pass;
        if (tid < 256) hist[tid] = 0u;
        __syncthreads();
        if (pass == 0) {
            for (int i = tid; i < N; i += 512) { const unsigned d = keys[i] >> 24; unsigned long long todo = __ballot(1);
                while (todo) { const int ln = __builtin_ctzll(todo); const unsigned d0 = __builtin_amdgcn_readlane(d, ln); const unsigned long long m = __ballot(d == d0) & todo;
                    if (lane == ln) (void)__hip_atomic_fetch_add(&hist[d0], (unsigned)__builtin_popcountll(m), __ATOMIC_RELAXED, __HIP_MEMORY_SCOPE_WORKGROUP); todo &= ~m; } }
        } else {
        for (int i = tid; i < N; i += 512) { const unsigned k = keys[i]; const unsigned hiq = (unsigned)((unsigned long long)k >> (shift + 8));
            if (hiq == prefix) (void)__hip_atomic_fetch_add(&hist[(k >> shift) & 255u], 1u, __ATOMIC_RELAXED, __HIP_MEMORY_SCOPE_WORKGROUP); }
        }
        __syncthreads();
        unsigned v = 0u, incl = 0u;
        if (tid < 256) { v = hist[255 - tid]; incl = v;
            incl = wave_scan_incl(incl, lane);
            if (lane == 63) wtot[wave] = incl; }
        __syncthreads();
        if (tid < 256) { unsigned off = 0u; for (int w = 0; w < wave; ++w) off += wtot[w]; incl += off; const unsigned excl = incl - v;
            if (incl >= kneed && excl < kneed) { sel[0] = 255u - (unsigned)tid; sel[1] = kneed - excl; } }
        __syncthreads();
        prefix = (prefix << 8) | sel[0]; kneed = sel[1];
        __syncthreads();
    }
    const unsigned T = prefix; const int cgt = KSEL - (int)kneed;
    unsigned cnt = 0u; const int base = tid * EPT;
    if (base < N) {
#pragma unroll
        for (int q = 0; q < EPT; ++q) { const unsigned k = keys[base + q]; cnt += (k > T) ? 1u : 0u; cnt += (k == T) ? 0x10000u : 0u; } }
    unsigned incl = wave_scan_incl(cnt, lane);
    if (lane == 63) wtot[wave] = incl;
    __syncthreads();
    { unsigned off = 0u; for (int w = 0; w < wave; ++w) off += wtot[w]; incl += off; }
    const unsigned excl = incl - cnt; int pg = (int)(excl & 0xffffu), pe = (int)(excl >> 16);
    if (base < N) {
#pragma unroll
        for (int q = 0; q < EPT; ++q) { const unsigned k = keys[base + q]; int slot = -1;
            if (k > T) slot = pg++; else if (k == T) { if (pe < (int)kneed) slot = cgt + pe; ++pe; }
            const int R = R0 + base + q; inv[(size_t)R * 16 + e] = slot < 0 ? -1 : slot0 + slot;
            if (slot >= 0) rowidx[e * RPE + slot0 + slot] = R; } }
    __syncthreads();
}
__device__ __forceinline__ void topk_phase(Frame& F, int l) {
    if (l == 0) { int* rowidx = (int*)(F.ws + WS_ROWIDX);
        if (blockIdx.x < 6) { const int i = blockIdx.x * 512 + F.tid; rowidx[(i / 192) * RPE + 2112 + (i % 192)] = 0; } }
    const int njobs = (l == 0) ? 64 : 32;
    for (int job = blockIdx.x; job < njobs; job += F.G) {
        if (job < 32) { const int b = job >> 4, e = job & 15; topk_list<SEQ, 1024>(F, b * SB + CTX, e, b * 1024); }
        else { const int j = job - 32, b = j >> 4, e = j & 15; topk_list<CTX, 32>(F, b * SB, e, 2048 + b * 32); }
    }
}
__device__ __forceinline__ void gather_phase(Frame& F, int l) {
    const int lane = F.lane, gw = F.vcu * NWAVES + F.wave, NGW = F.G * NWAVES; const int nrows = (l == 0) ? 2112 : 2048;
    const int* rowidx = (const int*)(F.ws + WS_ROWIDX); const bf16* h2 = (const bf16*)(F.ws + WS_H1); bf16* xg = (bf16*)(F.ws + WS_XG);
    for (int g = gw; g < NE * nrows; g += NGW) { const int e = g / nrows, slot = g - e * nrows; const int R = rowidx[e * RPE + slot];
        const v4u* src = (const v4u*)(h2 + (size_t)R * DM); v4u* dst = (v4u*)(xg + ((size_t)e * RPE + slot) * DM);
        const v4u a = src[lane], c = src[64 + lane]; dst[lane] = a; dst[64 + lane] = c; }
}
#ifndef MOE_BAUX
#define MOE_BAUX 0
#endif

struct Args { const float* in[26]; float* out; unsigned char* ws; int ph_lo, ph_hi, li, pad; };
__global__ void __launch_bounds__(NWAVES * 64, 2) fwd(Args args) {
    extern __shared__ __attribute__((aligned(16))) unsigned char lds[];
    Frame F;
    F.lds = (LAS unsigned char*)lds; F.MISC = (volatile LAS unsigned*)(F.lds + MISC_OFF);
    F.tid = threadIdx.x; F.lane = F.tid & 63; F.wave = __builtin_amdgcn_readfirstlane(F.tid >> 6);
    const int wv0 = F.wave;
    F.G = gridDim.x; { const int bx = blockIdx.x; F.vcu = (F.G % 8 == 0) ? (bx % 8) * (F.G / 8) + bx / 8 : bx; }
    int vcu0 = F.vcu; F.reg = 0; int reg0 = 0;
    F.ws = (unsigned char*)(GAS unsigned char*)args.ws; F.out = (float*)(GAS float*)args.out; F.ctl = (unsigned*)(GAS unsigned*)(args.ws + WS_CTL);
    F.in = args.in;
    if (F.tid < 64) F.MISC[F.tid] = 0u;
    __syncthreads();
    XcdBarrier bar = xcd_barrier_post(F.ctl + CW_BAR + args.li * XCD_BAR_WORDS, F.MISC + 8);
    const int lo = args.ph_lo, hi = args.ph_hi;
#ifndef PH_EN
#define PH_EN 0xFFFF
#endif
#define IN(k) (lo <= (k) && (k) < hi)
#define INT(k, t) ((((PH_EN) >> (t)) & 1) && IN(k))
#ifndef REP_MASK
#define REP_MASK 0
#endif
#define REPS(t) (1 + (((REP_MASK) >> (t)) & 1))
#define RETID() do { int wq_ = wv0; asm volatile("" : "+s"(wq_)); int ln_; asm volatile("v_mbcnt_lo_u32_b32 %0, -1, 0\n\tv_mbcnt_hi_u32_b32 %0, -1, %0" : "=v"(ln_)); int t_ = wq_ * 64 + ln_; F.tid = t_; F.lane = t_ & 63; F.wave = __builtin_amdgcn_readfirstlane(t_ >> 6); unsigned long long w_ = (unsigned long long)args.ws; asm volatile("" : "+s"(w_)); F.ws = (unsigned char*)(GAS unsigned char*)w_; int v_ = vcu0; asm volatile("" : "+s"(v_)); F.vcu = v_; int r_ = reg0; asm volatile("" : "+s"(r_)); F.reg = r_; } while (0)
#ifndef BAR_REP
#define BAR_REP 1
#endif
#ifndef PROBE_T
#define PROBE_T -1
#endif
#ifndef PROBE_A
#define PROBE_A 8
#endif
#ifndef PROBE_L
#define PROBE_L -1
#endif
#define PH_T0(t) unsigned long long pt0_ = 0; if ((t) == PROBE_T) pt0_ = __builtin_amdgcn_s_memrealtime();
#define PH_T1(t) do { if ((t) == PROBE_T && (PROBE_L < 0 || PROBE_L == pl_)) { __syncthreads(); const unsigned long long e_ = __builtin_amdgcn_s_memrealtime(); const unsigned long long w_ = (e_ - pt0_) * PROBE_A; while (__builtin_amdgcn_s_memrealtime() - e_ < w_) __builtin_amdgcn_s_sleep(8); } } while (0)
#define SEAM(k) do { if (IN(k) && IN((k) + 1)) { for (int br = 0; br < BAR_REP; ++br) xcd_barrier(bar); } } while (0)
#ifndef LBAR_REP
#define LBAR_REP 1
#endif
#ifndef LOCAL_SEAMS
#define LOCAL_SEAMS 1
#endif
#define LSEAM(k) do { if (IN(k) && IN((k) + 1)) { if (reg0) { for (int br = 0; br < LBAR_REP; ++br) xcd_local_barrier(bar); } else xcd_barrier(bar); } } while (0)
#define h1 ((bf16*)(F.ws + WS_H1))
#define z ((bf16*)(F.ws + WS_Z))
#define xg ((bf16*)(F.ws + WS_XG))
#define hid ((bf16*)(F.ws + WS_HID))

    int pl_ = 0; (void)pl_;
    if (INT(0, 0)) { PH_T0(0); for (int rep = 0; rep < REPS(0); ++rep) { RETID(); ph0(F); if (REPS(0) > 1) __syncthreads(); } PH_T1(0); SEAM(0); }
    if (LOCAL_SEAMS && IN(0) && IN(1) && F.G == 256) {
        if (threadIdx.x == 0) { const bool rg = xcd_grid_regular(bar); F.MISC[12] = rg ? 1u : 0u; F.MISC[13] = bar.x * 32u + F.MISC[10]; }
        __syncthreads();
        reg0 = __builtin_amdgcn_readfirstlane((int)F.MISC[12]); if (reg0) vcu0 = __builtin_amdgcn_readfirstlane((int)F.MISC[13]);
    }
    for (int l = 0; l < 2; ++l) {
        const int pb = 1 + 13 * l; pl_ = l;
        if (INT(pb + 0, 1)) { PH_T0(1); for (int rep = 0; rep < REPS(1); ++rep) { RETID(); if (l == 0) norm_phase<0>(F); else norm_phase<1>(F); } PH_T1(1); LSEAM(pb + 0); }
        if (INT(pb + 1, 2)) { PH_T0(2); for (int rep = 0; rep < REPS(2); ++rep) { RETID();
            pg8::Gemm g{h1, (const bf16*)(F.ws + WS_WIN) + (size_t)l * 1536 * 1024, 1024, 1024, nullptr}; pg8::GroupOrder S; const int gq = F.vcu >> 5, gj = F.vcu & 31; if (F.reg) S.init(6, grp_p0(gq), grp_np(gq), 32, gj, false); else S.init(6, 0, 66, F.G, F.vcu, false);
            pg8::EpiStore E{z, ZW, 6};
            pg8::gemm_phase<pg8::EpiStore, pg8::GroupOrder, true, true>(F.lds, g, S, E, F.tid);
            if (USE_WIN && rep == 0 && F.G == 256) {
                const int n2 = 6 * grp_np(gq) - 32; const int wr = F.reg ? (gj >= n2 ? (gq < 2 ? 10 * gq : 20 + 16 * (gq - 2)) + gj - n2 : -1) : F.vcu - 140;
                if (wr >= 0) { RETID(); conv_window(F, l, l == 0 ? BASE_IN0 : BASE_IN1, wr, WIN_IN_NB, WIN_IN_IPW); } }
            } PH_T1(2); LSEAM(pb + 1); }
        if (INT(pb + 2, 3)) { PH_T0(3); for (int rep = 0; rep < REPS(3); ++rep) { RETID(); prep_phase(F, l); } PH_T1(3); LSEAM(pb + 2); }
        if (INT(pb + 3, 4)) { PH_T0(4); for (int rep = 0; rep < REPS(4); ++rep) { RETID();
            { pg8::Gemm g{z + ZQ, (const bf16*)(F.ws + WS_WUQ) + (size_t)l * 768 * 256, 256, ZW, nullptr}; pg8::GroupOrder S; const int gq = F.vcu >> 5, gj = F.vcu & 31; if (F.reg) S.init(3, grp_p0(gq), grp_np(gq), 32, (gj + 3 * grp_np(gq)) & 31, false); else S.init(3, 0, 66, F.G, F.G == 256 ? ((F.vcu + 198) & 255) : F.vcu, false);
              pg8::EpiStore E{(bf16*)(F.ws + WS_QM), QW, 3};
              pg8::gemm_phase<pg8::EpiStore, pg8::GroupOrder, true, true>(F.lds, g, S, E, F.tid); }
            RETID();
            { pg8::Gemm g{z + ZKV, (const bf16*)(F.ws + WS_WUKV) + (size_t)l * 1024 * 128, 128, ZW, nullptr}; pg8::GroupOrder S; const int gq = F.vcu >> 5, gj = F.vcu & 31; if (F.reg) S.init(4, grp_p0(gq), grp_np(gq), 32, gj, false); else S.init(4, 0, 66, F.G, F.vcu, false);
              pg8::EpiStore E{(bf16*)(F.ws + WS_KVM), KVW, 4};
              pg8::gemm_phase<pg8::EpiStore, pg8::GroupOrder, true, true>(F.lds, g, S, E, F.tid); }
            } PH_T1(4); if (IN(pb + 3) && IN(pb + 5)) xcd_barrier(bar); }
        if (INT(pb + 5, 6)) { PH_T0(6); for (int rep = 0; rep < REPS(6); ++rep) { RETID(); convmix_phase(F, l); RETID(); attn_phase(F, l, (char*)lds);
            if (USE_WIN && rep == 0 && l == 0 && F.G == 256 && F.vcu >= 16) { RETID(); conv_window(F, 0, BASE_AT0, F.vcu - 16, WIN_AT_NB, WIN_AT_IPW); } } PH_T1(6); SEAM(pb + 5); }
        if (INT(pb + 6, 7)) { PH_T0(7); for (int rep = 0; rep < REPS(7); ++rep) { RETID(); gnorm_phase(F, l); } PH_T1(7); LSEAM(pb + 6); }
        if (INT(pb + 7, 8)) { PH_T0(8); for (int rep = 0; rep < REPS(8); ++rep) { RETID();
            pg8::Gemm g{h1, (const bf16*)(F.ws + WS_WOUT) + (size_t)l * 1024 * 1024, 1024, 1024, nullptr}; pg8::GroupOrder S; const int gq = F.vcu >> 5, gj = F.vcu & 31; if (F.reg) { if (l == 1) S.init(4, 8 * gq, 8, 32, gj, true); else S.init(4, grp_p0(gq), grp_np(gq), 32, gj, false); } else S.init(4, 0, l == 1 ? 64 : 66, F.G, F.vcu, l == 1);
            pg8::EpiRes E{gin(F, I_X), gin(F, I_CTX), (void*)(F.ws + WS_XRES), (const float*)(F.ws + WS_MOD) + (size_t)l * 3 * 6144 + 2048, l};
            pg8::gemm_phase<pg8::EpiRes, pg8::GroupOrder, true, true>(F.lds, g, S, E, F.tid);
            if (USE_WIN && rep == 0 && l == 0 && F.G == 256) {
                const int n2 = 4 * grp_np(gq) - 32; const int wr = F.reg ? (gj >= n2 ? (gq < 2 ? 28 * gq : 56 + 32 * (gq - 2)) + gj - n2 : -1) : F.vcu - 8;
                if (wr >= 0) { RETID(); conv_window(F, 0, BASE_OUT0, wr, WIN_OUT_NB, WIN_OUT_IPW); } }
            } PH_T1(8); LSEAM(pb + 7); }
        if (INT(pb + 8, 9)) { PH_T0(9); for (int rep = 0; rep < REPS(9); ++rep) { RETID(); router_phase(F, l); } PH_T1(9); SEAM(pb + 8); }
        if (INT(pb + 9, 10)) { PH_T0(10); for (int rep = 0; rep < REPS(10); ++rep) { RETID(); topk_phase(F, l);
            if (USE_WIN && rep == 0 && F.G == 256) { const int nj = (l == 0) ? 64 : 32; if ((int)blockIdx.x >= nj) conv_window(F, l, l == 0 ? BASE_TK0 : BASE_TK1, (int)blockIdx.x - nj, 256 - nj, WIN_TK_IPW); }
            } PH_T1(10); if (IN(pb + 9) && IN(pb + 11)) xcd_barrier(bar); }
        if (INT(pb + 11, 12)) { PH_T0(12); for (int rep = 0; rep < REPS(12); ++rep) { RETID();
            pg8::Gemm g{h1, (const bf16*)(F.ws + WS_W13) + (size_t)l * 16 * 5376 * 1024, 1024, 1024, (const int*)(F.ws + WS_ROWIDX)};     pg8::MoeOrder S; S.init(l == 0 ? 9 : 8, 21, F.G, F.vcu);
            pg8::EpiSwiglu E{hid};
            pg8::gemm_phase<pg8::EpiSwiglu, pg8::MoeOrder, true, true, true, MOE_BAUX>(F.lds, g, S, E, F.tid);
            if (USE_WIN && rep == 0 && F.G == 256) { const int j = F.vcu & 31, j0 = (l == 0) ? 26 : 16;
                if (j >= j0) { RETID(); conv_window_blocked(F, l, l == 0 ? BASE_M10 : BASE_M11, (F.vcu >> 5) * (32 - j0) + j - j0, WIN_M1_IPW); } }
            } PH_T1(12); LSEAM(pb + 11); }
        if (INT(pb + 12, 13)) { PH_T0(13); for (int rep = 0; rep < REPS(13); ++rep) { RETID();
            pg8::Gemm g{hid, (const bf16*)(F.ws + WS_W2) + (size_t)l * 16 * 1024 * W2P, FF, HIDP, nullptr, W2P};     pg8::MoeOrder S; S.init(l == 0 ? 9 : 8, 4, F.G, F.vcu);
            pg8::EpiStore E{xg, DM, 4};
            pg8::gemm_phase<pg8::EpiStore, pg8::MoeOrder, true, true, false, MOE_BAUX>(F.lds, g, S, E, F.tid);
            if (USE_WIN && rep == 0 && l == 0 && F.G == 256 && (F.vcu & 31) >= 8) { RETID(); conv_window(F, 1, BASE_M2, (F.vcu >> 5) * 24 + (F.vcu & 31) - 8, WIN_M2_NB, WIN_M2_IPW); }
            } PH_T1(13); SEAM(pb + 12); }
    }
    if (INT(27, 14)) { PH_T0(14); for (int rep = 0; rep < REPS(14); ++rep) { RETID(); norm_phase<2>(F); } PH_T1(14); }
#undef h1
#undef z
#undef xg
#undef hid
#undef IN
#undef INT
#undef REPS
#undef SEAM
}

#ifndef MK_MULTI
#define MK_MULTI 0
#endif
extern "C" void kernel_launch(void* const* d_in, const int* in_sizes, int n_in, void* d_out, int out_size, void* d_ws, size_t ws_size, hipStream_t stream) {
    static int grid = 0;
    if (grid == 0) {
        if (n_in != 26 || in_sizes[0] != NB * SEQ * DM || out_size != NB * SEQ * DM || ws_size < WS_END) { fprintf(stderr, "kernel_launch: shape / workspace mismatch (n_in %d, ws %zu)\n", n_in, ws_size); grid = -1; return; }
        int dev = 0, cus = 0, per_cu = 0;
        if (hipGetDevice(&dev) != hipSuccess || hipDeviceGetAttribute(&cus, hipDeviceAttributeMultiprocessorCount, dev) != hipSuccess) { grid = -1; return; }
        if (hipFuncSetAttribute((const void*)fwd, hipFuncAttributeMaxDynamicSharedMemorySize, LDS_BYTES) != hipSuccess) { fprintf(stderr, "kernel_launch: hipFuncSetAttribute failed\n"); grid = -1; return; }
        if (hipOccupancyMaxActiveBlocksPerMultiprocessor(&per_cu, (const void*)fwd, NWAVES * 64, LDS_BYTES) != hipSuccess || per_cu < 1) { fprintf(stderr, "kernel_launch: occupancy query reports %d\n", per_cu); (void)hipGetLastError(); per_cu = 1; }
        grid = cus;
    }
    if (grid < 0) return;
    if (hipMemsetAsync((char*)d_ws + WS_CTL, 0, CTL_ZERO_BYTES, stream) != hipSuccess) return;
    Args a{};
    for (int i = 0; i < 26; ++i) a.in[i] = (const float*)d_in[i];
    a.out = (float*)d_out; a.ws = (unsigned char*)d_ws; a.pad = 0;
#if MK_MULTI
    for (int p = 0; p < NPHASE; ++p) { a.ph_lo = p; a.ph_hi = p + 1; a.li = p; hipLaunchKernelGGL(fwd, dim3(grid), dim3(NWAVES * 64), LDS_BYTES, stream, a); }
#else
    a.ph_lo = 0; a.ph_hi = NPHASE; a.li = 0;
    hipLaunchKernelGGL(fwd, dim3(grid), dim3(NWAVES * 64), LDS_BYTES, stream, a);
#endif
    const hipError_t le = hipPeekAtLastError();
    if (le != hipSuccess) fprintf(stderr, "kernel_launch: launch failed: %s\n", hipGetErrorName(le));
}
```

```cpp
#include <hip/hip_runtime.h>
#include <cstdio>
#include <cstdint>

#define GAS __attribute__((address_space(1)))
#define LAS __attribute__((address_space(3)))
typedef unsigned short bf16;
typedef unsigned v4u __attribute__((ext_vector_type(4)));
typedef unsigned v2u __attribute__((ext_vector_type(2)));
typedef float f32x4 __attribute__((ext_vector_type(4)));
typedef float f32x2 __attribute__((ext_vector_type(2)));
typedef short bf16x8 __attribute__((ext_vector_type(8)));
typedef short s16x4 __attribute__((ext_vector_type(4)));
typedef float f32x16 __attribute__((ext_vector_type(16)));
#define LDS_WAIT() asm volatile("s_waitcnt lgkmcnt(0)" ::: "memory")
#define VM_WAIT() asm volatile("s_waitcnt vmcnt(0)" ::: "memory")

constexpr int DM = 1024, SEQ = 8192, CTX = 256, NB = 2, SB = SEQ + CTX, M = NB * SB, NPM = M / 256, PPB = SB / 256;
constexpr int ZW = 1536, QW = 768, KVW = 1024, OW = 768, FF = 2688, NE = 16, RPE = 2304;
constexpr int ZQ = 0, ZKV = 256, ZKR = 384, ZGQ = 416, ZGK = 672, ZGV = 800, ZCA = 928, ZCB = 1184;
constexpr float EPS = 1e-6f;
constexpr float LOG2E = 1.4426950408889634f;
constexpr float C_MLA = 0.10206207261596575f * LOG2E, C_GQA = 0.125f * LOG2E;

__device__ __forceinline__ unsigned f2bf(float f) { unsigned u = __builtin_bit_cast(unsigned, f); return (u + 0x7fffu + ((u >> 16) & 1u)) >> 16; }
__device__ __forceinline__ unsigned pk2(float lo, float hi) { unsigned r; asm volatile("v_cvt_pk_bf16_f32 %0, %1, %2" : "=v"(r) : "v"(lo), "v"(hi)); return r; }
__device__ __forceinline__ float bf2f(unsigned short h) { return __builtin_bit_cast(float, (unsigned)h << 16); }
__device__ __forceinline__ float bflo(unsigned w) { return __builtin_bit_cast(float, w << 16); }
__device__ __forceinline__ float bfhi(unsigned w) { return __builtin_bit_cast(float, w & 0xffff0000u); }
#ifndef OLD_SX
#define OLD_SX 0
#endif
#ifndef OLD_SCAN
#define OLD_SCAN 0
#endif
template <int X> __device__ __forceinline__ float sx(float v) { if (OLD_SX) return __shfl_xor(v, X); return __builtin_bit_cast(float, __builtin_amdgcn_ds_swizzle(__builtin_bit_cast(int, v), (X << 10) | 0x1f)); }
#ifndef OLD_S32
#define OLD_S32 OLD_SX
#endif
__device__ __forceinline__ float sum32(float v) {
    if (OLD_S32) return v + __shfl_xor(v, 32);
    float a_ = v, b_ = v; asm volatile("s_nop 1\n\tv_permlane32_swap_b32 %0, %1" : "+v"(a_), "+v"(b_)); return a_ + b_; }
__device__ __forceinline__ float wave_sum(float v) { v += sx<1>(v); v += sx<2>(v); v += sx<4>(v); v += sx<8>(v); v += sx<16>(v); return sum32(v); }
template <int N> __device__ __forceinline__ void wave_sum_n(float (&v)[N]) {
    float t[N];
#define WS_STEP(X) _Pragma("unroll") for (int i = 0; i < N; ++i) t[i] = sx<X>(v[i]); _Pragma("unroll") for (int i = 0; i < N; ++i) v[i] += t[i];
    WS_STEP(1) WS_STEP(2) WS_STEP(4) WS_STEP(8) WS_STEP(16)
#undef WS_STEP
#pragma unroll
    for (int i = 0; i < N; ++i) v[i] = sum32(v[i]);
}
template <int N> __device__ __forceinline__ void half_sum_n(float (&v)[N]) {
    float t[N];
#define WS_STEP(X) _Pragma("unroll") for (int i = 0; i < N; ++i) t[i] = sx<X>(v[i]); _Pragma("unroll") for (int i = 0; i < N; ++i) v[i] += t[i];
    WS_STEP(1) WS_STEP(2) WS_STEP(4) WS_STEP(8) WS_STEP(16)
#undef WS_STEP
}
__device__ __forceinline__ unsigned wave_scan_incl(unsigned v, int lane) {
    if (OLD_SCAN) { for (int o = 1; o < 64; o <<= 1) { const unsigned n = __shfl_up(v, o); if (lane >= o) v += n; } return v; }
    v += (unsigned)__builtin_amdgcn_update_dpp(0, (int)v, 0x111, 0xf, 0xf, false);
    v += (unsigned)__builtin_amdgcn_update_dpp(0, (int)v, 0x112, 0xf, 0xf, false);
    v += (unsigned)__builtin_amdgcn_update_dpp(0, (int)v, 0x114, 0xf, 0xf, false);
    v += (unsigned)__builtin_amdgcn_update_dpp(0, (int)v, 0x118, 0xf, 0xf, false);
    const unsigned s0 = __builtin_amdgcn_readlane(v, 15), s1 = __builtin_amdgcn_readlane(v, 31), s2 = __builtin_amdgcn_readlane(v, 47);
    return v + (lane >= 16 ? s0 : 0u) + (lane >= 32 ? s1 : 0u) + (lane >= 48 ? s2 : 0u);
}
__device__ __forceinline__ float sigmoidf_(float v) { return 1.f / (1.f + __expf(-v)); }

namespace pg8 {
#define PG8_LAS __attribute__((address_space(3)))
typedef unsigned short bf16_t;
typedef short bf16x8 __attribute__((ext_vector_type(8)));
typedef float f32x4 __attribute__((ext_vector_type(4)));
typedef unsigned u32x4 __attribute__((ext_vector_type(4)));
constexpr int BM = 256, BK = 64, HALF = 128, HTB = HALF * BK * 2  , STAGE_BYTES = 8 * HTB;

__host__ __device__ __forceinline__ int lds_byte(int r, int c) { const int st = (r >> 4) * 2 + (c >> 5), rr = r & 15, cc = c & 31, ob = rr * 64 + cc * 2; return st * 1024 + (ob ^ (((ob >> 9) & 1) << 5)); }
__host__ __device__ __forceinline__ void stage_rc(int b, int& R, int& C) { const int st = b / 1024, sb = b % 1024, swz = sb ^ (((sb >> 9) & 1) << 5); R = (st >> 1) * 16 + swz / 64; C = (st & 1) * 32 + (swz % 64) / 2; }
__host__ __device__ __forceinline__ int perm32(int rho) { const int n = rho >> 4, i = rho & 15; return 8 * (i >> 2) + 4 * n + (i & 3); }

struct Unit { int pm, pn; };
struct Gemm { const bf16_t* A; const bf16_t* Bt; int K, lda; const int* gidx; int ldb = 0;   unsigned kstepA = 0, kstepB = 0, pstepA = 0, pstepB = 0;   };


__device__ __forceinline__ void tile_of(int L, int nM, int nN, int& pm, int& pn) {
    const int nig = 8 * nN, gid = L / nig, fm = gid * 8, gsz = (nM - fm) < 8 ? (nM - fm) : 8, r = L % nig;
    pm = fm + r % gsz; pn = r / gsz;
}
struct RowOrder {
    int nM, nN, nwg, G, c; bool skip;
    __device__ __forceinline__ void init(int nN_, int G_, int c_, bool skip_ctx) { skip = skip_ctx; nM = skip_ctx ? 64 : 66; nN = nN_; nwg = nM * nN; G = G_; c = c_; }
    __device__ __forceinline__ bool next(int i, Unit& u) const {
        const int L = i * G + c; if (L >= nwg) return false;
        int pm, pn; tile_of(L, nM, nN, pm, pn);
        u.pm = skip ? pm + 1 + (pm >> 5) : pm; u.pn = pn; return true;
    }
    __device__ __forceinline__ void a_ready(const Unit&) const {}
    __device__ __forceinline__ void done(const Unit&) const {}
};
struct GroupOrder {
    int p0, np, nN, cpg, j; bool skip;
    __device__ __forceinline__ void init(int nN_, int p0_, int np_, int cpg_, int j_, bool skip_ctx) { nN = nN_; p0 = p0_; np = np_; cpg = cpg_; j = j_; skip = skip_ctx; }
    __device__ __forceinline__ bool next(int i, Unit& u) const {
        const int q = i * cpg + j; if (q >= np * nN || j >= cpg) return false;
        const int lp = p0 + q % np; u.pm = skip ? lp + 1 + (lp >> 5) : lp; u.pn = q / np; return true;
    }
    __device__ __forceinline__ void a_ready(const Unit&) const {}
    __device__ __forceinline__ void done(const Unit&) const {}
};
struct MoeOrder {
    int nMe, nNe, per, cpg, grp, j, epg;
    __device__ __forceinline__ void init(int nMe_, int nNe_, int G, int vcu) {
        nMe = nMe_; nNe = nNe_; per = nMe * nNe; const int ngrp = (G % 8 == 0) ? 8 : 1; cpg = G / ngrp; grp = vcu / cpg; j = vcu % cpg; epg = 16 / ngrp;
    }
    __device__ __forceinline__ bool next(int i, Unit& u) const {
        const int q = i * cpg + j; if (q >= epg * per) return false;
        const int e = grp * epg + q / per, r = q % per; u.pm = e * 9 + r % nMe; u.pn = e * nNe + r / nMe; return true;
    }
    __device__ __forceinline__ void a_ready(const Unit&) const {}
    __device__ __forceinline__ void done(const Unit&) const {}
};

#ifndef WT_STORES
#define WT_STORES 0
#endif
__device__ __forceinline__ void st16(void* p, u32x4 v) {
    if (WT_STORES == 1) asm volatile("global_store_dwordx4 %0, %1, off sc1\n\ts_nop 1" :: "v"(p), "v"(v) : "memory");     else if (WT_STORES == 2) __builtin_nontemporal_store(v, (u32x4*)p); else *(u32x4*)p = v; }
struct EpiStore {
    static constexpr bool PERM = true, AFTER_DRAIN = false;
    bf16_t* O; int ldc; int nNloc;
    __device__ __forceinline__ void operator()(const f32x4 (&acc)[2][2][4][2], const Unit& u, int wr, int wc, int fr, int fq) const {
        const int row0 = u.pm * BM + wr * 64 + fr, col0 = (u.pn % nNloc) * BM + wc * 32 + 8 * fq;
#pragma unroll
        for (int ai = 0; ai < 2; ++ai)
#pragma unroll
            for (int m = 0; m < 4; ++m) { bf16_t* rowp = O + (size_t)(row0 + ai * HALF + m * 16) * ldc + col0;
#pragma unroll
                for (int bj = 0; bj < 2; ++bj) { const f32x4 v0 = acc[ai][bj][m][0], v1 = acc[ai][bj][m][1];
                    u32x4 w; w.x = pk2(v0[0], v0[1]); w.y = pk2(v0[2], v0[3]); w.z = pk2(v1[0], v1[1]); w.w = pk2(v1[2], v1[3]);
                    st16(rowp + bj * HALF, w); } }
    }
};
struct EpiQ {
    static constexpr bool PERM = true, AFTER_DRAIN = false;
    bf16_t* O; const float* cosM; const float* sinM;
    __device__ __forceinline__ void operator()(const f32x4 (&acc)[2][2][4][2], const Unit& u, int wr, int wc, int fr, int fq) const {
        const int row0 = u.pm * BM + wr * 64 + fr, col0 = u.pn * BM + wc * 32 + 8 * fq;
        const int pb = u.pm % PPB; const bool lat = pb != 0; const int t0 = (pb - 1) * 256 + wr * 64 + fr;
#pragma unroll
        for (int ai = 0; ai < 2; ++ai)
#pragma unroll
            for (int m = 0; m < 4; ++m) { bf16_t* rowp = O + (size_t)(row0 + ai * HALF + m * 16) * QW + col0; const int t = t0 + ai * HALF + m * 16;
#pragma unroll
                for (int bj = 0; bj < 2; ++bj) { f32x4 v0 = acc[ai][bj][m][0], v1 = acc[ai][bj][m][1];
                    const int g32 = u.pn * 8 + bj * 4 + wc;
                    if (lat && (g32 % 3) == 2) {
                        const f32x4 c = *(const f32x4*)(cosM + (size_t)t * 16 + 4 * fq), s = *(const f32x4*)(sinM + (size_t)t * 16 + 4 * fq);
                        const f32x4 a0 = v0, a1 = v1;
                        v0[0] = a0[0] * c[0] - a0[1] * s[0]; v0[1] = a0[1] * c[0] + a0[0] * s[0]; v0[2] = a0[2] * c[1] - a0[3] * s[1]; v0[3] = a0[3] * c[1] + a0[2] * s[1];
                        v1[0] = a1[0] * c[2] - a1[1] * s[2]; v1[1] = a1[1] * c[2] + a1[0] * s[2]; v1[2] = a1[2] * c[3] - a1[3] * s[3]; v1[3] = a1[3] * c[3] + a1[2] * s[3];
                    }
                    u32x4 w; w.x = pk2(v0[0], v0[1]); w.y = pk2(v0[2], v0[3]); w.z = pk2(v1[0], v1[1]); w.w = pk2(v1[2], v1[3]);
                    *(u32x4*)(rowp + bj * HALF) = w; } }
    }
};
#ifndef XRES_BF16
#define XRES_BF16 1
#endif
struct EpiRes {
    static constexpr bool PERM = true, AFTER_DRAIN = false;
    const float* xin; const float* cin; void* xres; const float* gate; int layer;
    __device__ __forceinline__ void operator()(const f32x4 (&acc)[2][2][4][2], const Unit& u, int wr, int wc, int fr, int fq) const {
        const int b = u.pm / PPB, pb = u.pm % PPB, mv = pb == 0 ? 2 : b;
        const int col0 = u.pn * BM + wc * 32 + 8 * fq; const float* gp = gate + mv * 6144 + col0;
        f32x4 gv[2][2];
#pragma unroll
        for (int bj = 0; bj < 2; ++bj)
#pragma unroll
            for (int n = 0; n < 2; ++n) gv[bj][n] = *(const f32x4*)(gp + bj * HALF + 4 * n);
#pragma unroll
        for (int ai = 0; ai < 2; ++ai)
#pragma unroll
            for (int m = 0; m < 4; ++m) { const int rl = ai * HALF + wr * 64 + m * 16 + fr; const size_t R = (size_t)u.pm * BM + rl;
                const float* sp = (pb == 0 ? cin + ((size_t)b * CTX + rl) * DM : xin + ((size_t)b * SEQ + (pb - 1) * 256 + rl) * DM) + col0;
#pragma unroll
                for (int bj = 0; bj < 2; ++bj) { f32x4 x0, x1;
                    if (layer == 0) { x0 = *(const f32x4*)(sp + bj * HALF); x1 = *(const f32x4*)(sp + bj * HALF + 4); }
                    else if (XRES_BF16) { const u32x4 w = *(const u32x4*)((const bf16_t*)xres + R * DM + col0 + bj * HALF);
                        x0 = (f32x4){bflo(w.x), bfhi(w.x), bflo(w.y), bfhi(w.y)}; x1 = (f32x4){bflo(w.z), bfhi(w.z), bflo(w.w), bfhi(w.w)}; }
                    else { const float* xp = (const float*)xres + R * DM + col0 + bj * HALF; x0 = *(const f32x4*)xp; x1 = *(const f32x4*)(xp + 4); }
                    const f32x4 o0 = x0 + gv[bj][0] * acc[ai][bj][m][0], o1 = x1 + gv[bj][1] * acc[ai][bj][m][1];
                    if (XRES_BF16) { u32x4 w; w.x = pk2(o0[0], o0[1]); w.y = pk2(o0[2], o0[3]); w.z = pk2(o1[0], o1[1]); w.w = pk2(o1[2], o1[3]); *(u32x4*)((bf16_t*)xres + R * DM + col0 + bj * HALF) = w; }
                    else { float* op = (float*)xres + R * DM + col0 + bj * HALF; *(f32x4*)op = o0; *(f32x4*)(op + 4) = o1; } } }
    }
};
struct EpiSwiglu {
    static constexpr bool PERM = true, AFTER_DRAIN = false;
    bf16_t* H;
    __device__ __forceinline__ void operator()(const f32x4 (&acc)[2][2][4][2], const Unit& u, int wr, int wc, int fr, int fq) const {
        const int r0 = wr * 64 + fr, kt = (u.pn % 21) * 2 + (wc >> 1), c0 = (wc & 1) * 32 + 8 * fq;
        bf16_t* const blk = H + ((size_t)u.pm * 42 + kt) * (BM * 64) + c0;
#pragma unroll
        for (int ai = 0; ai < 2; ++ai)
#pragma unroll
            for (int m = 0; m < 4; ++m) { bf16_t* rowp = blk + (r0 + ai * HALF + m * 16) * 64;
                float h[8];
#pragma unroll
                for (int n = 0; n < 2; ++n)
#pragma unroll
                    for (int i = 0; i < 4; i += 2) { const f32x2 a = {acc[ai][0][m][n][i], acc[ai][0][m][n][i + 1]}, b = {acc[ai][1][m][n][i], acc[ai][1][m][n][i + 1]};
                        const f32x2 t = a * (-LOG2E); f32x2 d = {__builtin_amdgcn_exp2f(t.x), __builtin_amdgcn_exp2f(t.y)}; d = d + 1.0f;
                        const f32x2 r = {__builtin_amdgcn_rcpf(d.x), __builtin_amdgcn_rcpf(d.y)}; const f32x2 o = (a * b) * r; h[n * 4 + i] = o.x; h[n * 4 + i + 1] = o.y; }
                u32x4 w; w.x = pk2(h[0], h[1]); w.y = pk2(h[2], h[3]); w.z = pk2(h[4], h[5]); w.w = pk2(h[6], h[7]);
                st16(rowp, w); }
    }
};

template <class Epi, class Sched, bool ALIGN_EPI = false, bool SP2 = false, bool GATHER = false, int BAUX = 0>
__device__ __forceinline__ void gemm_phase(PG8_LAS unsigned char* lds, const Gemm g, const Sched& S, const Epi& E, const int tid_in) {
    int tid_ = tid_in; asm volatile("" : "+v"(tid_));
    const int tid = tid_, wid = __builtin_amdgcn_readfirstlane(tid >> 6), lane = tid & 63, wr = wid >> 2, wc = wid & 3, fr = lane & 15, fq = lane >> 4;
    int K_ = g.K; asm volatile("" : "+s"(K_));
    const int K = K_, nt = K / BK; int ldb_ = g.ldb ? g.ldb : K_; asm volatile("" : "+s"(ldb_)); const int LDB = ldb_;
    unsigned voffA[2], voffB[2]; int gR[2]; unsigned gC[2];
#pragma unroll
    for (int i = 0; i < 2; ++i) { int R, C; stage_rc(tid * 16 + i * 8192, R, C); const int Rb = Epi::PERM ? ((R & ~31) + perm32(R & 31)) : R;
        voffA[i] = (unsigned)(R * g.lda + C) * 2u; voffB[i] = (unsigned)(Rb * LDB + C) * 2u; gR[i] = R; gC[i] = (unsigned)C * 2u; }
    unsigned vC[2][2], vN[2][2];
#define PG8_GIDX(dst, U) do { _Pragma("unroll") for (int h_ = 0; h_ < 2; ++h_) _Pragma("unroll") for (int i_ = 0; i_ < 2; ++i_) \
        dst[h_][i_] = (unsigned)g.gidx[(U).pm * BM + h_ * HALF + gR[i_]] * (unsigned)(g.lda * 2) + gC[i_]; } while (0)
#define PG8_STGA(bufoff, kptr, h, USEN) do { if constexpr (GATHER) { const unsigned vsel_[2] = {(USEN) ? vN[h][0] : vC[h][0], (USEN) ? vN[h][1] : vC[h][1]}; PG8_STAGE(bufoff, kptr, vsel_); } \
        else { PG8_STAGE(bufoff, (kptr) + (h) * hstepA, voffA); } } while (0)
    unsigned ksa_ = g.kstepA ? g.kstepA : (unsigned)(BK * 2), ksb_ = g.kstepB ? g.kstepB : (unsigned)(BK * 2); asm volatile("" : "+s"(ksa_), "+s"(ksb_));
    const size_t kstepA = ksa_, kstepB = ksb_;
    const size_t hstepA = (size_t)HALF * g.lda * 2, hstepB = (size_t)HALF * LDB * 2;
    const size_t tstepA = g.pstepA ? (size_t)g.pstepA : 2 * hstepA, tstepB = g.pstepB ? (size_t)g.pstepB : 2 * hstepB;
    const unsigned ldsw = (unsigned)wid * 1024u;
    const int aoff = lds_byte(wr * 64 + fr, fq * 8), boff = lds_byte(wc * 32 + fr, fq * 8);
#define PG8_SA(b, h) (((b) * 2 + (h)) * HTB)
#define PG8_SB(b, h) ((4 + (b) * 2 + (h)) * HTB)
#define PG8_STAGE(bufoff, gbase, voff) do { _Pragma("unroll") for (int _i = 0; _i < 2; ++_i) \
        __builtin_amdgcn_global_load_lds((const unsigned*)((const char*)(gbase) + (voff)[_i]), (PG8_LAS unsigned*)(lds + (bufoff) + ldsw + _i * 8192), 16, 0, 0); } while (0)
#define PG8_STAGEB(bufoff, gbase, voff) do { _Pragma("unroll") for (int _i = 0; _i < 2; ++_i) \
        __builtin_amdgcn_global_load_lds((const unsigned*)((const char*)(gbase) + (voff)[_i]), (PG8_LAS unsigned*)(lds + (bufoff) + ldsw + _i * 8192), 16, 0, BAUX); } while (0)
#define PG8_LDA(dst, b, h) do { _Pragma("unroll") for (int m = 0; m < 4; ++m) _Pragma("unroll") for (int k = 0; k < 2; ++k) dst[m][k] = *(const PG8_LAS bf16x8*)(lds + PG8_SA(b, h) + aoff + m * 2048 + k * 1024); } while (0)
#define PG8_LDB(dst, b, h) do { _Pragma("unroll") for (int n = 0; n < 2; ++n) _Pragma("unroll") for (int k = 0; k < 2; ++k) dst[n][k] = *(const PG8_LAS bf16x8*)(lds + PG8_SB(b, h) + boff + n * 2048 + k * 1024); } while (0)
#define PG8_MMA(ai, bj, At, Bt) do { __builtin_amdgcn_s_setprio(1); _Pragma("unroll") for (int m = 0; m < 4; ++m) _Pragma("unroll") for (int n = 0; n < 2; ++n) _Pragma("unroll") for (int k = 0; k < 2; ++k) \
        acc[ai][bj][m][n] = __builtin_amdgcn_mfma_f32_16x16x32_bf16(Bt[n][k], At[m][k], acc[ai][bj][m][n], 0, 0, 0); __builtin_amdgcn_s_setprio(0); } while (0)
#define PG8_WAIT_V(n) asm volatile("s_waitcnt vmcnt(" #n ")" ::: "memory")
#define PG8_WAIT_L(n) asm volatile("s_waitcnt lgkmcnt(" #n ")" ::: "memory")
#define PG8_BAR __builtin_amdgcn_s_barrier()
#define PG8_SCHED __builtin_amdgcn_sched_barrier(0)
    Unit cur, nxt; int ui = 0;
    if (!S.next(0, cur)) return;
    f32x4 acc[2][2][4][2];
#pragma unroll
    for (int a = 0; a < 2; ++a)
#pragma unroll
        for (int b = 0; b < 2; ++b)
#pragma unroll
            for (int m = 0; m < 4; ++m)
#pragma unroll
                for (int n = 0; n < 2; ++n) acc[a][b][m][n] = (f32x4){0.f, 0.f, 0.f, 0.f};
    bf16x8 At[4][2], B0[2][2], B1[2][2];
    const char* cA = (const char*)g.A + (GATHER ? (size_t)0 : (size_t)cur.pm * tstepA); const char* cB = (const char*)g.Bt + (size_t)cur.pn * tstepB;
    if constexpr (GATHER) { PG8_GIDX(vC, cur); }
    S.a_ready(cur);
    if constexpr (SP2) {
        PG8_STAGEB(PG8_SB(0, 0), cB, voffB); PG8_STAGEB(PG8_SB(0, 1), cB + hstepB, voffB); PG8_STGA(PG8_SA(0, 0), cA, 0, false); PG8_STGA(PG8_SA(0, 1), cA, 1, false);
        if (wr == 1) PG8_BAR;
        PG8_WAIT_V(2); PG8_BAR;
        PG8_STAGEB(PG8_SB(1, 0), cB + kstepB, voffB); PG8_STGA(PG8_SA(1, 0), cA + kstepA, 0, false); PG8_STAGEB(PG8_SB(1, 1), cB + hstepB + kstepB, voffB);
        PG8_WAIT_V(6); PG8_BAR;
    } else {
        PG8_STAGEB(PG8_SB(0, 0), cB, voffB); PG8_STAGE(PG8_SA(0, 0), cA, voffA); PG8_STAGEB(PG8_SB(0, 1), cB + hstepB, voffB); PG8_STAGE(PG8_SA(0, 1), cA + hstepA, voffA);
        if (wr == 1) PG8_BAR;
        PG8_WAIT_V(4); PG8_BAR;
        PG8_STAGEB(PG8_SB(1, 0), cB + kstepB, voffB); PG8_STAGE(PG8_SA(1, 0), cA + kstepA, voffA); PG8_STAGEB(PG8_SB(1, 1), cB + hstepB + kstepB, voffB);
        PG8_WAIT_V(6); PG8_BAR;
    }
    for (;;) {
        const bool has_next = S.next(ui + 1, nxt);
        const char* nA = (has_next && !GATHER) ? (const char*)g.A + (size_t)nxt.pm * tstepA : cA;
        if constexpr (GATHER) { if (has_next) { PG8_GIDX(vN, nxt); } else { _Pragma("unroll") for (int h_ = 0; h_ < 2; ++h_) { vN[h_][0] = vC[h_][0]; vN[h_][1] = vC[h_][1]; } } } const char* nB = has_next ? (const char*)g.Bt + (size_t)nxt.pn * tstepB : cB;
        for (int t = 0; t < nt; t += 2) {
            const bool last = (t == nt - 2);
            const char* a1 = cA + (size_t)(t + 1) * kstepA;
            const char* a2 = last ? nA : cA + (size_t)(t + 2) * kstepA; const char* b2 = last ? nB : cB + (size_t)(t + 2) * kstepB;
            const char* a3 = a2 + kstepA; const char* b3 = b2 + kstepB;
            if (last && has_next) S.a_ready(nxt);
            if constexpr (SP2) {
            PG8_LDB(B0, 0, 0); PG8_LDB(B1, 0, 1); PG8_SCHED; PG8_LDA(At, 0, 0); PG8_STGA(PG8_SA(1, 1), a1, 1, false);
            PG8_WAIT_V(8); PG8_WAIT_L(0); PG8_BAR; PG8_MMA(0, 0, At, B0); PG8_MMA(0, 1, At, B1); PG8_BAR; PG8_SCHED;
            PG8_LDA(At, 0, 1); PG8_STAGEB(PG8_SB(0, 0), b2, voffB); PG8_STAGEB(PG8_SB(0, 1), b2 + hstepB, voffB); PG8_STGA(PG8_SA(0, 0), a2, 0, last);
            PG8_WAIT_V(8); PG8_WAIT_L(0); PG8_BAR; PG8_MMA(1, 0, At, B0); PG8_MMA(1, 1, At, B1); PG8_BAR; PG8_SCHED;
            PG8_LDB(B0, 1, 0); PG8_LDB(B1, 1, 1); PG8_SCHED; PG8_LDA(At, 1, 0); PG8_STGA(PG8_SA(0, 1), a2, 1, last);
            PG8_WAIT_V(8); PG8_WAIT_L(0); PG8_BAR; PG8_MMA(0, 0, At, B0); PG8_MMA(0, 1, At, B1); PG8_BAR; PG8_SCHED;
            PG8_LDA(At, 1, 1); PG8_STAGEB(PG8_SB(1, 0), b3, voffB); PG8_STAGEB(PG8_SB(1, 1), b3 + hstepB, voffB); PG8_STGA(PG8_SA(1, 0), a3, 0, last);
            PG8_WAIT_V(8); PG8_WAIT_L(0); PG8_BAR; PG8_MMA(1, 0, At, B0); PG8_MMA(1, 1, At, B1); PG8_BAR; PG8_SCHED;
            } else {
            PG8_LDB(B0, 0, 0); PG8_SCHED; PG8_LDA(At, 0, 0); PG8_STAGE(PG8_SA(1, 1), a1 + hstepA, voffA);
            PG8_WAIT_L(8); PG8_BAR; PG8_WAIT_L(0); PG8_MMA(0, 0, At, B0); PG8_BAR; PG8_SCHED;
            PG8_LDB(B1, 0, 1); PG8_STAGEB(PG8_SB(0, 0), b2, voffB);
            PG8_BAR; PG8_WAIT_L(0); PG8_MMA(0, 1, At, B1); PG8_BAR;
            PG8_LDA(At, 0, 1); PG8_STAGE(PG8_SA(0, 0), a2, voffA);
            PG8_BAR; PG8_WAIT_L(0); PG8_MMA(1, 0, At, B0); PG8_BAR; PG8_SCHED;
            PG8_STAGEB(PG8_SB(0, 1), b2 + hstepB, voffB);
            PG8_WAIT_V(6); PG8_BAR; PG8_MMA(1, 1, At, B1); PG8_BAR;
            PG8_LDB(B0, 1, 0); PG8_SCHED; PG8_LDA(At, 1, 0); PG8_STAGE(PG8_SA(0, 1), a2 + hstepA, voffA);
            PG8_WAIT_L(8); PG8_BAR; PG8_WAIT_L(0); PG8_MMA(0, 0, At, B0); PG8_BAR; PG8_SCHED;
            PG8_LDB(B1, 1, 1); PG8_STAGEB(PG8_SB(1, 0), b3, voffB);
            PG8_BAR; PG8_WAIT_L(0); PG8_MMA(0, 1, At, B1); PG8_BAR;
            PG8_LDA(At, 1, 1); PG8_STAGE(PG8_SA(1, 0), a3, voffA);
            PG8_BAR; PG8_WAIT_L(0); PG8_MMA(1, 0, At, B0); PG8_BAR; PG8_SCHED;
            PG8_STAGEB(PG8_SB(1, 1), b3 + hstepB, voffB);
            PG8_WAIT_V(6); PG8_BAR; PG8_MMA(1, 1, At, B1); PG8_BAR;
            }
        }
        if constexpr (ALIGN_EPI) { if (wr == 0) PG8_BAR; }
        if constexpr (!Epi::AFTER_DRAIN) { E(acc, cur, wr, wc, fr, fq); S.done(cur); }
        if (!has_next) break;
#pragma unroll
        for (int a = 0; a < 2; ++a)
#pragma unroll
            for (int b = 0; b < 2; ++b)
#pragma unroll
                for (int m = 0; m < 4; ++m)
#pragma unroll
                    for (int n = 0; n < 2; ++n) acc[a][b][m][n] = (f32x4){0.f, 0.f, 0.f, 0.f};
        cur = nxt; cA = nA; cB = nB; ++ui;
        if constexpr (GATHER) { _Pragma("unroll") for (int h_ = 0; h_ < 2; ++h_) { vC[h_][0] = vN[h_][0]; vC[h_][1] = vN[h_][1]; } }
        if constexpr (ALIGN_EPI) { if (wr == 1) PG8_BAR; }
    }
    PG8_WAIT_V(0);
    if constexpr (!ALIGN_EPI) { if (wr == 0) PG8_BAR; }
    PG8_BAR;
    if constexpr (Epi::AFTER_DRAIN) { E.fused(acc, cur, wr, wc, fr, fq, lds, wid, lane); S.done(cur); }
#undef PG8_SA
#undef PG8_SB
#undef PG8_STAGE
#undef PG8_STAGEB
#undef PG8_STGA
#undef PG8_GIDX
#undef PG8_LDA
#undef PG8_LDB
#undef PG8_MMA
#undef PG8_WAIT_V
#undef PG8_WAIT_L
#undef PG8_BAR
#undef PG8_SCHED
}
}

namespace att {
#define SBAR() __builtin_amdgcn_sched_barrier(0)
__device__ __forceinline__ int crow(int r, int hi) { return (r & 3) + 8 * (r >> 2) + 4 * hi; }
__device__ __forceinline__ unsigned cvtpk(float lo, float hi) { unsigned r; asm volatile("v_cvt_pk_bf16_f32 %0, %1, %2" : "=v"(r) : "v"(lo), "v"(hi)); return r; }

__device__ __forceinline__ void partialSM(f32x16& p0, f32x16& p1, float& mhat, f32x16& negm, float& alpha, const bool first, const float thr) {
  float pmax = p0[0];
#pragma unroll
  for (int r = 1; r < 16; ++r) pmax = fmaxf(pmax, p0[r]);
#pragma unroll
  for (int r = 0; r < 16; ++r) pmax = fmaxf(pmax, p1[r]);
  { auto rr = __builtin_amdgcn_permlane32_swap(__float_as_uint(pmax), __float_as_uint(pmax), false, false);
    pmax = fmaxf(__uint_as_float(rr[0]), __uint_as_float(rr[1])); }
  alpha = 1.f;
  if (__builtin_expect(first || __any(pmax > thr), 0)) {
    const float dl = first ? pmax : fmaxf(pmax, 0.f); mhat += dl;
#pragma unroll
    for (int r = 0; r < 16; ++r) { p0[r] -= dl; p1[r] -= dl; }
#pragma unroll
    for (int r = 0; r < 16; ++r) negm[r] = -mhat;
    asm volatile("" : "+v"(negm));
    alpha = first ? 1.f : __builtin_amdgcn_exp2f(-dl);
  }
#pragma unroll
  for (int r = 0; r < 16; ++r) p0[r] = __builtin_amdgcn_exp2f(p0[r]);
}
__device__ __forceinline__ void finishSM(f32x16& p0, f32x16& p1, float alpha, float& l_reg, bf16x8& pa0, bf16x8& pa1, bf16x8& pa2, bf16x8& pa3) {
#pragma unroll
  for (int r = 0; r < 16; ++r) p1[r] = __builtin_amdgcn_exp2f(p1[r]);
  float ps = 0;
#pragma unroll
  for (int r = 0; r < 16; ++r) ps += p0[r];
#pragma unroll
  for (int r = 0; r < 16; ++r) ps += p1[r];
  { auto rr = __builtin_amdgcn_permlane32_swap(__float_as_uint(ps), __float_as_uint(ps), false, false);
    ps = __uint_as_float(rr[0]) + __uint_as_float(rr[1]); }
  l_reg = l_reg * alpha + ps;
#define PK4(P, BASE, OUT) do { unsigned a0 = cvtpk(P[BASE + 0], P[BASE + 1]), a1 = cvtpk(P[BASE + 2], P[BASE + 3]);   \
    unsigned b0 = cvtpk(P[BASE + 4], P[BASE + 5]), b1 = cvtpk(P[BASE + 6], P[BASE + 7]);                              \
    auto r0 = __builtin_amdgcn_permlane32_swap(a0, b0, false, false); auto r1 = __builtin_amdgcn_permlane32_swap(a1, b1, false, false); \
    v4u w = {r0[0], r1[0], r0[1], r1[1]}; OUT = __builtin_bit_cast(bf16x8, w); } while (0)
  PK4(p0, 0, pa0); PK4(p0, 8, pa1); PK4(p1, 0, pa2); PK4(p1, 8, pa3);
#undef PK4
}
template <int ND, int KS>
__device__ __forceinline__ void qkt(f32x16& p0, f32x16& p1, const char* Ks, const bf16x8* qr, const f32x16& negm, int r32, int hi) {
#pragma unroll
  for (int d0 = 0; d0 < ND; ++d0) { const int cb = (d0 * 16 + hi * 8) * 2;
    const bf16x8 b0 = *reinterpret_cast<const bf16x8*>(Ks + r32 * KS + cb);
    const bf16x8 b1 = *reinterpret_cast<const bf16x8*>(Ks + (32 + r32) * KS + cb);
    p0 = __builtin_amdgcn_mfma_f32_32x32x16_bf16(b0, qr[d0], d0 == 0 ? negm : p0, 0, 0, 0);
    p1 = __builtin_amdgcn_mfma_f32_32x32x16_bf16(b1, qr[d0], d0 == 0 ? negm : p1, 0, 0, 0); }
}
__device__ __forceinline__ int v_st(int k, int c) { const int kk = (k & ~0xC) | ((k & 4) << 1) | ((k & 8) >> 1); return ((kk >> 3) * 2 + (c >> 5)) * 512 + ((kk & 7) * 32 + (c & 31)) * 2; }
__device__ __forceinline__ int v_rd_base(int lane) { return ((lane & 3) << 3) | (((lane >> 2) & 3) << 6) | (((lane >> 4) & 1) << 5) | (((lane >> 5) & 1) << 8); }
constexpr int v_rd_off(int d0, int ks, int half) { return ((2 * ks + half) * 2 + d0) * 512; }
template <int OFF> __device__ __forceinline__ s16x4 tr_read(int vb) {
  s16x4 r; asm volatile("ds_read_b64_tr_b16 %0, %1 offset:%2" : "=&v"(r) : "v"(vb), "i"(OFF) : "memory"); return r;
}
template <int D0> __device__ __forceinline__ void pv_one(f32x16& od, int vb, bf16x8 pa0, bf16x8 pa1, bf16x8 pa2, bf16x8 pa3) {
  const s16x4 l0 = tr_read<v_rd_off(D0, 0, 0)>(vb), h0 = tr_read<v_rd_off(D0, 0, 1)>(vb), l1 = tr_read<v_rd_off(D0, 1, 0)>(vb), h1 = tr_read<v_rd_off(D0, 1, 1)>(vb);
  const s16x4 l2 = tr_read<v_rd_off(D0, 2, 0)>(vb), h2 = tr_read<v_rd_off(D0, 2, 1)>(vb), l3 = tr_read<v_rd_off(D0, 3, 0)>(vb), h3 = tr_read<v_rd_off(D0, 3, 1)>(vb);
  asm volatile("s_waitcnt lgkmcnt(0)" ::: "memory"); SBAR();
#define PK(L, H) (bf16x8){L[0], L[1], L[2], L[3], H[0], H[1], H[2], H[3]}
  od = __builtin_amdgcn_mfma_f32_32x32x16_bf16(pa0, PK(l0, h0), od, 0, 0, 0);
  od = __builtin_amdgcn_mfma_f32_32x32x16_bf16(pa1, PK(l1, h1), od, 0, 0, 0);
  od = __builtin_amdgcn_mfma_f32_32x32x16_bf16(pa2, PK(l2, h2), od, 0, 0, 0);
  od = __builtin_amdgcn_mfma_f32_32x32x16_bf16(pa3, PK(l3, h3), od, 0, 0, 0);
#undef PK
}
__device__ __forceinline__ void pv_d0(f32x16* o, int vb, bf16x8 pa0, bf16x8 pa1, bf16x8 pa2, bf16x8 pa3) {
  pv_one<0>(o[0], vb, pa0, pa1, pa2, pa3); pv_one<1>(o[1], vb, pa0, pa1, pa2, pa3);
}

template <int DK, int LDQ, int LDK1, int LDK2, int LDV>
__device__ __forceinline__ void attn_unit(const bf16* __restrict__ Qb, const bf16* __restrict__ K1, const bf16* __restrict__ K2, const bf16* __restrict__ Vb,
                                          bf16* __restrict__ Ob, const float* ropeq, const int nkeys, char* lds, const int tid_in) {
  constexpr int ND = DK / 16, KS = DK * 2 + 16, SHM_K = 64 * KS, SHM_V = 8192;
  int tid_ = tid_in; asm volatile("" : "+v"(tid_));
  const int tid = tid_, wid = tid >> 6, lane = tid & 63, r32 = lane & 31, hi = lane >> 5;
  char* V_lds = lds; char* K_lds = lds + 2 * SHM_V;
  float* ws = (float*)(lds + 2 * SHM_V + 2 * SHM_K) + wid * 64; float* li_l = ws; float* al_l = ws + 32;
  constexpr float THR = 8.f;
  float mhat = 0.f, l_reg = 0; f32x16 o[2] = {}; bf16x8 qr[ND]; f32x16 negm = {}; asm volatile("" : "+v"(negm));
  const bf16* Qw = Qb + (long)(wid * 32 + r32) * LDQ + hi * 8;
#pragma unroll
  for (int d0 = 0; d0 < ND; ++d0) qr[d0] = *reinterpret_cast<const bf16x8*>(Qw + d0 * 16);
  if (DK == 96 && ropeq != nullptr) {
    const float* cr = ropeq + (size_t)(wid * 32 + r32) * 16 + 4 * hi;
#pragma unroll
    for (int d0 = 4; d0 < ND; ++d0) { const f32x4 c = *(const f32x4*)(cr + (d0 - 4) * 8), s = *(const f32x4*)(cr + 8192 * 16 + (d0 - 4) * 8);
      const v4u w = __builtin_bit_cast(v4u, qr[d0]); v4u o;
      { const float a = bflo(w.x), b = bfhi(w.x); o.x = cvtpk(a * c.x - b * s.x, b * c.x + a * s.x); }
      { const float a = bflo(w.y), b = bfhi(w.y); o.y = cvtpk(a * c.y - b * s.y, b * c.y + a * s.y); }
      { const float a = bflo(w.z), b = bfhi(w.z); o.z = cvtpk(a * c.z - b * s.z, b * c.z + a * s.z); }
      { const float a = bflo(w.w), b = bfhi(w.w); o.w = cvtpk(a * c.w - b * s.w, b * c.w + a * s.w); }
      qr[d0] = __builtin_bit_cast(bf16x8, o); }
  }
  const int sr = tid >> 3, sc = (tid & 7) * 8, vst = v_st(sr, sc), kst = sr * KS + sc * 2;
  const int sr2 = tid >> 2, sc2 = (tid & 3) * 8, kst2 = sr2 * KS + 128 + sc2 * 2;
  const bool has2 = (DK == 96) && (tid < 256);
  const int vb0 = (int)(uintptr_t)V_lds + v_rd_base(lane);
  struct { bf16x8 v, k1, k2; } sr_[2];
#define SLOAD(i, k0) do { sr_[i].v = *reinterpret_cast<const bf16x8*>(&Vb[(long)((k0) + sr) * LDV + sc]); sr_[i].k1 = *reinterpret_cast<const bf16x8*>(&K1[(long)((k0) + sr) * LDK1 + sc]); \
    if (has2) sr_[i].k2 = *reinterpret_cast<const bf16x8*>(&K2[(long)((k0) + sr2) * LDK2 + sc2]); } while (0)
#define SWRITE(b, i) do { *(bf16x8*)(V_lds + (b) * SHM_V + vst) = sr_[i].v; *(bf16x8*)(K_lds + (b) * SHM_K + kst) = sr_[i].k1; \
    if (has2) *(bf16x8*)(K_lds + (b) * SHM_K + kst2) = sr_[i].k2; } while (0)
#define RESC(a) do { if (__any((a) < 1.f)) { if (hi == 0) al_l[r32] = (a); asm volatile("s_waitcnt lgkmcnt(0)" ::: "memory"); \
    _Pragma("unroll") for (int d = 0; d < 2; ++d) _Pragma("unroll") for (int r = 0; r < 16; ++r) o[d][r] *= al_l[crow(r, hi)]; } } while (0)
  f32x16 pA0, pA1, pB0, pB1; float alA, alB; bf16x8 pa0, pa1, pa2, pa3; const int NT = nkeys / 64;
  constexpr int SE = 0, SO = 1;
  SLOAD(SE, 0); asm volatile("s_waitcnt vmcnt(0)" ::: "memory"); SWRITE(0, SE); __syncthreads();
  qkt<ND, KS>(pA0, pA1, K_lds, qr, negm, r32, hi); partialSM(pA0, pA1, mhat, negm, alA, true, THR);
  SLOAD(SO, 64); if (2 < NT) SLOAD(SE, 128);
  SWRITE(1, SO); __syncthreads();
  for (int j = 1; j + 1 < NT; j += 2) {
    SBAR(); qkt<ND, KS>(pB0, pB1, K_lds + SHM_K, qr, negm, r32, hi);
    finishSM(pA0, pA1, alA, l_reg, pa0, pa1, pa2, pa3); SBAR();
    SLOAD(SO, (j + 2) * 64); SBAR();
    pv_d0(o, vb0, pa0, pa1, pa2, pa3); partialSM(pB0, pB1, mhat, negm, alB, false, THR);
    __syncthreads(); SWRITE(0, SE);
    RESC(alB); __syncthreads();
    SBAR(); qkt<ND, KS>(pA0, pA1, K_lds, qr, negm, r32, hi);
    finishSM(pB0, pB1, alB, l_reg, pa0, pa1, pa2, pa3); SBAR();
    if (j + 3 < NT) SLOAD(SE, (j + 3) * 64); SBAR();
    pv_d0(o, vb0 + SHM_V, pa0, pa1, pa2, pa3); partialSM(pA0, pA1, mhat, negm, alA, false, THR);
    __syncthreads(); SWRITE(1, SO);
    RESC(alA); __syncthreads();
  }
  SBAR(); qkt<ND, KS>(pB0, pB1, K_lds + SHM_K, qr, negm, r32, hi);
  finishSM(pA0, pA1, alA, l_reg, pa0, pa1, pa2, pa3); SBAR();
  pv_d0(o, vb0, pa0, pa1, pa2, pa3); partialSM(pB0, pB1, mhat, negm, alB, false, THR);
  __syncthreads(); RESC(alB);
  finishSM(pB0, pB1, alB, l_reg, pa0, pa1, pa2, pa3); SBAR();
  pv_d0(o, vb0 + SHM_V, pa0, pa1, pa2, pa3);
  if (hi == 0) li_l[r32] = l_reg; asm volatile("s_waitcnt lgkmcnt(0)" ::: "memory");
  float rli[16];
#pragma unroll
  for (int r = 0; r < 16; ++r) rli[r] = __builtin_amdgcn_rcpf(li_l[crow(r, hi)]);
  bf16* Ow = Ob + (long)(wid * 32) * OW;
#pragma unroll
  for (int r = 0; r < 16; ++r) { const int orow = crow(r, hi);
#pragma unroll
    for (int d0 = 0; d0 < 2; ++d0) Ow[(long)orow * OW + d0 * 32 + r32] = (bf16)f2bf(o[d0][r] * rli[r]); }
  __syncthreads();
#undef SLOAD
#undef SWRITE
#undef RESC
}
#undef SBAR
}

namespace att2 {
using u32x4 = v4u;
typedef __attribute__((address_space(3))) const char* lds_cptr;
typedef short v4i16_t __attribute__((ext_vector_type(4)));
typedef float f32x2_t __attribute__((ext_vector_type(2))); typedef __bf16 bf16x2_t __attribute__((ext_vector_type(2)));
#define SBAR() __builtin_amdgcn_sched_barrier(0)
__device__ __forceinline__ int crow(int r, int hi) { return (r & 3) + 8 * (r >> 2) + 4 * hi; }
__device__ __forceinline__ void glds16(const void* gbase, unsigned voff, unsigned lds_dst) { unsigned keep;
  asm volatile("s_mov_b32 %0, m0\n\ts_mov_b32 m0, %3\n\ts_nop 0\n\tglobal_load_lds_dwordx4 %1, %2\n\ts_mov_b32 m0, %0" : "=&s"(keep) : "v"(voff), "s"(gbase), "s"(lds_dst) : "memory"); }
__device__ __forceinline__ float max3f(float a, float b, float c) { float r; asm("v_max3_f32 %0, %1, %2, %3" : "=v"(r) : "v"(a), "v"(b), "v"(c)); return r; }
__device__ __forceinline__ float max2f(float a, float b) { float r; asm("v_max_f32_e32 %0, %1, %2" : "=v"(r) : "v"(a), "v"(b)); return r; }
__device__ __forceinline__ float fadd_s(float a, float b) { float r; asm("v_add_f32_e32 %0, %1, %2" : "=v"(r) : "v"(a), "v"(b)); return r; }
__device__ __forceinline__ float fsub_s(float a, float b) { float r; asm("v_sub_f32_e32 %0, %1, %2" : "=v"(r) : "v"(a), "v"(b)); return r; }
__device__ __forceinline__ unsigned cvtpk_s(float lo, float hi) { f32x2_t v = {lo, hi}; bf16x2_t b = __builtin_convertvector(v, bf16x2_t); return __builtin_bit_cast(unsigned, b); }
template <int N> __device__ __forceinline__ void wait_bar() { asm volatile("s_waitcnt vmcnt(%0) lgkmcnt(0)\n\ts_barrier" :: "n"(N) : "memory"); }
template <int ND> __device__ __forceinline__ void qkt(f32x16& p0, f32x16& p1, const char* Kslot, const bf16x8* qr, const f32x16& negm, int r32, int hi) {
  const char* kb = Kslot + hi * 1024 + r32 * 16;
#pragma unroll
  for (int d0 = 0; d0 < ND; ++d0) {
    const bf16x8 b0 = *reinterpret_cast<const bf16x8*>(kb + d0 * 2048);
    const bf16x8 b1 = *reinterpret_cast<const bf16x8*>(kb + d0 * 2048 + 512);
    if (d0 == 0) { p0 = __builtin_amdgcn_mfma_f32_32x32x16_bf16(b0, qr[0], negm, 0, 0, 0); p1 = __builtin_amdgcn_mfma_f32_32x32x16_bf16(b1, qr[0], negm, 0, 0, 0); }
    else { p0 = __builtin_amdgcn_mfma_f32_32x32x16_bf16(b0, qr[d0], p0, 0, 0, 0); p1 = __builtin_amdgcn_mfma_f32_32x32x16_bf16(b1, qr[d0], p1, 0, 0, 0); } }
}
__device__ __forceinline__ void kload2(bf16x8* kf, lds_cptr kp, int j) { kf[2 * j] = *(const LAS bf16x8*)(kp + j * 2048); kf[2 * j + 1] = *(const LAS bf16x8*)(kp + j * 2048 + 512); }
__device__ __forceinline__ s16x4 vtr(lds_cptr p) { return __builtin_bit_cast(s16x4, __builtin_amdgcn_ds_read_tr16_b64_v4i16((LAS v4i16_t*)p)); }
__device__ __forceinline__ float rowmax(const f32x16& p0, const f32x16& p1) {
  float a = max3f(p0[0], p0[1], p1[0]), b = max3f(p0[2], p0[3], p1[1]); a = max3f(a, p1[2], p1[3]);
#pragma unroll
  for (int r = 4; r < 16; r += 4) { a = max3f(a, p0[r], p0[r + 1]); b = max3f(b, p0[r + 2], p0[r + 3]); a = max3f(a, p1[r], p1[r + 1]); b = max3f(b, p1[r + 2], p1[r + 3]); }
  const float m = max2f(a, b);
  auto rr = __builtin_amdgcn_permlane32_swap(__float_as_uint(m), __float_as_uint(m), false, false);
  return max2f(__uint_as_float(rr[0]), __uint_as_float(rr[1]));
}
__device__ __forceinline__ void pv(f32x16* o, int vb, bf16x8 pa0, bf16x8 pa1, bf16x8 pa2, bf16x8 pa3) {
#pragma unroll
  for (int d0 = 0; d0 < 2; ++d0) { s16x4 lo[4], hi[4];
#pragma unroll
    for (int ks = 0; ks < 4; ++ks) {
      asm volatile("ds_read_b64_tr_b16 %0,%1 offset:%c2" : "=&v"(lo[ks]) : "v"(vb), "i"(d0 * 4096 + ks * 1024) : "memory");
      asm volatile("ds_read_b64_tr_b16 %0,%1 offset:%c2" : "=&v"(hi[ks]) : "v"(vb), "i"(d0 * 4096 + ks * 1024 + 512) : "memory"); }
    asm volatile("s_waitcnt lgkmcnt(0)" ::: "memory"); SBAR();
#define PK(k) (bf16x8){lo[k][0], lo[k][1], lo[k][2], lo[k][3], hi[k][0], hi[k][1], hi[k][2], hi[k][3]}
    o[d0] = __builtin_amdgcn_mfma_f32_32x32x16_bf16(pa0, PK(0), o[d0], 0, 0, 0);
    o[d0] = __builtin_amdgcn_mfma_f32_32x32x16_bf16(pa1, PK(1), o[d0], 0, 0, 0);
    o[d0] = __builtin_amdgcn_mfma_f32_32x32x16_bf16(pa2, PK(2), o[d0], 0, 0, 0);
    o[d0] = __builtin_amdgcn_mfma_f32_32x32x16_bf16(pa3, PK(3), o[d0], 0, 0, 0);
#undef PK
  }
}

template <int DK> struct Lay { static constexpr int ND = DK / 16, NC = DK / 8, SLOTK = NC * 1024, SLOTV = 8192, LDS_K = 0, LDS_V = 3 * SLOTK, LDS_WS = LDS_V + 3 * SLOTV, LDS_OST = LDS_WS + 8 * 256, LDS_BYTES = LDS_OST + 8 * 4096, KD = (DK == 96) ? 2 : 1; };

template <int DK, int LDQ, int LDK1, int LDK2, int LDV, int THRL>
__device__ __forceinline__ void attn_unit(const bf16* Qb, const bf16* __restrict__ K1, const bf16* __restrict__ K2, const bf16* __restrict__ Vh, bf16* Ob, const float* ropeq, const int NT, char* shm, const int tid_in) {
  using L = Lay<DK>; constexpr int ND = L::ND, SLOTK = L::SLOTK, SLOTV = L::SLOTV, LDS_K = L::LDS_K, LDS_V = L::LDS_V, LDS_WS = L::LDS_WS, LDS_OST = L::LDS_OST, KD = L::KD;
  int tid_ = tid_in; asm volatile("" : "+v"(tid_));
  const int tid = tid_, lane = tid & 63, r32 = lane & 31, hi = lane >> 5; const int wid = __builtin_amdgcn_readfirstlane(tid >> 6);
  const bf16* Qw = Qb + (long)(wid * 32) * LDQ;
  const unsigned lds0 = (unsigned)(uintptr_t)shm;
  float* wsf = (float*)(shm + LDS_WS) + wid * 64;
  const unsigned koff = (unsigned)(lane * LDK1 + wid * 8) * 2u;
  const unsigned koff2 = (unsigned)(lane * LDK2 + (wid & 3) * 8) * 2u;
  const unsigned voffv = (unsigned)((16 * (wid & 3) + (lane >> 2)) * LDV + (wid >> 2) * 32 + (lane & 3) * 8) * 2u;
  const unsigned kdst = lds0 + LDS_K + wid * 1024, kdst2 = lds0 + LDS_K + (8 + (wid & 3)) * 1024, vdst = lds0 + LDS_V + wid * 1024;
#define DMA_K(t, s) do { glds16(K1 + (long)(t) * 64 * LDK1, koff, (unsigned)__builtin_amdgcn_readfirstlane(kdst + (s) * SLOTK)); \
    if (DK == 96) glds16(K2 + (long)(t) * 64 * LDK2, koff2, (unsigned)__builtin_amdgcn_readfirstlane(kdst2 + (s) * SLOTK)); } while (0)
#define DMA_V(t, s) glds16(Vh + (long)(t) * 64 * LDV, voffv, (unsigned)__builtin_amdgcn_readfirstlane(vdst + (s) * SLOTV))
  const int vb0 = (int)(lds0 + LDS_V) + ((lane >> 4) & 1) * 32 + (lane & 3) * 8 + (4 * hi + ((lane & 15) >> 2)) * 64;
  const char* Kbase = shm + LDS_K; bf16x8 kf[12];
  const lds_cptr shm3 = (lds_cptr)shm; const lds_cptr kp0 = shm3 + LDS_K + hi * 1024 + r32 * 16; const lds_cptr vp0 = shm3 + LDS_V + ((lane >> 4) & 1) * 32 + (lane & 3) * 8 + (4 * hi + ((lane & 15) >> 2)) * 64;
  DMA_K(0, 0); DMA_V(0, 0); DMA_K(1, 1);
  bf16x8 qr[6];
#pragma unroll
  for (int d0 = 0; d0 < ND; ++d0) qr[d0] = *reinterpret_cast<const bf16x8*>(&Qw[(long)r32 * LDQ + d0 * 16 + hi * 8]);
  if (DK == 96 && ropeq != nullptr) {
    const float* cr = ropeq + (size_t)(wid * 32 + r32) * 16 + 4 * hi;
#pragma unroll
    for (int d0 = 4; d0 < ND; ++d0) { const f32x4 c = *(const f32x4*)(cr + (d0 - 4) * 8), s = *(const f32x4*)(cr + 8192 * 16 + (d0 - 4) * 8);
      const v4u w = __builtin_bit_cast(v4u, qr[d0]); v4u o;
      { const float a = bflo(w.x), b = bfhi(w.x); o.x = cvtpk_s(a * c.x - b * s.x, b * c.x + a * s.x); }
      { const float a = bflo(w.y), b = bfhi(w.y); o.y = cvtpk_s(a * c.y - b * s.y, b * c.y + a * s.y); }
      { const float a = bflo(w.z), b = bfhi(w.z); o.z = cvtpk_s(a * c.z - b * s.z, b * c.z + a * s.z); }
      { const float a = bflo(w.w), b = bfhi(w.w); o.w = cvtpk_s(a * c.w - b * s.w, b * c.w + a * s.w); }
      qr[d0] = __builtin_bit_cast(bf16x8, o); }
  }
  float mhat = 0.f, l_reg = 0.f; f32x16 o[2]; o[0] = f32x16{}; o[1] = f32x16{}; f32x16 negm = f32x16{}; asm volatile("" : "+v"(negm));
  bool resc = false;
#define START(P0, P1) do { const float rm = rowmax(P0, P1); resc = false; \
    { const float dl = rm; mhat = fadd_s(mhat, dl); \
      _Pragma("unroll") for (int r = 0; r < 16; ++r) { P0[r] = fsub_s(P0[r], dl); P1[r] = fsub_s(P1[r], dl); } \
      _Pragma("unroll") for (int r = 0; r < 16; ++r) negm[r] = -mhat; asm volatile("" : "+v"(negm)); } \
    _Pragma("unroll") for (int r = 0; r < 16; ++r) P0[r] = __builtin_amdgcn_exp2f(P0[r]); } while (0)
#define RESC() do { if (resc) { asm volatile("s_waitcnt lgkmcnt(0)" ::: "memory"); \
      _Pragma("unroll") for (int d_ = 0; d_ < 2; ++d_) _Pragma("unroll") for (int r = 0; r < 16; ++r) o[d_][r] *= wsf[crow(r, hi)]; } } while (0)
  f32x16 pA0, pA1, pB0, pB1;
  int sp = 0, sc = 0, sn = 1;
#define ROT() do { sp = sc; sc = sn; sn = (sn == 2) ? 0 : sn + 1; } while (0)
  DMA_K(2, 2);
  wait_bar<1 + 2 * KD>();
  qkt<ND>(pA0, pA1, Kbase, qr, negm, r32, hi); asm volatile("s_nop 15\n\ts_nop 7" : "+v"(pA0), "+v"(pA1));
  START(pA0, pA1);
  _Pragma("unroll") for (int r = 0; r < 16; ++r) pA1[r] = __builtin_amdgcn_exp2f(pA1[r]);
  wait_bar<0>();
  DMA_K(3, 0); DMA_V(1, 1);
  ROT();
#pragma unroll
  for (int j = 0; j < ND; ++j) kload2(kf, kp0 + sc * SLOTK, j);
  wait_bar<KD + 1>();
  s16x4 vlo[8], vhi[8]; u32x4 pw0, pw1, pw2, pw3;
#define PKW(P, B) cvtpk_s(P[B], P[B + 1])
#define PAF(k) __builtin_bit_cast(bf16x8, pw##k)
#define VFR(i) (bf16x8){vlo[i][0], vlo[i][1], vlo[i][2], vlo[i][3], vhi[i][0], vhi[i][1], vhi[i][2], vhi[i][3]}
#define PIN(x) asm volatile("" : "+v"(x))
#define MX3(a, b, c) __builtin_fmaxf(__builtin_fmaxf((a), (b)), (c))
#define EX(v) __builtin_amdgcn_exp2f(v)
#define GAPB(MF, X, B) do { MF; X[B] = EX(X[B]); X[B + 1] = EX(X[B + 1]); X[B + 2] = EX(X[B + 2]); X[B + 3] = EX(X[B + 3]); PIN(X); SBAR(); } while (0)
#define VRD(i) do { vlo[i] = vtr(vp_ + (((i) >> 2) * 4096 + ((i) & 3) * 1024)); vhi[i] = vtr(vp_ + (((i) >> 2) * 4096 + ((i) & 3) * 1024 + 512)); } while (0)
#define KRD(G, j) do { if (G) { kload2(kf, kp0 + sn * SLOTK, j); SBAR(); } } while (0)
#define MFQ(C, i, d, INIT) C = __builtin_amdgcn_mfma_f32_32x32x16_bf16(kf[i], qr[d], INIT, 0, 0, 0)
#define PHASE_A64(C0, C1, P0, P1) do { \
    VRD(0); SBAR(); float sacc = (P0[0] + P0[1]); \
    MFQ(C0, 0, 0, negm); sacc += P0[2]; sacc += P0[3]; sacc += P0[4]; sacc += P0[5]; PIN(sacc); pw0[0] = PKW(P0, 0); pw0[1] = PKW(P0, 2); PIN(pw0); SBAR(); \
    VRD(4); SBAR(); MFQ(C1, 1, 0, negm); sacc += P0[6]; sacc += P0[7]; sacc += P0[8]; sacc += P0[9]; PIN(sacc); pw0[2] = PKW(P0, 4); pw0[3] = PKW(P0, 6); PIN(pw0); SBAR(); \
    VRD(1); SBAR(); MFQ(C0, 2, 1, C0); sacc += P0[10]; sacc += P0[11]; sacc += P0[12]; sacc += P0[13]; PIN(sacc); pw1[0] = PKW(P0, 8); pw1[1] = PKW(P0, 10); PIN(pw1); SBAR(); \
    VRD(5); SBAR(); MFQ(C1, 3, 1, C1); sacc += P0[14]; sacc += P0[15]; sacc += P1[0]; sacc += P1[1]; PIN(sacc); pw1[2] = PKW(P0, 12); pw1[3] = PKW(P0, 14); PIN(pw1); SBAR(); \
    VRD(2); SBAR(); MFQ(C0, 4, 2, C0); sacc += P1[2]; sacc += P1[3]; sacc += P1[4]; sacc += P1[5]; PIN(sacc); pw2[0] = PKW(P1, 0); pw2[1] = PKW(P1, 2); PIN(pw2); SBAR(); \
    VRD(6); SBAR(); MFQ(C1, 5, 2, C1); sacc += P1[6]; sacc += P1[7]; sacc += P1[8]; sacc += P1[9]; PIN(sacc); pw2[2] = PKW(P1, 4); pw2[3] = PKW(P1, 6); PIN(pw2); SBAR(); \
    VRD(3); SBAR(); MFQ(C0, 6, 3, C0); sacc += P1[10]; sacc += P1[11]; sacc += P1[12]; sacc += P1[13]; PIN(sacc); pw3[0] = PKW(P1, 8); pw3[1] = PKW(P1, 10); PIN(pw3); SBAR(); \
    VRD(7); SBAR(); MFQ(C1, 7, 3, C1); sacc += P1[14]; sacc += P1[15]; PIN(sacc); pw3[2] = PKW(P1, 12); pw3[3] = PKW(P1, 14); PIN(pw3); SBAR(); \
    l_reg += sacc; } while (0)
#define PHASE_A96(C0, C1, P0, P1) do { \
    VRD(0); SBAR(); float sacc = (P0[0] + P0[1]); \
    MFQ(C0, 0, 0, negm); sacc += P0[2]; sacc += P0[3]; sacc += P0[4]; PIN(sacc); pw0[0] = PKW(P0, 0); PIN(pw0); SBAR(); \
    VRD(4); SBAR(); MFQ(C1, 1, 0, negm); sacc += P0[5]; sacc += P0[6]; sacc += P0[7]; PIN(sacc); pw0[1] = PKW(P0, 2); PIN(pw0); SBAR(); \
    VRD(1); SBAR(); MFQ(C0, 2, 1, C0); sacc += P0[8]; sacc += P0[9]; sacc += P0[10]; PIN(sacc); pw0[2] = PKW(P0, 4); PIN(pw0); SBAR(); \
    VRD(5); SBAR(); MFQ(C1, 3, 1, C1); sacc += P0[11]; sacc += P0[12]; sacc += P0[13]; PIN(sacc); pw0[3] = PKW(P0, 6); PIN(pw0); SBAR(); \
    VRD(2); SBAR(); MFQ(C0, 4, 2, C0); sacc += P0[14]; sacc += P0[15]; PIN(sacc); pw1[0] = PKW(P0, 8); PIN(pw1); SBAR(); \
    VRD(6); SBAR(); MFQ(C1, 5, 2, C1); sacc += P1[0]; sacc += P1[1]; PIN(sacc); pw1[1] = PKW(P0, 10); PIN(pw1); SBAR(); \
    VRD(3); SBAR(); MFQ(C0, 6, 3, C0); sacc += P1[2]; sacc += P1[3]; PIN(sacc); pw1[2] = PKW(P0, 12); PIN(pw1); SBAR(); \
    VRD(7); SBAR(); MFQ(C1, 7, 3, C1); sacc += P1[4]; sacc += P1[5]; PIN(sacc); pw1[3] = PKW(P0, 14); PIN(pw1); SBAR(); \
    MFQ(C0, 8, 4, C0); sacc += P1[6]; sacc += P1[7]; sacc += P1[8]; PIN(sacc); pw2[0] = PKW(P1, 0); pw2[1] = PKW(P1, 2); PIN(pw2); SBAR(); \
    MFQ(C1, 9, 4, C1); sacc += P1[9]; sacc += P1[10]; sacc += P1[11]; PIN(sacc); pw2[2] = PKW(P1, 4); pw2[3] = PKW(P1, 6); PIN(pw2); SBAR(); \
    MFQ(C0, 10, 5, C0); sacc += P1[12]; sacc += P1[13]; PIN(sacc); pw3[0] = PKW(P1, 8); pw3[1] = PKW(P1, 10); PIN(pw3); SBAR(); \
    MFQ(C1, 11, 5, C1); sacc += P1[14]; sacc += P1[15]; PIN(sacc); pw3[2] = PKW(P1, 12); pw3[3] = PKW(P1, 14); PIN(pw3); SBAR(); \
    l_reg += sacc; } while (0)
#define STEP(C0, C1, P0, P1, t, GK, GV, GL) do { SBAR(); \
    const lds_cptr vp_ = vp0 + sp * SLOTV; \
    if (DK == 96) PHASE_A96(C0, C1, P0, P1); else PHASE_A64(C0, C1, P0, P1); \
    if (GK) { DMA_K((t) + 3, sc); } if (GV) { DMA_V((t) + 1, sn); } \
    { float a = MX3(C0[0], C0[1], C1[0]), b = MX3(C0[2], C0[3], C1[1]); a = MX3(a, C1[2], C1[3]); \
      _Pragma("unroll") for (int r = 4; r < 16; r += 4) { a = MX3(a, C0[r], C0[r + 1]); b = MX3(b, C0[r + 2], C0[r + 3]); a = MX3(a, C1[r], C1[r + 1]); b = MX3(b, C1[r + 2], C1[r + 3]); } \
      float rm = __builtin_fmaxf(a, b); { auto rr = __builtin_amdgcn_permlane32_swap(__float_as_uint(rm), __float_as_uint(rm), false, false); rm = __builtin_fmaxf(__uint_as_float(rr[0]), __uint_as_float(rr[1])); } \
      resc = false; \
      if (__builtin_expect(__any(rm > (float)THRL), 0)) { const float dl = __builtin_fmaxf(rm, 0.f); mhat += dl; \
        _Pragma("unroll") for (int r = 0; r < 16; ++r) { C0[r] -= dl; C1[r] -= dl; } \
        _Pragma("unroll") for (int r = 0; r < 16; ++r) negm[r] = -mhat; asm volatile("" : "+v"(negm)); \
        const float f = __builtin_amdgcn_exp2f(-dl); l_reg *= f; if (hi == 0) wsf[r32] = f; resc = true; } } \
    SBAR(); \
    GAPB(o[0] = __builtin_amdgcn_mfma_f32_32x32x16_bf16(PAF(0), VFR(0), o[0], 0, 0, 0), C0, 0); \
    KRD(GL && ND == 6, 0); GAPB(o[1] = __builtin_amdgcn_mfma_f32_32x32x16_bf16(PAF(0), VFR(4), o[1], 0, 0, 0), C0, 4); \
    KRD(GL, ND == 6 ? 1 : 0); GAPB(o[0] = __builtin_amdgcn_mfma_f32_32x32x16_bf16(PAF(1), VFR(1), o[0], 0, 0, 0), C0, 8); \
    KRD(GL, ND == 6 ? 2 : 1); GAPB(o[1] = __builtin_amdgcn_mfma_f32_32x32x16_bf16(PAF(1), VFR(5), o[1], 0, 0, 0), C0, 12); \
    KRD(GL, ND == 6 ? 3 : 2); GAPB(o[0] = __builtin_amdgcn_mfma_f32_32x32x16_bf16(PAF(2), VFR(2), o[0], 0, 0, 0), C1, 0); \
    KRD(GL, ND == 6 ? 4 : 3); GAPB(o[1] = __builtin_amdgcn_mfma_f32_32x32x16_bf16(PAF(2), VFR(6), o[1], 0, 0, 0), C1, 4); \
    KRD(GL && ND == 6, 5); GAPB(o[0] = __builtin_amdgcn_mfma_f32_32x32x16_bf16(PAF(3), VFR(3), o[0], 0, 0, 0), C1, 8); \
    GAPB(o[1] = __builtin_amdgcn_mfma_f32_32x32x16_bf16(PAF(3), VFR(7), o[1], 0, 0, 0), C1, 12); \
  } while (0)
  int t = 1;
  for (; t + 5 < NT; t += 2) {
    STEP(pB0, pB1, pA0, pA1, t, true, true, true);     wait_bar<KD + 1>(); RESC(); ROT();
    STEP(pA0, pA1, pB0, pB1, t + 1, true, true, true); wait_bar<KD + 1>(); RESC(); ROT();
  }
#define ENDW(tt) do { if ((tt) + 3 < NT) { wait_bar<KD + 1>(); } else if ((tt) + 2 < NT) { wait_bar<1>(); } else { wait_bar<0>(); } } while (0)
  for (; t + 1 < NT; t += 2) {
    STEP(pB0, pB1, pA0, pA1, t, (t + 3 < NT), (t + 1 < NT), (t + 1 < NT));         ENDW(t);     RESC(); ROT();
    STEP(pA0, pA1, pB0, pB1, t + 1, (t + 4 < NT), (t + 2 < NT), (t + 2 < NT));     ENDW(t + 1); RESC(); ROT();
  }
  STEP(pB0, pB1, pA0, pA1, NT - 1, false, false, false); RESC();
  { float sacc = pB0[0] + pB0[1];
    _Pragma("unroll") for (int r = 2; r < 16; ++r) sacc += pB0[r];
    _Pragma("unroll") for (int r = 0; r < 16; ++r) sacc += pB1[r];
    l_reg += sacc;
    pw0 = (u32x4){PKW(pB0, 0), PKW(pB0, 2), PKW(pB0, 4), PKW(pB0, 6)}; pw1 = (u32x4){PKW(pB0, 8), PKW(pB0, 10), PKW(pB0, 12), PKW(pB0, 14)};
    pw2 = (u32x4){PKW(pB1, 0), PKW(pB1, 2), PKW(pB1, 4), PKW(pB1, 6)}; pw3 = (u32x4){PKW(pB1, 8), PKW(pB1, 10), PKW(pB1, 12), PKW(pB1, 14)};
    SBAR(); pv(o, vb0 + sc * SLOTV, PAF(0), PAF(1), PAF(2), PAF(3)); }
  { auto rr = __builtin_amdgcn_permlane32_swap(__float_as_uint(l_reg), __float_as_uint(l_reg), false, false); l_reg = __uint_as_float(rr[0]) + __uint_as_float(rr[1]); }
  if (hi == 0) wsf[32 + r32] = l_reg; asm volatile("s_waitcnt lgkmcnt(0)" ::: "memory");
  float rli[16];
#pragma unroll
  for (int r = 0; r < 16; ++r) rli[r] = __builtin_amdgcn_rcpf(wsf[32 + crow(r, hi)]);
  bf16* Ow = Ob + (long)(wid * 32) * OW;
  { bf16* stg = (bf16*)(shm + LDS_OST) + wid * 2048;
#pragma unroll
    for (int r = 0; r < 16; ++r) { const int orow = crow(r, hi);
#pragma unroll
      for (int d0 = 0; d0 < 2; ++d0) stg[orow * 64 + d0 * 32 + r32] = (bf16)f2bf(o[d0][r] * rli[r]); }
    asm volatile("s_waitcnt lgkmcnt(0)" ::: "memory");
#pragma unroll
    for (int i = 0; i < 4; ++i) { const int row = i * 8 + (lane >> 3), ch = lane & 7; const u32x4 v = *(const u32x4*)(stg + row * 64 + ch * 8); *(u32x4*)(Ow + (long)row * OW + ch * 8) = v; } }
  asm volatile("s_waitcnt lgkmcnt(0)\n\ts_barrier" ::: "memory");
#undef DMA_K
#undef DMA_V
#undef START
#undef RESC
#undef ROT
#undef PKW
#undef PAF
#undef VFR
#undef PIN
#undef MX3
#undef EX
#undef GAPB
#undef VRD
#undef KRD
#undef MFQ
#undef PHASE_A64
#undef PHASE_A96
#undef STEP
#undef ENDW
}
#undef SBAR
}

constexpr size_t MiB = 1u << 20;
constexpr size_t WS_CTL = 0, CTL_ZERO_BYTES = 1 * MiB;
constexpr size_t WS_MOD = 1 * MiB;
constexpr size_t WS_ROPE = 2 * MiB;
constexpr size_t WS_AFF = 5 * MiB;
constexpr size_t WS_INV = 8 * MiB;
constexpr size_t WS_ROWIDX = 10 * MiB;
constexpr size_t WS_WIN = 12 * MiB, WS_WUQ = 18 * MiB, WS_WUKV = 19 * MiB, WS_WOUT = 20 * MiB;
constexpr size_t WS_XRES = 24 * MiB;
constexpr size_t WS_H1 = 90 * MiB;
constexpr size_t WS_Z = 123 * MiB;
constexpr size_t WS_QM = 173 * MiB, WS_KVM = 198 * MiB, WS_O = 231 * MiB;
constexpr size_t WS_XG = 256 * MiB;
constexpr size_t WS_HID = 328 * MiB;
constexpr size_t WS_W13 = 520 * MiB, WS_W2 = 856 * MiB, WS_END = 1024 * MiB;
constexpr int CW_BAR = 4096;
constexpr int NPHASE = 28;
constexpr int LDS_BYTES = 147456, MISC_OFF = LDS_BYTES - 256;
constexpr int NWAVES = 8;

#define XB_TMO      128
#define XB_XCNT(j)  (256  + 64 * (j))
#define XB_XSUB(j)  (1280 + 64 * (j))
#define XB_XGEN(j)  (2304 + 64 * (j))
#define XB_TOP      3328
#define XB_TOPGEN   3392
#define XB_LSUB(j)  (3456 + 64 * (j))
#define XB_LGEN(j)  (4480 + 64 * (j))
#define XCD_BAR_WORDS 5504
#define XB_SPIN_CAP (1u << 18)

__device__ __forceinline__ unsigned xb_ld(unsigned* p)              { return __hip_atomic_load(p, __ATOMIC_RELAXED, __HIP_MEMORY_SCOPE_AGENT); }
__device__ __forceinline__ unsigned xb_add(unsigned* p, unsigned v) { return __hip_atomic_fetch_add(p, v, __ATOMIC_RELAXED, __HIP_MEMORY_SCOPE_AGENT); }
__device__ __forceinline__ unsigned xb_xcc_id() { return (unsigned)__builtin_amdgcn_s_getreg((3 << 11) | 20) & 0xFu; }
#define XB_SPIN(cond, bar) do { unsigned _sp = 0; while (cond) { __builtin_amdgcn_s_sleep(1); \
    if ((++_sp & 255u) == 0u) { if (xb_ld(&(bar)[XB_TMO])) break; if (_sp > XB_SPIN_CAP) { atomicAdd(&(bar)[XB_TMO], 1u); break; } } } } while (0)

struct XcdBarrier {
    unsigned* bar; unsigned x;
    volatile LAS unsigned* st;
};

__device__ __forceinline__ XcdBarrier xcd_barrier_post(unsigned* bar, volatile LAS unsigned* st) {
    XcdBarrier b; b.bar = bar; b.x = xb_xcc_id(); b.st = st;
    if (threadIdx.x == 0) st[2] = xb_add(&bar[XB_XCNT(b.x)], 1u);
    return b;
}
__device__ __forceinline__ void xcd_barrier_complete(unsigned* bar, unsigned x, unsigned& nloc, unsigned& nx) {
    const unsigned G = gridDim.x * gridDim.y * gridDim.z;
    unsigned sum, cnt, mine, sp = 0u;
    for (;;) {
        sum = 0u; cnt = 0u; mine = 0u;
#pragma unroll
        for (unsigned j = 0; j < 16; ++j) { const unsigned c = xb_ld(&bar[XB_XCNT(j)]); sum += c; cnt += (c > 0u) ? 1u : 0u; mine = (j == x) ? c : mine; }
        if (sum == G) break;
        __builtin_amdgcn_s_sleep(1);
        if ((++sp & 255u) == 0u) { if (xb_ld(&bar[XB_TMO])) break; if (sp > XB_SPIN_CAP) { atomicAdd(&bar[XB_TMO], 1u); break; } }
    }
    nloc = mine > 0u ? mine : 1u; nx = cnt > 0u ? cnt : 1u;
}

__device__ __forceinline__ void xcd_barrier(const XcdBarrier& b) {
    asm volatile("s_waitcnt vmcnt(0)" ::: "memory");
    __syncthreads();
    if (threadIdx.x == 0) {
        unsigned* bar = b.bar;
        __builtin_amdgcn_s_waitcnt(0);
        unsigned nloc = b.st[0], nx = b.st[1];
        if (nloc == 0u) { xcd_barrier_complete(bar, b.x, nloc, nx); b.st[0] = nloc; b.st[1] = nx; }
        const unsigned old = xb_add(&bar[XB_XSUB(b.x)], 1u);
        const unsigned gen = old / nloc;
        if (old + 1u == (gen + 1u) * nloc) {
            __builtin_amdgcn_fence(__ATOMIC_RELEASE, "agent");
            asm volatile("s_waitcnt vmcnt(0)" ::: "memory");
            const unsigned og = xb_add(&bar[XB_TOP], 1u);
            const unsigned tg = og / nx;
            if (og + 1u == (tg + 1u) * nx) xb_add(&bar[XB_TOPGEN], 1u);
            else XB_SPIN(xb_ld(&bar[XB_TOPGEN]) == tg, bar);
            __builtin_amdgcn_fence(__ATOMIC_ACQUIRE, "agent");
            xb_add(&bar[XB_XGEN(b.x)], 1u);
            asm volatile("s_waitcnt vmcnt(0)" ::: "memory");
        } else {
            XB_SPIN(xb_ld(&bar[XB_XGEN(b.x)]) == gen, bar);
            __builtin_amdgcn_fence(__ATOMIC_ACQUIRE, "agent");
            asm volatile("s_waitcnt vmcnt(0)" ::: "memory");
        }
    }
    __syncthreads();
}

__device__ __forceinline__ bool xcd_grid_regular(const XcdBarrier& b) {
    unsigned n32 = 0u, nz = 0u;
#pragma unroll
    for (unsigned j = 0; j < 16; ++j) { const unsigned c = xb_ld(&b.bar[XB_XCNT(j)]); n32 += (c == 32u) ? 1u : 0u; nz += (c > 0u) ? 1u : 0u; }
    return n32 == 8u && nz == 8u && b.x < 8u;
}
__device__ __forceinline__ void xcd_local_barrier(const XcdBarrier& b) {
    asm volatile("s_waitcnt vmcnt(0)" ::: "memory");
    __syncthreads();
    if (threadIdx.x == 0) {
        unsigned* bar = b.bar;
        __builtin_amdgcn_s_waitcnt(0);
        const unsigned nloc = b.st[0];
        const unsigned old = xb_add(&bar[XB_LSUB(b.x)], 1u);
        const unsigned gen = old / nloc;
        if (old + 1u == (gen + 1u) * nloc) xb_add(&bar[XB_LGEN(b.x)], 1u);
        else XB_SPIN(xb_ld(&bar[XB_LGEN(b.x)]) == gen, bar);
        __builtin_amdgcn_fence(__ATOMIC_ACQUIRE, "agent");
        asm volatile("s_waitcnt vmcnt(0)" ::: "memory");
    }
    __syncthreads();
}

struct Frame {
    LAS unsigned char* lds; volatile LAS unsigned* MISC; unsigned* ctl;
    int tid, lane, wave, vcu, G;
    int reg;
    const float* const* in; float* out; unsigned char* ws;
};
__device__ __forceinline__ const float* gin(const Frame& F, int i) { return (const float*)(const GAS float*)F.in[i]; }
struct Span { int lo, hi, step; };
__device__ __forceinline__ int grp_p0(int g) { return 8 * g + (g < 2 ? g : 2); }
__device__ __forceinline__ int grp_np(int g) { return g < 2 ? 9 : 8; }
__device__ __forceinline__ Span row_span(const Frame& F, bool latent_only) {
    Span s;
    if (F.reg) { const int g = F.vcu >> 5, j = F.vcu & 31; const int lo = latent_only ? 2048 * g : 256 * grp_p0(g); s.hi = latent_only ? lo + 2048 : lo + 256 * grp_np(g); s.lo = lo + j * NWAVES + F.wave; s.step = 32 * NWAVES; }
    else { s.lo = F.vcu * NWAVES + F.wave; s.hi = latent_only ? NB * SEQ : M; s.step = F.G * NWAVES; }
    return s;
}
enum { I_X = 0, I_C, I_CTX, I_CCTX, I_MODW, I_MODB, I_N1G, I_WIN, I_QNG, I_WUQ, I_KVNG, I_WUKV, I_GQG, I_GKG, I_CVW, I_CVB, I_LNG, I_LNB, I_MOG, I_WOUT, I_N2G, I_RW, I_W1, I_W3, I_W2, I_FG };

__device__ __forceinline__ void sincos_acc(float ang, float& s, float& c) {
    const double x = (double)ang; const double k = __builtin_rint(x * 0.63661977236758134);
    double r = __builtin_fma(-k, 1.5707963267948966, x); r = __builtin_fma(-k, 6.123233995736766e-17, r);
    const double r2 = r * r;
    const double sp = r * (1.0 + r2 * (-1.0 / 6 + r2 * (1.0 / 120 + r2 * (-1.0 / 5040 + r2 * (1.0 / 362880 + r2 * (-1.0 / 39916800 + r2 * (1.0 / 6227020800.0)))))));
    const double cp = 1.0 + r2 * (-0.5 + r2 * (1.0 / 24 + r2 * (-1.0 / 720 + r2 * (1.0 / 40320 + r2 * (-1.0 / 3628800 + r2 * (1.0 / 479001600.0 + r2 * (-1.0 / 87178291200.0)))))));
    const int q = (int)k & 3;
    const double sv = (q == 0) ? sp : (q == 1) ? cp : (q == 2) ? -sp : -cp;
    const double cv = (q == 0) ? cp : (q == 1) ? -sp : (q == 2) ? -cp : sp;
    s = (float)sv; c = (float)cv;
}
template <int NW, class RowMap>
__device__ __forceinline__ void tr_item(const float* W, int N, int k0, int n0, bf16* WT, int ldwt, RowMap rowmap, LAS float* scr, int lane, const float vs = 1.f) {
    constexpr int LPR = NW / 4, RPI = 64 / LPR, NI = 64 / RPI, NO = NW * 8 / 64;
    const int r = lane / LPR, c4 = lane % LPR;
    f32x4 v[NI];
#pragma unroll
    for (int i = 0; i < NI; ++i) v[i] = *(const GAS f32x4*)(W + (size_t)(k0 + i * RPI + r) * N + n0 + 4 * c4);
#pragma unroll
    for (int i = 0; i < NI; ++i) { const int k = i * RPI + r;
#pragma unroll
        for (int j = 0; j < 4; ++j) scr[(4 * c4 + j) * 65 + k] = v[i][j]; }
    LDS_WAIT(); asm volatile("" ::: "memory");
#pragma unroll
    for (int j = 0; j < NO; ++j) { const int n = (lane >> 3) + 8 * j, c = lane & 7; const LAS float* s = scr + n * 65 + 8 * c;
        v4u o; o.x = pk2(s[0] * vs, s[1] * vs); o.y = pk2(s[2] * vs, s[3] * vs); o.z = pk2(s[4] * vs, s[5] * vs); o.w = pk2(s[6] * vs, s[7] * vs);
        *(GAS v4u*)(WT + (size_t)rowmap(n0 + n) * ldwt + k0 + 8 * c) = o; }
    LDS_WAIT(); asm volatile("" ::: "memory");
}
constexpr int NLI = 32256, NMI = 10752;
#ifndef MOE_LSEAM
#define MOE_LSEAM 0
#endif
constexpr int WIN_IN_NB = 116, WIN_IN_IPW = 5, WIN_OUT_NB = 248, WIN_OUT_IPW = 5, WIN_TK0_NB = 192, WIN_TK1_NB = 224, WIN_TK_IPW = 4, WIN_M2_NB = 192, WIN_M2_IPW = 10;
constexpr int N_WIN_IN = WIN_IN_NB * 8 * WIN_IN_IPW, N_WIN_OUT = WIN_OUT_NB * 8 * WIN_OUT_IPW, N_WIN_TK0 = WIN_TK0_NB * 8 * WIN_TK_IPW, N_WIN_TK1 = WIN_TK1_NB * 8 * WIN_TK_IPW, N_WIN_M2 = WIN_M2_NB * 8 * WIN_M2_IPW;
constexpr int WIN_M10_NB = 48, WIN_M11_NB = 128, WIN_M1_IPW = 3, N_WIN_M10 = WIN_M10_NB * 8 * WIN_M1_IPW, N_WIN_M11 = WIN_M11_NB * 8 * WIN_M1_IPW;
constexpr int WIN_AT_NB = 240, WIN_AT_IPW = 1, N_WIN_AT = WIN_AT_NB * 8 * WIN_AT_IPW;
constexpr int PRO_L0 = NLI - N_WIN_IN - N_WIN_AT - N_WIN_OUT - N_WIN_TK0 - N_WIN_M10;
constexpr int PRO_L1 = NLI - N_WIN_M2 - N_WIN_IN - N_WIN_TK1 - N_WIN_M11;
constexpr int BASE_IN0 = PRO_L0, BASE_AT0 = BASE_IN0 + N_WIN_IN, BASE_OUT0 = BASE_AT0 + N_WIN_AT, BASE_TK0 = BASE_OUT0 + N_WIN_OUT, BASE_M10 = BASE_TK0 + N_WIN_TK0;
constexpr int BASE_M2 = PRO_L1, BASE_IN1 = BASE_M2 + N_WIN_M2, BASE_TK1 = BASE_IN1 + N_WIN_IN, BASE_M11 = BASE_TK1 + N_WIN_TK1;
static_assert(BASE_M10 + N_WIN_M10 == NLI && BASE_M11 + N_WIN_M11 == NLI && PRO_L0 > 0 && PRO_L1 > 0 && BASE_M10 >= 2 * NMI && BASE_M11 >= 2 * NMI, "window partition (the MOE1 windows hold w2 tiles only)");
#ifndef XNT
#define XNT 1
#endif
struct XItem { const float* W; bf16* WT; int N, ldwt, k0, n0, r0, kc; };
__device__ __forceinline__ void xitem_desc(Frame& F, int l, int x, XItem& d) {
    const int mat = x / NMI; int r = x - mat * NMI;
    if (MOE_LSEAM && mat == 2) {
        const int T8 = (l == 0 ? N_WIN_M10 : N_WIN_M11) / 8, H = 1344 - T8; int g, idx;
        if (r < 8 * H) { g = r / H; idx = r - g * H; } else { const int t = r - 8 * H; g = t / T8; idx = H + t - g * T8; }
        r = g * 1344 + idx; }
    const int e = r / 672, q = r - e * 672, le = l * 16 + e;
    if (mat < 2) { d.W = (mat == 0 ? gin(F, I_W1) : gin(F, I_W3)) + (size_t)le * 1024 * FF; d.N = FF; d.k0 = (q / 42) * 64; d.n0 = (q % 42) * 64;
        const int rr = (d.n0 >> 7) * 256 + mat * 128 + (d.n0 & 127);
        d.WT = (bf16*)(F.ws + WS_W13) + (((size_t)le * 21 + (rr >> 8)) * 16 + (d.k0 >> 6)) * (256 * 64); d.ldwt = 64; d.r0 = rr & 255; d.kc = 0; }
    else { d.W = gin(F, I_W2) + (size_t)le * FF * 1024; d.N = 1024; d.k0 = (q / 16) * 64; d.n0 = (q % 16) * 64;
        d.WT = (bf16*)(F.ws + WS_W2) + (((size_t)le * 4 + (d.n0 >> 8)) * 42 + (d.k0 >> 6)) * (256 * 64); d.ldwt = 64; d.r0 = d.n0 & 255; d.kc = 0; }
}
__device__ __forceinline__ void xitem_load(const XItem& d, f32x4 (&v)[16], int lane) {
    const int r = lane >> 4, c4 = lane & 15; const float* p = d.W + (size_t)(d.k0 + r) * d.N + d.n0 + 4 * c4;
#pragma unroll
    for (int i = 0; i < 16; ++i) v[i] = XNT ? __builtin_nontemporal_load((const GAS f32x4*)(p + (size_t)(4 * i) * d.N)) : *(const GAS f32x4*)(p + (size_t)(4 * i) * d.N);
}
__device__ __forceinline__ void xitem_store(const XItem& d, const f32x4 (&v)[16], LAS float* scr, int lane) {
    const int r = lane >> 4, c4 = lane & 15;
#pragma unroll
    for (int i = 0; i < 16; ++i) { const int k = i * 4 + r;
#pragma unroll
        for (int j = 0; j < 4; ++j) scr[(4 * c4 + j) * 65 + k] = v[i][j]; }
    LDS_WAIT(); asm volatile("" ::: "memory");
#pragma unroll
    for (int j = 0; j < 8; ++j) { const int nn = (lane >> 3) + 8 * j, c = lane & 7; const LAS float* s = scr + nn * 65 + 8 * c;
        const int row = d.r0 + nn;
        v4u o; o.x = pk2(s[0], s[1]); o.y = pk2(s[2], s[3]); o.z = pk2(s[4], s[5]); o.w = pk2(s[6], s[7]);
        if (XNT == 1) __builtin_nontemporal_store(o, (GAS v4u*)(d.WT + (size_t)row * d.ldwt + d.kc + 8 * c)); else *(GAS v4u*)(d.WT + (size_t)row * d.ldwt + d.kc + 8 * c) = o; }
    LDS_WAIT(); asm volatile("" ::: "memory");
}
template <class IdxFn>
__device__ __forceinline__ void conv_stream(Frame& F, int n, IdxFn idx, LAS float* scr, int lane) {
    XItem da, db; f32x4 va[16], vb[16]; int l_, x_;
    if (n > 0) { idx(0, l_, x_); xitem_desc(F, l_, x_, da); xitem_load(da, va, lane); }
    for (int j = 0; j < n; j += 2) {
        const bool hb = j + 1 < n;
        if (hb) { idx(j + 1, l_, x_); xitem_desc(F, l_, x_, db); xitem_load(db, vb, lane); }
        xitem_store(da, va, scr, lane);
        if (hb) { if (j + 2 < n) { idx(j + 2, l_, x_); xitem_desc(F, l_, x_, da); xitem_load(da, va, lane); }
            xitem_store(db, vb, scr, lane); }
    }
}
__device__ __forceinline__ void conv_window_blocked(Frame& F, int l, int base, int rank, int ipw) {
    LAS float* scr = (LAS float*)(F.lds + F.wave * 16640); const int w0 = base + rank * ipw * 8 + F.wave;
    conv_stream(F, ipw, [=](int j, int& ll, int& xx) { ll = l; xx = w0 + j * 8; }, scr, F.lane);
}
__device__ __forceinline__ void conv_window(Frame& F, int l, int base, int rank, int nblk, int ipw) {
    LAS float* scr = (LAS float*)(F.lds + F.wave * 16640); const int w0 = base + rank * 8 + F.wave, st = nblk * 8;
    conv_stream(F, ipw, [=](int j, int& ll, int& xx) { ll = l; xx = w0 + j * st; }, scr, F.lane);
}
__device__ __forceinline__ void ph0(Frame& F) {
    const int tid = F.tid, lane = F.lane;
    const int gw = F.vcu * NWAVES + F.wave, NGW = F.G * NWAVES;
    const int gt = blockIdx.x * 512 + tid, NGT = F.G * 512;
    float* cosM = (float*)(F.ws + WS_ROPE); float* sinM = cosM + 8192 * 16; float* cosG = sinM + 8192 * 16; float* sinG = cosG + 8192 * 32;
    for (int i = gt; i < 8192 * 16; i += NGT) { const int t = i >> 4, p = i & 15; const float pos = (p < 8) ? (float)(t >> 6) : (float)(t & 63);
        const float inv = exp2f(-(float)(p & 7) * (13.287712379549449f / 8.f)); float s, c; sincos_acc(pos * inv, s, c); cosM[i] = c; sinM[i] = s; }
    for (int i = gt; i < 8192 * 32; i += NGT) { const int t = i >> 5, p = i & 31; const float pos = (p < 16) ? (float)(t >> 6) : (float)(t & 63);
        const float inv = exp2f(-(float)(p & 15) * (13.287712379549449f / 16.f)); float s, c; sincos_acc(pos * inv, s, c); cosG[i] = c; sinG[i] = s; }
    { bf16* wt = (bf16*)(F.ws + WS_WIN);
      for (int i = gt; i < 2 * 96 * 128; i += NGT) { const int l = i / (96 * 128), r = i % (96 * 128); *(v4u*)(wt + ((size_t)l * 1536 + 1440) * 1024 + (size_t)r * 8) = (v4u){0u, 0u, 0u, 0u}; } }
    { LAS float* sv = (LAS float*)F.lds; LAS f32x4* part = (LAS f32x4*)(F.lds + 12288);
      float* modv = (float*)(F.ws + WS_MOD);
      for (int job = blockIdx.x; job < 256; job += F.G) {
          const int l = job >> 7, grp = job & 127;
          for (int i = tid; i < 3072; i += 512) { const int mv = i >> 10, k = i & 1023; const float v = (mv < 2) ? gin(F, I_C)[mv * 1024 + k] : gin(F, I_CCTX)[k]; sv[i] = v * sigmoidf_(v); }
          __syncthreads();
          if (tid < 384) { const int kq = tid / 12, cq = tid % 12, col = grp * 48 + cq * 4;
              f32x4 a0 = {0.f, 0.f, 0.f, 0.f}, a1 = a0, a2 = a0;
              const float* wp = gin(F, I_MODW) + ((size_t)l * 1024 + kq * 32) * 6144 + col;
#pragma unroll 8
              for (int kk = 0; kk < 32; ++kk) { const f32x4 w = *(const f32x4*)(wp + (size_t)kk * 6144); const int k = kq * 32 + kk; a0 += sv[k] * w; a1 += sv[1024 + k] * w; a2 += sv[2048 + k] * w; }
              part[(kq * 12 + cq) * 3 + 0] = a0; part[(kq * 12 + cq) * 3 + 1] = a1; part[(kq * 12 + cq) * 3 + 2] = a2; }
          __syncthreads();
          if (tid < 36) { const int cq = tid % 12, mv = tid / 12, col = grp * 48 + cq * 4; f32x4 s = *(const f32x4*)(gin(F, I_MODB) + l * 6144 + col);
              for (int kq = 0; kq < 32; ++kq) s += part[(kq * 12 + cq) * 3 + mv];
              *(f32x4*)(modv + (size_t)(l * 3 + mv) * 6144 + col) = s; }
          __syncthreads();
      } }
    LAS float* scr = (LAS float*)(F.lds + F.wave * 16640);
    constexpr int N_WIN = 2 * 16 * 45, N_WUQ = 2 * 4 * 12, N_WUKV = 2 * 2 * 16, N_WOUT = 2 * 16 * 16;
#ifndef USE_WIN
#define USE_WIN 1
#endif
    const bool win = USE_WIN && (F.G == 256);
    const int n0 = win ? PRO_L0 : NLI, n1 = win ? PRO_L1 : NLI;
    const int NITEMS = n0 + n1 + N_WIN + N_WUQ + N_WUKV + N_WOUT;
    { const int nx = n0 + n1, cnt = (nx - gw + NGW - 1) / NGW;
      conv_stream(F, cnt > 0 ? cnt : 0, [=](int j, int& ll, int& xx) { const int r = gw + j * NGW; ll = r >= n0 ? 1 : 0; xx = r >= n0 ? r - n0 : r; }, scr, lane); }
    for (int it = gw; it < NITEMS - (n0 + n1); it += NGW) {
        int r = it;
        if (r < N_WIN) { const int l = r / 720, q = r % 720, kb = q / 45, nb = q % 45;
            tr_item<32>(gin(F, I_WIN) + (size_t)l * 1024 * 1440, 1440, kb * 64, nb * 32, (bf16*)(F.ws + WS_WIN) + (size_t)l * 1536 * 1024, 1024, [](int n) { return n; }, scr, lane); continue; } r -= N_WIN;
        if (r < N_WOUT) { const int l = r / 256, q = r % 256, kb = q / 16, nb = q % 16;
            tr_item<64>(gin(F, I_WOUT) + (size_t)l * 1024 * 1024, 1024, kb * 64, nb * 64, (bf16*)(F.ws + WS_WOUT) + (size_t)l * 1024 * 1024, 1024, [](int n) { return n; }, scr, lane); continue; } r -= N_WOUT;
        if (r < N_WUQ) { const int l = r / 48, q = r % 48, kb = q / 12, nb = q % 12;
            tr_item<64>(gin(F, I_WUQ) + (size_t)l * 256 * 768, 768, kb * 64, nb * 64, (bf16*)(F.ws + WS_WUQ) + (size_t)l * 768 * 256, 256,
                        [](int n) { const int h = n / 96, j = n % 96; return j < 64 ? n : (j < 80 ? h * 96 + 64 + 2 * (j - 64) : h * 96 + 64 + 2 * (j - 80) + 1); }, scr, lane, C_MLA); continue; } r -= N_WUQ;
        { const int l = r / 32, q = r % 32, kb = q / 16, nb = q % 16;
            tr_item<64>(gin(F, I_WUKV) + (size_t)l * 128 * 1024, 1024, kb * 64, nb * 64, (bf16*)(F.ws + WS_WUKV) + (size_t)l * 1024 * 128, 128, [](int n) { return n; }, scr, lane); }
    }
}

template <int MODE>
__device__ __forceinline__ void norm_phase(Frame& F) {
    const int lane = F.lane; Span sp_; if (MODE == 2) { sp_.lo = F.vcu * NWAVES + F.wave; sp_.hi = M; sp_.step = F.G * NWAVES; } else sp_ = row_span(F, false);
    const int gw = sp_.lo, NGW = sp_.step, MH = sp_.hi;
    float* xres = (float*)(F.ws + WS_XRES); bf16* xrb = (bf16*)(F.ws + WS_XRES); bf16* h1 = (bf16*)(F.ws + WS_H1);
    const float* modv = (const float*)(F.ws + WS_MOD); const float* aff = (const float*)(F.ws + WS_AFF); const int* inv = (const int*)(F.ws + WS_INV); const bf16* ybuf = (const bf16*)(F.ws + WS_XG);
    const float* xin = gin(F, I_X); const float* cin = gin(F, I_CTX);
#define NP_LOAD(R_, V_, S_, G_) do { const int b_ = (R_) / SB, s_ = (R_) - b_ * SB; \
        const float* src_ = (MODE == 0) ? (s_ < CTX ? cin + ((size_t)b_ * CTX + s_) * DM : xin + ((size_t)b_ * SEQ + (s_ - CTX)) * DM) : xres + (size_t)(R_) * DM; \
        _Pragma("unroll") for (int j = 0; j < 4; ++j) { if (MODE == 0) V_[j] = __builtin_nontemporal_load((const f32x4*)(src_ + 4 * lane + 256 * j)); \
            else if (XRES_BF16) { const v2u w_ = *(const v2u*)(xrb + (size_t)(R_) * DM + 4 * lane + 256 * j); V_[j] = (f32x4){bflo(w_.x), bfhi(w_.x), bflo(w_.y), bfhi(w_.y)}; } \
            else V_[j] = *(const f32x4*)(src_ + 4 * lane + 256 * j); } \
        if (MODE >= 1) { S_ = (lane < 16) ? inv[(size_t)(R_) * 16 + lane] : -1; G_ = (lane < 16) ? aff[(size_t)(R_) * 16 + lane] : 0.f; } } while (0)
#define NP_YREQ(S_, G_, P0_, P1_, PG0_, PG1_, REST_) do { unsigned long long m_ = __ballot((S_) >= 0); PG0_ = 0.f; PG1_ = 0.f; \
        if (m_) { const int e_ = __builtin_ctzll(m_); m_ &= m_ - 1; const int s_ = __builtin_amdgcn_readlane((S_), e_); PG0_ = __builtin_bit_cast(float, __builtin_amdgcn_readlane(__builtin_bit_cast(int, (G_)), e_)); \
            const bf16* y_ = ybuf + ((size_t)e_ * RPE + s_) * DM + 4 * lane; _Pragma("unroll") for (int j = 0; j < 4; ++j) P0_[j] = *(const v2u*)(y_ + 256 * j); } \
        else { _Pragma("unroll") for (int j = 0; j < 4; ++j) P0_[j] = (v2u){0u, 0u}; } \
        if (m_) { const int e_ = __builtin_ctzll(m_); m_ &= m_ - 1; const int s_ = __builtin_amdgcn_readlane((S_), e_); PG1_ = __builtin_bit_cast(float, __builtin_amdgcn_readlane(__builtin_bit_cast(int, (G_)), e_)); \
            const bf16* y_ = ybuf + ((size_t)e_ * RPE + s_) * DM + 4 * lane; _Pragma("unroll") for (int j = 0; j < 4; ++j) P1_[j] = *(const v2u*)(y_ + 256 * j); } \
        else { _Pragma("unroll") for (int j = 0; j < 4; ++j) P1_[j] = (v2u){0u, 0u}; } \
        REST_ = m_; } while (0)
    f32x4 cv[4], n1v[4], n2v[4]; int cs = -1, n1s = -1, n2s = -1; float cg = 0.f, n1g = 0.f, n2g = 0.f;
    v2u cp0[4], cp1[4], np0[4], np1[4]; float cpg0 = 0.f, cpg1 = 0.f, npg0 = 0.f, npg1 = 0.f; unsigned long long crest = 0ull, nrest = 0ull;
    int R = gw;
    if (R < MH) NP_LOAD(R, cv, cs, cg);
    if (R + NGW < MH) NP_LOAD(R + NGW, n1v, n1s, n1g);
    if (MODE >= 1 && R < MH) NP_YREQ(cs, cg, cp0, cp1, cpg0, cpg1, crest);
    for (; R < MH; R += NGW) {
        if (R + 2 * NGW < MH) NP_LOAD(R + 2 * NGW, n2v, n2s, n2g);
        if (MODE >= 1 && R + NGW < MH) NP_YREQ(n1s, n1g, np0, np1, npg0, npg1, nrest);
        const int b = R / SB, s = R - b * SB; const bool isctx = s < CTX; const int mv = isctx ? 2 : b;
        if (!(MODE == 2 && isctx)) {
        f32x4 v[4];
#pragma unroll
        for (int j = 0; j < 4; ++j) v[j] = cv[j];
        if (MODE >= 1) {
            const float* g2 = modv + (size_t)((MODE - 1) * 3 + mv) * 6144 + 5120;
            f32x4 acc[4];
#pragma unroll
            for (int j = 0; j < 4; ++j) { acc[j] = cpg0 * (f32x4){bflo(cp0[j].x), bfhi(cp0[j].x), bflo(cp0[j].y), bfhi(cp0[j].y)}; acc[j] += cpg1 * (f32x4){bflo(cp1[j].x), bfhi(cp1[j].x), bflo(cp1[j].y), bfhi(cp1[j].y)}; }
            unsigned long long mask = crest;
            while (mask) {
                const int e0 = __builtin_ctzll(mask); mask &= mask - 1; const bool two = mask != 0; const int e1 = two ? __builtin_ctzll(mask) : e0; if (two) mask &= mask - 1;
                const int s0 = __builtin_amdgcn_readlane(cs, e0), s1 = __builtin_amdgcn_readlane(cs, e1);
                const float g0 = __builtin_bit_cast(float, __builtin_amdgcn_readlane(__builtin_bit_cast(int, cg), e0)), g1 = two ? __builtin_bit_cast(float, __builtin_amdgcn_readlane(__builtin_bit_cast(int, cg), e1)) : 0.f;
                const bf16* y0 = ybuf + ((size_t)e0 * RPE + s0) * DM + 4 * lane; const bf16* y1 = ybuf + ((size_t)e1 * RPE + s1) * DM + 4 * lane;
                v2u r0[4], r1[4];
#pragma unroll
                for (int j = 0; j < 4; ++j) { r0[j] = *(const v2u*)(y0 + 256 * j); r1[j] = *(const v2u*)(y1 + 256 * j); }
#pragma unroll
                for (int j = 0; j < 4; ++j) { acc[j] += g0 * (f32x4){bflo(r0[j].x), bfhi(r0[j].x), bflo(r0[j].y), bfhi(r0[j].y)}; acc[j] += g1 * (f32x4){bflo(r1[j].x), bfhi(r1[j].x), bflo(r1[j].y), bfhi(r1[j].y)}; }
            }
#pragma unroll
            for (int j = 0; j < 4; ++j) v[j] += *(const f32x4*)(g2 + 4 * lane + 256 * j) * acc[j];
            if (MODE == 1) {
#pragma unroll
                for (int j = 0; j < 4; ++j) { if (XRES_BF16) { v2u w_; w_.x = pk2(v[j].x, v[j].y); w_.y = pk2(v[j].z, v[j].w); *(v2u*)(xrb + (size_t)R * DM + 4 * lane + 256 * j) = w_; } else *(f32x4*)(xres + (size_t)R * DM + 4 * lane + 256 * j) = v[j]; } }
        }
        float ss = 0.f;
#pragma unroll
        for (int j = 0; j < 4; ++j) ss += (v[j].x * v[j].x + v[j].y * v[j].y) + (v[j].z * v[j].z + v[j].w * v[j].w);
        const float rs = rsqrtf(wave_sum(ss) * (1.f / DM) + EPS);
        if (MODE == 2) {
            float* op = F.out + ((size_t)b * SEQ + (s - CTX)) * DM;
#pragma unroll
            for (int j = 0; j < 4; ++j) __builtin_nontemporal_store(v[j] * rs * *(const f32x4*)(gin(F, I_FG) + 4 * lane + 256 * j), (f32x4*)(op + 4 * lane + 256 * j));
        } else {
            constexpr int l = MODE; const float* mp = modv + (size_t)(l * 3 + mv) * 6144; const float* ng = gin(F, I_N1G) + l * DM;
#pragma unroll
            for (int j = 0; j < 4; ++j) { const int c = 4 * lane + 256 * j; const f32x4 g = *(const f32x4*)(ng + c), sh = *(const f32x4*)(mp + c), sc = *(const f32x4*)(mp + 1024 + c);
                const f32x4 h = v[j] * rs * g * (1.f + sc) + sh; v2u o; o.x = pk2(h.x, h.y); o.y = pk2(h.z, h.w); *(v2u*)(h1 + (size_t)R * DM + c) = o; }
        }
        }
#pragma unroll
        for (int j = 0; j < 4; ++j) { cv[j] = n1v[j]; n1v[j] = n2v[j]; cp0[j] = np0[j]; cp1[j] = np1[j]; }
        cs = n1s; cg = n1g; n1s = n2s; n1g = n2g; cpg0 = npg0; cpg1 = npg1; crest = nrest;
    }
#undef NP_LOAD
#undef NP_YREQ
}

struct PrepIn { v2u q; unsigned kv; float kr1, kr2, h1[3], h2[3]; float cm, sm, cg, sg; };
__device__ __forceinline__ void prep_load(Frame& F, int R, PrepIn& I) {
    const bf16* zr = (const bf16*)(F.ws + WS_Z) + (size_t)R * ZW; const int lane = F.lane;
    const int s = R % SB; const bool lat = s >= CTX; const int t = lat ? s - CTX : 0;
    const float* cosM = (const float*)(F.ws + WS_ROPE); const float* sinM = cosM + 8192 * 16; const float* cosG = sinM + 8192 * 16; const float* sinG = cosG + 8192 * 32;
    I.q = *(const v2u*)(zr + ZQ + 4 * lane); I.kv = *(const unsigned*)(zr + ZKV + 2 * lane);
    I.kr1 = bf2f(zr[ZKR + (lane & 15)]); I.kr2 = bf2f(zr[ZKR + 16 + (lane & 15)]);
#pragma unroll
    for (int p = 0; p < 3; ++p) { const bf16* hp = zr + ZGQ + (2 * p + (lane >> 5)) * 64; I.h1[p] = bf2f(hp[lane & 31]); I.h2[p] = bf2f(hp[(lane & 31) + 32]); }
    I.cm = cosM[(size_t)t * 16 + (lane & 15)]; I.sm = sinM[(size_t)t * 16 + (lane & 15)]; I.cg = cosG[(size_t)t * 32 + (lane & 31)]; I.sg = sinG[(size_t)t * 32 + (lane & 31)];
}
__device__ __forceinline__ void prep_store(Frame& F, int l, int R, const PrepIn& I, const float ssq, const float sskv, const float (&ssh)[3]) {
    bf16* zr = (bf16*)(F.ws + WS_Z) + (size_t)R * ZW; const int lane = F.lane;
    const bool lat = (R % SB) >= CTX;
    {
        const float x0 = bflo(I.q.x), x1 = bfhi(I.q.x), x2 = bflo(I.q.y), x3 = bfhi(I.q.y);
        const float rs = rsqrtf(ssq * (1.f / 256) + EPS);
        const f32x4 g = *(const f32x4*)(gin(F, I_QNG) + l * 256 + 4 * lane);
        v2u o; o.x = pk2(x0 * rs * g.x, x1 * rs * g.y); o.y = pk2(x2 * rs * g.z, x3 * rs * g.w); *(v2u*)(zr + ZQ + 4 * lane) = o; }
    {
        const float x0 = bflo(I.kv), x1 = bfhi(I.kv);
        const float rs = rsqrtf(sskv * (1.f / 128) + EPS);
        const f32x2 g = *(const f32x2*)(gin(F, I_KVNG) + l * 128 + 2 * lane);
        *(unsigned*)(zr + ZKV + 2 * lane) = pk2(x0 * rs * g.x, x1 * rs * g.y); }
    {
        const int i = lane & 15; float o1 = I.kr1, o2 = I.kr2;
        if (lat) { o1 = I.kr1 * I.cm - I.kr2 * I.sm; o2 = I.kr2 * I.cm + I.kr1 * I.sm; }
        const unsigned w = pk2(o1, o2);
        if (lane < 16) *(unsigned*)(zr + ZKR + 2 * i) = w; }
#pragma unroll
    for (int p = 0; p < 3; ++p) { const int hh = 2 * p + (lane >> 5), i = lane & 31; bf16* hp = zr + ZGQ + hh * 64;
        const float x1 = I.h1[p], x2 = I.h2[p];
        const float rs = rsqrtf(ssh[p] * (1.f / 64) + EPS);
        const float* g = (p < 2 ? gin(F, I_GQG) : gin(F, I_GKG)) + l * 64;
        const float qs = (p < 2) ? C_GQA : 1.f;
        float y1 = x1 * rs * g[i] * qs, y2 = x2 * rs * g[i + 32] * qs;
        if (lat) { const float a = y1 * I.cg - y2 * I.sg, bb = y2 * I.cg + y1 * I.sg; y1 = a; y2 = bb; }
        hp[i] = (bf16)f2bf(y1); hp[i + 32] = (bf16)f2bf(y2); }
}
__device__ __forceinline__ void prep_quad(Frame& F, int l, int R0, int NGW, int MH) {
    PrepIn I[4]; int R[4]; bool ok[4];
#pragma unroll
    for (int u = 0; u < 4; ++u) { R[u] = R0 + u * NGW; ok[u] = R[u] < MH; if (!ok[u]) R[u] = R0; prep_load(F, R[u], I[u]); }
    float w[8], h[12];
#pragma unroll
    for (int u = 0; u < 4; ++u) { const float a0 = bflo(I[u].q.x), a1 = bfhi(I[u].q.x), a2 = bflo(I[u].q.y), a3 = bfhi(I[u].q.y); w[2 * u] = (a0 * a0 + a1 * a1) + (a2 * a2 + a3 * a3);
        const float k0 = bflo(I[u].kv), k1 = bfhi(I[u].kv); w[2 * u + 1] = k0 * k0 + k1 * k1;
#pragma unroll
        for (int p = 0; p < 3; ++p) h[3 * u + p] = I[u].h1[p] * I[u].h1[p] + I[u].h2[p] * I[u].h2[p]; }
    wave_sum_n<8>(w); half_sum_n<12>(h);
#pragma unroll
    for (int u = 0; u < 4; ++u) if (ok[u]) { const float sa[3] = {h[3 * u], h[3 * u + 1], h[3 * u + 2]}; prep_store(F, l, R[u], I[u], w[2 * u], w[2 * u + 1], sa); }
}
struct ConvIn { v4u av[4], gv[4]; bool ok[4]; };
__device__ __forceinline__ void conv_load(Frame& F, int tile, ConvIn& I) {
    const int tid = F.tid; const int R0 = tile * 32; const int b = R0 / SB, s0 = R0 - b * SB; const bool isctx = s0 < CTX;
    const int seq_lo = b * SB + (isctx ? 0 : CTX), seq_hi = b * SB + (isctx ? CTX : SB);
    const bf16* z = (const bf16*)(F.ws + WS_Z);
#pragma unroll
    for (int j = 0; j < 4; ++j) { const int it = tid + 512 * j; const int rr = it >> 5, c8 = (it & 31) * 8; const int R = R0 - 15 + rr;
        I.ok[j] = (it < 62 * 32) && R >= seq_lo && R < seq_hi; const size_t ro = (size_t)(I.ok[j] ? R : R0) * ZW;
        I.av[j] = *(const v4u*)(z + ro + ZCA + c8); I.gv[j] = *(const v4u*)(z + ro + ZCB + c8); }
}
__device__ __forceinline__ void conv_tile(Frame& F, int l, int tile, const ConvIn& I, int next_tile, ConvIn& N) {
    const int tid = F.tid, lane = F.lane, wave = F.wave; const int R0 = tile * 32;
    LAS float* U = (LAS float*)F.lds; LAS float* Y = U + 62 * 256;
#pragma unroll
    for (int j = 0; j < 4; ++j) { const int it = tid + 512 * j; if (it < 62 * 32) { const int rr = it >> 5, c8 = (it & 31) * 8;
        f32x4 u0 = {0.f, 0.f, 0.f, 0.f}, u1 = u0;
        if (I.ok[j]) { const v4u a = I.av[j], g = I.gv[j];
            u0.x = bflo(a.x) * sigmoidf_(bflo(g.x)); u0.y = bfhi(a.x) * sigmoidf_(bfhi(g.x)); u0.z = bflo(a.y) * sigmoidf_(bflo(g.y)); u0.w = bfhi(a.y) * sigmoidf_(bfhi(g.y));
            u1.x = bflo(a.z) * sigmoidf_(bflo(g.z)); u1.y = bfhi(a.z) * sigmoidf_(bfhi(g.z)); u1.z = bflo(a.w) * sigmoidf_(bflo(g.w)); u1.w = bfhi(a.w) * sigmoidf_(bfhi(g.w)); }
        *(LAS f32x4*)(U + rr * 256 + c8) = u0; *(LAS f32x4*)(U + rr * 256 + c8 + 4) = u1; } }
    if (next_tile >= 0) conv_load(F, next_tile, N);
    __syncthreads();
    { const int c = tid & 255, hf = tid >> 8; const float* wp = gin(F, I_CVW) + (size_t)l * 31 * 256 + c; const float bias = gin(F, I_CVB)[l * 256 + c];
      float w[31];
#pragma unroll
      for (int j = 0; j < 31; ++j) w[j] = wp[j * 256];
#pragma unroll
      for (int ch = 0; ch < 2; ++ch) { const int r0 = hf * 16 + ch * 8; float win[38];
#pragma unroll
          for (int q = 0; q < 38; ++q) win[q] = U[(r0 + q) * 256 + c];
#pragma unroll
          for (int o = 0; o < 8; ++o) { float y = bias;
#pragma unroll
              for (int j = 0; j < 31; ++j) y = fmaf(win[o + j], w[j], y);
              Y[(r0 + o) * 256 + c] = y; } } }
    __syncthreads();
    { const float* lg = gin(F, I_LNG) + l * 256; const float* lb = gin(F, I_LNB) + l * 256; const float* mg = gin(F, I_MOG) + l * 1024 + 768; bf16* cat = (bf16*)(F.ws + WS_H1);
      float y[4][4], red[8];
#pragma unroll
      for (int rr = 0; rr < 4; ++rr) { const int row = wave * 4 + rr; float sm = 0.f, sq = 0.f;
#pragma unroll
          for (int q = 0; q < 4; ++q) { y[rr][q] = Y[row * 256 + lane + 64 * q]; sm += y[rr][q]; sq += y[rr][q] * y[rr][q]; }
          red[rr] = sm; red[4 + rr] = sq; }
      wave_sum_n<8>(red);
      float r2[4];
#pragma unroll
      for (int rr = 0; rr < 4; ++rr) { const float mean = red[rr] * (1.f / 256), var = fmaxf(red[4 + rr] * (1.f / 256) - mean * mean, 0.f); const float rstd = rsqrtf(var + EPS); float s2 = 0.f;
#pragma unroll
          for (int q = 0; q < 4; ++q) { const int c = lane + 64 * q; const float v = (y[rr][q] - mean) * rstd * lg[c] + lb[c]; y[rr][q] = v * sigmoidf_(v); s2 += y[rr][q] * y[rr][q]; }
          r2[rr] = s2; }
      wave_sum_n<4>(r2);
#pragma unroll
      for (int rr = 0; rr < 4; ++rr) { const int row = wave * 4 + rr; const float rs = rsqrtf(r2[rr] * (1.f / 256) + EPS);
#pragma unroll
          for (int q = 0; q < 4; ++q) { const int c = lane + 64 * q; cat[(size_t)(R0 + row) * DM + 768 + c] = (bf16)f2bf(y[rr][q] * rs * mg[c]); } } }
    __syncthreads();
}
__device__ __forceinline__ void prep_phase(Frame& F, int l) {
    const Span sp = row_span(F, false);
    for (int R = sp.lo; R < sp.hi; R += 4 * sp.step) prep_quad(F, l, R, sp.step, sp.hi);
}
__device__ __forceinline__ void convmix_phase(Frame& F, int l) {
    const int ntile = (l == 1) ? NB * SEQ / 32 : M / 32;
#define CV_TILE(ti_) ((l == 1) ? ((ti_) / (SEQ / 32)) * (SB / 32) + CTX / 32 + ((ti_) % (SEQ / 32)) : (ti_))
    ConvIn A, B; int ti = F.vcu;
    if (ti < ntile) conv_load(F, CV_TILE(ti), A);
    while (ti < ntile) {
        const int t1 = ti + F.G, t2 = t1 + F.G;
        conv_tile(F, l, CV_TILE(ti), A, t1 < ntile ? CV_TILE(t1) : -1, B);
        if (t1 < ntile) conv_tile(F, l, CV_TILE(t1), B, t2 < ntile ? CV_TILE(t2) : -1, A);
        ti = t2;
    }
#undef CV_TILE
}
#ifndef ATT_TUNED
#define ATT_TUNED 1
#endif
__device__ __forceinline__ void attn_phase(Frame& F, int l, char* ldsg) {
    const bf16* z = (const bf16*)(F.ws + WS_Z); const bf16* qm = (const bf16*)(F.ws + WS_QM); const bf16* kvm = (const bf16*)(F.ws + WS_KVM); bf16* ob = (bf16*)(F.ws + WS_O);
    const float* cosM = (const float*)(F.ws + WS_ROPE);
    const int nctx = (l == 0) ? 16 : 0;
    for (int u = F.vcu; u < 512 + nctx; u += F.G) {
        int b, h; size_t rq, rk; int nk;
        if (u < 512) { const int bh = u >> 5, qb = u & 31; b = bh >> 3; h = bh & 7; rk = (size_t)b * SB; rq = rk + CTX + (size_t)qb * 256; nk = SB; }
        else { const int v = u - 512; b = v >> 3; h = v & 7; rk = (size_t)b * SB; rq = rk; nk = CTX; }
#if ATT_TUNED
        att2::attn_unit<96, QW, KVW, ZW, KVW, 8>(qm + rq * QW + 96 * h, kvm + rk * KVW + 128 * h, z + rk * ZW + ZKR, kvm + rk * KVW + 128 * h + 64, ob + rq * OW + 64 * h, (u < 512) ? cosM + (size_t)(u & 31) * 256 * 16 : nullptr, nk / 64, ldsg, F.tid);
#else
        att::attn_unit<96, QW, KVW, ZW, KVW>(qm + rq * QW + 96 * h, kvm + rk * KVW + 128 * h, z + rk * ZW + ZKR, kvm + rk * KVW + 128 * h + 64, ob + rq * OW + 64 * h, (u < 512) ? cosM + (size_t)(u & 31) * 256 * 16 : nullptr, nk, ldsg, F.tid);
#endif
    }
    const int nctx2 = (l == 0) ? 8 : 0;
    for (int u = F.vcu; u < 256 + nctx2; u += F.G) {
        int b, h; size_t rq, rk; int nk;
        if (u < 256) { const int bh = u >> 5, qb = u & 31; b = bh >> 2; h = bh & 3; rk = (size_t)b * SB; rq = rk + CTX + (size_t)qb * 256; nk = SB; }
        else { const int v = u - 256; b = v >> 2; h = v & 3; rk = (size_t)b * SB; rq = rk; nk = CTX; }
#if ATT_TUNED
        att2::attn_unit<64, ZW, ZW, ZW, ZW, 8>(z + rq * ZW + ZGQ + 64 * h, z + rk * ZW + ZGK + 64 * (h >> 1), nullptr, z + rk * ZW + ZGV + 64 * (h >> 1), ob + rq * OW + 512 + 64 * h, nullptr, nk / 64, ldsg, F.tid);
#else
        att::attn_unit<64, ZW, ZW, ZW, ZW>(z + rq * ZW + ZGQ + 64 * h, z + rk * ZW + ZGK + 64 * (h >> 1), nullptr, z + rk * ZW + ZGV + 64 * (h >> 1), ob + rq * OW + 512 + 64 * h, nullptr, nk, ldsg, F.tid);
#endif
    }
}

__device__ __forceinline__ void gnorm_phase(Frame& F, int l) {
    const int lane = F.lane; const Span sp = row_span(F, l == 1); const int gw = sp.lo, NGW = sp.step;
    const bf16* ob = (const bf16*)(F.ws + WS_O); bf16* cat = (bf16*)(F.ws + WS_H1); const float* mg = gin(F, I_MOG) + l * 1024;
    const f32x4 g0 = *(const f32x4*)(mg + 8 * lane), g1 = *(const f32x4*)(mg + 8 * lane + 4), g2 = *(const f32x4*)(mg + 512 + 4 * lane);
    const int nrow = sp.hi;
#define GN_ROW(i_) ((l == 1) ? ((i_) / SEQ) * SB + CTX + ((i_) % SEQ) : (i_))
    for (int i = gw; i < nrow; i += 4 * NGW) {
        v4u a[4]; v2u c[4]; int R[4]; bool ok[4];
#pragma unroll
        for (int u = 0; u < 4; ++u) { const int ii = i + u * NGW; ok[u] = ii < nrow; R[u] = GN_ROW(ok[u] ? ii : i); a[u] = *(const v4u*)(ob + (size_t)R[u] * OW + 8 * lane); c[u] = *(const v2u*)(ob + (size_t)R[u] * OW + 512 + 4 * lane); }
#pragma unroll
        for (int u = 0; u < 4; ++u) { if (!ok[u]) continue;
            float x[8] = {bflo(a[u].x), bfhi(a[u].x), bflo(a[u].y), bfhi(a[u].y), bflo(a[u].z), bfhi(a[u].z), bflo(a[u].w), bfhi(a[u].w)}; float y[4] = {bflo(c[u].x), bfhi(c[u].x), bflo(c[u].y), bfhi(c[u].y)};
            float s1 = 0.f, s2 = 0.f;
#pragma unroll
            for (int k = 0; k < 8; ++k) s1 += x[k] * x[k];
#pragma unroll
            for (int k = 0; k < 4; ++k) s2 += y[k] * y[k];
            const float r1 = rsqrtf(wave_sum(s1) * (1.f / 512) + EPS), r2 = rsqrtf(wave_sum(s2) * (1.f / 256) + EPS);
            v4u o; o.x = pk2(x[0] * r1 * g0.x, x[1] * r1 * g0.y); o.y = pk2(x[2] * r1 * g0.z, x[3] * r1 * g0.w); o.z = pk2(x[4] * r1 * g1.x, x[5] * r1 * g1.y); o.w = pk2(x[6] * r1 * g1.z, x[7] * r1 * g1.w);
            *(v4u*)(cat + (size_t)R[u] * DM + 8 * lane) = o;
            v2u p; p.x = pk2(y[0] * r2 * g2.x, y[1] * r2 * g2.y); p.y = pk2(y[2] * r2 * g2.z, y[3] * r2 * g2.w);
            *(v2u*)(cat + (size_t)R[u] * DM + 512 + 4 * lane) = p; }
    }
#undef GN_ROW
}

#ifndef RT_ROWS
#define RT_ROWS 2
#endif
__device__ __forceinline__ void router_phase(Frame& F, int l) {
    constexpr int RT = RT_ROWS;
    const int tid = F.tid, lane = F.lane; const Span sp = row_span(F, l == 1);
    LAS float* W = (LAS float*)F.lds; LAS float* G2 = W + 1024 * 20; LAS float* S2 = G2 + 3072;
    const float* rw = gin(F, I_RW) + (size_t)l * 1024 * 16; const float* n2 = gin(F, I_N2G) + l * DM; const float* modl = (const float*)(F.ws + WS_MOD) + (size_t)l * 3 * 6144;
    const float* xres = (const float*)(F.ws + WS_XRES); bf16* h2 = (bf16*)(F.ws + WS_H1); float* aff = (float*)(F.ws + WS_AFF);
    for (int i = tid; i < 4096; i += 512) *(LAS f32x4*)(W + (i >> 2) * 20 + (i & 3) * 4) = *(const f32x4*)(rw + 4 * i);
    for (int i = tid; i < 3072; i += 512) { const int mv = i >> 10, k = i & 1023; G2[i] = n2[k] * (1.f + modl[mv * 6144 + 4096 + k]); S2[i] = modl[mv * 6144 + 3072 + k]; }
    __syncthreads();
    const int gbase = (sp.lo - (sp.lo % sp.step)) , gw = sp.lo % sp.step;
    for (int gi = gw; gbase + gi * RT < sp.hi; gi += sp.step) {
        const int i0 = gbase + gi * RT; const int R0 = (l == 1) ? (i0 / SEQ) * SB + CTX + (i0 % SEQ) : i0;
        const int b = R0 / SB, s = R0 - b * SB; const int mv = (s < CTX) ? 2 : b;
        const float* xl = xres + (size_t)R0 * DM + lane; const bf16* xlb = (const bf16*)(F.ws + WS_XRES) + (size_t)R0 * DM + lane; bf16* hl = h2 + (size_t)R0 * DM + lane;
        float x[RT][16]; float ss[RT];
#pragma unroll
        for (int u = 0; u < RT; ++u)
#pragma unroll
            for (int q = 0; q < 16; ++q) x[u][q] = XRES_BF16 ? bf2f(xlb[u * DM + 64 * q]) : xl[u * DM + 64 * q];
        float rs[RT];
#pragma unroll
        for (int u = 0; u < RT; ++u) {
            ss[u] = 0.f;
#pragma unroll
            for (int q = 0; q < 16; ++q) ss[u] += x[u][q] * x[u][q];
            asm volatile("" : "+v"(ss[u]));
            rs[u] = rsqrtf(wave_sum(ss[u]) * (1.f / DM) + EPS); }
        float acc[RT][16];
#pragma unroll
        for (int u = 0; u < RT; ++u)
#pragma unroll
            for (int e = 0; e < 16; ++e) acc[u][e] = 0.f;
        f32x4 cw0, cw1, cw2, cw3; float cg, csh;
#define RT_LD(q_, A0, A1, A2, A3, G_, S_) do { const int k_ = lane + 64 * (q_); const LAS f32x4* wp_ = (const LAS f32x4*)(W + k_ * 20); A0 = wp_[0]; A1 = wp_[1]; A2 = wp_[2]; A3 = wp_[3]; G_ = G2[mv * 1024 + k_]; S_ = S2[mv * 1024 + k_]; } while (0)
        RT_LD(0, cw0, cw1, cw2, cw3, cg, csh);
#pragma unroll
        for (int q = 0; q < 16; ++q) { f32x4 nw0 = cw0, nw1 = cw1, nw2 = cw2, nw3 = cw3; float ng = cg, nsh = csh;
            if (q < 15) RT_LD(q + 1, nw0, nw1, nw2, nw3, ng, nsh);
#pragma unroll
            for (int u = 0; u < RT; ++u) { float h = x[u][q] * rs[u] * cg + csh; asm volatile("" : "+v"(h));
                hl[u * DM + 64 * q] = (bf16)f2bf(h);
#define RFMA(A_, W_) asm("v_fmac_f32_e32 %0, %1, %2" : "+v"(A_) : "v"(h), "v"(W_))
                RFMA(acc[u][0], cw0.x); RFMA(acc[u][1], cw0.y); RFMA(acc[u][2], cw0.z); RFMA(acc[u][3], cw0.w);
                RFMA(acc[u][4], cw1.x); RFMA(acc[u][5], cw1.y); RFMA(acc[u][6], cw1.z); RFMA(acc[u][7], cw1.w);
                RFMA(acc[u][8], cw2.x); RFMA(acc[u][9], cw2.y); RFMA(acc[u][10], cw2.z); RFMA(acc[u][11], cw2.w);
                RFMA(acc[u][12], cw3.x); RFMA(acc[u][13], cw3.y); RFMA(acc[u][14], cw3.z); RFMA(acc[u][15], cw3.w); }
#undef RFMA
            cw0 = nw0; cw1 = nw1; cw2 = nw2; cw3 = nw3; cg = ng; csh = nsh;
            __builtin_amdgcn_sched_barrier(0); }
#undef RT_LD
        const int e = ((lane & 1) << 3) | ((lane & 2) << 1) | ((lane & 4) >> 1) | ((lane & 8) >> 3);
#pragma unroll
        for (int u = 0; u < RT; ++u) {
#define RT_STAGE(ST) do { constexpr int half_ = 8 >> (ST); const bool up = (lane >> (ST)) & 1; \
                _Pragma("unroll") for (int j = 0; j < half_; ++j) { const float a = acc[u][j], c = acc[u][j + half_]; const float mine = up ? c : a, other = up ? a : c; acc[u][j] = mine + sx<(1 << (ST))>(other); } } while (0)
            RT_STAGE(0); RT_STAGE(1); RT_STAGE(2); RT_STAGE(3);
#undef RT_STAGE
            float lg = acc[u][0]; lg += sx<16>(lg); lg = sum32(lg);
            float mx = lg;
            mx = fmaxf(mx, sx<1>(mx)); mx = fmaxf(mx, sx<2>(mx)); mx = fmaxf(mx, sx<4>(mx)); mx = fmaxf(mx, sx<8>(mx));
            const float p = __expf(lg - mx); float sum = p;
            sum += sx<1>(sum); sum += sx<2>(sum); sum += sx<4>(sum); sum += sx<8>(sum);
            if (lane < 16) aff[(size_t)(R0 + u) * 16 + e] = p / sum; }
    }
}

template <int N, int KSEL>
__device__ __forceinline__ void topk_list(Frame& F, int R0, int e, int slot0) {
    constexpr int EPT = N >= 512 ? N / 512 : 1;
    LAS unsigned* keys = (LAS unsigned*)F.lds; LAS unsigned* hist = keys + 8192; LAS unsigned* wtot = hist + 256; LAS unsigned* sel = wtot + 16;
    const float* aff = (const float*)(F.ws + WS_AFF); int* inv = (int*)(F.ws + WS_INV); int* rowidx = (int*)(F.ws + WS_ROWIDX);
    const int tid = F.tid, lane = F.lane, wave = F.wave;
    for (int i = tid; i < N; i += 512) keys[i] = __float_as_uint(aff[(size_t)(R0 + i) * 16 + e]);
    unsigned prefix = 0u; unsigned kneed = KSEL;
    for (int pass = 0; pass < 4; ++pass) {
        const int shift = 24 - 8 * pass;
        if (tid < 256) hist[tid] = 0u;
        __syncthreads();
        if (pass == 0) {
            for (int i = tid; i < N; i += 512) { const unsigned d = keys[i] >> 24; unsigned long long todo = __ballot(1);
                while (todo) { const int ln = __builtin_ctzll(todo); const unsigned d0 = __builtin_amdgcn_readlane(d, ln); const unsigned long long m = __ballot(d == d0) & todo;
                    if (lane == ln) (void)__hip_atomic_fetch_add(&hist[d0], (unsigned)__builtin_popcountll(m), __ATOMIC_RELAXED, __HIP_MEMORY_SCOPE_WORKGROUP); todo &= ~m; } }
        } else {
        for (int i = tid; i < N; i += 512) { const unsigned k = keys[i]; const unsigned hiq = (unsigned)((unsigned long long)k >> (shift + 8));
            if (hiq == prefix) (void)__hip_atomic_fetch_add(&hist[(k >> shift) & 255u], 1u, __ATOMIC_RELAXED, __HIP_MEMORY_SCOPE_WORKGROUP); }
        }
        __syncthreads();
        unsigned v = 0u, incl = 0u;
        if (tid < 256) { v = hist[255 - tid]; incl = v;
            incl = wave_scan_incl(incl, lane);
            if (lane == 63) wtot[wave] = incl; }
        __syncthreads();
        if (tid < 256) { unsigned off = 0u; for (int w = 0; w < wave; ++w) off += wtot[w]; incl += off; const unsigned excl = incl - v;
            if (incl >= kneed && excl < kneed) { sel[0] = 255u - (unsigned)tid; sel[1] = kneed - excl; } }
        __syncthreads();
        prefix = (prefix << 8) | sel[0]; kneed = sel[1];
        __syncthreads();
    }
    const unsigned T = prefix; const int cgt = KSEL - (int)kneed;
    unsigned cnt = 0u; const int base = tid * EPT;
    if (base < N) {
#pragma unroll
        for (int q = 0; q < EPT; ++q) { const unsigned k = keys[base + q]; cnt += (k > T) ? 1u : 0u; cnt += (k == T) ? 0x10000u : 0u; } }
    unsigned incl = wave_scan_incl(cnt, lane);
    if (lane == 63) wtot[wave] = incl;
    __syncthreads();
    { unsigned off = 0u; for (int w = 0; w < wave; ++w) off += wtot[w]; incl += off; }
    const unsigned excl = incl - cnt; int pg = (int)(excl & 0xffffu), pe = (int)(excl >> 16);
    if (base < N) {
#pragma unroll
        for (int q = 0; q < EPT; ++q) { const unsigned k = keys[base + q]; int slot = -1;
            if (k > T) slot = pg++; else if (k == T) { if (pe < (int)kneed) slot = cgt + pe; ++pe; }
            const int R = R0 + base + q; inv[(size_t)R * 16 + e] = slot < 0 ? -1 : slot0 + slot;
            if (slot >= 0) rowidx[e * RPE + slot0 + slot] = R; } }
    __syncthreads();
}
__device__ __forceinline__ void topk_phase(Frame& F, int l) {
    if (l == 0) { int* rowidx = (int*)(F.ws + WS_ROWIDX);
        if (blockIdx.x < 6) { const int i = blockIdx.x * 512 + F.tid; rowidx[(i / 192) * RPE + 2112 + (i % 192)] = 0; } }
    const int njobs = (l == 0) ? 64 : 32;
    for (int job = blockIdx.x; job < njobs; job += F.G) {
        if (job < 32) { const int b = job >> 4, e = job & 15; topk_list<SEQ, 1024>(F, b * SB + CTX, e, b * 1024); }
        else { const int j = job - 32, b = j >> 4, e = j & 15; topk_list<CTX, 32>(F, b * SB, e, 2048 + b * 32); }
    }
}
__device__ __forceinline__ void gather_phase(Frame& F, int l) {
    const int lane = F.lane, gw = F.vcu * NWAVES + F.wave, NGW = F.G * NWAVES; const int nrows = (l == 0) ? 2112 : 2048;
    const int* rowidx = (const int*)(F.ws + WS_ROWIDX); const bf16* h2 = (const bf16*)(F.ws + WS_H1); bf16* xg = (bf16*)(F.ws + WS_XG);
    for (int g = gw; g < NE * nrows; g += NGW) { const int e = g / nrows, slot = g - e * nrows; const int R = rowidx[e * RPE + slot];
        const v4u* src = (const v4u*)(h2 + (size_t)R * DM); v4u* dst = (v4u*)(xg + ((size_t)e * RPE + slot) * DM);
        const v4u a = src[lane], c = src[64 + lane]; dst[lane] = a; dst[64 + lane] = c; }
}
#ifndef MOE_BAUX
#define MOE_BAUX 0
#endif

struct Args { const float* in[26]; float* out; unsigned char* ws; int ph_lo, ph_hi, li, pad; };
__global__ void __launch_bounds__(NWAVES * 64, 2) fwd(Args args) {
    extern __shared__ __attribute__((aligned(16))) unsigned char lds[];
    Frame F;
    F.lds = (LAS unsigned char*)lds; F.MISC = (volatile LAS unsigned*)(F.lds + MISC_OFF);
    F.tid = threadIdx.x; F.lane = F.tid & 63; F.wave = __builtin_amdgcn_readfirstlane(F.tid >> 6);
    const int wv0 = F.wave;
    F.G = gridDim.x; { const int bx = blockIdx.x; F.vcu = (F.G % 8 == 0) ? (bx % 8) * (F.G / 8) + bx / 8 : bx; }
    int vcu0 = F.vcu; F.reg = 0; int reg0 = 0;
    F.ws = (unsigned char*)(GAS unsigned char*)args.ws; F.out = (float*)(GAS float*)args.out; F.ctl = (unsigned*)(GAS unsigned*)(args.ws + WS_CTL);
    F.in = args.in;
    if (F.tid < 64) F.MISC[F.tid] = 0u;
    __syncthreads();
    XcdBarrier bar = xcd_barrier_post(F.ctl + CW_BAR + args.li * XCD_BAR_WORDS, F.MISC + 8);
    const int lo = args.ph_lo, hi = args.ph_hi;
#ifndef PH_EN
#define PH_EN 0xFFFF
#endif
#define IN(k) (lo <= (k) && (k) < hi)
#define INT(k, t) ((((PH_EN) >> (t)) & 1) && IN(k))
#ifndef REP_MASK
#define REP_MASK 0
#endif
#define REPS(t) (1 + (((REP_MASK) >> (t)) & 1))
#define RETID() do { int wq_ = wv0; asm volatile("" : "+s"(wq_)); int ln_; asm volatile("v_mbcnt_lo_u32_b32 %0, -1, 0\n\tv_mbcnt_hi_u32_b32 %0, -1, %0" : "=v"(ln_)); int t_ = wq_ * 64 + ln_; F.tid = t_; F.lane = t_ & 63; F.wave = __builtin_amdgcn_readfirstlane(t_ >> 6); unsigned long long w_ = (unsigned long long)args.ws; asm volatile("" : "+s"(w_)); F.ws = (unsigned char*)(GAS unsigned char*)w_; int v_ = vcu0; asm volatile("" : "+s"(v_)); F.vcu = v_; int r_ = reg0; asm volatile("" : "+s"(r_)); F.reg = r_; } while (0)
#ifndef BAR_REP
#define BAR_REP 1
#endif
#ifndef PROBE_T
#define PROBE_T -1
#endif
#ifndef PROBE_A
#define PROBE_A 8
#endif
#ifndef PROBE_L
#define PROBE_L -1
#endif
#define PH_T0(t) unsigned long long pt0_ = 0; if ((t) == PROBE_T) pt0_ = __builtin_amdgcn_s_memrealtime();
#define PH_T1(t) do { if ((t) == PROBE_T && (PROBE_L < 0 || PROBE_L == pl_)) { __syncthreads(); const unsigned long long e_ = __builtin_amdgcn_s_memrealtime(); const unsigned long long w_ = (e_ - pt0_) * PROBE_A; while (__builtin_amdgcn_s_memrealtime() - e_ < w_) __builtin_amdgcn_s_sleep(8); } } while (0)
#define SEAM(k) do { if (IN(k) && IN((k) + 1)) { for (int br = 0; br < BAR_REP; ++br) xcd_barrier(bar); } } while (0)
#ifndef LBAR_REP
#define LBAR_REP 1
#endif
#ifndef LOCAL_SEAMS
#define LOCAL_SEAMS 1
#endif
#define LSEAM(k) do { if (IN(k) && IN((k) + 1)) { if (reg0) { for (int br = 0; br < LBAR_REP; ++br) xcd_local_barrier(bar); } else xcd_barrier(bar); } } while (0)
#define h1 ((bf16*)(F.ws + WS_H1))
#define z ((bf16*)(F.ws + WS_Z))
#define xg ((bf16*)(F.ws + WS_XG))
#define hid ((bf16*)(F.ws + WS_HID))

    int pl_ = 0; (void)pl_;
    if (INT(0, 0)) { PH_T0(0); for (int rep = 0; rep < REPS(0); ++rep) { RETID(); ph0(F); if (REPS(0) > 1) __syncthreads(); } PH_T1(0); SEAM(0); }
    if (LOCAL_SEAMS && IN(0) && IN(1) && F.G == 256) {
        if (threadIdx.x == 0) { const bool rg = xcd_grid_regular(bar); F.MISC[12] = rg ? 1u : 0u; F.MISC[13] = bar.x * 32u + F.MISC[10]; }
        __syncthreads();
        reg0 = __builtin_amdgcn_readfirstlane((int)F.MISC[12]); if (reg0) vcu0 = __builtin_amdgcn_readfirstlane((int)F.MISC[13]);
    }
    for (int l = 0; l < 2; ++l) {
        const int pb = 1 + 13 * l; pl_ = l;
        if (INT(pb + 0, 1)) { PH_T0(1); for (int rep = 0; rep < REPS(1); ++rep) { RETID(); if (l == 0) norm_phase<0>(F); else norm_phase<1>(F); } PH_T1(1); LSEAM(pb + 0); }
        if (INT(pb + 1, 2)) { PH_T0(2); for (int rep = 0; rep < REPS(2); ++rep) { RETID();
            pg8::Gemm g{h1, (const bf16*)(F.ws + WS_WIN) + (size_t)l * 1536 * 1024, 1024, 1024, nullptr}; pg8::GroupOrder S; const int gq = F.vcu >> 5, gj = F.vcu & 31; if (F.reg) S.init(6, grp_p0(gq), grp_np(gq), 32, gj, false); else S.init(6, 0, 66, F.G, F.vcu, false);
            pg8::EpiStore E{z, ZW, 6};
            pg8::gemm_phase<pg8::EpiStore, pg8::GroupOrder, true, true>(F.lds, g, S, E, F.tid);
            if (USE_WIN && rep == 0 && F.G == 256) {
                const int n2 = 6 * grp_np(gq) - 32; const int wr = F.reg ? (gj >= n2 ? (gq < 2 ? 10 * gq : 20 + 16 * (gq - 2)) + gj - n2 : -1) : F.vcu - 140;
                if (wr >= 0) { RETID(); conv_window(F, l, l == 0 ? BASE_IN0 : BASE_IN1, wr, WIN_IN_NB, WIN_IN_IPW); } }
            } PH_T1(2); LSEAM(pb + 1); }
        if (INT(pb + 2, 3)) { PH_T0(3); for (int rep = 0; rep < REPS(3); ++rep) { RETID(); prep_phase(F, l); } PH_T1(3); LSEAM(pb + 2); }
        if (INT(pb + 3, 4)) { PH_T0(4); for (int rep = 0; rep < REPS(4); ++rep) { RETID();
            { pg8::Gemm g{z + ZQ, (const bf16*)(F.ws + WS_WUQ) + (size_t)l * 768 * 256, 256, ZW, nullptr}; pg8::GroupOrder S; const int gq = F.vcu >> 5, gj = F.vcu & 31; if (F.reg) S.init(3, grp_p0(gq), grp_np(gq), 32, (gj + 3 * grp_np(gq)) & 31, false); else S.init(3, 0, 66, F.G, F.G == 256 ? ((F.vcu + 198) & 255) : F.vcu, false);
              pg8::EpiStore E{(bf16*)(F.ws + WS_QM), QW, 3};
              pg8::gemm_phase<pg8::EpiStore, pg8::GroupOrder, true, true>(F.lds, g, S, E, F.tid); }
            RETID();
            { pg8::Gemm g{z + ZKV, (const bf16*)(F.ws + WS_WUKV) + (size_t)l * 1024 * 128, 128, ZW, nullptr}; pg8::GroupOrder S; const int gq = F.vcu >> 5, gj = F.vcu & 31; if (F.reg) S.init(4, grp_p0(gq), grp_np(gq), 32, gj, false); else S.init(4, 0, 66, F.G, F.vcu, false);
              pg8::EpiStore E{(bf16*)(F.ws + WS_KVM), KVW, 4};
              pg8::gemm_phase<pg8::EpiStore, pg8::GroupOrder, true, true>(F.lds, g, S, E, F.tid); }
            } PH_T1(4); if (IN(pb + 3) && IN(pb + 5)) xcd_barrier(bar); }
        if (INT(pb + 5, 6)) { PH_T0(6); for (int rep = 0; rep < REPS(6); ++rep) { RETID(); convmix_phase(F, l); RETID(); attn_phase(F, l, (char*)lds);
            if (USE_WIN && rep == 0 && l == 0 && F.G == 256 && F.vcu >= 16) { RETID(); conv_window(F, 0, BASE_AT0, F.vcu - 16, WIN_AT_NB, WIN_AT_IPW); } } PH_T1(6); SEAM(pb + 5); }
        if (INT(pb + 6, 7)) { PH_T0(7); for (int rep = 0; rep < REPS(7); ++rep) { RETID(); gnorm_phase(F, l); } PH_T1(7); LSEAM(pb + 6); }
        if (INT(pb + 7, 8)) { PH_T0(8); for (int rep = 0; rep < REPS(8); ++rep) { RETID();
            pg8::Gemm g{h1, (const bf16*)(F.ws + WS_WOUT) + (size_t)l * 1024 * 1024, 1024, 1024, nullptr}; pg8::GroupOrder S; const int gq = F.vcu >> 5, gj = F.vcu & 31; if (F.reg) { if (l == 1) S.init(4, 8 * gq, 8, 32, gj, true); else S.init(4, grp_p0(gq), grp_np(gq), 32, gj, false); } else S.init(4, 0, l == 1 ? 64 : 66, F.G, F.vcu, l == 1);
            pg8::EpiRes E{gin(F, I_X), gin(F, I_CTX), (void*)(F.ws + WS_XRES), (const float*)(F.ws + WS_MOD) + (size_t)l * 3 * 6144 + 2048, l};
            pg8::gemm_phase<pg8::EpiRes, pg8::GroupOrder, true, true>(F.lds, g, S, E, F.tid);
            if (USE_WIN && rep == 0 && l == 0 && F.G == 256) {
                const int n2 = 4 * grp_np(gq) - 32; const int wr = F.reg ? (gj >= n2 ? (gq < 2 ? 28 * gq : 56 + 32 * (gq - 2)) + gj - n2 : -1) : F.vcu - 8;
                if (wr >= 0) { RETID(); conv_window(F, 0, BASE_OUT0, wr, WIN_OUT_NB, WIN_OUT_IPW); } }
            } PH_T1(8); LSEAM(pb + 7); }
        if (INT(pb + 8, 9)) { PH_T0(9); for (int rep = 0; rep < REPS(9); ++rep) { RETID(); router_phase(F, l); } PH_T1(9); SEAM(pb + 8); }
        if (INT(pb + 9, 10)) { PH_T0(10); for (int rep = 0; rep < REPS(10); ++rep) { RETID(); topk_phase(F, l);
            if (USE_WIN && rep == 0 && F.G == 256) { const int nj = (l == 0) ? 64 : 32; if ((int)blockIdx.x >= nj) conv_window(F, l, l == 0 ? BASE_TK0 : BASE_TK1, (int)blockIdx.x - nj, 256 - nj, WIN_TK_IPW); }
            } PH_T1(10); if (IN(pb + 9) && IN(pb + 11)) xcd_barrier(bar); }
        if (INT(pb + 11, 12)) { PH_T0(12); for (int rep = 0; rep < REPS(12); ++rep) { RETID();
            pg8::Gemm g{h1, (const bf16*)(F.ws + WS_W13) + (size_t)l * 16 * 5376 * 1024, 1024, 1024, (const int*)(F.ws + WS_ROWIDX), 64, 0u, 32768u, 0u, 16u * 32768u};         pg8::MoeOrder S; S.init(l == 0 ? 9 : 8, 21, F.G, F.vcu);
            pg8::EpiSwiglu E{hid};
            pg8::gemm_phase<pg8::EpiSwiglu, pg8::MoeOrder, true, true, true, MOE_BAUX>(F.lds, g, S, E, F.tid);
            if (USE_WIN && rep == 0 && F.G == 256) { const int j = F.vcu & 31, j0 = (l == 0) ? 26 : 16;
                if (j >= j0) { RETID(); if (MOE_LSEAM) conv_window_blocked(F, l, l == 0 ? BASE_M10 : BASE_M11, (F.vcu >> 5) * (32 - j0) + j - j0, WIN_M1_IPW); else conv_window(F, l, l == 0 ? BASE_M10 : BASE_M11, (F.vcu >> 5) * (32 - j0) + j - j0, l == 0 ? WIN_M10_NB : WIN_M11_NB, WIN_M1_IPW); } }
            } PH_T1(12); if (MOE_LSEAM) LSEAM(pb + 11); else SEAM(pb + 11); }
        if (INT(pb + 12, 13)) { PH_T0(13); for (int rep = 0; rep < REPS(13); ++rep) { RETID();
            pg8::Gemm g{hid, (const bf16*)(F.ws + WS_W2) + (size_t)l * 16 * 1024 * FF, FF, 64, nullptr, 64, 32768u, 32768u, 42u * 32768u, 42u * 32768u};     pg8::MoeOrder S; S.init(l == 0 ? 9 : 8, 4, F.G, F.vcu);
            pg8::EpiStore E{xg, DM, 4};
#ifndef MOE2_XP
#define MOE2_XP 0
#endif
            pg8::gemm_phase<pg8::EpiStore, pg8::MoeOrder, true, true, false, MOE_BAUX>(F.lds, g, S, E, F.tid);
            if (USE_WIN && rep == 0 && l == 0 && F.G == 256 && (F.vcu & 31) >= 8) { RETID(); conv_window(F, 1, BASE_M2, (F.vcu >> 5) * 24 + (F.vcu & 31) - 8, WIN_M2_NB, WIN_M2_IPW); }
            if (REPS(13) > 1) __syncthreads();
            } PH_T1(13); SEAM(pb + 12); }
    }
    if (INT(27, 14)) { PH_T0(14); for (int rep = 0; rep < REPS(14); ++rep) { RETID(); norm_phase<2>(F); } PH_T1(14); }
#undef h1
#undef z
#undef xg
#undef hid
#undef IN
#undef INT
#undef REPS
#undef SEAM
}

#ifndef MK_MULTI
#define MK_MULTI 0
#endif
extern "C" void kernel_launch(void* const* d_in, const int* in_sizes, int n_in, void* d_out, int out_size, void* d_ws, size_t ws_size, hipStream_t stream) {
    static int grid = 0;
    if (grid == 0) {
        if (n_in != 26 || in_sizes[0] != NB * SEQ * DM || out_size != NB * SEQ * DM || ws_size < WS_END) { fprintf(stderr, "kernel_launch: shape / workspace mismatch (n_in %d, ws %zu)\n", n_in, ws_size); grid = -1; return; }
        int dev = 0, cus = 0, per_cu = 0;
        if (hipGetDevice(&dev) != hipSuccess || hipDeviceGetAttribute(&cus, hipDeviceAttributeMultiprocessorCount, dev) != hipSuccess) { grid = -1; return; }
        if (hipFuncSetAttribute((const void*)fwd, hipFuncAttributeMaxDynamicSharedMemorySize, LDS_BYTES) != hipSuccess) { fprintf(stderr, "kernel_launch: hipFuncSetAttribute failed\n"); grid = -1; return; }
        if (hipOccupancyMaxActiveBlocksPerMultiprocessor(&per_cu, (const void*)fwd, NWAVES * 64, LDS_BYTES) != hipSuccess || per_cu < 1) { fprintf(stderr, "kernel_launch: occupancy query reports %d\n", per_cu); (void)hipGetLastError(); per_cu = 1; }
        grid = cus;
    }
    if (grid < 0) return;
    if (hipMemsetAsync((char*)d_ws + WS_CTL, 0, CTL_ZERO_BYTES, stream) != hipSuccess) return;
    Args a{};
    for (int i = 0; i < 26; ++i) a.in[i] = (const float*)d_in[i];
    a.out = (float*)d_out; a.ws = (unsigned char*)d_ws; a.pad = 0;
#if MK_MULTI
    for (int p = 0; p < NPHASE; ++p) { a.ph_lo = p; a.ph_hi = p + 1; a.li = p; hipLaunchKernelGGL(fwd, dim3(grid), dim3(NWAVES * 64), LDS_BYTES, stream, a); }
#else
    a.ph_lo = 0; a.ph_hi = NPHASE; a.li = 0;
    hipLaunchKernelGGL(fwd, dim3(grid), dim3(NWAVES * 64), LDS_BYTES, stream, a);
#endif
    const hipError_t le = hipPeekAtLastError();
    if (le != hipSuccess) fprintf(stderr, "kernel_launch: launch failed: %s\n", hipGetErrorName(le));
}
```

```cpp
#include <hip/hip_runtime.h>
#include <cstdio>
#include <cstdint>

#define GAS __attribute__((address_space(1)))
#define LAS __attribute__((address_space(3)))
typedef unsigned short bf16;
typedef unsigned v4u __attribute__((ext_vector_type(4)));
typedef unsigned v2u __attribute__((ext_vector_type(2)));
typedef float f32x4 __attribute__((ext_vector_type(4)));
typedef float f32x2 __attribute__((ext_vector_type(2)));
typedef short bf16x8 __attribute__((ext_vector_type(8)));
typedef short s16x4 __attribute__((ext_vector_type(4)));
typedef float f32x16 __attribute__((ext_vector_type(16)));
#define LDS_WAIT() asm volatile("s_waitcnt lgkmcnt(0)" ::: "memory")
#define VM_WAIT() asm volatile("s_waitcnt vmcnt(0)" ::: "memory")

constexpr int DM = 1024, SEQ = 8192, CTX = 256, NB = 2, SB = SEQ + CTX, M = NB * SB, NPM = M / 256, PPB = SB / 256;
constexpr int ZW = 1536, QW = 768, KVW = 1024, OW = 768, FF = 2688, NE = 16, RPE = 2304;
constexpr int ZQ = 0, ZKV = 256, ZKR = 384, ZGQ = 416, ZGK = 672, ZGV = 800, ZCA = 928, ZCB = 1184;
constexpr float EPS = 1e-6f;
constexpr float LOG2E = 1.4426950408889634f;
constexpr float C_MLA = 0.10206207261596575f * LOG2E, C_GQA = 0.125f * LOG2E;

__device__ __forceinline__ unsigned f2bf(float f) { unsigned u = __builtin_bit_cast(unsigned, f); return (u + 0x7fffu + ((u >> 16) & 1u)) >> 16; }
__device__ __forceinline__ unsigned pk2(float lo, float hi) { unsigned r; asm volatile("v_cvt_pk_bf16_f32 %0, %1, %2" : "=v"(r) : "v"(lo), "v"(hi)); return r; }
__device__ __forceinline__ float bf2f(unsigned short h) { return __builtin_bit_cast(float, (unsigned)h << 16); }
__device__ __forceinline__ float bflo(unsigned w) { return __builtin_bit_cast(float, w << 16); }
__device__ __forceinline__ float bfhi(unsigned w) { return __builtin_bit_cast(float, w & 0xffff0000u); }
#ifndef OLD_SX
#define OLD_SX 0
#endif
#ifndef OLD_SCAN
#define OLD_SCAN 0
#endif
template <int X> __device__ __forceinline__ float sx(float v) { if (OLD_SX) return __shfl_xor(v, X); return __builtin_bit_cast(float, __builtin_amdgcn_ds_swizzle(__builtin_bit_cast(int, v), (X << 10) | 0x1f)); }
#ifndef OLD_S32
#define OLD_S32 OLD_SX
#endif
__device__ __forceinline__ float sum32(float v) {
    if (OLD_S32) return v + __shfl_xor(v, 32);
    float a_ = v, b_ = v; asm volatile("s_nop 1\n\tv_permlane32_swap_b32 %0, %1" : "+v"(a_), "+v"(b_)); return a_ + b_; }
__device__ __forceinline__ float wave_sum(float v) { v += sx<1>(v); v += sx<2>(v); v += sx<4>(v); v += sx<8>(v); v += sx<16>(v); return sum32(v); }
template <int N> __device__ __forceinline__ void wave_sum_n(float (&v)[N]) {
    float t[N];
#define WS_STEP(X) _Pragma("unroll") for (int i = 0; i < N; ++i) t[i] = sx<X>(v[i]); _Pragma("unroll") for (int i = 0; i < N; ++i) v[i] += t[i];
    WS_STEP(1) WS_STEP(2) WS_STEP(4) WS_STEP(8) WS_STEP(16)
#undef WS_STEP
#pragma unroll
    for (int i = 0; i < N; ++i) v[i] = sum32(v[i]);
}
template <int N> __device__ __forceinline__ void half_sum_n(float (&v)[N]) {
    float t[N];
#define WS_STEP(X) _Pragma("unroll") for (int i = 0; i < N; ++i) t[i] = sx<X>(v[i]); _Pragma("unroll") for (int i = 0; i < N; ++i) v[i] += t[i];
    WS_STEP(1) WS_STEP(2) WS_STEP(4) WS_STEP(8) WS_STEP(16)
#undef WS_STEP
}
__device__ __forceinline__ unsigned wave_scan_incl(unsigned v, int lane) {
    if (OLD_SCAN) { for (int o = 1; o < 64; o <<= 1) { const unsigned n = __shfl_up(v, o); if (lane >= o) v += n; } return v; }
    v += (unsigned)__builtin_amdgcn_update_dpp(0, (int)v, 0x111, 0xf, 0xf, false);
    v += (unsigned)__builtin_amdgcn_update_dpp(0, (int)v, 0x112, 0xf, 0xf, false);
    v += (unsigned)__builtin_amdgcn_update_dpp(0, (int)v, 0x114, 0xf, 0xf, false);
    v += (unsigned)__builtin_amdgcn_update_dpp(0, (int)v, 0x118, 0xf, 0xf, false);
    const unsigned s0 = __builtin_amdgcn_readlane(v, 15), s1 = __builtin_amdgcn_readlane(v, 31), s2 = __builtin_amdgcn_readlane(v, 47);
    return v + (lane >= 16 ? s0 : 0u) + (lane >= 32 ? s1 : 0u) + (lane >= 48 ? s2 : 0u);
}
__device__ __forceinline__ float sigmoidf_(float v) { return 1.f / (1.f + __expf(-v)); }

namespace pg8 {
#define PG8_LAS __attribute__((address_space(3)))
typedef unsigned short bf16_t;
typedef short bf16x8 __attribute__((ext_vector_type(8)));
typedef float f32x4 __attribute__((ext_vector_type(4)));
typedef unsigned u32x4 __attribute__((ext_vector_type(4)));
constexpr int BM = 256, BK = 64, HALF = 128, HTB = HALF * BK * 2  , STAGE_BYTES = 8 * HTB;

__host__ __device__ __forceinline__ int lds_byte(int r, int c) { const int st = (r >> 4) * 2 + (c >> 5), rr = r & 15, cc = c & 31, ob = rr * 64 + cc * 2; return st * 1024 + (ob ^ (((ob >> 9) & 1) << 5)); }
__host__ __device__ __forceinline__ void stage_rc(int b, int& R, int& C) { const int st = b / 1024, sb = b % 1024, swz = sb ^ (((sb >> 9) & 1) << 5); R = (st >> 1) * 16 + swz / 64; C = (st & 1) * 32 + (swz % 64) / 2; }
__host__ __device__ __forceinline__ int perm32(int rho) { const int n = rho >> 4, i = rho & 15; return 8 * (i >> 2) + 4 * n + (i & 3); }

struct Unit { int pm, pn; };
struct Gemm { const bf16_t* A; const bf16_t* Bt; int K, lda; const int* gidx; int ldb = 0;   unsigned kstepA = 0, kstepB = 0, pstepA = 0, pstepB = 0;   };


__device__ __forceinline__ void tile_of(int L, int nM, int nN, int& pm, int& pn) {
    const int nig = 8 * nN, gid = L / nig, fm = gid * 8, gsz = (nM - fm) < 8 ? (nM - fm) : 8, r = L % nig;
    pm = fm + r % gsz; pn = r / gsz;
}
struct RowOrder {
    int nM, nN, nwg, G, c; bool skip;
    __device__ __forceinline__ void init(int nN_, int G_, int c_, bool skip_ctx) { skip = skip_ctx; nM = skip_ctx ? 64 : 66; nN = nN_; nwg = nM * nN; G = G_; c = c_; }
    __device__ __forceinline__ bool next(int i, Unit& u) const {
        const int L = i * G + c; if (L >= nwg) return false;
        int pm, pn; tile_of(L, nM, nN, pm, pn);
        u.pm = skip ? pm + 1 + (pm >> 5) : pm; u.pn = pn; return true;
    }
    __device__ __forceinline__ void a_ready(const Unit&) const {}
    __device__ __forceinline__ void done(const Unit&) const {}
};
struct GroupOrder {
    int p0, np, nN, cpg, j; bool skip;
    __device__ __forceinline__ void init(int nN_, int p0_, int np_, int cpg_, int j_, bool skip_ctx) { nN = nN_; p0 = p0_; np = np_; cpg = cpg_; j = j_; skip = skip_ctx; }
    __device__ __forceinline__ bool next(int i, Unit& u) const {
        const int q = i * cpg + j; if (q >= np * nN || j >= cpg) return false;
        const int lp = p0 + q % np; u.pm = skip ? lp + 1 + (lp >> 5) : lp; u.pn = q / np; return true;
    }
    __device__ __forceinline__ void a_ready(const Unit&) const {}
    __device__ __forceinline__ void done(const Unit&) const {}
};
struct MoeOrder {
    int nMe, nNe, per, cpg, grp, j, epg;
    __device__ __forceinline__ void init(int nMe_, int nNe_, int G, int vcu) {
        nMe = nMe_; nNe = nNe_; per = nMe * nNe; const int ngrp = (G % 8 == 0) ? 8 : 1; cpg = G / ngrp; grp = vcu / cpg; j = vcu % cpg; epg = 16 / ngrp;
    }
    __device__ __forceinline__ bool next(int i, Unit& u) const {
        const int q = i * cpg + j; if (q >= epg * per) return false;
        const int e = grp * epg + q / per, r = q % per; u.pm = e * 9 + r % nMe; u.pn = e * nNe + r / nMe; return true;
    }
    __device__ __forceinline__ void a_ready(const Unit&) const {}
    __device__ __forceinline__ void done(const Unit&) const {}
};

#ifndef WT_STORES
#define WT_STORES 0
#endif
__device__ __forceinline__ void st16(void* p, u32x4 v) {
    if (WT_STORES == 1) asm volatile("global_store_dwordx4 %0, %1, off sc1\n\ts_nop 1" :: "v"(p), "v"(v) : "memory");     else if (WT_STORES == 2) __builtin_nontemporal_store(v, (u32x4*)p); else *(u32x4*)p = v; }
struct EpiStore {
    static constexpr bool PERM = true, AFTER_DRAIN = false;
    bf16_t* O; int ldc; int nNloc;
    __device__ __forceinline__ void operator()(const f32x4 (&acc)[2][2][4][2], const Unit& u, int wr, int wc, int fr, int fq) const {
        const int row0 = u.pm * BM + wr * 64 + fr, col0 = (u.pn % nNloc) * BM + wc * 32 + 8 * fq;
#pragma unroll
        for (int ai = 0; ai < 2; ++ai)
#pragma unroll
            for (int m = 0; m < 4; ++m) { bf16_t* rowp = O + (size_t)(row0 + ai * HALF + m * 16) * ldc + col0;
#pragma unroll
                for (int bj = 0; bj < 2; ++bj) { const f32x4 v0 = acc[ai][bj][m][0], v1 = acc[ai][bj][m][1];
                    u32x4 w; w.x = pk2(v0[0], v0[1]); w.y = pk2(v0[2], v0[3]); w.z = pk2(v1[0], v1[1]); w.w = pk2(v1[2], v1[3]);
                    st16(rowp + bj * HALF, w); } }
    }
};
struct EpiQ {
    static constexpr bool PERM = true, AFTER_DRAIN = false;
    bf16_t* O; const float* cosM; const float* sinM;
    __device__ __forceinline__ void operator()(const f32x4 (&acc)[2][2][4][2], const Unit& u, int wr, int wc, int fr, int fq) const {
        const int row0 = u.pm * BM + wr * 64 + fr, col0 = u.pn * BM + wc * 32 + 8 * fq;
        const int pb = u.pm % PPB; const bool lat = pb != 0; const int t0 = (pb - 1) * 256 + wr * 64 + fr;
#pragma unroll
        for (int ai = 0; ai < 2; ++ai)
#pragma unroll
            for (int m = 0; m < 4; ++m) { bf16_t* rowp = O + (size_t)(row0 + ai * HALF + m * 16) * QW + col0; const int t = t0 + ai * HALF + m * 16;
#pragma unroll
                for (int bj = 0; bj < 2; ++bj) { f32x4 v0 = acc[ai][bj][m][0], v1 = acc[ai][bj][m][1];
                    const int g32 = u.pn * 8 + bj * 4 + wc;
                    if (lat && (g32 % 3) == 2) {
                        const f32x4 c = *(const f32x4*)(cosM + (size_t)t * 16 + 4 * fq), s = *(const f32x4*)(sinM + (size_t)t * 16 + 4 * fq);
                        const f32x4 a0 = v0, a1 = v1;
                        v0[0] = a0[0] * c[0] - a0[1] * s[0]; v0[1] = a0[1] * c[0] + a0[0] * s[0]; v0[2] = a0[2] * c[1] - a0[3] * s[1]; v0[3] = a0[3] * c[1] + a0[2] * s[1];
                        v1[0] = a1[0] * c[2] - a1[1] * s[2]; v1[1] = a1[1] * c[2] + a1[0] * s[2]; v1[2] = a1[2] * c[3] - a1[3] * s[3]; v1[3] = a1[3] * c[3] + a1[2] * s[3];
                    }
                    u32x4 w; w.x = pk2(v0[0], v0[1]); w.y = pk2(v0[2], v0[3]); w.z = pk2(v1[0], v1[1]); w.w = pk2(v1[2], v1[3]);
                    *(u32x4*)(rowp + bj * HALF) = w; } }
    }
};
#ifndef XRES_BF16
#define XRES_BF16 1
#endif
struct EpiRes {
    static constexpr bool PERM = true, AFTER_DRAIN = false;
    const float* xin; const float* cin; void* xres; const float* gate; int layer;
    __device__ __forceinline__ void operator()(const f32x4 (&acc)[2][2][4][2], const Unit& u, int wr, int wc, int fr, int fq) const {
        const int b = u.pm / PPB, pb = u.pm % PPB, mv = pb == 0 ? 2 : b;
        const int col0 = u.pn * BM + wc * 32 + 8 * fq; const float* gp = gate + mv * 6144 + col0;
        f32x4 gv[2][2];
#pragma unroll
        for (int bj = 0; bj < 2; ++bj)
#pragma unroll
            for (int n = 0; n < 2; ++n) gv[bj][n] = *(const f32x4*)(gp + bj * HALF + 4 * n);
#pragma unroll
        for (int ai = 0; ai < 2; ++ai)
#pragma unroll
            for (int m = 0; m < 4; ++m) { const int rl = ai * HALF + wr * 64 + m * 16 + fr; const size_t R = (size_t)u.pm * BM + rl;
                const float* sp = (pb == 0 ? cin + ((size_t)b * CTX + rl) * DM : xin + ((size_t)b * SEQ + (pb - 1) * 256 + rl) * DM) + col0;
#pragma unroll
                for (int bj = 0; bj < 2; ++bj) { f32x4 x0, x1;
                    if (layer == 0) { x0 = *(const f32x4*)(sp + bj * HALF); x1 = *(const f32x4*)(sp + bj * HALF + 4); }
                    else if (XRES_BF16) { const u32x4 w = *(const u32x4*)((const bf16_t*)xres + R * DM + col0 + bj * HALF);
                        x0 = (f32x4){bflo(w.x), bfhi(w.x), bflo(w.y), bfhi(w.y)}; x1 = (f32x4){bflo(w.z), bfhi(w.z), bflo(w.w), bfhi(w.w)}; }
                    else { const float* xp = (const float*)xres + R * DM + col0 + bj * HALF; x0 = *(const f32x4*)xp; x1 = *(const f32x4*)(xp + 4); }
                    const f32x4 o0 = x0 + gv[bj][0] * acc[ai][bj][m][0], o1 = x1 + gv[bj][1] * acc[ai][bj][m][1];
                    if (XRES_BF16) { u32x4 w; w.x = pk2(o0[0], o0[1]); w.y = pk2(o0[2], o0[3]); w.z = pk2(o1[0], o1[1]); w.w = pk2(o1[2], o1[3]); *(u32x4*)((bf16_t*)xres + R * DM + col0 + bj * HALF) = w; }
                    else { float* op = (float*)xres + R * DM + col0 + bj * HALF; *(f32x4*)op = o0; *(f32x4*)(op + 4) = o1; } } }
    }
};
struct EpiSwiglu {
    static constexpr bool PERM = true, AFTER_DRAIN = false;
    bf16_t* H;
    __device__ __forceinline__ void operator()(const f32x4 (&acc)[2][2][4][2], const Unit& u, int wr, int wc, int fr, int fq) const {
        const int r0 = wr * 64 + fr, kt = (u.pn % 21) * 2 + (wc >> 1), c0 = (wc & 1) * 32 + 8 * fq;
        bf16_t* const blk = H + ((size_t)u.pm * 42 + kt) * (BM * 64) + c0;
#pragma unroll
        for (int ai = 0; ai < 2; ++ai)
#pragma unroll
            for (int m = 0; m < 4; ++m) { bf16_t* rowp = blk + (r0 + ai * HALF + m * 16) * 64;
                float h[8];
#pragma unroll
                for (int n = 0; n < 2; ++n)
#pragma unroll
                    for (int i = 0; i < 4; i += 2) { const f32x2 a = {acc[ai][0][m][n][i], acc[ai][0][m][n][i + 1]}, b = {acc[ai][1][m][n][i], acc[ai][1][m][n][i + 1]};
                        const f32x2 t = a * (-LOG2E); f32x2 d = {__builtin_amdgcn_exp2f(t.x), __builtin_amdgcn_exp2f(t.y)}; d = d + 1.0f;
                        const f32x2 r = {__builtin_amdgcn_rcpf(d.x), __builtin_amdgcn_rcpf(d.y)}; const f32x2 o = (a * b) * r; h[n * 4 + i] = o.x; h[n * 4 + i + 1] = o.y; }
                u32x4 w; w.x = pk2(h[0], h[1]); w.y = pk2(h[2], h[3]); w.z = pk2(h[4], h[5]); w.w = pk2(h[6], h[7]);
                st16(rowp, w); }
    }
};

template <class Epi, class Sched, bool ALIGN_EPI = false, bool SP2 = false, bool GATHER = false, int BAUX = 0>
__device__ __forceinline__ void gemm_phase(PG8_LAS unsigned char* lds, const Gemm g, const Sched& S, const Epi& E, const int tid_in) {
    int tid_ = tid_in; asm volatile("" : "+v"(tid_));
    const int tid = tid_, wid = __builtin_amdgcn_readfirstlane(tid >> 6), lane = tid & 63, wr = wid >> 2, wc = wid & 3, fr = lane & 15, fq = lane >> 4;
    int K_ = g.K; asm volatile("" : "+s"(K_));
    const int K = K_, nt = K / BK; int ldb_ = g.ldb ? g.ldb : K_; asm volatile("" : "+s"(ldb_)); const int LDB = ldb_;
    unsigned voffA[2], voffB[2]; int gR[2]; unsigned gC[2];
#pragma unroll
    for (int i = 0; i < 2; ++i) { int R, C; stage_rc(tid * 16 + i * 8192, R, C); const int Rb = Epi::PERM ? ((R & ~31) + perm32(R & 31)) : R;
        voffA[i] = (unsigned)(R * g.lda + C) * 2u; voffB[i] = (unsigned)(Rb * LDB + C) * 2u; gR[i] = R; gC[i] = (unsigned)C * 2u; }
    unsigned vC[2][2], vN[2][2];
#define PG8_GIDX(dst, U) do { _Pragma("unroll") for (int h_ = 0; h_ < 2; ++h_) _Pragma("unroll") for (int i_ = 0; i_ < 2; ++i_) \
        dst[h_][i_] = (unsigned)g.gidx[(U).pm * BM + h_ * HALF + gR[i_]] * (unsigned)(g.lda * 2) + gC[i_]; } while (0)
#define PG8_STGA(bufoff, kptr, h, USEN) do { if constexpr (GATHER) { const unsigned vsel_[2] = {(USEN) ? vN[h][0] : vC[h][0], (USEN) ? vN[h][1] : vC[h][1]}; PG8_STAGE(bufoff, kptr, vsel_); } \
        else { PG8_STAGE(bufoff, (kptr) + (h) * hstepA, voffA); } } while (0)
    unsigned ksa_ = g.kstepA ? g.kstepA : (unsigned)(BK * 2), ksb_ = g.kstepB ? g.kstepB : (unsigned)(BK * 2); asm volatile("" : "+s"(ksa_), "+s"(ksb_));
    const size_t kstepA = ksa_, kstepB = ksb_;
    const size_t hstepA = (size_t)HALF * g.lda * 2, hstepB = (size_t)HALF * LDB * 2;
    const size_t tstepA = g.pstepA ? (size_t)g.pstepA : 2 * hstepA, tstepB = g.pstepB ? (size_t)g.pstepB : 2 * hstepB;
    const unsigned ldsw = (unsigned)wid * 1024u;
    const int aoff = lds_byte(wr * 64 + fr, fq * 8), boff = lds_byte(wc * 32 + fr, fq * 8);
#define PG8_SA(b, h) (((b) * 2 + (h)) * HTB)
#define PG8_SB(b, h) ((4 + (b) * 2 + (h)) * HTB)
#define PG8_STAGE(bufoff, gbase, voff) do { _Pragma("unroll") for (int _i = 0; _i < 2; ++_i) \
        __builtin_amdgcn_global_load_lds((const unsigned*)((const char*)(gbase) + (voff)[_i]), (PG8_LAS unsigned*)(lds + (bufoff) + ldsw + _i * 8192), 16, 0, 0); } while (0)
#define PG8_STAGEB(bufoff, gbase, voff) do { _Pragma("unroll") for (int _i = 0; _i < 2; ++_i) \
        __builtin_amdgcn_global_load_lds((const unsigned*)((const char*)(gbase) + (voff)[_i]), (PG8_LAS unsigned*)(lds + (bufoff) + ldsw + _i * 8192), 16, 0, BAUX); } while (0)
#define PG8_LDA(dst, b, h) do { _Pragma("unroll") for (int m = 0; m < 4; ++m) _Pragma("unroll") for (int k = 0; k < 2; ++k) dst[m][k] = *(const PG8_LAS bf16x8*)(lds + PG8_SA(b, h) + aoff + m * 2048 + k * 1024); } while (0)
#define PG8_LDB(dst, b, h) do { _Pragma("unroll") for (int n = 0; n < 2; ++n) _Pragma("unroll") for (int k = 0; k < 2; ++k) dst[n][k] = *(const PG8_LAS bf16x8*)(lds + PG8_SB(b, h) + boff + n * 2048 + k * 1024); } while (0)
#define PG8_MMA(ai, bj, At, Bt) do { __builtin_amdgcn_s_setprio(1); _Pragma("unroll") for (int m = 0; m < 4; ++m) _Pragma("unroll") for (int n = 0; n < 2; ++n) _Pragma("unroll") for (int k = 0; k < 2; ++k) \
        acc[ai][bj][m][n] = __builtin_amdgcn_mfma_f32_16x16x32_bf16(Bt[n][k], At[m][k], acc[ai][bj][m][n], 0, 0, 0); __builtin_amdgcn_s_setprio(0); } while (0)
#define PG8_WAIT_V(n) asm volatile("s_waitcnt vmcnt(" #n ")" ::: "memory")
#define PG8_WAIT_L(n) asm volatile("s_waitcnt lgkmcnt(" #n ")" ::: "memory")
#define PG8_BAR __builtin_amdgcn_s_barrier()
#define PG8_SCHED __builtin_amdgcn_sched_barrier(0)
    Unit cur, nxt; int ui = 0;
    if (!S.next(0, cur)) return;
    f32x4 acc[2][2][4][2];
#pragma unroll
    for (int a = 0; a < 2; ++a)
#pragma unroll
        for (int b = 0; b < 2; ++b)
#pragma unroll
            for (int m = 0; m < 4; ++m)
#pragma unroll
                for (int n = 0; n < 2; ++n) acc[a][b][m][n] = (f32x4){0.f, 0.f, 0.f, 0.f};
    bf16x8 At[4][2], B0[2][2], B1[2][2];
    const char* cA = (const char*)g.A + (GATHER ? (size_t)0 : (size_t)cur.pm * tstepA); const char* cB = (const char*)g.Bt + (size_t)cur.pn * tstepB;
    if constexpr (GATHER) { PG8_GIDX(vC, cur); }
    S.a_ready(cur);
    if constexpr (SP2) {
        PG8_STAGEB(PG8_SB(0, 0), cB, voffB); PG8_STAGEB(PG8_SB(0, 1), cB + hstepB, voffB); PG8_STGA(PG8_SA(0, 0), cA, 0, false); PG8_STGA(PG8_SA(0, 1), cA, 1, false);
        if (wr == 1) PG8_BAR;
        PG8_WAIT_V(2); PG8_BAR;
        PG8_STAGEB(PG8_SB(1, 0), cB + kstepB, voffB); PG8_STGA(PG8_SA(1, 0), cA + kstepA, 0, false); PG8_STAGEB(PG8_SB(1, 1), cB + hstepB + kstepB, voffB);
        PG8_WAIT_V(6); PG8_BAR;
    } else {
        PG8_STAGEB(PG8_SB(0, 0), cB, voffB); PG8_STAGE(PG8_SA(0, 0), cA, voffA); PG8_STAGEB(PG8_SB(0, 1), cB + hstepB, voffB); PG8_STAGE(PG8_SA(0, 1), cA + hstepA, voffA);
        if (wr == 1) PG8_BAR;
        PG8_WAIT_V(4); PG8_BAR;
        PG8_STAGEB(PG8_SB(1, 0), cB + kstepB, voffB); PG8_STAGE(PG8_SA(1, 0), cA + kstepA, voffA); PG8_STAGEB(PG8_SB(1, 1), cB + hstepB + kstepB, voffB);
        PG8_WAIT_V(6); PG8_BAR;
    }
    for (;;) {
        const bool has_next = S.next(ui + 1, nxt);
        const char* nA = (has_next && !GATHER) ? (const char*)g.A + (size_t)nxt.pm * tstepA : cA;
        if constexpr (GATHER) { if (has_next) { PG8_GIDX(vN, nxt); } else { _Pragma("unroll") for (int h_ = 0; h_ < 2; ++h_) { vN[h_][0] = vC[h_][0]; vN[h_][1] = vC[h_][1]; } } } const char* nB = has_next ? (const char*)g.Bt + (size_t)nxt.pn * tstepB : cB;
        for (int t = 0; t < nt; t += 2) {
            const bool last = (t == nt - 2);
            const char* a1 = cA + (size_t)(t + 1) * kstepA;
            const char* a2 = last ? nA : cA + (size_t)(t + 2) * kstepA; const char* b2 = last ? nB : cB + (size_t)(t + 2) * kstepB;
            const char* a3 = a2 + kstepA; const char* b3 = b2 + kstepB;
            if (last && has_next) S.a_ready(nxt);
            if constexpr (SP2) {
            PG8_LDB(B0, 0, 0); PG8_LDB(B1, 0, 1); PG8_SCHED; PG8_LDA(At, 0, 0); PG8_STGA(PG8_SA(1, 1), a1, 1, false);
            PG8_WAIT_V(8); PG8_WAIT_L(0); PG8_BAR; PG8_MMA(0, 0, At, B0); PG8_MMA(0, 1, At, B1); PG8_BAR; PG8_SCHED;
            PG8_LDA(At, 0, 1); PG8_STAGEB(PG8_SB(0, 0), b2, voffB); PG8_STAGEB(PG8_SB(0, 1), b2 + hstepB, voffB); PG8_STGA(PG8_SA(0, 0), a2, 0, last);
            PG8_WAIT_V(8); PG8_WAIT_L(0); PG8_BAR; PG8_MMA(1, 0, At, B0); PG8_MMA(1, 1, At, B1); PG8_BAR; PG8_SCHED;
            PG8_LDB(B0, 1, 0); PG8_LDB(B1, 1, 1); PG8_SCHED; PG8_LDA(At, 1, 0); PG8_STGA(PG8_SA(0, 1), a2, 1, last);
            PG8_WAIT_V(8); PG8_WAIT_L(0); PG8_BAR; PG8_MMA(0, 0, At, B0); PG8_MMA(0, 1, At, B1); PG8_BAR; PG8_SCHED;
            PG8_LDA(At, 1, 1); PG8_STAGEB(PG8_SB(1, 0), b3, voffB); PG8_STAGEB(PG8_SB(1, 1), b3 + hstepB, voffB); PG8_STGA(PG8_SA(1, 0), a3, 0, last);
            PG8_WAIT_V(8); PG8_WAIT_L(0); PG8_BAR; PG8_MMA(1, 0, At, B0); PG8_MMA(1, 1, At, B1); PG8_BAR; PG8_SCHED;
            } else {
            PG8_LDB(B0, 0, 0); PG8_SCHED; PG8_LDA(At, 0, 0); PG8_STAGE(PG8_SA(1, 1), a1 + hstepA, voffA);
            PG8_WAIT_L(8); PG8_BAR; PG8_WAIT_L(0); PG8_MMA(0, 0, At, B0); PG8_BAR; PG8_SCHED;
            PG8_LDB(B1, 0, 1); PG8_STAGEB(PG8_SB(0, 0), b2, voffB);
            PG8_BAR; PG8_WAIT_L(0); PG8_MMA(0, 1, At, B1); PG8_BAR;
            PG8_LDA(At, 0, 1); PG8_STAGE(PG8_SA(0, 0), a2, voffA);
            PG8_BAR; PG8_WAIT_L(0); PG8_MMA(1, 0, At, B0); PG8_BAR; PG8_SCHED;
            PG8_STAGEB(PG8_SB(0, 1), b2 + hstepB, voffB);
            PG8_WAIT_V(6); PG8_BAR; PG8_MMA(1, 1, At, B1); PG8_BAR;
            PG8_LDB(B0, 1, 0); PG8_SCHED; PG8_LDA(At, 1, 0); PG8_STAGE(PG8_SA(0, 1), a2 + hstepA, voffA);
            PG8_WAIT_L(8); PG8_BAR; PG8_WAIT_L(0); PG8_MMA(0, 0, At, B0); PG8_BAR; PG8_SCHED;
            PG8_LDB(B1, 1, 1); PG8_STAGEB(PG8_SB(1, 0), b3, voffB);
            PG8_BAR; PG8_WAIT_L(0); PG8_MMA(0, 1, At, B1); PG8_BAR;
            PG8_LDA(At, 1, 1); PG8_STAGE(PG8_SA(1, 0), a3, voffA);
            PG8_BAR; PG8_WAIT_L(0); PG8_MMA(1, 0, At, B0); PG8_BAR; PG8_SCHED;
            PG8_STAGEB(PG8_SB(1, 1), b3 + hstepB, voffB);
            PG8_WAIT_V(6); PG8_BAR; PG8_MMA(1, 1, At, B1); PG8_BAR;
            }
        }
        if constexpr (ALIGN_EPI) { if (wr == 0) PG8_BAR; }
        if constexpr (!Epi::AFTER_DRAIN) { E(acc, cur, wr, wc, fr, fq); S.done(cur); }
        if (!has_next) break;
#pragma unroll
        for (int a = 0; a < 2; ++a)
#pragma unroll
            for (int b = 0; b < 2; ++b)
#pragma unroll
                for (int m = 0; m < 4; ++m)
#pragma unroll
                    for (int n = 0; n < 2; ++n) acc[a][b][m][n] = (f32x4){0.f, 0.f, 0.f, 0.f};
        cur = nxt; cA = nA; cB = nB; ++ui;
        if constexpr (GATHER) { _Pragma("unroll") for (int h_ = 0; h_ < 2; ++h_) { vC[h_][0] = vN[h_][0]; vC[h_][1] = vN[h_][1]; } }
        if constexpr (ALIGN_EPI) { if (wr == 1) PG8_BAR; }
    }
    PG8_WAIT_V(0);
    if constexpr (!ALIGN_EPI) { if (wr == 0) PG8_BAR; }
    PG8_BAR;
    if constexpr (Epi::AFTER_DRAIN) { E.fused(acc, cur, wr, wc, fr, fq, lds, wid, lane); S.done(cur); }
#undef PG8_SA
#undef PG8_SB
#undef PG8_STAGE
#undef PG8_STAGEB
#undef PG8_STGA
#undef PG8_GIDX
#undef PG8_LDA
#undef PG8_LDB
#undef PG8_MMA
#undef PG8_WAIT_V
#undef PG8_WAIT_L
#undef PG8_BAR
#undef PG8_SCHED
}
}

namespace att {
#define SBAR() __builtin_amdgcn_sched_barrier(0)
__device__ __forceinline__ int crow(int r, int hi) { return (r & 3) + 8 * (r >> 2) + 4 * hi; }
__device__ __forceinline__ unsigned cvtpk(float lo, float hi) { unsigned r; asm volatile("v_cvt_pk_bf16_f32 %0, %1, %2" : "=v"(r) : "v"(lo), "v"(hi)); return r; }

__device__ __forceinline__ void partialSM(f32x16& p0, f32x16& p1, float& mhat, f32x16& negm, float& alpha, const bool first, const float thr) {
  float pmax = p0[0];
#pragma unroll
  for (int r = 1; r < 16; ++r) pmax = fmaxf(pmax, p0[r]);
#pragma unroll
  for (int r = 0; r < 16; ++r) pmax = fmaxf(pmax, p1[r]);
  { auto rr = __builtin_amdgcn_permlane32_swap(__float_as_uint(pmax), __float_as_uint(pmax), false, false);
    pmax = fmaxf(__uint_as_float(rr[0]), __uint_as_float(rr[1])); }
  alpha = 1.f;
  if (__builtin_expect(first || __any(pmax > thr), 0)) {
    const float dl = first ? pmax : fmaxf(pmax, 0.f); mhat += dl;
#pragma unroll
    for (int r = 0; r < 16; ++r) { p0[r] -= dl; p1[r] -= dl; }
#pragma unroll
    for (int r = 0; r < 16; ++r) negm[r] = -mhat;
    asm volatile("" : "+v"(negm));
    alpha = first ? 1.f : __builtin_amdgcn_exp2f(-dl);
  }
#pragma unroll
  for (int r = 0; r < 16; ++r) p0[r] = __builtin_amdgcn_exp2f(p0[r]);
}
__device__ __forceinline__ void finishSM(f32x16& p0, f32x16& p1, float alpha, float& l_reg, bf16x8& pa0, bf16x8& pa1, bf16x8& pa2, bf16x8& pa3) {
#pragma unroll
  for (int r = 0; r < 16; ++r) p1[r] = __builtin_amdgcn_exp2f(p1[r]);
  float ps = 0;
#pragma unroll
  for (int r = 0; r < 16; ++r) ps += p0[r];
#pragma unroll
  for (int r = 0; r < 16; ++r) ps += p1[r];
  { auto rr = __builtin_amdgcn_permlane32_swap(__float_as_uint(ps), __float_as_uint(ps), false, false);
    ps = __uint_as_float(rr[0]) + __uint_as_float(rr[1]); }
  l_reg = l_reg * alpha + ps;
#define PK4(P, BASE, OUT) do { unsigned a0 = cvtpk(P[BASE + 0], P[BASE + 1]), a1 = cvtpk(P[BASE + 2], P[BASE + 3]);   \
    unsigned b0 = cvtpk(P[BASE + 4], P[BASE + 5]), b1 = cvtpk(P[BASE + 6], P[BASE + 7]);                              \
    auto r0 = __builtin_amdgcn_permlane32_swap(a0, b0, false, false); auto r1 = __builtin_amdgcn_permlane32_swap(a1, b1, false, false); \
    v4u w = {r0[0], r1[0], r0[1], r1[1]}; OUT = __builtin_bit_cast(bf16x8, w); } while (0)
  PK4(p0, 0, pa0); PK4(p0, 8, pa1); PK4(p1, 0, pa2); PK4(p1, 8, pa3);
#undef PK4
}
template <int ND, int KS>
__device__ __forceinline__ void qkt(f32x16& p0, f32x16& p1, const char* Ks, const bf16x8* qr, const f32x16& negm, int r32, int hi) {
#pragma unroll
  for (int d0 = 0; d0 < ND; ++d0) { const int cb = (d0 * 16 + hi * 8) * 2;
    const bf16x8 b0 = *reinterpret_cast<const bf16x8*>(Ks + r32 * KS + cb);
    const bf16x8 b1 = *reinterpret_cast<const bf16x8*>(Ks + (32 + r32) * KS + cb);
    p0 = __builtin_amdgcn_mfma_f32_32x32x16_bf16(b0, qr[d0], d0 == 0 ? negm : p0, 0, 0, 0);
    p1 = __builtin_amdgcn_mfma_f32_32x32x16_bf16(b1, qr[d0], d0 == 0 ? negm : p1, 0, 0, 0); }
}
__device__ __forceinline__ int v_st(int k, int c) { const int kk = (k & ~0xC) | ((k & 4) << 1) | ((k & 8) >> 1); return ((kk >> 3) * 2 + (c >> 5)) * 512 + ((kk & 7) * 32 + (c & 31)) * 2; }
__device__ __forceinline__ int v_rd_base(int lane) { return ((lane & 3) << 3) | (((lane >> 2) & 3) << 6) | (((lane >> 4) & 1) << 5) | (((lane >> 5) & 1) << 8); }
constexpr int v_rd_off(int d0, int ks, int half) { return ((2 * ks + half) * 2 + d0) * 512; }
template <int OFF> __device__ __forceinline__ s16x4 tr_read(int vb) {
  s16x4 r; asm volatile("ds_read_b64_tr_b16 %0, %1 offset:%2" : "=&v"(r) : "v"(vb), "i"(OFF) : "memory"); return r;
}
template <int D0> __device__ __forceinline__ void pv_one(f32x16& od, int vb, bf16x8 pa0, bf16x8 pa1, bf16x8 pa2, bf16x8 pa3) {
  const s16x4 l0 = tr_read<v_rd_off(D0, 0, 0)>(vb), h0 = tr_read<v_rd_off(D0, 0, 1)>(vb), l1 = tr_read<v_rd_off(D0, 1, 0)>(vb), h1 = tr_read<v_rd_off(D0, 1, 1)>(vb);
  const s16x4 l2 = tr_read<v_rd_off(D0, 2, 0)>(vb), h2 = tr_read<v_rd_off(D0, 2, 1)>(vb), l3 = tr_read<v_rd_off(D0, 3, 0)>(vb), h3 = tr_read<v_rd_off(D0, 3, 1)>(vb);
  asm volatile("s_waitcnt lgkmcnt(0)" ::: "memory"); SBAR();
#define PK(L, H) (bf16x8){L[0], L[1], L[2], L[3], H[0], H[1], H[2], H[3]}
  od = __builtin_amdgcn_mfma_f32_32x32x16_bf16(pa0, PK(l0, h0), od, 0, 0, 0);
  od = __builtin_amdgcn_mfma_f32_32x32x16_bf16(pa1, PK(l1, h1), od, 0, 0, 0);
  od = __builtin_amdgcn_mfma_f32_32x32x16_bf16(pa2, PK(l2, h2), od, 0, 0, 0);
  od = __builtin_amdgcn_mfma_f32_32x32x16_bf16(pa3, PK(l3, h3), od, 0, 0, 0);
#undef PK
}
__device__ __forceinline__ void pv_d0(f32x16* o, int vb, bf16x8 pa0, bf16x8 pa1, bf16x8 pa2, bf16x8 pa3) {
  pv_one<0>(o[0], vb, pa0, pa1, pa2, pa3); pv_one<1>(o[1], vb, pa0, pa1, pa2, pa3);
}

template <int DK, int LDQ, int LDK1, int LDK2, int LDV>
__device__ __forceinline__ void attn_unit(const bf16* __restrict__ Qb, const bf16* __restrict__ K1, const bf16* __restrict__ K2, const bf16* __restrict__ Vb,
                                          bf16* __restrict__ Ob, const float* ropeq, const int nkeys, char* lds, const int tid_in) {
  constexpr int ND = DK / 16, KS = DK * 2 + 16, SHM_K = 64 * KS, SHM_V = 8192;
  int tid_ = tid_in; asm volatile("" : "+v"(tid_));
  const int tid = tid_, wid = tid >> 6, lane = tid & 63, r32 = lane & 31, hi = lane >> 5;
  char* V_lds = lds; char* K_lds = lds + 2 * SHM_V;
  float* ws = (float*)(lds + 2 * SHM_V + 2 * SHM_K) + wid * 64; float* li_l = ws; float* al_l = ws + 32;
  constexpr float THR = 8.f;
  float mhat = 0.f, l_reg = 0; f32x16 o[2] = {}; bf16x8 qr[ND]; f32x16 negm = {}; asm volatile("" : "+v"(negm));
  const bf16* Qw = Qb + (long)(wid * 32 + r32) * LDQ + hi * 8;
#pragma unroll
  for (int d0 = 0; d0 < ND; ++d0) qr[d0] = *reinterpret_cast<const bf16x8*>(Qw + d0 * 16);
  if (DK == 96 && ropeq != nullptr) {
    const float* cr = ropeq + (size_t)(wid * 32 + r32) * 16 + 4 * hi;
#pragma unroll
    for (int d0 = 4; d0 < ND; ++d0) { const f32x4 c = *(const f32x4*)(cr + (d0 - 4) * 8), s = *(const f32x4*)(cr + 8192 * 16 + (d0 - 4) * 8);
      const v4u w = __builtin_bit_cast(v4u, qr[d0]); v4u o;
      { const float a = bflo(w.x), b = bfhi(w.x); o.x = cvtpk(a * c.x - b * s.x, b * c.x + a * s.x); }
      { const float a = bflo(w.y), b = bfhi(w.y); o.y = cvtpk(a * c.y - b * s.y, b * c.y + a * s.y); }
      { const float a = bflo(w.z), b = bfhi(w.z); o.z = cvtpk(a * c.z - b * s.z, b * c.z + a * s.z); }
      { const float a = bflo(w.w), b = bfhi(w.w); o.w = cvtpk(a * c.w - b * s.w, b * c.w + a * s.w); }
      qr[d0] = __builtin_bit_cast(bf16x8, o); }
  }
  const int sr = tid >> 3, sc = (tid & 7) * 8, vst = v_st(sr, sc), kst = sr * KS + sc * 2;
  const int sr2 = tid >> 2, sc2 = (tid & 3) * 8, kst2 = sr2 * KS + 128 + sc2 * 2;
  const bool has2 = (DK == 96) && (tid < 256);
  const int vb0 = (int)(uintptr_t)V_lds + v_rd_base(lane);
  struct { bf16x8 v, k1, k2; } sr_[2];
#define SLOAD(i, k0) do { sr_[i].v = *reinterpret_cast<const bf16x8*>(&Vb[(long)((k0) + sr) * LDV + sc]); sr_[i].k1 = *reinterpret_cast<const bf16x8*>(&K1[(long)((k0) + sr) * LDK1 + sc]); \
    if (has2) sr_[i].k2 = *reinterpret_cast<const bf16x8*>(&K2[(long)((k0) + sr2) * LDK2 + sc2]); } while (0)
#define SWRITE(b, i) do { *(bf16x8*)(V_lds + (b) * SHM_V + vst) = sr_[i].v; *(bf16x8*)(K_lds + (b) * SHM_K + kst) = sr_[i].k1; \
    if (has2) *(bf16x8*)(K_lds + (b) * SHM_K + kst2) = sr_[i].k2; } while (0)
#define RESC(a) do { if (__any((a) < 1.f)) { if (hi == 0) al_l[r32] = (a); asm volatile("s_waitcnt lgkmcnt(0)" ::: "memory"); \
    _Pragma("unroll") for (int d = 0; d < 2; ++d) _Pragma("unroll") for (int r = 0; r < 16; ++r) o[d][r] *= al_l[crow(r, hi)]; } } while (0)
  f32x16 pA0, pA1, pB0, pB1; float alA, alB; bf16x8 pa0, pa1, pa2, pa3; const int NT = nkeys / 64;
  constexpr int SE = 0, SO = 1;
  SLOAD(SE, 0); asm volatile("s_waitcnt vmcnt(0)" ::: "memory"); SWRITE(0, SE); __syncthreads();
  qkt<ND, KS>(pA0, pA1, K_lds, qr, negm, r32, hi); partialSM(pA0, pA1, mhat, negm, alA, true, THR);
  SLOAD(SO, 64); if (2 < NT) SLOAD(SE, 128);
  SWRITE(1, SO); __syncthreads();
  for (int j = 1; j + 1 < NT; j += 2) {
    SBAR(); qkt<ND, KS>(pB0, pB1, K_lds + SHM_K, qr, negm, r32, hi);
    finishSM(pA0, pA1, alA, l_reg, pa0, pa1, pa2, pa3); SBAR();
    SLOAD(SO, (j + 2) * 64); SBAR();
    pv_d0(o, vb0, pa0, pa1, pa2, pa3); partialSM(pB0, pB1, mhat, negm, alB, false, THR);
    __syncthreads(); SWRITE(0, SE);
    RESC(alB); __syncthreads();
    SBAR(); qkt<ND, KS>(pA0, pA1, K_lds, qr, negm, r32, hi);
    finishSM(pB0, pB1, alB, l_reg, pa0, pa1, pa2, pa3); SBAR();
    if (j + 3 < NT) SLOAD(SE, (j + 3) * 64); SBAR();
    pv_d0(o, vb0 + SHM_V, pa0, pa1, pa2, pa3); partialSM(pA0, pA1, mhat, negm, alA, false, THR);
    __syncthreads(); SWRITE(1, SO);
    RESC(alA); __syncthreads();
  }
  SBAR(); qkt<ND, KS>(pB0, pB1, K_lds + SHM_K, qr, negm, r32, hi);
  finishSM(pA0, pA1, alA, l_reg, pa0, pa1, pa2, pa3); SBAR();
  pv_d0(o, vb0, pa0, pa1, pa2, pa3); partialSM(pB0, pB1, mhat, negm, alB, false, THR);
  __syncthreads(); RESC(alB);
  finishSM(pB0, pB1, alB, l_reg, pa0, pa1, pa2, pa3); SBAR();
  pv_d0(o, vb0 + SHM_V, pa0, pa1, pa2, pa3);
  if (hi == 0) li_l[r32] = l_reg; asm volatile("s_waitcnt lgkmcnt(0)" ::: "memory");
  float rli[16];
#pragma unroll
  for (int r = 0; r < 16; ++r) rli[r] = __builtin_amdgcn_rcpf(li_l[crow(r, hi)]);
  bf16* Ow = Ob + (long)(wid * 32) * OW;
#pragma unroll
  for (int r = 0; r < 16; ++r) { const int orow = crow(r, hi);
#pragma unroll
    for (int d0 = 0; d0 < 2; ++d0) Ow[(long)orow * OW + d0 * 32 + r32] = (bf16)f2bf(o[d0][r] * rli[r]); }
  __syncthreads();
#undef SLOAD
#undef SWRITE
#undef RESC
}
#undef SBAR
}

namespace att2 {
using u32x4 = v4u;
typedef __attribute__((address_space(3))) const char* lds_cptr;
typedef short v4i16_t __attribute__((ext_vector_type(4)));
typedef float f32x2_t __attribute__((ext_vector_type(2))); typedef __bf16 bf16x2_t __attribute__((ext_vector_type(2)));
#define SBAR() __builtin_amdgcn_sched_barrier(0)
__device__ __forceinline__ int crow(int r, int hi) { return (r & 3) + 8 * (r >> 2) + 4 * hi; }
__device__ __forceinline__ void glds16(const void* gbase, unsigned voff, unsigned lds_dst) { unsigned keep;
  asm volatile("s_mov_b32 %0, m0\n\ts_mov_b32 m0, %3\n\ts_nop 0\n\tglobal_load_lds_dwordx4 %1, %2\n\ts_mov_b32 m0, %0" : "=&s"(keep) : "v"(voff), "s"(gbase), "s"(lds_dst) : "memory"); }
__device__ __forceinline__ float max3f(float a, float b, float c) { float r; asm("v_max3_f32 %0, %1, %2, %3" : "=v"(r) : "v"(a), "v"(b), "v"(c)); return r; }
__device__ __forceinline__ float max2f(float a, float b) { float r; asm("v_max_f32_e32 %0, %1, %2" : "=v"(r) : "v"(a), "v"(b)); return r; }
__device__ __forceinline__ float fadd_s(float a, float b) { float r; asm("v_add_f32_e32 %0, %1, %2" : "=v"(r) : "v"(a), "v"(b)); return r; }
__device__ __forceinline__ float fsub_s(float a, float b) { float r; asm("v_sub_f32_e32 %0, %1, %2" : "=v"(r) : "v"(a), "v"(b)); return r; }
__device__ __forceinline__ unsigned cvtpk_s(float lo, float hi) { f32x2_t v = {lo, hi}; bf16x2_t b = __builtin_convertvector(v, bf16x2_t); return __builtin_bit_cast(unsigned, b); }
template <int N> __device__ __forceinline__ void wait_bar() { asm volatile("s_waitcnt vmcnt(%0) lgkmcnt(0)\n\ts_barrier" :: "n"(N) : "memory"); }
template <int ND> __device__ __forceinline__ void qkt(f32x16& p0, f32x16& p1, const char* Kslot, const bf16x8* qr, const f32x16& negm, int r32, int hi) {
  const char* kb = Kslot + hi * 1024 + r32 * 16;
#pragma unroll
  for (int d0 = 0; d0 < ND; ++d0) {
    const bf16x8 b0 = *reinterpret_cast<const bf16x8*>(kb + d0 * 2048);
    const bf16x8 b1 = *reinterpret_cast<const bf16x8*>(kb + d0 * 2048 + 512);
    if (d0 == 0) { p0 = __builtin_amdgcn_mfma_f32_32x32x16_bf16(b0, qr[0], negm, 0, 0, 0); p1 = __builtin_amdgcn_mfma_f32_32x32x16_bf16(b1, qr[0], negm, 0, 0, 0); }
    else { p0 = __builtin_amdgcn_mfma_f32_32x32x16_bf16(b0, qr[d0], p0, 0, 0, 0); p1 = __builtin_amdgcn_mfma_f32_32x32x16_bf16(b1, qr[d0], p1, 0, 0, 0); } }
}
__device__ __forceinline__ void kload2(bf16x8* kf, lds_cptr kp, int j) { kf[2 * j] = *(const LAS bf16x8*)(kp + j * 2048); kf[2 * j + 1] = *(const LAS bf16x8*)(kp + j * 2048 + 512); }
__device__ __forceinline__ s16x4 vtr(lds_cptr p) { return __builtin_bit_cast(s16x4, __builtin_amdgcn_ds_read_tr16_b64_v4i16((LAS v4i16_t*)p)); }
__device__ __forceinline__ float rowmax(const f32x16& p0, const f32x16& p1) {
  float a = max3f(p0[0], p0[1], p1[0]), b = max3f(p0[2], p0[3], p1[1]); a = max3f(a, p1[2], p1[3]);
#pragma unroll
  for (int r = 4; r < 16; r += 4) { a = max3f(a, p0[r], p0[r + 1]); b = max3f(b, p0[r + 2], p0[r + 3]); a = max3f(a, p1[r], p1[r + 1]); b = max3f(b, p1[r + 2], p1[r + 3]); }
  const float m = max2f(a, b);
  auto rr = __builtin_amdgcn_permlane32_swap(__float_as_uint(m), __float_as_uint(m), false, false);
  return max2f(__uint_as_float(rr[0]), __uint_as_float(rr[1]));
}
__device__ __forceinline__ void pv(f32x16* o, int vb, bf16x8 pa0, bf16x8 pa1, bf16x8 pa2, bf16x8 pa3) {
#pragma unroll
  for (int d0 = 0; d0 < 2; ++d0) { s16x4 lo[4], hi[4];
#pragma unroll
    for (int ks = 0; ks < 4; ++ks) {
      asm volatile("ds_read_b64_tr_b16 %0,%1 offset:%c2" : "=&v"(lo[ks]) : "v"(vb), "i"(d0 * 4096 + ks * 1024) : "memory");
      asm volatile("ds_read_b64_tr_b16 %0,%1 offset:%c2" : "=&v"(hi[ks]) : "v"(vb), "i"(d0 * 4096 + ks * 1024 + 512) : "memory"); }
    asm volatile("s_waitcnt lgkmcnt(0)" ::: "memory"); SBAR();
#define PK(k) (bf16x8){lo[k][0], lo[k][1], lo[k][2], lo[k][3], hi[k][0], hi[k][1], hi[k][2], hi[k][3]}
    o[d0] = __builtin_amdgcn_mfma_f32_32x32x16_bf16(pa0, PK(0), o[d0], 0, 0, 0);
    o[d0] = __builtin_amdgcn_mfma_f32_32x32x16_bf16(pa1, PK(1), o[d0], 0, 0, 0);
    o[d0] = __builtin_amdgcn_mfma_f32_32x32x16_bf16(pa2, PK(2), o[d0], 0, 0, 0);
    o[d0] = __builtin_amdgcn_mfma_f32_32x32x16_bf16(pa3, PK(3), o[d0], 0, 0, 0);
#undef PK
  }
}

template <int DK> struct Lay { static constexpr int ND = DK / 16, NC = DK / 8, SLOTK = NC * 1024, SLOTV = 8192, LDS_K = 0, LDS_V = 3 * SLOTK, LDS_WS = LDS_V + 3 * SLOTV, LDS_OST = LDS_WS + 8 * 256, LDS_BYTES = LDS_OST + 8 * 4096, KD = (DK == 96) ? 2 : 1; };

template <int DK, int LDQ, int LDK1, int LDK2, int LDV, int THRL>
__device__ __forceinline__ void attn_unit(const bf16* Qb, const bf16* __restrict__ K1, const bf16* __restrict__ K2, const bf16* __restrict__ Vh, bf16* Ob, const float* ropeq, const int NT, char* shm, const int tid_in) {
  using L = Lay<DK>; constexpr int ND = L::ND, SLOTK = L::SLOTK, SLOTV = L::SLOTV, LDS_K = L::LDS_K, LDS_V = L::LDS_V, LDS_WS = L::LDS_WS, LDS_OST = L::LDS_OST, KD = L::KD;
  int tid_ = tid_in; asm volatile("" : "+v"(tid_));
  const int tid = tid_, lane = tid & 63, r32 = lane & 31, hi = lane >> 5; const int wid = __builtin_amdgcn_readfirstlane(tid >> 6);
  const bf16* Qw = Qb + (long)(wid * 32) * LDQ;
  const unsigned lds0 = (unsigned)(uintptr_t)shm;
  float* wsf = (float*)(shm + LDS_WS) + wid * 64;
  const unsigned koff = (unsigned)(lane * LDK1 + wid * 8) * 2u;
  const unsigned koff2 = (unsigned)(lane * LDK2 + (wid & 3) * 8) * 2u;
  const unsigned voffv = (unsigned)((16 * (wid & 3) + (lane >> 2)) * LDV + (wid >> 2) * 32 + (lane & 3) * 8) * 2u;
  const unsigned kdst = lds0 + LDS_K + wid * 1024, kdst2 = lds0 + LDS_K + (8 + (wid & 3)) * 1024, vdst = lds0 + LDS_V + wid * 1024;
#define DMA_K(t, s) do { glds16(K1 + (long)(t) * 64 * LDK1, koff, (unsigned)__builtin_amdgcn_readfirstlane(kdst + (s) * SLOTK)); \
    if (DK == 96) glds16(K2 + (long)(t) * 64 * LDK2, koff2, (unsigned)__builtin_amdgcn_readfirstlane(kdst2 + (s) * SLOTK)); } while (0)
#define DMA_V(t, s) glds16(Vh + (long)(t) * 64 * LDV, voffv, (unsigned)__builtin_amdgcn_readfirstlane(vdst + (s) * SLOTV))
  const int vb0 = (int)(lds0 + LDS_V) + ((lane >> 4) & 1) * 32 + (lane & 3) * 8 + (4 * hi + ((lane & 15) >> 2)) * 64;
  const char* Kbase = shm + LDS_K; bf16x8 kf[12];
  const lds_cptr shm3 = (lds_cptr)shm; const lds_cptr kp0 = shm3 + LDS_K + hi * 1024 + r32 * 16; const lds_cptr vp0 = shm3 + LDS_V + ((lane >> 4) & 1) * 32 + (lane & 3) * 8 + (4 * hi + ((lane & 15) >> 2)) * 64;
  DMA_K(0, 0); DMA_V(0, 0); DMA_K(1, 1);
  bf16x8 qr[6];
#pragma unroll
  for (int d0 = 0; d0 < ND; ++d0) qr[d0] = *reinterpret_cast<const bf16x8*>(&Qw[(long)r32 * LDQ + d0 * 16 + hi * 8]);
  if (DK == 96 && ropeq != nullptr) {
    const float* cr = ropeq + (size_t)(wid * 32 + r32) * 16 + 4 * hi;
#pragma unroll
    for (int d0 = 4; d0 < ND; ++d0) { const f32x4 c = *(const f32x4*)(cr + (d0 - 4) * 8), s = *(const f32x4*)(cr + 8192 * 16 + (d0 - 4) * 8);
      const v4u w = __builtin_bit_cast(v4u, qr[d0]); v4u o;
      { const float a = bflo(w.x), b = bfhi(w.x); o.x = cvtpk_s(a * c.x - b * s.x, b * c.x + a * s.x); }
      { const float a = bflo(w.y), b = bfhi(w.y); o.y = cvtpk_s(a * c.y - b * s.y, b * c.y + a * s.y); }
      { const float a = bflo(w.z), b = bfhi(w.z); o.z = cvtpk_s(a * c.z - b * s.z, b * c.z + a * s.z); }
      { const float a = bflo(w.w), b = bfhi(w.w); o.w = cvtpk_s(a * c.w - b * s.w, b * c.w + a * s.w); }
      qr[d0] = __builtin_bit_cast(bf16x8, o); }
  }
  float mhat = 0.f, l_reg = 0.f; f32x16 o[2]; o[0] = f32x16{}; o[1] = f32x16{}; f32x16 negm = f32x16{}; asm volatile("" : "+v"(negm));
  bool resc = false;
#define START(P0, P1) do { const float rm = rowmax(P0, P1); resc = false; \
    { const float dl = rm; mhat = fadd_s(mhat, dl); \
      _Pragma("unroll") for (int r = 0; r < 16; ++r) { P0[r] = fsub_s(P0[r], dl); P1[r] = fsub_s(P1[r], dl); } \
      _Pragma("unroll") for (int r = 0; r < 16; ++r) negm[r] = -mhat; asm volatile("" : "+v"(negm)); } \
    _Pragma("unroll") for (int r = 0; r < 16; ++r) P0[r] = __builtin_amdgcn_exp2f(P0[r]); } while (0)
#define RESC() do { if (resc) { asm volatile("s_waitcnt lgkmcnt(0)" ::: "memory"); \
      _Pragma("unroll") for (int d_ = 0; d_ < 2; ++d_) _Pragma("unroll") for (int r = 0; r < 16; ++r) o[d_][r] *= wsf[crow(r, hi)]; } } while (0)
  f32x16 pA0, pA1, pB0, pB1;
  int sp = 0, sc = 0, sn = 1;
#define ROT() do { sp = sc; sc = sn; sn = (sn == 2) ? 0 : sn + 1; } while (0)
  DMA_K(2, 2);
  wait_bar<1 + 2 * KD>();
  qkt<ND>(pA0, pA1, Kbase, qr, negm, r32, hi); asm volatile("s_nop 15\n\ts_nop 7" : "+v"(pA0), "+v"(pA1));
  START(pA0, pA1);
  _Pragma("unroll") for (int r = 0; r < 16; ++r) pA1[r] = __builtin_amdgcn_exp2f(pA1[r]);
  wait_bar<0>();
  DMA_K(3, 0); DMA_V(1, 1);
  ROT();
#pragma unroll
  for (int j = 0; j < ND; ++j) kload2(kf, kp0 + sc * SLOTK, j);
  wait_bar<KD + 1>();
  s16x4 vlo[8], vhi[8]; u32x4 pw0, pw1, pw2, pw3;
#define PKW(P, B) cvtpk_s(P[B], P[B + 1])
#define PAF(k) __builtin_bit_cast(bf16x8, pw##k)
#define VFR(i) (bf16x8){vlo[i][0], vlo[i][1], vlo[i][2], vlo[i][3], vhi[i][0], vhi[i][1], vhi[i][2], vhi[i][3]}
#define PIN(x) asm volatile("" : "+v"(x))
#define MX3(a, b, c) __builtin_fmaxf(__builtin_fmaxf((a), (b)), (c))
#define EX(v) __builtin_amdgcn_exp2f(v)
#define GAPB(MF, X, B) do { MF; X[B] = EX(X[B]); X[B + 1] = EX(X[B + 1]); X[B + 2] = EX(X[B + 2]); X[B + 3] = EX(X[B + 3]); PIN(X); SBAR(); } while (0)
#define VRD(i) do { vlo[i] = vtr(vp_ + (((i) >> 2) * 4096 + ((i) & 3) * 1024)); vhi[i] = vtr(vp_ + (((i) >> 2) * 4096 + ((i) & 3) * 1024 + 512)); } while (0)
#define KRD(G, j) do { if (G) { kload2(kf, kp0 + sn * SLOTK, j); SBAR(); } } while (0)
#define MFQ(C, i, d, INIT) C = __builtin_amdgcn_mfma_f32_32x32x16_bf16(kf[i], qr[d], INIT, 0, 0, 0)
#define PHASE_A64(C0, C1, P0, P1) do { \
    VRD(0); SBAR(); float sacc = (P0[0] + P0[1]); \
    MFQ(C0, 0, 0, negm); sacc += P0[2]; sacc += P0[3]; sacc += P0[4]; sacc += P0[5]; PIN(sacc); pw0[0] = PKW(P0, 0); pw0[1] = PKW(P0, 2); PIN(pw0); SBAR(); \
    VRD(4); SBAR(); MFQ(C1, 1, 0, negm); sacc += P0[6]; sacc += P0[7]; sacc += P0[8]; sacc += P0[9]; PIN(sacc); pw0[2] = PKW(P0, 4); pw0[3] = PKW(P0, 6); PIN(pw0); SBAR(); \
    VRD(1); SBAR(); MFQ(C0, 2, 1, C0); sacc += P0[10]; sacc += P0[11]; sacc += P0[12]; sacc += P0[13]; PIN(sacc); pw1[0] = PKW(P0, 8); pw1[1] = PKW(P0, 10); PIN(pw1); SBAR(); \
    VRD(5); SBAR(); MFQ(C1, 3, 1, C1); sacc += P0[14]; sacc += P0[15]; sacc += P1[0]; sacc += P1[1]; PIN(sacc); pw1[2] = PKW(P0, 12); pw1[3] = PKW(P0, 14); PIN(pw1); SBAR(); \
    VRD(2); SBAR(); MFQ(C0, 4, 2, C0); sacc += P1[2]; sacc += P1[3]; sacc += P1[4]; sacc += P1[5]; PIN(sacc); pw2[0] = PKW(P1, 0); pw2[1] = PKW(P1, 2); PIN(pw2); SBAR(); \
    VRD(6); SBAR(); MFQ(C1, 5, 2, C1); sacc += P1[6]; sacc += P1[7]; sacc += P1[8]; sacc += P1[9]; PIN(sacc); pw2[2] = PKW(P1, 4); pw2[3] = PKW(P1, 6); PIN(pw2); SBAR(); \
    VRD(3); SBAR(); MFQ(C0, 6, 3, C0); sacc += P1[10]; sacc += P1[11]; sacc += P1[12]; sacc += P1[13]; PIN(sacc); pw3[0] = PKW(P1, 8); pw3[1] = PKW(P1, 10); PIN(pw3); SBAR(); \
    VRD(7); SBAR(); MFQ(C1, 7, 3, C1); sacc += P1[14]; sacc += P1[15]; PIN(sacc); pw3[2] = PKW(P1, 12); pw3[3] = PKW(P1, 14); PIN(pw3); SBAR(); \
    l_reg += sacc; } while (0)
#define PHASE_A96(C0, C1, P0, P1) do { \
    VRD(0); SBAR(); float sacc = (P0[0] + P0[1]); \
    MFQ(C0, 0, 0, negm); sacc += P0[2]; sacc += P0[3]; sacc += P0[4]; PIN(sacc); pw0[0] = PKW(P0, 0); PIN(pw0); SBAR(); \
    VRD(4); SBAR(); MFQ(C1, 1, 0, negm); sacc += P0[5]; sacc += P0[6]; sacc += P0[7]; PIN(sacc); pw0[1] = PKW(P0, 2); PIN(pw0); SBAR(); \
    VRD(1); SBAR(); MFQ(C0, 2, 1, C0); sacc += P0[8]; sacc += P0[9]; sacc += P0[10]; PIN(sacc); pw0[2] = PKW(P0, 4); PIN(pw0); SBAR(); \
    VRD(5); SBAR(); MFQ(C1, 3, 1, C1); sacc += P0[11]; sacc += P0[12]; sacc += P0[13]; PIN(sacc); pw0[3] = PKW(P0, 6); PIN(pw0); SBAR(); \
    VRD(2); SBAR(); MFQ(C0, 4, 2, C0); sacc += P0[14]; sacc += P0[15]; PIN(sacc); pw1[0] = PKW(P0, 8); PIN(pw1); SBAR(); \
    VRD(6); SBAR(); MFQ(C1, 5, 2, C1); sacc += P1[0]; sacc += P1[1]; PIN(sacc); pw1[1] = PKW(P0, 10); PIN(pw1); SBAR(); \
    VRD(3); SBAR(); MFQ(C0, 6, 3, C0); sacc += P1[2]; sacc += P1[3]; PIN(sacc); pw1[2] = PKW(P0, 12); PIN(pw1); SBAR(); \
    VRD(7); SBAR(); MFQ(C1, 7, 3, C1); sacc += P1[4]; sacc += P1[5]; PIN(sacc); pw1[3] = PKW(P0, 14); PIN(pw1); SBAR(); \
    MFQ(C0, 8, 4, C0); sacc += P1[6]; sacc += P1[7]; sacc += P1[8]; PIN(sacc); pw2[0] = PKW(P1, 0); pw2[1] = PKW(P1, 2); PIN(pw2); SBAR(); \
    MFQ(C1, 9, 4, C1); sacc += P1[9]; sacc += P1[10]; sacc += P1[11]; PIN(sacc); pw2[2] = PKW(P1, 4); pw2[3] = PKW(P1, 6); PIN(pw2); SBAR(); \
    MFQ(C0, 10, 5, C0); sacc += P1[12]; sacc += P1[13]; PIN(sacc); pw3[0] = PKW(P1, 8); pw3[1] = PKW(P1, 10); PIN(pw3); SBAR(); \
    MFQ(C1, 11, 5, C1); sacc += P1[14]; sacc += P1[15]; PIN(sacc); pw3[2] = PKW(P1, 12); pw3[3] = PKW(P1, 14); PIN(pw3); SBAR(); \
    l_reg += sacc; } while (0)
#define STEP(C0, C1, P0, P1, t, GK, GV, GL) do { SBAR(); \
    const lds_cptr vp_ = vp0 + sp * SLOTV; \
    if (DK == 96) PHASE_A96(C0, C1, P0, P1); else PHASE_A64(C0, C1, P0, P1); \
    if (GK) { DMA_K((t) + 3, sc); } if (GV) { DMA_V((t) + 1, sn); } \
    { float a = MX3(C0[0], C0[1], C1[0]), b = MX3(C0[2], C0[3], C1[1]); a = MX3(a, C1[2], C1[3]); \
      _Pragma("unroll") for (int r = 4; r < 16; r += 4) { a = MX3(a, C0[r], C0[r + 1]); b = MX3(b, C0[r + 2], C0[r + 3]); a = MX3(a, C1[r], C1[r + 1]); b = MX3(b, C1[r + 2], C1[r + 3]); } \
      float rm = __builtin_fmaxf(a, b); { auto rr = __builtin_amdgcn_permlane32_swap(__float_as_uint(rm), __float_as_uint(rm), false, false); rm = __builtin_fmaxf(__uint_as_float(rr[0]), __uint_as_float(rr[1])); } \
      resc = false; \
      if (__builtin_expect(__any(rm > (float)THRL), 0)) { const float dl = __builtin_fmaxf(rm, 0.f); mhat += dl; \
        _Pragma("unroll") for (int r = 0; r < 16; ++r) { C0[r] -= dl; C1[r] -= dl; } \
        _Pragma("unroll") for (int r = 0; r < 16; ++r) negm[r] = -mhat; asm volatile("" : "+v"(negm)); \
        const float f = __builtin_amdgcn_exp2f(-dl); l_reg *= f; if (hi == 0) wsf[r32] = f; resc = true; } } \
    SBAR(); \
    GAPB(o[0] = __builtin_amdgcn_mfma_f32_32x32x16_bf16(PAF(0), VFR(0), o[0], 0, 0, 0), C0, 0); \
    KRD(GL && ND == 6, 0); GAPB(o[1] = __builtin_amdgcn_mfma_f32_32x32x16_bf16(PAF(0), VFR(4), o[1], 0, 0, 0), C0, 4); \
    KRD(GL, ND == 6 ? 1 : 0); GAPB(o[0] = __builtin_amdgcn_mfma_f32_32x32x16_bf16(PAF(1), VFR(1), o[0], 0, 0, 0), C0, 8); \
    KRD(GL, ND == 6 ? 2 : 1); GAPB(o[1] = __builtin_amdgcn_mfma_f32_32x32x16_bf16(PAF(1), VFR(5), o[1], 0, 0, 0), C0, 12); \
    KRD(GL, ND == 6 ? 3 : 2); GAPB(o[0] = __builtin_amdgcn_mfma_f32_32x32x16_bf16(PAF(2), VFR(2), o[0], 0, 0, 0), C1, 0); \
    KRD(GL, ND == 6 ? 4 : 3); GAPB(o[1] = __builtin_amdgcn_mfma_f32_32x32x16_bf16(PAF(2), VFR(6), o[1], 0, 0, 0), C1, 4); \
    KRD(GL && ND == 6, 5); GAPB(o[0] = __builtin_amdgcn_mfma_f32_32x32x16_bf16(PAF(3), VFR(3), o[0], 0, 0, 0), C1, 8); \
    GAPB(o[1] = __builtin_amdgcn_mfma_f32_32x32x16_bf16(PAF(3), VFR(7), o[1], 0, 0, 0), C1, 12); \
  } while (0)
  int t = 1;
  for (; t + 5 < NT; t += 2) {
    STEP(pB0, pB1, pA0, pA1, t, true, true, true);     wait_bar<KD + 1>(); RESC(); ROT();
    STEP(pA0, pA1, pB0, pB1, t + 1, true, true, true); wait_bar<KD + 1>(); RESC(); ROT();
  }
#define ENDW(tt) do { if ((tt) + 3 < NT) { wait_bar<KD + 1>(); } else if ((tt) + 2 < NT) { wait_bar<1>(); } else { wait_bar<0>(); } } while (0)
  for (; t + 1 < NT; t += 2) {
    STEP(pB0, pB1, pA0, pA1, t, (t + 3 < NT), (t + 1 < NT), (t + 1 < NT));         ENDW(t);     RESC(); ROT();
    STEP(pA0, pA1, pB0, pB1, t + 1, (t + 4 < NT), (t + 2 < NT), (t + 2 < NT));     ENDW(t + 1); RESC(); ROT();
  }
  STEP(pB0, pB1, pA0, pA1, NT - 1, false, false, false); RESC();
  { float sacc = pB0[0] + pB0[1];
    _Pragma("unroll") for (int r = 2; r < 16; ++r) sacc += pB0[r];
    _Pragma("unroll") for (int r = 0; r < 16; ++r) sacc += pB1[r];
    l_reg += sacc;
    pw0 = (u32x4){PKW(pB0, 0), PKW(pB0, 2), PKW(pB0, 4), PKW(pB0, 6)}; pw1 = (u32x4){PKW(pB0, 8), PKW(pB0, 10), PKW(pB0, 12), PKW(pB0, 14)};
    pw2 = (u32x4){PKW(pB1, 0), PKW(pB1, 2), PKW(pB1, 4), PKW(pB1, 6)}; pw3 = (u32x4){PKW(pB1, 8), PKW(pB1, 10), PKW(pB1, 12), PKW(pB1, 14)};
    SBAR(); pv(o, vb0 + sc * SLOTV, PAF(0), PAF(1), PAF(2), PAF(3)); }
  { auto rr = __builtin_amdgcn_permlane32_swap(__float_as_uint(l_reg), __float_as_uint(l_reg), false, false); l_reg = __uint_as_float(rr[0]) + __uint_as_float(rr[1]); }
  if (hi == 0) wsf[32 + r32] = l_reg; asm volatile("s_waitcnt lgkmcnt(0)" ::: "memory");
  float rli[16];
#pragma unroll
  for (int r = 0; r < 16; ++r) rli[r] = __builtin_amdgcn_rcpf(wsf[32 + crow(r, hi)]);
  bf16* Ow = Ob + (long)(wid * 32) * OW;
  { bf16* stg = (bf16*)(shm + LDS_OST) + wid * 2048;
#pragma unroll
    for (int r = 0; r < 16; ++r) { const int orow = crow(r, hi);
#pragma unroll
      for (int d0 = 0; d0 < 2; ++d0) stg[orow * 64 + d0 * 32 + r32] = (bf16)f2bf(o[d0][r] * rli[r]); }
    asm volatile("s_waitcnt lgkmcnt(0)" ::: "memory");
#pragma unroll
    for (int i = 0; i < 4; ++i) { const int row = i * 8 + (lane >> 3), ch = lane & 7; const u32x4 v = *(const u32x4*)(stg + row * 64 + ch * 8); *(u32x4*)(Ow + (long)row * OW + ch * 8) = v; } }
  asm volatile("s_waitcnt lgkmcnt(0)\n\ts_barrier" ::: "memory");
#undef DMA_K
#undef DMA_V
#undef START
#undef RESC
#undef ROT
#undef PKW
#undef PAF
#undef VFR
#undef PIN
#undef MX3
#undef EX
#undef GAPB
#undef VRD
#undef KRD
#undef MFQ
#undef PHASE_A64
#undef PHASE_A96
#undef STEP
#undef ENDW
}
#undef SBAR
}

constexpr size_t MiB = 1u << 20;
constexpr size_t WS_CTL = 0, CTL_ZERO_BYTES = 1 * MiB;
constexpr size_t WS_MOD = 1 * MiB;
constexpr size_t WS_ROPE = 2 * MiB;
constexpr size_t WS_AFF = 5 * MiB;
constexpr size_t WS_INV = 8 * MiB;
constexpr size_t WS_ROWIDX = 10 * MiB;
constexpr size_t WS_WIN = 12 * MiB, WS_WUQ = 18 * MiB, WS_WUKV = 19 * MiB, WS_WOUT = 20 * MiB;
constexpr size_t WS_XRES = 24 * MiB;
constexpr size_t WS_H1 = 90 * MiB;
constexpr size_t WS_Z = 123 * MiB;
constexpr size_t WS_QM = 173 * MiB, WS_KVM = 198 * MiB, WS_O = 231 * MiB;
constexpr size_t WS_XG = 256 * MiB;
constexpr size_t WS_HID = 328 * MiB;
constexpr size_t WS_W13 = 520 * MiB, WS_W2 = 856 * MiB, WS_END = 1024 * MiB;
constexpr int CW_BAR = 4096;
constexpr int NPHASE = 28;
constexpr int LDS_BYTES = 147456, MISC_OFF = LDS_BYTES - 256;
constexpr int NWAVES = 8;

#define XB_TMO      128
#define XB_XCNT(j)  (256  + 64 * (j))
#define XB_XSUB(j)  (1280 + 64 * (j))
#define XB_XGEN(j)  (2304 + 64 * (j))
#define XB_TOP      3328
#define XB_TOPGEN   3392
#define XB_LSUB(j)  (3456 + 64 * (j))
#define XB_LGEN(j)  (4480 + 64 * (j))
#define XCD_BAR_WORDS 5504
#define XB_SPIN_CAP (1u << 18)

__device__ __forceinline__ unsigned xb_ld(unsigned* p)              { return __hip_atomic_load(p, __ATOMIC_RELAXED, __HIP_MEMORY_SCOPE_AGENT); }
__device__ __forceinline__ unsigned xb_add(unsigned* p, unsigned v) { return __hip_atomic_fetch_add(p, v, __ATOMIC_RELAXED, __HIP_MEMORY_SCOPE_AGENT); }
__device__ __forceinline__ unsigned xb_xcc_id() { return (unsigned)__builtin_amdgcn_s_getreg((3 << 11) | 20) & 0xFu; }
#define XB_SPIN(cond, bar) do { unsigned _sp = 0; while (cond) { __builtin_amdgcn_s_sleep(1); \
    if ((++_sp & 255u) == 0u) { if (xb_ld(&(bar)[XB_TMO])) break; if (_sp > XB_SPIN_CAP) { atomicAdd(&(bar)[XB_TMO], 1u); break; } } } } while (0)

struct XcdBarrier {
    unsigned* bar; unsigned x;
    volatile LAS unsigned* st;
};

__device__ __forceinline__ XcdBarrier xcd_barrier_post(unsigned* bar, volatile LAS unsigned* st) {
    XcdBarrier b; b.bar = bar; b.x = xb_xcc_id(); b.st = st;
    if (threadIdx.x == 0) st[2] = xb_add(&bar[XB_XCNT(b.x)], 1u);
    return b;
}
__device__ __forceinline__ void xcd_barrier_complete(unsigned* bar, unsigned x, unsigned& nloc, unsigned& nx) {
    const unsigned G = gridDim.x * gridDim.y * gridDim.z;
    unsigned sum, cnt, mine, sp = 0u;
    for (;;) {
        sum = 0u; cnt = 0u; mine = 0u;
#pragma unroll
        for (unsigned j = 0; j < 16; ++j) { const unsigned c = xb_ld(&bar[XB_XCNT(j)]); sum += c; cnt += (c > 0u) ? 1u : 0u; mine = (j == x) ? c : mine; }
        if (sum == G) break;
        __builtin_amdgcn_s_sleep(1);
        if ((++sp & 255u) == 0u) { if (xb_ld(&bar[XB_TMO])) break; if (sp > XB_SPIN_CAP) { atomicAdd(&bar[XB_TMO], 1u); break; } }
    }
    nloc = mine > 0u ? mine : 1u; nx = cnt > 0u ? cnt : 1u;
}

__device__ __forceinline__ void xcd_barrier(const XcdBarrier& b) {
    asm volatile("s_waitcnt vmcnt(0)" ::: "memory");
    __syncthreads();
    if (threadIdx.x == 0) {
        unsigned* bar = b.bar;
        __builtin_amdgcn_s_waitcnt(0);
        unsigned nloc = b.st[0], nx = b.st[1];
        if (nloc == 0u) { xcd_barrier_complete(bar, b.x, nloc, nx); b.st[0] = nloc; b.st[1] = nx; }
        const unsigned old = xb_add(&bar[XB_XSUB(b.x)], 1u);
        const unsigned gen = old / nloc;
        if (old + 1u == (gen + 1u) * nloc) {
            __builtin_amdgcn_fence(__ATOMIC_RELEASE, "agent");
            asm volatile("s_waitcnt vmcnt(0)" ::: "memory");
            const unsigned og = xb_add(&bar[XB_TOP], 1u);
            const unsigned tg = og / nx;
            if (og + 1u == (tg + 1u) * nx) xb_add(&bar[XB_TOPGEN], 1u);
            else XB_SPIN(xb_ld(&bar[XB_TOPGEN]) == tg, bar);
            __builtin_amdgcn_fence(__ATOMIC_ACQUIRE, "agent");
            xb_add(&bar[XB_XGEN(b.x)], 1u);
            asm volatile("s_waitcnt vmcnt(0)" ::: "memory");
        } else {
            XB_SPIN(xb_ld(&bar[XB_XGEN(b.x)]) == gen, bar);
            __builtin_amdgcn_fence(__ATOMIC_ACQUIRE, "agent");
            asm volatile("s_waitcnt vmcnt(0)" ::: "memory");
        }
    }
    __syncthreads();
}

__device__ __forceinline__ bool xcd_grid_regular(const XcdBarrier& b) {
    unsigned n32 = 0u, nz = 0u;
#pragma unroll
    for (unsigned j = 0; j < 16; ++j) { const unsigned c = xb_ld(&b.bar[XB_XCNT(j)]); n32 += (c == 32u) ? 1u : 0u; nz += (c > 0u) ? 1u : 0u; }
    return n32 == 8u && nz == 8u && b.x < 8u;
}
__device__ __forceinline__ void xcd_local_barrier(const XcdBarrier& b) {
    asm volatile("s_waitcnt vmcnt(0)" ::: "memory");
    __syncthreads();
    if (threadIdx.x == 0) {
        unsigned* bar = b.bar;
        __builtin_amdgcn_s_waitcnt(0);
        const unsigned nloc = b.st[0];
        const unsigned old = xb_add(&bar[XB_LSUB(b.x)], 1u);
        const unsigned gen = old / nloc;
        if (old + 1u == (gen + 1u) * nloc) xb_add(&bar[XB_LGEN(b.x)], 1u);
        else XB_SPIN(xb_ld(&bar[XB_LGEN(b.x)]) == gen, bar);
        __builtin_amdgcn_fence(__ATOMIC_ACQUIRE, "agent");
        asm volatile("s_waitcnt vmcnt(0)" ::: "memory");
    }
    __syncthreads();
}

struct Frame {
    LAS unsigned char* lds; volatile LAS unsigned* MISC; unsigned* ctl;
    int tid, lane, wave, vcu, G;
    int reg;
    const float* const* in; float* out; unsigned char* ws;
};
__device__ __forceinline__ const float* gin(const Frame& F, int i) { return (const float*)(const GAS float*)F.in[i]; }
struct Span { int lo, hi, step; };
__device__ __forceinline__ int grp_p0(int g) { return 8 * g + (g < 2 ? g : 2); }
__device__ __forceinline__ int grp_np(int g) { return g < 2 ? 9 : 8; }
__device__ __forceinline__ Span row_span(const Frame& F, bool latent_only) {
    Span s;
    if (F.reg) { const int g = F.vcu >> 5, j = F.vcu & 31; const int lo = latent_only ? 2048 * g : 256 * grp_p0(g); s.hi = latent_only ? lo + 2048 : lo + 256 * grp_np(g); s.lo = lo + j * NWAVES + F.wave; s.step = 32 * NWAVES; }
    else { s.lo = F.vcu * NWAVES + F.wave; s.hi = latent_only ? NB * SEQ : M; s.step = F.G * NWAVES; }
    return s;
}
enum { I_X = 0, I_C, I_CTX, I_CCTX, I_MODW, I_MODB, I_N1G, I_WIN, I_QNG, I_WUQ, I_KVNG, I_WUKV, I_GQG, I_GKG, I_CVW, I_CVB, I_LNG, I_LNB, I_MOG, I_WOUT, I_N2G, I_RW, I_W1, I_W3, I_W2, I_FG };

__device__ __forceinline__ void sincos_acc(float ang, float& s, float& c) {
    const double x = (double)ang; const double k = __builtin_rint(x * 0.63661977236758134);
    double r = __builtin_fma(-k, 1.5707963267948966, x); r = __builtin_fma(-k, 6.123233995736766e-17, r);
    const double r2 = r * r;
    const double sp = r * (1.0 + r2 * (-1.0 / 6 + r2 * (1.0 / 120 + r2 * (-1.0 / 5040 + r2 * (1.0 / 362880 + r2 * (-1.0 / 39916800 + r2 * (1.0 / 6227020800.0)))))));
    const double cp = 1.0 + r2 * (-0.5 + r2 * (1.0 / 24 + r2 * (-1.0 / 720 + r2 * (1.0 / 40320 + r2 * (-1.0 / 3628800 + r2 * (1.0 / 479001600.0 + r2 * (-1.0 / 87178291200.0)))))));
    const int q = (int)k & 3;
    const double sv = (q == 0) ? sp : (q == 1) ? cp : (q == 2) ? -sp : -cp;
    const double cv = (q == 0) ? cp : (q == 1) ? -sp : (q == 2) ? -cp : sp;
    s = (float)sv; c = (float)cv;
}
template <int NW, class RowMap>
__device__ __forceinline__ void tr_item(const float* W, int N, int k0, int n0, bf16* WT, int ldwt, RowMap rowmap, LAS float* scr, int lane, const float vs = 1.f) {
    constexpr int LPR = NW / 4, RPI = 64 / LPR, NI = 64 / RPI, NO = NW * 8 / 64;
    const int r = lane / LPR, c4 = lane % LPR;
    f32x4 v[NI];
#pragma unroll
    for (int i = 0; i < NI; ++i) v[i] = *(const GAS f32x4*)(W + (size_t)(k0 + i * RPI + r) * N + n0 + 4 * c4);
#pragma unroll
    for (int i = 0; i < NI; ++i) { const int k = i * RPI + r;
#pragma unroll
        for (int j = 0; j < 4; ++j) scr[(4 * c4 + j) * 65 + k] = v[i][j]; }
    LDS_WAIT(); asm volatile("" ::: "memory");
#pragma unroll
    for (int j = 0; j < NO; ++j) { const int n = (lane >> 3) + 8 * j, c = lane & 7; const LAS float* s = scr + n * 65 + 8 * c;
        v4u o; o.x = pk2(s[0] * vs, s[1] * vs); o.y = pk2(s[2] * vs, s[3] * vs); o.z = pk2(s[4] * vs, s[5] * vs); o.w = pk2(s[6] * vs, s[7] * vs);
        *(GAS v4u*)(WT + (size_t)rowmap(n0 + n) * ldwt + k0 + 8 * c) = o; }
    LDS_WAIT(); asm volatile("" ::: "memory");
}
constexpr int NLI = 32256, NMI = 10752;
#ifndef MOE_LSEAM
#define MOE_LSEAM 1
#endif
constexpr int WIN_IN_NB = 116, WIN_IN_IPW = 5, WIN_OUT_NB = 248, WIN_OUT_IPW = 5, WIN_TK0_NB = 192, WIN_TK1_NB = 224, WIN_TK_IPW = 4, WIN_M2_NB = 192, WIN_M2_IPW = 10;
constexpr int N_WIN_IN = WIN_IN_NB * 8 * WIN_IN_IPW, N_WIN_OUT = WIN_OUT_NB * 8 * WIN_OUT_IPW, N_WIN_TK0 = WIN_TK0_NB * 8 * WIN_TK_IPW, N_WIN_TK1 = WIN_TK1_NB * 8 * WIN_TK_IPW, N_WIN_M2 = WIN_M2_NB * 8 * WIN_M2_IPW;
constexpr int WIN_M10_NB = 48, WIN_M11_NB = 128, WIN_M1_IPW = 3, N_WIN_M10 = WIN_M10_NB * 8 * WIN_M1_IPW, N_WIN_M11 = WIN_M11_NB * 8 * WIN_M1_IPW;
constexpr int WIN_AT_NB = 240, WIN_AT_IPW = 1, N_WIN_AT = WIN_AT_NB * 8 * WIN_AT_IPW;
constexpr int PRO_L0 = NLI - N_WIN_IN - N_WIN_AT - N_WIN_OUT - N_WIN_TK0 - N_WIN_M10;
constexpr int PRO_L1 = NLI - N_WIN_M2 - N_WIN_IN - N_WIN_TK1 - N_WIN_M11;
constexpr int BASE_IN0 = PRO_L0, BASE_AT0 = BASE_IN0 + N_WIN_IN, BASE_OUT0 = BASE_AT0 + N_WIN_AT, BASE_TK0 = BASE_OUT0 + N_WIN_OUT, BASE_M10 = BASE_TK0 + N_WIN_TK0;
constexpr int BASE_M2 = PRO_L1, BASE_IN1 = BASE_M2 + N_WIN_M2, BASE_TK1 = BASE_IN1 + N_WIN_IN, BASE_M11 = BASE_TK1 + N_WIN_TK1;
static_assert(BASE_M10 + N_WIN_M10 == NLI && BASE_M11 + N_WIN_M11 == NLI && PRO_L0 > 0 && PRO_L1 > 0 && BASE_M10 >= 2 * NMI && BASE_M11 >= 2 * NMI, "window partition (the MOE1 windows hold w2 tiles only)");
#ifndef XNT
#define XNT 1
#endif
struct XItem { const float* W; bf16* WT; int N, ldwt, k0, n0, r0, kc; };
__device__ __forceinline__ void xitem_desc(Frame& F, int l, int x, XItem& d) {
    const int mat = x / NMI; int r = x - mat * NMI;
    if (MOE_LSEAM && mat == 2) {
        const int T8 = (l == 0 ? N_WIN_M10 : N_WIN_M11) / 8, H = 1344 - T8; int g, idx;
        if (r < 8 * H) { g = r / H; idx = r - g * H; } else { const int t = r - 8 * H; g = t / T8; idx = H + t - g * T8; }
        r = g * 1344 + idx; }
    const int e = r / 672, q = r - e * 672, le = l * 16 + e;
    if (mat < 2) { d.W = (mat == 0 ? gin(F, I_W1) : gin(F, I_W3)) + (size_t)le * 1024 * FF; d.N = FF; d.k0 = (q / 42) * 64; d.n0 = (q % 42) * 64;
        const int rr = (d.n0 >> 7) * 256 + mat * 128 + (d.n0 & 127);
        d.WT = (bf16*)(F.ws + WS_W13) + (((size_t)le * 21 + (rr >> 8)) * 16 + (d.k0 >> 6)) * (256 * 64); d.ldwt = 64; d.r0 = rr & 255; d.kc = 0; }
    else { d.W = gin(F, I_W2) + (size_t)le * FF * 1024; d.N = 1024; d.k0 = (q / 16) * 64; d.n0 = (q % 16) * 64;
        d.WT = (bf16*)(F.ws + WS_W2) + (((size_t)le * 4 + (d.n0 >> 8)) * 42 + (d.k0 >> 6)) * (256 * 64); d.ldwt = 64; d.r0 = d.n0 & 255; d.kc = 0; }
}
__device__ __forceinline__ void xitem_load(const XItem& d, f32x4 (&v)[16], int lane) {
    const int r = lane >> 4, c4 = lane & 15; const float* p = d.W + (size_t)(d.k0 + r) * d.N + d.n0 + 4 * c4;
#pragma unroll
    for (int i = 0; i < 16; ++i) v[i] = XNT ? __builtin_nontemporal_load((const GAS f32x4*)(p + (size_t)(4 * i) * d.N)) : *(const GAS f32x4*)(p + (size_t)(4 * i) * d.N);
}
__device__ __forceinline__ void xitem_store(const XItem& d, const f32x4 (&v)[16], LAS float* scr, int lane) {
    const int r = lane >> 4, c4 = lane & 15;
#pragma unroll
    for (int i = 0; i < 16; ++i) { const int k = i * 4 + r;
#pragma unroll
        for (int j = 0; j < 4; ++j) scr[(4 * c4 + j) * 65 + k] = v[i][j]; }
    LDS_WAIT(); asm volatile("" ::: "memory");
#pragma unroll
    for (int j = 0; j < 8; ++j) { const int nn = (lane >> 3) + 8 * j, c = lane & 7; const LAS float* s = scr + nn * 65 + 8 * c;
        const int row = d.r0 + nn;
        v4u o; o.x = pk2(s[0], s[1]); o.y = pk2(s[2], s[3]); o.z = pk2(s[4], s[5]); o.w = pk2(s[6], s[7]);
        if (XNT == 1) __builtin_nontemporal_store(o, (GAS v4u*)(d.WT + (size_t)row * d.ldwt + d.kc + 8 * c)); else *(GAS v4u*)(d.WT + (size_t)row * d.ldwt + d.kc + 8 * c) = o; }
    LDS_WAIT(); asm volatile("" ::: "memory");
}
template <class IdxFn>
__device__ __forceinline__ void conv_stream(Frame& F, int n, IdxFn idx, LAS float* scr, int lane) {
    XItem da, db; f32x4 va[16], vb[16]; int l_, x_;
    if (n > 0) { idx(0, l_, x_); xitem_desc(F, l_, x_, da); xitem_load(da, va, lane); }
    for (int j = 0; j < n; j += 2) {
        const bool hb = j + 1 < n;
        if (hb) { idx(j + 1, l_, x_); xitem_desc(F, l_, x_, db); xitem_load(db, vb, lane); }
        xitem_store(da, va, scr, lane);
        if (hb) { if (j + 2 < n) { idx(j + 2, l_, x_); xitem_desc(F, l_, x_, da); xitem_load(da, va, lane); }
            xitem_store(db, vb, scr, lane); }
    }
}
__device__ __forceinline__ void conv_window_blocked(Frame& F, int l, int base, int rank, int ipw) {
    LAS float* scr = (LAS float*)(F.lds + F.wave * 16640); const int w0 = base + rank * ipw * 8 + F.wave;
    conv_stream(F, ipw, [=](int j, int& ll, int& xx) { ll = l; xx = w0 + j * 8; }, scr, F.lane);
}
__device__ __forceinline__ void conv_window(Frame& F, int l, int base, int rank, int nblk, int ipw) {
    LAS float* scr = (LAS float*)(F.lds + F.wave * 16640); const int w0 = base + rank * 8 + F.wave, st = nblk * 8;
    conv_stream(F, ipw, [=](int j, int& ll, int& xx) { ll = l; xx = w0 + j * st; }, scr, F.lane);
}
__device__ __forceinline__ void ph0(Frame& F) {
    const int tid = F.tid, lane = F.lane;
    const int gw = F.vcu * NWAVES + F.wave, NGW = F.G * NWAVES;
    const int gt = blockIdx.x * 512 + tid, NGT = F.G * 512;
    float* cosM = (float*)(F.ws + WS_ROPE); float* sinM = cosM + 8192 * 16; float* cosG = sinM + 8192 * 16; float* sinG = cosG + 8192 * 32;
    for (int i = gt; i < 8192 * 16; i += NGT) { const int t = i >> 4, p = i & 15; const float pos = (p < 8) ? (float)(t >> 6) : (float)(t & 63);
        const float inv = exp2f(-(float)(p & 7) * (13.287712379549449f / 8.f)); float s, c; sincos_acc(pos * inv, s, c); cosM[i] = c; sinM[i] = s; }
    for (int i = gt; i < 8192 * 32; i += NGT) { const int t = i >> 5, p = i & 31; const float pos = (p < 16) ? (float)(t >> 6) : (float)(t & 63);
        const float inv = exp2f(-(float)(p & 15) * (13.287712379549449f / 16.f)); float s, c; sincos_acc(pos * inv, s, c); cosG[i] = c; sinG[i] = s; }
    { bf16* wt = (bf16*)(F.ws + WS_WIN);
      for (int i = gt; i < 2 * 96 * 128; i += NGT) { const int l = i / (96 * 128), r = i % (96 * 128); *(v4u*)(wt + ((size_t)l * 1536 + 1440) * 1024 + (size_t)r * 8) = (v4u){0u, 0u, 0u, 0u}; } }
    { LAS float* sv = (LAS float*)F.lds; LAS f32x4* part = (LAS f32x4*)(F.lds + 12288);
      float* modv = (float*)(F.ws + WS_MOD);
      for (int job = blockIdx.x; job < 256; job += F.G) {
          const int l = job >> 7, grp = job & 127;
          for (int i = tid; i < 3072; i += 512) { const int mv = i >> 10, k = i & 1023; const float v = (mv < 2) ? gin(F, I_C)[mv * 1024 + k] : gin(F, I_CCTX)[k]; sv[i] = v * sigmoidf_(v); }
          __syncthreads();
          if (tid < 384) { const int kq = tid / 12, cq = tid % 12, col = grp * 48 + cq * 4;
              f32x4 a0 = {0.f, 0.f, 0.f, 0.f}, a1 = a0, a2 = a0;
              const float* wp = gin(F, I_MODW) + ((size_t)l * 1024 + kq * 32) * 6144 + col;
#pragma unroll 8
              for (int kk = 0; kk < 32; ++kk) { const f32x4 w = *(const f32x4*)(wp + (size_t)kk * 6144); const int k = kq * 32 + kk; a0 += sv[k] * w; a1 += sv[1024 + k] * w; a2 += sv[2048 + k] * w; }
              part[(kq * 12 + cq) * 3 + 0] = a0; part[(kq * 12 + cq) * 3 + 1] = a1; part[(kq * 12 + cq) * 3 + 2] = a2; }
          __syncthreads();
          if (tid < 36) { const int cq = tid % 12, mv = tid / 12, col = grp * 48 + cq * 4; f32x4 s = *(const f32x4*)(gin(F, I_MODB) + l * 6144 + col);
              for (int kq = 0; kq < 32; ++kq) s += part[(kq * 12 + cq) * 3 + mv];
              *(f32x4*)(modv + (size_t)(l * 3 + mv) * 6144 + col) = s; }
          __syncthreads();
      } }
    LAS float* scr = (LAS float*)(F.lds + F.wave * 16640);
    constexpr int N_WIN = 2 * 16 * 45, N_WUQ = 2 * 4 * 12, N_WUKV = 2 * 2 * 16, N_WOUT = 2 * 16 * 16;
#ifndef USE_WIN
#define USE_WIN 1
#endif
    const bool win = USE_WIN && (F.G == 256);
    const int n0 = win ? PRO_L0 : NLI, n1 = win ? PRO_L1 : NLI;
    const int NITEMS = n0 + n1 + N_WIN + N_WUQ + N_WUKV + N_WOUT;
    { const int nx = n0 + n1, cnt = (nx - gw + NGW - 1) / NGW;
      conv_stream(F, cnt > 0 ? cnt : 0, [=](int j, int& ll, int& xx) { const int r = gw + j * NGW; ll = r >= n0 ? 1 : 0; xx = r >= n0 ? r - n0 : r; }, scr, lane); }
    for (int it = gw; it < NITEMS - (n0 + n1); it += NGW) {
        int r = it;
        if (r < N_WIN) { const int l = r / 720, q = r % 720, kb = q / 45, nb = q % 45;
            tr_item<32>(gin(F, I_WIN) + (size_t)l * 1024 * 1440, 1440, kb * 64, nb * 32, (bf16*)(F.ws + WS_WIN) + (size_t)l * 1536 * 1024, 1024, [](int n) { return n; }, scr, lane); continue; } r -= N_WIN;
        if (r < N_WOUT) { const int l = r / 256, q = r % 256, kb = q / 16, nb = q % 16;
            tr_item<64>(gin(F, I_WOUT) + (size_t)l * 1024 * 1024, 1024, kb * 64, nb * 64, (bf16*)(F.ws + WS_WOUT) + (size_t)l * 1024 * 1024, 1024, [](int n) { return n; }, scr, lane); continue; } r -= N_WOUT;
        if (r < N_WUQ) { const int l = r / 48, q = r % 48, kb = q / 12, nb = q % 12;
            tr_item<64>(gin(F, I_WUQ) + (size_t)l * 256 * 768, 768, kb * 64, nb * 64, (bf16*)(F.ws + WS_WUQ) + (size_t)l * 768 * 256, 256,
                        [](int n) { const int h = n / 96, j = n % 96; return j < 64 ? n : (j < 80 ? h * 96 + 64 + 2 * (j - 64) : h * 96 + 64 + 2 * (j - 80) + 1); }, scr, lane, C_MLA); continue; } r -= N_WUQ;
        { const int l = r / 32, q = r % 32, kb = q / 16, nb = q % 16;
            tr_item<64>(gin(F, I_WUKV) + (size_t)l * 128 * 1024, 1024, kb * 64, nb * 64, (bf16*)(F.ws + WS_WUKV) + (size_t)l * 1024 * 128, 128, [](int n) { return n; }, scr, lane); }
    }
}

template <int MODE>
__device__ __forceinline__ void norm_phase(Frame& F) {
    const int lane = F.lane; Span sp_; if (MODE == 2) { sp_.lo = F.vcu * NWAVES + F.wave; sp_.hi = M; sp_.step = F.G * NWAVES; } else sp_ = row_span(F, false);
    const int gw = sp_.lo, NGW = sp_.step, MH = sp_.hi;
    float* xres = (float*)(F.ws + WS_XRES); bf16* xrb = (bf16*)(F.ws + WS_XRES); bf16* h1 = (bf16*)(F.ws + WS_H1);
    const float* modv = (const float*)(F.ws + WS_MOD); const float* aff = (const float*)(F.ws + WS_AFF); const int* inv = (const int*)(F.ws + WS_INV); const bf16* ybuf = (const bf16*)(F.ws + WS_XG);
    const float* xin = gin(F, I_X); const float* cin = gin(F, I_CTX);
#define NP_LOAD(R_, V_, S_, G_) do { const int b_ = (R_) / SB, s_ = (R_) - b_ * SB; \
        const float* src_ = (MODE == 0) ? (s_ < CTX ? cin + ((size_t)b_ * CTX + s_) * DM : xin + ((size_t)b_ * SEQ + (s_ - CTX)) * DM) : xres + (size_t)(R_) * DM; \
        _Pragma("unroll") for (int j = 0; j < 4; ++j) { if (MODE == 0) V_[j] = __builtin_nontemporal_load((const f32x4*)(src_ + 4 * lane + 256 * j)); \
            else if (XRES_BF16) { const v2u w_ = *(const v2u*)(xrb + (size_t)(R_) * DM + 4 * lane + 256 * j); V_[j] = (f32x4){bflo(w_.x), bfhi(w_.x), bflo(w_.y), bfhi(w_.y)}; } \
            else V_[j] = *(const f32x4*)(src_ + 4 * lane + 256 * j); } \
        if (MODE >= 1) { S_ = (lane < 16) ? inv[(size_t)(R_) * 16 + lane] : -1; G_ = (lane < 16) ? aff[(size_t)(R_) * 16 + lane] : 0.f; } } while (0)
#define NP_YREQ(S_, G_, P0_, P1_, PG0_, PG1_, REST_) do { unsigned long long m_ = __ballot((S_) >= 0); PG0_ = 0.f; PG1_ = 0.f; \
        if (m_) { const int e_ = __builtin_ctzll(m_); m_ &= m_ - 1; const int s_ = __builtin_amdgcn_readlane((S_), e_); PG0_ = __builtin_bit_cast(float, __builtin_amdgcn_readlane(__builtin_bit_cast(int, (G_)), e_)); \
            const bf16* y_ = ybuf + ((size_t)e_ * RPE + s_) * DM + 4 * lane; _Pragma("unroll") for (int j = 0; j < 4; ++j) P0_[j] = *(const v2u*)(y_ + 256 * j); } \
        else { _Pragma("unroll") for (int j = 0; j < 4; ++j) P0_[j] = (v2u){0u, 0u}; } \
        if (m_) { const int e_ = __builtin_ctzll(m_); m_ &= m_ - 1; const int s_ = __builtin_amdgcn_readlane((S_), e_); PG1_ = __builtin_bit_cast(float, __builtin_amdgcn_readlane(__builtin_bit_cast(int, (G_)), e_)); \
            const bf16* y_ = ybuf + ((size_t)e_ * RPE + s_) * DM + 4 * lane; _Pragma("unroll") for (int j = 0; j < 4; ++j) P1_[j] = *(const v2u*)(y_ + 256 * j); } \
        else { _Pragma("unroll") for (int j = 0; j < 4; ++j) P1_[j] = (v2u){0u, 0u}; } \
        REST_ = m_; } while (0)
    f32x4 cv[4], n1v[4], n2v[4]; int cs = -1, n1s = -1, n2s = -1; float cg = 0.f, n1g = 0.f, n2g = 0.f;
    v2u cp0[4], cp1[4], np0[4], np1[4]; float cpg0 = 0.f, cpg1 = 0.f, npg0 = 0.f, npg1 = 0.f; unsigned long long crest = 0ull, nrest = 0ull;
    int R = gw;
    if (R < MH) NP_LOAD(R, cv, cs, cg);
    if (R + NGW < MH) NP_LOAD(R + NGW, n1v, n1s, n1g);
    if (MODE >= 1 && R < MH) NP_YREQ(cs, cg, cp0, cp1, cpg0, cpg1, crest);
    for (; R < MH; R += NGW) {
        if (R + 2 * NGW < MH) NP_LOAD(R + 2 * NGW, n2v, n2s, n2g);
        if (MODE >= 1 && R + NGW < MH) NP_YREQ(n1s, n1g, np0, np1, npg0, npg1, nrest);
        const int b = R / SB, s = R - b * SB; const bool isctx = s < CTX; const int mv = isctx ? 2 : b;
        if (!(MODE == 2 && isctx)) {
        f32x4 v[4];
#pragma unroll
        for (int j = 0; j < 4; ++j) v[j] = cv[j];
        if (MODE >= 1) {
            const float* g2 = modv + (size_t)((MODE - 1) * 3 + mv) * 6144 + 5120;
            f32x4 acc[4];
#pragma unroll
            for (int j = 0; j < 4; ++j) { acc[j] = cpg0 * (f32x4){bflo(cp0[j].x), bfhi(cp0[j].x), bflo(cp0[j].y), bfhi(cp0[j].y)}; acc[j] += cpg1 * (f32x4){bflo(cp1[j].x), bfhi(cp1[j].x), bflo(cp1[j].y), bfhi(cp1[j].y)}; }
            unsigned long long mask = crest;
            while (mask) {
                const int e0 = __builtin_ctzll(mask); mask &= mask - 1; const bool two = mask != 0; const int e1 = two ? __builtin_ctzll(mask) : e0; if (two) mask &= mask - 1;
                const int s0 = __builtin_amdgcn_readlane(cs, e0), s1 = __builtin_amdgcn_readlane(cs, e1);
                const float g0 = __builtin_bit_cast(float, __builtin_amdgcn_readlane(__builtin_bit_cast(int, cg), e0)), g1 = two ? __builtin_bit_cast(float, __builtin_amdgcn_readlane(__builtin_bit_cast(int, cg), e1)) : 0.f;
                const bf16* y0 = ybuf + ((size_t)e0 * RPE + s0) * DM + 4 * lane; const bf16* y1 = ybuf + ((size_t)e1 * RPE + s1) * DM + 4 * lane;
                v2u r0[4], r1[4];
#pragma unroll
                for (int j = 0; j < 4; ++j) { r0[j] = *(const v2u*)(y0 + 256 * j); r1[j] = *(const v2u*)(y1 + 256 * j); }
#pragma unroll
                for (int j = 0; j < 4; ++j) { acc[j] += g0 * (f32x4){bflo(r0[j].x), bfhi(r0[j].x), bflo(r0[j].y), bfhi(r0[j].y)}; acc[j] += g1 * (f32x4){bflo(r1[j].x), bfhi(r1[j].x), bflo(r1[j].y), bfhi(r1[j].y)}; }
            }
#pragma unroll
            for (int j = 0; j < 4; ++j) v[j] += *(const f32x4*)(g2 + 4 * lane + 256 * j) * acc[j];
            if (MODE == 1) {
#pragma unroll
                for (int j = 0; j < 4; ++j) { if (XRES_BF16) { v2u w_; w_.x = pk2(v[j].x, v[j].y); w_.y = pk2(v[j].z, v[j].w); *(v2u*)(xrb + (size_t)R * DM + 4 * lane + 256 * j) = w_; } else *(f32x4*)(xres + (size_t)R * DM + 4 * lane + 256 * j) = v[j]; } }
        }
        float ss = 0.f;
#pragma unroll
        for (int j = 0; j < 4; ++j) ss += (v[j].x * v[j].x + v[j].y * v[j].y) + (v[j].z * v[j].z + v[j].w * v[j].w);
        const float rs = rsqrtf(wave_sum(ss) * (1.f / DM) + EPS);
        if (MODE == 2) {
            float* op = F.out + ((size_t)b * SEQ + (s - CTX)) * DM;
#pragma unroll
            for (int j = 0; j < 4; ++j) __builtin_nontemporal_store(v[j] * rs * *(const f32x4*)(gin(F, I_FG) + 4 * lane + 256 * j), (f32x4*)(op + 4 * lane + 256 * j));
        } else {
            constexpr int l = MODE; const float* mp = modv + (size_t)(l * 3 + mv) * 6144; const float* ng = gin(F, I_N1G) + l * DM;
#pragma unroll
            for (int j = 0; j < 4; ++j) { const int c = 4 * lane + 256 * j; const f32x4 g = *(const f32x4*)(ng + c), sh = *(const f32x4*)(mp + c), sc = *(const f32x4*)(mp + 1024 + c);
                const f32x4 h = v[j] * rs * g * (1.f + sc) + sh; v2u o; o.x = pk2(h.x, h.y); o.y = pk2(h.z, h.w); *(v2u*)(h1 + (size_t)R * DM + c) = o; }
        }
        }
#pragma unroll
        for (int j = 0; j < 4; ++j) { cv[j] = n1v[j]; n1v[j] = n2v[j]; cp0[j] = np0[j]; cp1[j] = np1[j]; }
        cs = n1s; cg = n1g; n1s = n2s; n1g = n2g; cpg0 = npg0; cpg1 = npg1; crest = nrest;
    }
#undef NP_LOAD
#undef NP_YREQ
}

struct PrepIn { v2u q; unsigned kv; float kr1, kr2, h1[3], h2[3]; float cm, sm, cg, sg; };
__device__ __forceinline__ void prep_load(Frame& F, int R, PrepIn& I) {
    const bf16* zr = (const bf16*)(F.ws + WS_Z) + (size_t)R * ZW; const int lane = F.lane;
    const int s = R % SB; const bool lat = s >= CTX; const int t = lat ? s - CTX : 0;
    const float* cosM = (const float*)(F.ws + WS_ROPE); const float* sinM = cosM + 8192 * 16; const float* cosG = sinM + 8192 * 16; const float* sinG = cosG + 8192 * 32;
    I.q = *(const v2u*)(zr + ZQ + 4 * lane); I.kv = *(const unsigned*)(zr + ZKV + 2 * lane);
    I.kr1 = bf2f(zr[ZKR + (lane & 15)]); I.kr2 = bf2f(zr[ZKR + 16 + (lane & 15)]);
#pragma unroll
    for (int p = 0; p < 3; ++p) { const bf16* hp = zr + ZGQ + (2 * p + (lane >> 5)) * 64; I.h1[p] = bf2f(hp[lane & 31]); I.h2[p] = bf2f(hp[(lane & 31) + 32]); }
    I.cm = cosM[(size_t)t * 16 + (lane & 15)]; I.sm = sinM[(size_t)t * 16 + (lane & 15)]; I.cg = cosG[(size_t)t * 32 + (lane & 31)]; I.sg = sinG[(size_t)t * 32 + (lane & 31)];
}
__device__ __forceinline__ void prep_store(Frame& F, int l, int R, const PrepIn& I, const float ssq, const float sskv, const float (&ssh)[3]) {
    bf16* zr = (bf16*)(F.ws + WS_Z) + (size_t)R * ZW; const int lane = F.lane;
    const bool lat = (R % SB) >= CTX;
    {
        const float x0 = bflo(I.q.x), x1 = bfhi(I.q.x), x2 = bflo(I.q.y), x3 = bfhi(I.q.y);
        const float rs = rsqrtf(ssq * (1.f / 256) + EPS);
        const f32x4 g = *(const f32x4*)(gin(F, I_QNG) + l * 256 + 4 * lane);
        v2u o; o.x = pk2(x0 * rs * g.x, x1 * rs * g.y); o.y = pk2(x2 * rs * g.z, x3 * rs * g.w); *(v2u*)(zr + ZQ + 4 * lane) = o; }
    {
        const float x0 = bflo(I.kv), x1 = bfhi(I.kv);
        const float rs = rsqrtf(sskv * (1.f / 128) + EPS);
        const f32x2 g = *(const f32x2*)(gin(F, I_KVNG) + l * 128 + 2 * lane);
        *(unsigned*)(zr + ZKV + 2 * lane) = pk2(x0 * rs * g.x, x1 * rs * g.y); }
    {
        const int i = lane & 15; float o1 = I.kr1, o2 = I.kr2;
        if (lat) { o1 = I.kr1 * I.cm - I.kr2 * I.sm; o2 = I.kr2 * I.cm + I.kr1 * I.sm; }
        const unsigned w = pk2(o1, o2);
        if (lane < 16) *(unsigned*)(zr + ZKR + 2 * i) = w; }
#pragma unroll
    for (int p = 0; p < 3; ++p) { const int hh = 2 * p + (lane >> 5), i = lane & 31; bf16* hp = zr + ZGQ + hh * 64;
        const float x1 = I.h1[p], x2 = I.h2[p];
        const float rs = rsqrtf(ssh[p] * (1.f / 64) + EPS);
        const float* g = (p < 2 ? gin(F, I_GQG) : gin(F, I_GKG)) + l * 64;
        const float qs = (p < 2) ? C_GQA : 1.f;
        float y1 = x1 * rs * g[i] * qs, y2 = x2 * rs * g[i + 32] * qs;
        if (lat) { const float a = y1 * I.cg - y2 * I.sg, bb = y2 * I.cg + y1 * I.sg; y1 = a; y2 = bb; }
        hp[i] = (bf16)f2bf(y1); hp[i + 32] = (bf16)f2bf(y2); }
}
__device__ __forceinline__ void prep_quad(Frame& F, int l, int R0, int NGW, int MH) {
    PrepIn I[4]; int R[4]; bool ok[4];
#pragma unroll
    for (int u = 0; u < 4; ++u) { R[u] = R0 + u * NGW; ok[u] = R[u] < MH; if (!ok[u]) R[u] = R0; prep_load(F, R[u], I[u]); }
    float w[8], h[12];
#pragma unroll
    for (int u = 0; u < 4; ++u) { const float a0 = bflo(I[u].q.x), a1 = bfhi(I[u].q.x), a2 = bflo(I[u].q.y), a3 = bfhi(I[u].q.y); w[2 * u] = (a0 * a0 + a1 * a1) + (a2 * a2 + a3 * a3);
        const float k0 = bflo(I[u].kv), k1 = bfhi(I[u].kv); w[2 * u + 1] = k0 * k0 + k1 * k1;
#pragma unroll
        for (int p = 0; p < 3; ++p) h[3 * u + p] = I[u].h1[p] * I[u].h1[p] + I[u].h2[p] * I[u].h2[p]; }
    wave_sum_n<8>(w); half_sum_n<12>(h);
#pragma unroll
    for (int u = 0; u < 4; ++u) if (ok[u]) { const float sa[3] = {h[3 * u], h[3 * u + 1], h[3 * u + 2]}; prep_store(F, l, R[u], I[u], w[2 * u], w[2 * u + 1], sa); }
}
struct ConvIn { v4u av[4], gv[4]; bool ok[4]; };
__device__ __forceinline__ void conv_load(Frame& F, int tile, ConvIn& I) {
    const int tid = F.tid; const int R0 = tile * 32; const int b = R0 / SB, s0 = R0 - b * SB; const bool isctx = s0 < CTX;
    const int seq_lo = b * SB + (isctx ? 0 : CTX), seq_hi = b * SB + (isctx ? CTX : SB);
    const bf16* z = (const bf16*)(F.ws + WS_Z);
#pragma unroll
    for (int j = 0; j < 4; ++j) { const int it = tid + 512 * j; const int rr = it >> 5, c8 = (it & 31) * 8; const int R = R0 - 15 + rr;
        I.ok[j] = (it < 62 * 32) && R >= seq_lo && R < seq_hi; const size_t ro = (size_t)(I.ok[j] ? R : R0) * ZW;
        I.av[j] = *(const v4u*)(z + ro + ZCA + c8); I.gv[j] = *(const v4u*)(z + ro + ZCB + c8); }
}
__device__ __forceinline__ void conv_tile(Frame& F, int l, int tile, const ConvIn& I, int next_tile, ConvIn& N) {
    const int tid = F.tid, lane = F.lane, wave = F.wave; const int R0 = tile * 32;
    LAS float* U = (LAS float*)F.lds; LAS float* Y = U + 62 * 256;
#pragma unroll
    for (int j = 0; j < 4; ++j) { const int it = tid + 512 * j; if (it < 62 * 32) { const int rr = it >> 5, c8 = (it & 31) * 8;
        f32x4 u0 = {0.f, 0.f, 0.f, 0.f}, u1 = u0;
        if (I.ok[j]) { const v4u a = I.av[j], g = I.gv[j];
            u0.x = bflo(a.x) * sigmoidf_(bflo(g.x)); u0.y = bfhi(a.x) * sigmoidf_(bfhi(g.x)); u0.z = bflo(a.y) * sigmoidf_(bflo(g.y)); u0.w = bfhi(a.y) * sigmoidf_(bfhi(g.y));
            u1.x = bflo(a.z) * sigmoidf_(bflo(g.z)); u1.y = bfhi(a.z) * sigmoidf_(bfhi(g.z)); u1.z = bflo(a.w) * sigmoidf_(bflo(g.w)); u1.w = bfhi(a.w) * sigmoidf_(bfhi(g.w)); }
        *(LAS f32x4*)(U + rr * 256 + c8) = u0; *(LAS f32x4*)(U + rr * 256 + c8 + 4) = u1; } }
    if (next_tile >= 0) conv_load(F, next_tile, N);
    __syncthreads();
    { const int c = tid & 255, hf = tid >> 8; const float* wp = gin(F, I_CVW) + (size_t)l * 31 * 256 + c; const float bias = gin(F, I_CVB)[l * 256 + c];
      float w[31];
#pragma unroll
      for (int j = 0; j < 31; ++j) w[j] = wp[j * 256];
#pragma unroll
      for (int ch = 0; ch < 2; ++ch) { const int r0 = hf * 16 + ch * 8; float win[38];
#pragma unroll
          for (int q = 0; q < 38; ++q) win[q] = U[(r0 + q) * 256 + c];
#pragma unroll
          for (int o = 0; o < 8; ++o) { float y = bias;
#pragma unroll
              for (int j = 0; j < 31; ++j) y = fmaf(win[o + j], w[j], y);
              Y[(r0 + o) * 256 + c] = y; } } }
    __syncthreads();
    { const float* lg = gin(F, I_LNG) + l * 256; const float* lb = gin(F, I_LNB) + l * 256; const float* mg = gin(F, I_MOG) + l * 1024 + 768; bf16* cat = (bf16*)(F.ws + WS_H1);
      float y[4][4], red[8];
#pragma unroll
      for (int rr = 0; rr < 4; ++rr) { const int row = wave * 4 + rr; float sm = 0.f, sq = 0.f;
#pragma unroll
          for (int q = 0; q < 4; ++q) { y[rr][q] = Y[row * 256 + lane + 64 * q]; sm += y[rr][q]; sq += y[rr][q] * y[rr][q]; }
          red[rr] = sm; red[4 + rr] = sq; }
      wave_sum_n<8>(red);
      float r2[4];
#pragma unroll
      for (int rr = 0; rr < 4; ++rr) { const float mean = red[rr] * (1.f / 256), var = fmaxf(red[4 + rr] * (1.f / 256) - mean * mean, 0.f); const float rstd = rsqrtf(var + EPS); float s2 = 0.f;
#pragma unroll
          for (int q = 0; q < 4; ++q) { const int c = lane + 64 * q; const float v = (y[rr][q] - mean) * rstd * lg[c] + lb[c]; y[rr][q] = v * sigmoidf_(v); s2 += y[rr][q] * y[rr][q]; }
          r2[rr] = s2; }
      wave_sum_n<4>(r2);
#pragma unroll
      for (int rr = 0; rr < 4; ++rr) { const int row = wave * 4 + rr; const float rs = rsqrtf(r2[rr] * (1.f / 256) + EPS);
#pragma unroll
          for (int q = 0; q < 4; ++q) { const int c = lane + 64 * q; cat[(size_t)(R0 + row) * DM + 768 + c] = (bf16)f2bf(y[rr][q] * rs * mg[c]); } } }
    __syncthreads();
}
__device__ __forceinline__ void prep_phase(Frame& F, int l) {
    const Span sp = row_span(F, false);
    for (int R = sp.lo; R < sp.hi; R += 4 * sp.step) prep_quad(F, l, R, sp.step, sp.hi);
}
__device__ __forceinline__ void convmix_phase(Frame& F, int l) {
    const int ntile = (l == 1) ? NB * SEQ / 32 : M / 32;
#define CV_TILE(ti_) ((l == 1) ? ((ti_) / (SEQ / 32)) * (SB / 32) + CTX / 32 + ((ti_) % (SEQ / 32)) : (ti_))
    ConvIn A, B; int ti = F.vcu;
    if (ti < ntile) conv_load(F, CV_TILE(ti), A);
    while (ti < ntile) {
        const int t1 = ti + F.G, t2 = t1 + F.G;
        conv_tile(F, l, CV_TILE(ti), A, t1 < ntile ? CV_TILE(t1) : -1, B);
        if (t1 < ntile) conv_tile(F, l, CV_TILE(t1), B, t2 < ntile ? CV_TILE(t2) : -1, A);
        ti = t2;
    }
#undef CV_TILE
}
#ifndef ATT_TUNED
#define ATT_TUNED 1
#endif
__device__ __forceinline__ void attn_phase(Frame& F, int l, char* ldsg) {
    const bf16* z = (const bf16*)(F.ws + WS_Z); const bf16* qm = (const bf16*)(F.ws + WS_QM); const bf16* kvm = (const bf16*)(F.ws + WS_KVM); bf16* ob = (bf16*)(F.ws + WS_O);
    const float* cosM = (const float*)(F.ws + WS_ROPE);
    const int nctx = (l == 0) ? 16 : 0;
    for (int u = F.vcu; u < 512 + nctx; u += F.G) {
        int b, h; size_t rq, rk; int nk;
        if (u < 512) { const int bh = u >> 5, qb = u & 31; b = bh >> 3; h = bh & 7; rk = (size_t)b * SB; rq = rk + CTX + (size_t)qb * 256; nk = SB; }
        else { const int v = u - 512; b = v >> 3; h = v & 7; rk = (size_t)b * SB; rq = rk; nk = CTX; }
#if ATT_TUNED
        att2::attn_unit<96, QW, KVW, ZW, KVW, 8>(qm + rq * QW + 96 * h, kvm + rk * KVW + 128 * h, z + rk * ZW + ZKR, kvm + rk * KVW + 128 * h + 64, ob + rq * OW + 64 * h, (u < 512) ? cosM + (size_t)(u & 31) * 256 * 16 : nullptr, nk / 64, ldsg, F.tid);
#else
        att::attn_unit<96, QW, KVW, ZW, KVW>(qm + rq * QW + 96 * h, kvm + rk * KVW + 128 * h, z + rk * ZW + ZKR, kvm + rk * KVW + 128 * h + 64, ob + rq * OW + 64 * h, (u < 512) ? cosM + (size_t)(u & 31) * 256 * 16 : nullptr, nk, ldsg, F.tid);
#endif
    }
    const int nctx2 = (l == 0) ? 8 : 0;
    for (int u = F.vcu; u < 256 + nctx2; u += F.G) {
        int b, h; size_t rq, rk; int nk;
        if (u < 256) { const int bh = u >> 5, qb = u & 31; b = bh >> 2; h = bh & 3; rk = (size_t)b * SB; rq = rk + CTX + (size_t)qb * 256; nk = SB; }
        else { const int v = u - 256; b = v >> 2; h = v & 3; rk = (size_t)b * SB; rq = rk; nk = CTX; }
#if ATT_TUNED
        att2::attn_unit<64, ZW, ZW, ZW, ZW, 8>(z + rq * ZW + ZGQ + 64 * h, z + rk * ZW + ZGK + 64 * (h >> 1), nullptr, z + rk * ZW + ZGV + 64 * (h >> 1), ob + rq * OW + 512 + 64 * h, nullptr, nk / 64, ldsg, F.tid);
#else
        att::attn_unit<64, ZW, ZW, ZW, ZW>(z + rq * ZW + ZGQ + 64 * h, z + rk * ZW + ZGK + 64 * (h >> 1), nullptr, z + rk * ZW + ZGV + 64 * (h >> 1), ob + rq * OW + 512 + 64 * h, nullptr, nk, ldsg, F.tid);
#endif
    }
}

__device__ __forceinline__ void gnorm_phase(Frame& F, int l) {
    const int lane = F.lane; const Span sp = row_span(F, l == 1); const int gw = sp.lo, NGW = sp.step;
    const bf16* ob = (const bf16*)(F.ws + WS_O); bf16* cat = (bf16*)(F.ws + WS_H1); const float* mg = gin(F, I_MOG) + l * 1024;
    const f32x4 g0 = *(const f32x4*)(mg + 8 * lane), g1 = *(const f32x4*)(mg + 8 * lane + 4), g2 = *(const f32x4*)(mg + 512 + 4 * lane);
    const int nrow = sp.hi;
#define GN_ROW(i_) ((l == 1) ? ((i_) / SEQ) * SB + CTX + ((i_) % SEQ) : (i_))
    for (int i = gw; i < nrow; i += 4 * NGW) {
        v4u a[4]; v2u c[4]; int R[4]; bool ok[4];
#pragma unroll
        for (int u = 0; u < 4; ++u) { const int ii = i + u * NGW; ok[u] = ii < nrow; R[u] = GN_ROW(ok[u] ? ii : i); a[u] = *(const v4u*)(ob + (size_t)R[u] * OW + 8 * lane); c[u] = *(const v2u*)(ob + (size_t)R[u] * OW + 512 + 4 * lane); }
#pragma unroll
        for (int u = 0; u < 4; ++u) { if (!ok[u]) continue;
            float x[8] = {bflo(a[u].x), bfhi(a[u].x), bflo(a[u].y), bfhi(a[u].y), bflo(a[u].z), bfhi(a[u].z), bflo(a[u].w), bfhi(a[u].w)}; float y[4] = {bflo(c[u].x), bfhi(c[u].x), bflo(c[u].y), bfhi(c[u].y)};
            float s1 = 0.f, s2 = 0.f;
#pragma unroll
            for (int k = 0; k < 8; ++k) s1 += x[k] * x[k];
#pragma unroll
            for (int k = 0; k < 4; ++k) s2 += y[k] * y[k];
            const float r1 = rsqrtf(wave_sum(s1) * (1.f / 512) + EPS), r2 = rsqrtf(wave_sum(s2) * (1.f / 256) + EPS);
            v4u o; o.x = pk2(x[0] * r1 * g0.x, x[1] * r1 * g0.y); o.y = pk2(x[2] * r1 * g0.z, x[3] * r1 * g0.w); o.z = pk2(x[4] * r1 * g1.x, x[5] * r1 * g1.y); o.w = pk2(x[6] * r1 * g1.z, x[7] * r1 * g1.w);
            *(v4u*)(cat + (size_t)R[u] * DM + 8 * lane) = o;
            v2u p; p.x = pk2(y[0] * r2 * g2.x, y[1] * r2 * g2.y); p.y = pk2(y[2] * r2 * g2.z, y[3] * r2 * g2.w);
            *(v2u*)(cat + (size_t)R[u] * DM + 512 + 4 * lane) = p; }
    }
#undef GN_ROW
}

#ifndef RT_ROWS
#define RT_ROWS 2
#endif
__device__ __forceinline__ void router_phase(Frame& F, int l) {
    constexpr int RT = RT_ROWS;
    const int tid = F.tid, lane = F.lane; const Span sp = row_span(F, l == 1);
    LAS float* W = (LAS float*)F.lds; LAS float* G2 = W + 1024 * 20; LAS float* S2 = G2 + 3072;
    const float* rw = gin(F, I_RW) + (size_t)l * 1024 * 16; const float* n2 = gin(F, I_N2G) + l * DM; const float* modl = (const float*)(F.ws + WS_MOD) + (size_t)l * 3 * 6144;
    const float* xres = (const float*)(F.ws + WS_XRES); bf16* h2 = (bf16*)(F.ws + WS_H1); float* aff = (float*)(F.ws + WS_AFF);
    for (int i = tid; i < 4096; i += 512) *(LAS f32x4*)(W + (i >> 2) * 20 + (i & 3) * 4) = *(const f32x4*)(rw + 4 * i);
    for (int i = tid; i < 3072; i += 512) { const int mv = i >> 10, k = i & 1023; G2[i] = n2[k] * (1.f + modl[mv * 6144 + 4096 + k]); S2[i] = modl[mv * 6144 + 3072 + k]; }
    __syncthreads();
    const int gbase = (sp.lo - (sp.lo % sp.step)) , gw = sp.lo % sp.step;
    for (int gi = gw; gbase + gi * RT < sp.hi; gi += sp.step) {
        const int i0 = gbase + gi * RT; const int R0 = (l == 1) ? (i0 / SEQ) * SB + CTX + (i0 % SEQ) : i0;
        const int b = R0 / SB, s = R0 - b * SB; const int mv = (s < CTX) ? 2 : b;
        const float* xl = xres + (size_t)R0 * DM + lane; const bf16* xlb = (const bf16*)(F.ws + WS_XRES) + (size_t)R0 * DM + lane; bf16* hl = h2 + (size_t)R0 * DM + lane;
        float x[RT][16]; float ss[RT];
#pragma unroll
        for (int u = 0; u < RT; ++u)
#pragma unroll
            for (int q = 0; q < 16; ++q) x[u][q] = XRES_BF16 ? bf2f(xlb[u * DM + 64 * q]) : xl[u * DM + 64 * q];
        float rs[RT];
#pragma unroll
        for (int u = 0; u < RT; ++u) {
            ss[u] = 0.f;
#pragma unroll
            for (int q = 0; q < 16; ++q) ss[u] += x[u][q] * x[u][q];
            asm volatile("" : "+v"(ss[u]));
            rs[u] = rsqrtf(wave_sum(ss[u]) * (1.f / DM) + EPS); }
        float acc[RT][16];
#pragma unroll
        for (int u = 0; u < RT; ++u)
#pragma unroll
            for (int e = 0; e < 16; ++e) acc[u][e] = 0.f;
        f32x4 cw0, cw1, cw2, cw3; float cg, csh;
#define RT_LD(q_, A0, A1, A2, A3, G_, S_) do { const int k_ = lane + 64 * (q_); const LAS f32x4* wp_ = (const LAS f32x4*)(W + k_ * 20); A0 = wp_[0]; A1 = wp_[1]; A2 = wp_[2]; A3 = wp_[3]; G_ = G2[mv * 1024 + k_]; S_ = S2[mv * 1024 + k_]; } while (0)
        RT_LD(0, cw0, cw1, cw2, cw3, cg, csh);
#pragma unroll
        for (int q = 0; q < 16; ++q) { f32x4 nw0 = cw0, nw1 = cw1, nw2 = cw2, nw3 = cw3; float ng = cg, nsh = csh;
            if (q < 15) RT_LD(q + 1, nw0, nw1, nw2, nw3, ng, nsh);
#pragma unroll
            for (int u = 0; u < RT; ++u) { float h = x[u][q] * rs[u] * cg + csh; asm volatile("" : "+v"(h));
                hl[u * DM + 64 * q] = (bf16)f2bf(h);
#define RFMA(A_, W_) asm("v_fmac_f32_e32 %0, %1, %2" : "+v"(A_) : "v"(h), "v"(W_))
                RFMA(acc[u][0], cw0.x); RFMA(acc[u][1], cw0.y); RFMA(acc[u][2], cw0.z); RFMA(acc[u][3], cw0.w);
                RFMA(acc[u][4], cw1.x); RFMA(acc[u][5], cw1.y); RFMA(acc[u][6], cw1.z); RFMA(acc[u][7], cw1.w);
                RFMA(acc[u][8], cw2.x); RFMA(acc[u][9], cw2.y); RFMA(acc[u][10], cw2.z); RFMA(acc[u][11], cw2.w);
                RFMA(acc[u][12], cw3.x); RFMA(acc[u][13], cw3.y); RFMA(acc[u][14], cw3.z); RFMA(acc[u][15], cw3.w); }
#undef RFMA
            cw0 = nw0; cw1 = nw1; cw2 = nw2; cw3 = nw3; cg = ng; csh = nsh;
            __builtin_amdgcn_sched_barrier(0); }
#undef RT_LD
        const int e = ((lane & 1) << 3) | ((lane & 2) << 1) | ((lane & 4) >> 1) | ((lane & 8) >> 3);
#pragma unroll
        for (int u = 0; u < RT; ++u) {
#define RT_STAGE(ST) do { constexpr int half_ = 8 >> (ST); const bool up = (lane >> (ST)) & 1; \
                _Pragma("unroll") for (int j = 0; j < half_; ++j) { const float a = acc[u][j], c = acc[u][j + half_]; const float mine = up ? c : a, other = up ? a : c; acc[u][j] = mine + sx<(1 << (ST))>(other); } } while (0)
            RT_STAGE(0); RT_STAGE(1); RT_STAGE(2); RT_STAGE(3);
#undef RT_STAGE
            float lg = acc[u][0]; lg += sx<16>(lg); lg = sum32(lg);
            float mx = lg;
            mx = fmaxf(mx, sx<1>(mx)); mx = fmaxf(mx, sx<2>(mx)); mx = fmaxf(mx, sx<4>(mx)); mx = fmaxf(mx, sx<8>(mx));
            const float p = __expf(lg - mx); float sum = p;
            sum += sx<1>(sum); sum += sx<2>(sum); sum += sx<4>(sum); sum += sx<8>(sum);
            if (lane < 16) aff[(size_t)(R0 + u) * 16 + e] = p / sum; }
    }
}

template <int N, int KSEL>
__device__ __forceinline__ void topk_list(Frame& F, int R0, int e, int slot0) {
    constexpr int EPT = N >= 512 ? N / 512 : 1;
    LAS unsigned* keys = (LAS unsigned*)F.lds; LAS unsigned* hist = keys + 8192; LAS unsigned* wtot = hist + 256; LAS unsigned* sel = wtot + 16;
    const float* aff = (const float*)(F.ws + WS_AFF); int* inv = (int*)(F.ws + WS_INV); int* rowidx = (int*)(F.ws + WS_ROWIDX);
    const int tid = F.tid, lane = F.lane, wave = F.wave;
    for (int i = tid; i < N; i += 512) keys[i] = __float_as_uint(aff[(size_t)(R0 + i) * 16 + e]);
    unsigned prefix = 0u; unsigned kneed = KSEL;
    for (int pass = 0; pass < 4; ++pass) {
        const int shift = 24 - 8 * pass;
        if (tid < 256) hist[tid] = 0u;
        __syncthreads();
        if (pass == 0) {
            for (int i = tid; i < N; i += 512) { const unsigned d = keys[i] >> 24; unsigned long long todo = __ballot(1);
                while (todo) { const int ln = __builtin_ctzll(todo); const unsigned d0 = __builtin_amdgcn_readlane(d, ln); const unsigned long long m = __ballot(d == d0) & todo;
                    if (lane == ln) (void)__hip_atomic_fetch_add(&hist[d0], (unsigned)__builtin_popcountll(m), __ATOMIC_RELAXED, __HIP_MEMORY_SCOPE_WORKGROUP); todo &= ~m; } }
        } else {
        for (int i = tid; i < N; i += 512) { const unsigned k = keys[i]; const unsigned hiq = (unsigned)((unsigned long long)k >> (shift + 8));
            if (hiq == prefix) (void)__hip_atomic_fetch_add(&hist[(k >> shift) & 255u], 1u, __ATOMIC_RELAXED, __HIP_MEMORY_SCOPE_WORKGROUP); }
        }
        __syncthreads();
        unsigned v = 0u, incl = 0u;
        if (tid < 256) { v = hist[255 - tid]; incl = v;
            incl = wave_scan_incl(incl, lane);
            if (lane == 63) wtot[wave] = incl; }
        __syncthreads();
        if (tid < 256) { unsigned off = 0u; for (int w = 0; w < wave; ++w) off += wtot[w]; incl += off; const unsigned excl = incl - v;
            if (incl >= kneed && excl < kneed) { sel[0] = 255u - (unsigned)tid; sel[1] = kneed - excl; } }
        __syncthreads();
        prefix = (prefix << 8) | sel[0]; kneed = sel[1];
        __syncthreads();
    }
    const unsigned T = prefix; const int cgt = KSEL - (int)kneed;
    unsigned cnt = 0u; const int base = tid * EPT;
    if (base < N) {
#pragma unroll
        for (int q = 0; q < EPT; ++q) { const unsigned k = keys[base + q]; cnt += (k > T) ? 1u : 0u; cnt += (k == T) ? 0x10000u : 0u; } }
    unsigned incl = wave_scan_incl(cnt, lane);
    if (lane == 63) wtot[wave] = incl;
    __syncthreads();
    { unsigned off = 0u; for (int w = 0; w < wave; ++w) off += wtot[w]; incl += off; }
    const unsigned excl = incl - cnt; int pg = (int)(excl & 0xffffu), pe = (int)(excl >> 16);
    if (base < N) {
#pragma unroll
        for (int q = 0; q < EPT; ++q) { const unsigned k = keys[base + q]; int slot = -1;
            if (k > T) slot = pg++; else if (k == T) { if (pe < (int)kneed) slot = cgt + pe; ++pe; }
            const int R = R0 + base + q; inv[(size_t)R * 16 + e] = slot < 0 ? -1 : slot0 + slot;
            if (slot >= 0) rowidx[e * RPE + slot0 + slot] = R; } }
    __syncthreads();
}
__device__ __forceinline__ void topk_phase(Frame& F, int l) {
    if (l == 0) { int* rowidx = (int*)(F.ws + WS_ROWIDX);
        if (blockIdx.x < 6) { const int i = blockIdx.x * 512 + F.tid; rowidx[(i / 192) * RPE + 2112 + (i % 192)] = 0; } }
    const int njobs = (l == 0) ? 64 : 32;
    for (int job = blockIdx.x; job < njobs; job += F.G) {
        if (job < 32) { const int b = job >> 4, e = job & 15; topk_list<SEQ, 1024>(F, b * SB + CTX, e, b * 1024); }
        else { const int j = job - 32, b = j >> 4, e = j & 15; topk_list<CTX, 32>(F, b * SB, e, 2048 + b * 32); }
    }
}
__device__ __forceinline__ void gather_phase(Frame& F, int l) {
    const int lane = F.lane, gw = F.vcu * NWAVES + F.wave, NGW = F.G * NWAVES; const int nrows = (l == 0) ? 2112 : 2048;
    const int* rowidx = (const int*)(F.ws + WS_ROWIDX); const bf16* h2 = (const bf16*)(F.ws + WS_H1); bf16* xg = (bf16*)(F.ws + WS_XG);
    for (int g = gw; g < NE * nrows; g += NGW) { const int e = g / nrows, slot = g - e * nrows; const int R = rowidx[e * RPE + slot];
        const v4u* src = (const v4u*)(h2 + (size_t)R * DM); v4u* dst = (v4u*)(xg + ((size_t)e * RPE + slot) * DM);
        const v4u a = src[lane], c = src[64 + lane]; dst[lane] = a; dst[64 + lane] = c; }
}
#ifndef MOE_BAUX
#define MOE_BAUX 0
#endif

struct Args { const float* in[26]; float* out; unsigned char* ws; int ph_lo, ph_hi, li, pad; };
__global__ void __launch_bounds__(NWAVES * 64, 2) fwd(Args args) {
    extern __shared__ __attribute__((aligned(16))) unsigned char lds[];
    Frame F;
    F.lds = (LAS unsigned char*)lds; F.MISC = (volatile LAS unsigned*)(F.lds + MISC_OFF);
    F.tid = threadIdx.x; F.lane = F.tid & 63; F.wave = __builtin_amdgcn_readfirstlane(F.tid >> 6);
    const int wv0 = F.wave;
    F.G = gridDim.x; { const int bx = blockIdx.x; F.vcu = (F.G % 8 == 0) ? (bx % 8) * (F.G / 8) + bx / 8 : bx; }
    int vcu0 = F.vcu; F.reg = 0; int reg0 = 0;
    F.ws = (unsigned char*)(GAS unsigned char*)args.ws; F.out = (float*)(GAS float*)args.out; F.ctl = (unsigned*)(GAS unsigned*)(args.ws + WS_CTL);
    F.in = args.in;
    if (F.tid < 64) F.MISC[F.tid] = 0u;
    __syncthreads();
    XcdBarrier bar = xcd_barrier_post(F.ctl + CW_BAR + args.li * XCD_BAR_WORDS, F.MISC + 8);
    const int lo = args.ph_lo, hi = args.ph_hi;
#ifndef PH_EN
#define PH_EN 0xFFFF
#endif
#define IN(k) (lo <= (k) && (k) < hi)
#define INT(k, t) ((((PH_EN) >> (t)) & 1) && IN(k))
#ifndef REP_MASK
#define REP_MASK 0
#endif
#define REPS(t) (1 + (((REP_MASK) >> (t)) & 1))
#define RETID() do { int wq_ = wv0; asm volatile("" : "+s"(wq_)); int ln_; asm volatile("v_mbcnt_lo_u32_b32 %0, -1, 0\n\tv_mbcnt_hi_u32_b32 %0, -1, %0" : "=v"(ln_)); int t_ = wq_ * 64 + ln_; F.tid = t_; F.lane = t_ & 63; F.wave = __builtin_amdgcn_readfirstlane(t_ >> 6); unsigned long long w_ = (unsigned long long)args.ws; asm volatile("" : "+s"(w_)); F.ws = (unsigned char*)(GAS unsigned char*)w_; int v_ = vcu0; asm volatile("" : "+s"(v_)); F.vcu = v_; int r_ = reg0; asm volatile("" : "+s"(r_)); F.reg = r_; } while (0)
#ifndef BAR_REP
#define BAR_REP 1
#endif
#ifndef PROBE_T
#define PROBE_T -1
#endif
#ifndef PROBE_A
#define PROBE_A 8
#endif
#ifndef PROBE_L
#define PROBE_L -1
#endif
#define PH_T0(t) unsigned long long pt0_ = 0; if ((t) == PROBE_T) pt0_ = __builtin_amdgcn_s_memrealtime();
#define PH_T1(t) do { if ((t) == PROBE_T && (PROBE_L < 0 || PROBE_L == pl_)) { __syncthreads(); const unsigned long long e_ = __builtin_amdgcn_s_memrealtime(); const unsigned long long w_ = (e_ - pt0_) * PROBE_A; while (__builtin_amdgcn_s_memrealtime() - e_ < w_) __builtin_amdgcn_s_sleep(8); } } while (0)
#define SEAM(k) do { if (IN(k) && IN((k) + 1)) { for (int br = 0; br < BAR_REP; ++br) xcd_barrier(bar); } } while (0)
#ifndef LBAR_REP
#define LBAR_REP 1
#endif
#ifndef LOCAL_SEAMS
#define LOCAL_SEAMS 1
#endif
#define LSEAM(k) do { if (IN(k) && IN((k) + 1)) { if (reg0) { for (int br = 0; br < LBAR_REP; ++br) xcd_local_barrier(bar); } else xcd_barrier(bar); } } while (0)
#define h1 ((bf16*)(F.ws + WS_H1))
#define z ((bf16*)(F.ws + WS_Z))
#define xg ((bf16*)(F.ws + WS_XG))
#define hid ((bf16*)(F.ws + WS_HID))

    int pl_ = 0; (void)pl_;
    if (INT(0, 0)) { PH_T0(0); for (int rep = 0; rep < REPS(0); ++rep) { RETID(); ph0(F); if (REPS(0) > 1) __syncthreads(); } PH_T1(0); SEAM(0); }
    if (LOCAL_SEAMS && IN(0) && IN(1) && F.G == 256) {
        if (threadIdx.x == 0) { const bool rg = xcd_grid_regular(bar); F.MISC[12] = rg ? 1u : 0u; F.MISC[13] = bar.x * 32u + F.MISC[10]; }
        __syncthreads();
        reg0 = __builtin_amdgcn_readfirstlane((int)F.MISC[12]); if (reg0) vcu0 = __builtin_amdgcn_readfirstlane((int)F.MISC[13]);
    }
    for (int l = 0; l < 2; ++l) {
        const int pb = 1 + 13 * l; pl_ = l;
        if (INT(pb + 0, 1)) { PH_T0(1); for (int rep = 0; rep < REPS(1); ++rep) { RETID(); if (l == 0) norm_phase<0>(F); else norm_phase<1>(F); } PH_T1(1); LSEAM(pb + 0); }
        if (INT(pb + 1, 2)) { PH_T0(2); for (int rep = 0; rep < REPS(2); ++rep) { RETID();
            pg8::Gemm g{h1, (const bf16*)(F.ws + WS_WIN) + (size_t)l * 1536 * 1024, 1024, 1024, nullptr}; pg8::GroupOrder S; const int gq = F.vcu >> 5, gj = F.vcu & 31; if (F.reg) S.init(6, grp_p0(gq), grp_np(gq), 32, gj, false); else S.init(6, 0, 66, F.G, F.vcu, false);
            pg8::EpiStore E{z, ZW, 6};
            pg8::gemm_phase<pg8::EpiStore, pg8::GroupOrder, true, true>(F.lds, g, S, E, F.tid);
            if (USE_WIN && rep == 0 && F.G == 256) {
                const int n2 = 6 * grp_np(gq) - 32; const int wr = F.reg ? (gj >= n2 ? (gq < 2 ? 10 * gq : 20 + 16 * (gq - 2)) + gj - n2 : -1) : F.vcu - 140;
                if (wr >= 0) { RETID(); conv_window(F, l, l == 0 ? BASE_IN0 : BASE_IN1, wr, WIN_IN_NB, WIN_IN_IPW); } }
            } PH_T1(2); LSEAM(pb + 1); }
        if (INT(pb + 2, 3)) { PH_T0(3); for (int rep = 0; rep < REPS(3); ++rep) { RETID(); prep_phase(F, l); } PH_T1(3); LSEAM(pb + 2); }
        if (INT(pb + 3, 4)) { PH_T0(4); for (int rep = 0; rep < REPS(4); ++rep) { RETID();
            { pg8::Gemm g{z + ZQ, (const bf16*)(F.ws + WS_WUQ) + (size_t)l * 768 * 256, 256, ZW, nullptr}; pg8::GroupOrder S; const int gq = F.vcu >> 5, gj = F.vcu & 31; if (F.reg) S.init(3, grp_p0(gq), grp_np(gq), 32, (gj + 3 * grp_np(gq)) & 31, false); else S.init(3, 0, 66, F.G, F.G == 256 ? ((F.vcu + 198) & 255) : F.vcu, false);
              pg8::EpiStore E{(bf16*)(F.ws + WS_QM), QW, 3};
              pg8::gemm_phase<pg8::EpiStore, pg8::GroupOrder, true, true>(F.lds, g, S, E, F.tid); }
            RETID();
            { pg8::Gemm g{z + ZKV, (const bf16*)(F.ws + WS_WUKV) + (size_t)l * 1024 * 128, 128, ZW, nullptr}; pg8::GroupOrder S; const int gq = F.vcu >> 5, gj = F.vcu & 31; if (F.reg) S.init(4, grp_p0(gq), grp_np(gq), 32, gj, false); else S.init(4, 0, 66, F.G, F.vcu, false);
              pg8::EpiStore E{(bf16*)(F.ws + WS_KVM), KVW, 4};
              pg8::gemm_phase<pg8::EpiStore, pg8::GroupOrder, true, true>(F.lds, g, S, E, F.tid); }
            } PH_T1(4); if (IN(pb + 3) && IN(pb + 5)) xcd_barrier(bar); }
        if (INT(pb + 5, 6)) { PH_T0(6); for (int rep = 0; rep < REPS(6); ++rep) { RETID(); convmix_phase(F, l); RETID(); attn_phase(F, l, (char*)lds);
            if (USE_WIN && rep == 0 && l == 0 && F.G == 256 && F.vcu >= 16) { RETID(); conv_window(F, 0, BASE_AT0, F.vcu - 16, WIN_AT_NB, WIN_AT_IPW); } } PH_T1(6); SEAM(pb + 5); }
        if (INT(pb + 6, 7)) { PH_T0(7); for (int rep = 0; rep < REPS(7); ++rep) { RETID(); gnorm_phase(F, l); } PH_T1(7); LSEAM(pb + 6); }
        if (INT(pb + 7, 8)) { PH_T0(8); for (int rep = 0; rep < REPS(8); ++rep) { RETID();
            pg8::Gemm g{h1, (const bf16*)(F.ws + WS_WOUT) + (size_t)l * 1024 * 1024, 1024, 1024, nullptr}; pg8::GroupOrder S; const int gq = F.vcu >> 5, gj = F.vcu & 31; if (F.reg) { if (l == 1) S.init(4, 8 * gq, 8, 32, gj, true); else S.init(4, grp_p0(gq), grp_np(gq), 32, gj, false); } else S.init(4, 0, l == 1 ? 64 : 66, F.G, F.vcu, l == 1);
            pg8::EpiRes E{gin(F, I_X), gin(F, I_CTX), (void*)(F.ws + WS_XRES), (const float*)(F.ws + WS_MOD) + (size_t)l * 3 * 6144 + 2048, l};
            pg8::gemm_phase<pg8::EpiRes, pg8::GroupOrder, true, true>(F.lds, g, S, E, F.tid);
            if (USE_WIN && rep == 0 && l == 0 && F.G == 256) {
                const int n2 = 4 * grp_np(gq) - 32; const int wr = F.reg ? (gj >= n2 ? (gq < 2 ? 28 * gq : 56 + 32 * (gq - 2)) + gj - n2 : -1) : F.vcu - 8;
                if (wr >= 0) { RETID(); conv_window(F, 0, BASE_OUT0, wr, WIN_OUT_NB, WIN_OUT_IPW); } }
            } PH_T1(8); LSEAM(pb + 7); }
        if (INT(pb + 8, 9)) { PH_T0(9); for (int rep = 0; rep < REPS(9); ++rep) { RETID(); router_phase(F, l); } PH_T1(9); SEAM(pb + 8); }
        if (INT(pb + 9, 10)) { PH_T0(10); for (int rep = 0; rep < REPS(10); ++rep) { RETID(); topk_phase(F, l);
            if (USE_WIN && rep == 0 && F.G == 256) { const int nj = (l == 0) ? 64 : 32; if ((int)blockIdx.x >= nj) conv_window(F, l, l == 0 ? BASE_TK0 : BASE_TK1, (int)blockIdx.x - nj, 256 - nj, WIN_TK_IPW); }
            } PH_T1(10); if (IN(pb + 9) && IN(pb + 11)) xcd_barrier(bar); }
        if (INT(pb + 11, 12)) { PH_T0(12); for (int rep = 0; rep < REPS(12); ++rep) { RETID();
            pg8::Gemm g{h1, (const bf16*)(F.ws + WS_W13) + (size_t)l * 16 * 5376 * 1024, 1024, 1024, (const int*)(F.ws + WS_ROWIDX), 64, 0u, 32768u, 0u, 16u * 32768u};         pg8::MoeOrder S; S.init(l == 0 ? 9 : 8, 21, F.G, F.vcu);
            pg8::EpiSwiglu E{hid};
            pg8::gemm_phase<pg8::EpiSwiglu, pg8::MoeOrder, true, true, true, MOE_BAUX>(F.lds, g, S, E, F.tid);
            if (USE_WIN && rep == 0 && F.G == 256) { const int j = F.vcu & 31, j0 = (l == 0) ? 26 : 16;
                if (j >= j0) { RETID(); if (MOE_LSEAM) conv_window_blocked(F, l, l == 0 ? BASE_M10 : BASE_M11, (F.vcu >> 5) * (32 - j0) + j - j0, WIN_M1_IPW); else conv_window(F, l, l == 0 ? BASE_M10 : BASE_M11, (F.vcu >> 5) * (32 - j0) + j - j0, l == 0 ? WIN_M10_NB : WIN_M11_NB, WIN_M1_IPW); } }
            } PH_T1(12); if (MOE_LSEAM) LSEAM(pb + 11); else SEAM(pb + 11); }
        if (INT(pb + 12, 13)) { PH_T0(13); for (int rep = 0; rep < REPS(13); ++rep) { RETID();
            pg8::Gemm g{hid, (const bf16*)(F.ws + WS_W2) + (size_t)l * 16 * 1024 * FF, FF, 64, nullptr, 64, 32768u, 32768u, 42u * 32768u, 42u * 32768u};     pg8::MoeOrder S; S.init(l == 0 ? 9 : 8, 4, F.G, F.vcu);
            pg8::EpiStore E{xg, DM, 4};
#ifndef MOE2_XP
#define MOE2_XP 0
#endif
            pg8::gemm_phase<pg8::EpiStore, pg8::MoeOrder, true, true, false, MOE_BAUX>(F.lds, g, S, E, F.tid);
            if (USE_WIN && rep == 0 && l == 0 && F.G == 256 && (F.vcu & 31) >= 8) { RETID(); conv_window(F, 1, BASE_M2, (F.vcu >> 5) * 24 + (F.vcu & 31) - 8, WIN_M2_NB, WIN_M2_IPW); }
            if (REPS(13) > 1) __syncthreads();
            } PH_T1(13); SEAM(pb + 12); }
    }
    if (INT(27, 14)) { PH_T0(14); for (int rep = 0; rep < REPS(14); ++rep) { RETID(); norm_phase<2>(F); } PH_T1(14); }
#undef h1
#undef z
#undef xg
#undef hid
#undef IN
#undef INT
#undef REPS
#undef SEAM
}

#ifndef MK_MULTI
#define MK_MULTI 0
#endif
extern "C" void kernel_launch(void* const* d_in, const int* in_sizes, int n_in, void* d_out, int out_size, void* d_ws, size_t ws_size, hipStream_t stream) {
    static int grid = 0;
    if (grid == 0) {
        if (n_in != 26 || in_sizes[0] != NB * SEQ * DM || out_size != NB * SEQ * DM || ws_size < WS_END) { fprintf(stderr, "kernel_launch: shape / workspace mismatch (n_in %d, ws %zu)\n", n_in, ws_size); grid = -1; return; }
        int dev = 0, cus = 0, per_cu = 0;
        if (hipGetDevice(&dev) != hipSuccess || hipDeviceGetAttribute(&cus, hipDeviceAttributeMultiprocessorCount, dev) != hipSuccess) { grid = -1; return; }
        if (hipFuncSetAttribute((const void*)fwd, hipFuncAttributeMaxDynamicSharedMemorySize, LDS_BYTES) != hipSuccess) { fprintf(stderr, "kernel_launch: hipFuncSetAttribute failed\n"); grid = -1; return; }
        if (hipOccupancyMaxActiveBlocksPerMultiprocessor(&per_cu, (const void*)fwd, NWAVES * 64, LDS_BYTES) != hipSuccess || per_cu < 1) { fprintf(stderr, "kernel_launch: occupancy query reports %d\n", per_cu); (void)hipGetLastError(); per_cu = 1; }
        grid = cus;
    }
    if (grid < 0) return;
    if (hipMemsetAsync((char*)d_ws + WS_CTL, 0, CTL_ZERO_BYTES, stream) != hipSuccess) return;
    Args a{};
    for (int i = 0; i < 26; ++i) a.in[i] = (const float*)d_in[i];
    a.out = (float*)d_out; a.ws = (unsigned char*)d_ws; a.pad = 0;
#if MK_MULTI
    for (int p = 0; p < NPHASE; ++p) { a.ph_lo = p; a.ph_hi = p + 1; a.li = p; hipLaunchKernelGGL(fwd, dim3(grid), dim3(NWAVES * 64), LDS_BYTES, stream, a); }
#else
    a.ph_lo = 0; a.ph_hi = NPHASE; a.li = 0;
    hipLaunchKernelGGL(fwd, dim3(grid), dim3(NWAVES * 64), LDS_BYTES, stream, a);
#endif
    const hipError_t le = hipPeekAtLastError();
    if (le != hipSuccess) fprintf(stderr, "kernel_launch: launch failed: %s\n", hipGetErrorName(le));
}
```

```cpp
#include <hip/hip_runtime.h>
#include <cstdio>
#include <cstdint>

#define GAS __attribute__((address_space(1)))
#define LAS __attribute__((address_space(3)))
typedef unsigned short bf16;
typedef unsigned v4u __attribute__((ext_vector_type(4)));
typedef unsigned v2u __attribute__((ext_vector_type(2)));
typedef float f32x4 __attribute__((ext_vector_type(4)));
typedef float f32x2 __attribute__((ext_vector_type(2)));
typedef short bf16x8 __attribute__((ext_vector_type(8)));
typedef short s16x4 __attribute__((ext_vector_type(4)));
typedef float f32x16 __attribute__((ext_vector_type(16)));
#define LDS_WAIT() asm volatile("s_waitcnt lgkmcnt(0)" ::: "memory")
#define VM_WAIT() asm volatile("s_waitcnt vmcnt(0)" ::: "memory")

constexpr int DM = 1024, SEQ = 8192, CTX = 256, NB = 2, SB = SEQ + CTX, M = NB * SB, NPM = M / 256, PPB = SB / 256;
constexpr int ZW = 1536, QW = 768, KVW = 1024, OW = 768, FF = 2688, NE = 16, RPE = 2304;
constexpr int ZQ = 0, ZKV = 256, ZKR = 384, ZGQ = 416, ZGK = 672, ZGV = 800, ZCA = 928, ZCB = 1184;
constexpr float EPS = 1e-6f;
constexpr float LOG2E = 1.4426950408889634f;
constexpr float C_MLA = 0.10206207261596575f * LOG2E, C_GQA = 0.125f * LOG2E;

__device__ __forceinline__ unsigned f2bf(float f) { unsigned u = __builtin_bit_cast(unsigned, f); return (u + 0x7fffu + ((u >> 16) & 1u)) >> 16; }
__device__ __forceinline__ unsigned pk2(float lo, float hi) { unsigned r; asm volatile("v_cvt_pk_bf16_f32 %0, %1, %2" : "=v"(r) : "v"(lo), "v"(hi)); return r; }
__device__ __forceinline__ float bf2f(unsigned short h) { return __builtin_bit_cast(float, (unsigned)h << 16); }
__device__ __forceinline__ float bflo(unsigned w) { return __builtin_bit_cast(float, w << 16); }
__device__ __forceinline__ float bfhi(unsigned w) { return __builtin_bit_cast(float, w & 0xffff0000u); }
#ifndef OLD_SX
#define OLD_SX 0
#endif
#ifndef OLD_SCAN
#define OLD_SCAN 0
#endif
template <int X> __device__ __forceinline__ float sx(float v) { if (OLD_SX) return __shfl_xor(v, X); return __builtin_bit_cast(float, __builtin_amdgcn_ds_swizzle(__builtin_bit_cast(int, v), (X << 10) | 0x1f)); }
#ifndef OLD_S32
#define OLD_S32 OLD_SX
#endif
__device__ __forceinline__ float sum32(float v) {
    if (OLD_S32) return v + __shfl_xor(v, 32);
    float a_ = v, b_ = v; asm volatile("s_nop 1\n\tv_permlane32_swap_b32 %0, %1" : "+v"(a_), "+v"(b_)); return a_ + b_; }
__device__ __forceinline__ float wave_sum(float v) { v += sx<1>(v); v += sx<2>(v); v += sx<4>(v); v += sx<8>(v); v += sx<16>(v); return sum32(v); }
template <int N> __device__ __forceinline__ void wave_sum_n(float (&v)[N]) {
    float t[N];
#define WS_STEP(X) _Pragma("unroll") for (int i = 0; i < N; ++i) t[i] = sx<X>(v[i]); _Pragma("unroll") for (int i = 0; i < N; ++i) v[i] += t[i];
    WS_STEP(1) WS_STEP(2) WS_STEP(4) WS_STEP(8) WS_STEP(16)
#undef WS_STEP
#pragma unroll
    for (int i = 0; i < N; ++i) v[i] = sum32(v[i]);
}
template <int N> __device__ __forceinline__ void half_sum_n(float (&v)[N]) {
    float t[N];
#define WS_STEP(X) _Pragma("unroll") for (int i = 0; i < N; ++i) t[i] = sx<X>(v[i]); _Pragma("unroll") for (int i = 0; i < N; ++i) v[i] += t[i];
    WS_STEP(1) WS_STEP(2) WS_STEP(4) WS_STEP(8) WS_STEP(16)
#undef WS_STEP
}
__device__ __forceinline__ unsigned wave_scan_incl(unsigned v, int lane) {
    if (OLD_SCAN) { for (int o = 1; o < 64; o <<= 1) { const unsigned n = __shfl_up(v, o); if (lane >= o) v += n; } return v; }
    v += (unsigned)__builtin_amdgcn_update_dpp(0, (int)v, 0x111, 0xf, 0xf, false);
    v += (unsigned)__builtin_amdgcn_update_dpp(0, (int)v, 0x112, 0xf, 0xf, false);
    v += (unsigned)__builtin_amdgcn_update_dpp(0, (int)v, 0x114, 0xf, 0xf, false);
    v += (unsigned)__builtin_amdgcn_update_dpp(0, (int)v, 0x118, 0xf, 0xf, false);
    const unsigned s0 = __builtin_amdgcn_readlane(v, 15), s1 = __builtin_amdgcn_readlane(v, 31), s2 = __builtin_amdgcn_readlane(v, 47);
    return v + (lane >= 16 ? s0 : 0u) + (lane >= 32 ? s1 : 0u) + (lane >= 48 ? s2 : 0u);
}
__device__ __forceinline__ float sigmoidf_(float v) { return 1.f / (1.f + __expf(-v)); }

namespace pg8 {
#define PG8_LAS __attribute__((address_space(3)))
typedef unsigned short bf16_t;
typedef short bf16x8 __attribute__((ext_vector_type(8)));
typedef float f32x4 __attribute__((ext_vector_type(4)));
typedef unsigned u32x4 __attribute__((ext_vector_type(4)));
constexpr int BM = 256, BK = 64, HALF = 128, HTB = HALF * BK * 2  , STAGE_BYTES = 8 * HTB;

__host__ __device__ __forceinline__ int lds_byte(int r, int c) { const int st = (r >> 4) * 2 + (c >> 5), rr = r & 15, cc = c & 31, ob = rr * 64 + cc * 2; return st * 1024 + (ob ^ (((ob >> 9) & 1) << 5)); }
__host__ __device__ __forceinline__ void stage_rc(int b, int& R, int& C) { const int st = b / 1024, sb = b % 1024, swz = sb ^ (((sb >> 9) & 1) << 5); R = (st >> 1) * 16 + swz / 64; C = (st & 1) * 32 + (swz % 64) / 2; }
__host__ __device__ __forceinline__ int perm32(int rho) { const int n = rho >> 4, i = rho & 15; return 8 * (i >> 2) + 4 * n + (i & 3); }

struct Unit { int pm, pn; };
struct Gemm { const bf16_t* A; const bf16_t* Bt; int K, lda; const int* gidx; int ldb = 0;   unsigned kstepA = 0, kstepB = 0, pstepA = 0, pstepB = 0;   };


__device__ __forceinline__ void tile_of(int L, int nM, int nN, int& pm, int& pn) {
    const int nig = 8 * nN, gid = L / nig, fm = gid * 8, gsz = (nM - fm) < 8 ? (nM - fm) : 8, r = L % nig;
    pm = fm + r % gsz; pn = r / gsz;
}
struct RowOrder {
    int nM, nN, nwg, G, c; bool skip;
    __device__ __forceinline__ void init(int nN_, int G_, int c_, bool skip_ctx) { skip = skip_ctx; nM = skip_ctx ? 64 : 66; nN = nN_; nwg = nM * nN; G = G_; c = c_; }
    __device__ __forceinline__ bool next(int i, Unit& u) const {
        const int L = i * G + c; if (L >= nwg) return false;
        int pm, pn; tile_of(L, nM, nN, pm, pn);
        u.pm = skip ? pm + 1 + (pm >> 5) : pm; u.pn = pn; return true;
    }
    __device__ __forceinline__ void a_ready(const Unit&) const {}
    __device__ __forceinline__ void done(const Unit&) const {}
};
struct GroupOrder {
    int p0, np, nN, cpg, j; bool skip;
    __device__ __forceinline__ void init(int nN_, int p0_, int np_, int cpg_, int j_, bool skip_ctx) { nN = nN_; p0 = p0_; np = np_; cpg = cpg_; j = j_; skip = skip_ctx; }
    __device__ __forceinline__ bool next(int i, Unit& u) const {
        const int q = i * cpg + j; if (q >= np * nN || j >= cpg) return false;
        const int lp = p0 + q % np; u.pm = skip ? lp + 1 + (lp >> 5) : lp; u.pn = q / np; return true;
    }
    __device__ __forceinline__ void a_ready(const Unit&) const {}
    __device__ __forceinline__ void done(const Unit&) const {}
};
struct MoeOrder {
    int nMe, nNe, per, cpg, grp, j, epg;
    __device__ __forceinline__ void init(int nMe_, int nNe_, int G, int vcu) {
        nMe = nMe_; nNe = nNe_; per = nMe * nNe; const int ngrp = (G % 8 == 0) ? 8 : 1; cpg = G / ngrp; grp = vcu / cpg; j = vcu % cpg; epg = 16 / ngrp;
    }
    __device__ __forceinline__ bool next(int i, Unit& u) const {
        const int q = i * cpg + j; if (q >= epg * per) return false;
        const int e = grp * epg + q / per, r = q % per; u.pm = e * 9 + r % nMe; u.pn = e * nNe + r / nMe; return true;
    }
    __device__ __forceinline__ void a_ready(const Unit&) const {}
    __device__ __forceinline__ void done(const Unit&) const {}
};

#ifndef WT_STORES
#define WT_STORES 0
#endif
__device__ __forceinline__ void st16(void* p, u32x4 v) {
    if (WT_STORES == 1) asm volatile("global_store_dwordx4 %0, %1, off sc1\n\ts_nop 1" :: "v"(p), "v"(v) : "memory");     else if (WT_STORES == 2) __builtin_nontemporal_store(v, (u32x4*)p); else *(u32x4*)p = v; }
struct EpiStore {
    static constexpr bool PERM = true, AFTER_DRAIN = false;
    bf16_t* O; int ldc; int nNloc;
    __device__ __forceinline__ void operator()(const f32x4 (&acc)[2][2][4][2], const Unit& u, int wr, int wc, int fr, int fq) const {
        const int row0 = u.pm * BM + wr * 64 + fr, col0 = (u.pn % nNloc) * BM + wc * 32 + 8 * fq;
#pragma unroll
        for (int ai = 0; ai < 2; ++ai)
#pragma unroll
            for (int m = 0; m < 4; ++m) { bf16_t* rowp = O + (size_t)(row0 + ai * HALF + m * 16) * ldc + col0;
#pragma unroll
                for (int bj = 0; bj < 2; ++bj) { const f32x4 v0 = acc[ai][bj][m][0], v1 = acc[ai][bj][m][1];
                    u32x4 w; w.x = pk2(v0[0], v0[1]); w.y = pk2(v0[2], v0[3]); w.z = pk2(v1[0], v1[1]); w.w = pk2(v1[2], v1[3]);
                    st16(rowp + bj * HALF, w); } }
    }
};
struct EpiQ {
    static constexpr bool PERM = true, AFTER_DRAIN = false;
    bf16_t* O; const float* cosM; const float* sinM;
    __device__ __forceinline__ void operator()(const f32x4 (&acc)[2][2][4][2], const Unit& u, int wr, int wc, int fr, int fq) const {
        const int row0 = u.pm * BM + wr * 64 + fr, col0 = u.pn * BM + wc * 32 + 8 * fq;
        const int pb = u.pm % PPB; const bool lat = pb != 0; const int t0 = (pb - 1) * 256 + wr * 64 + fr;
#pragma unroll
        for (int ai = 0; ai < 2; ++ai)
#pragma unroll
            for (int m = 0; m < 4; ++m) { bf16_t* rowp = O + (size_t)(row0 + ai * HALF + m * 16) * QW + col0; const int t = t0 + ai * HALF + m * 16;
#pragma unroll
                for (int bj = 0; bj < 2; ++bj) { f32x4 v0 = acc[ai][bj][m][0], v1 = acc[ai][bj][m][1];
                    const int g32 = u.pn * 8 + bj * 4 + wc;
                    if (lat && (g32 % 3) == 2) {
                        const f32x4 c = *(const f32x4*)(cosM + (size_t)t * 16 + 4 * fq), s = *(const f32x4*)(sinM + (size_t)t * 16 + 4 * fq);
                        const f32x4 a0 = v0, a1 = v1;
                        v0[0] = a0[0] * c[0] - a0[1] * s[0]; v0[1] = a0[1] * c[0] + a0[0] * s[0]; v0[2] = a0[2] * c[1] - a0[3] * s[1]; v0[3] = a0[3] * c[1] + a0[2] * s[1];
                        v1[0] = a1[0] * c[2] - a1[1] * s[2]; v1[1] = a1[1] * c[2] + a1[0] * s[2]; v1[2] = a1[2] * c[3] - a1[3] * s[3]; v1[3] = a1[3] * c[3] + a1[2] * s[3];
                    }
                    u32x4 w; w.x = pk2(v0[0], v0[1]); w.y = pk2(v0[2], v0[3]); w.z = pk2(v1[0], v1[1]); w.w = pk2(v1[2], v1[3]);
                    *(u32x4*)(rowp + bj * HALF) = w; } }
    }
};
#ifndef XRES_BF16
#define XRES_BF16 1
#endif
struct EpiRes {
    static constexpr bool PERM = true, AFTER_DRAIN = false;
    const float* xin; const float* cin; void* xres; const float* gate; int layer;
    __device__ __forceinline__ void operator()(const f32x4 (&acc)[2][2][4][2], const Unit& u, int wr, int wc, int fr, int fq) const {
        const int b = u.pm / PPB, pb = u.pm % PPB, mv = pb == 0 ? 2 : b;
        const int col0 = u.pn * BM + wc * 32 + 8 * fq; const float* gp = gate + mv * 6144 + col0;
        f32x4 gv[2][2];
#pragma unroll
        for (int bj = 0; bj < 2; ++bj)
#pragma unroll
            for (int n = 0; n < 2; ++n) gv[bj][n] = *(const f32x4*)(gp + bj * HALF + 4 * n);
#pragma unroll
        for (int ai = 0; ai < 2; ++ai)
#pragma unroll
            for (int m = 0; m < 4; ++m) { const int rl = ai * HALF + wr * 64 + m * 16 + fr; const size_t R = (size_t)u.pm * BM + rl;
                const float* sp = (pb == 0 ? cin + ((size_t)b * CTX + rl) * DM : xin + ((size_t)b * SEQ + (pb - 1) * 256 + rl) * DM) + col0;
#pragma unroll
                for (int bj = 0; bj < 2; ++bj) { f32x4 x0, x1;
                    if (layer == 0) { x0 = *(const f32x4*)(sp + bj * HALF); x1 = *(const f32x4*)(sp + bj * HALF + 4); }
                    else if (XRES_BF16) { const u32x4 w = *(const u32x4*)((const bf16_t*)xres + R * DM + col0 + bj * HALF);
                        x0 = (f32x4){bflo(w.x), bfhi(w.x), bflo(w.y), bfhi(w.y)}; x1 = (f32x4){bflo(w.z), bfhi(w.z), bflo(w.w), bfhi(w.w)}; }
                    else { const float* xp = (const float*)xres + R * DM + col0 + bj * HALF; x0 = *(const f32x4*)xp; x1 = *(const f32x4*)(xp + 4); }
                    const f32x4 o0 = x0 + gv[bj][0] * acc[ai][bj][m][0], o1 = x1 + gv[bj][1] * acc[ai][bj][m][1];
                    if (XRES_BF16) { u32x4 w; w.x = pk2(o0[0], o0[1]); w.y = pk2(o0[2], o0[3]); w.z = pk2(o1[0], o1[1]); w.w = pk2(o1[2], o1[3]); *(u32x4*)((bf16_t*)xres + R * DM + col0 + bj * HALF) = w; }
                    else { float* op = (float*)xres + R * DM + col0 + bj * HALF; *(f32x4*)op = o0; *(f32x4*)(op + 4) = o1; } } }
    }
};
struct EpiSwiglu {
    static constexpr bool PERM = true, AFTER_DRAIN = false;
    bf16_t* H;
    __device__ __forceinline__ void operator()(const f32x4 (&acc)[2][2][4][2], const Unit& u, int wr, int wc, int fr, int fq) const {
        const int r0 = wr * 64 + fr, kt = (u.pn % 21) * 2 + (wc >> 1), c0 = (wc & 1) * 32 + 8 * fq;
        bf16_t* const blk = H + ((size_t)u.pm * 42 + kt) * (BM * 64) + c0;
#pragma unroll
        for (int ai = 0; ai < 2; ++ai)
#pragma unroll
            for (int m = 0; m < 4; ++m) { bf16_t* rowp = blk + (r0 + ai * HALF + m * 16) * 64;
                float h[8];
#pragma unroll
                for (int n = 0; n < 2; ++n)
#pragma unroll
                    for (int i = 0; i < 4; i += 2) { const f32x2 a = {acc[ai][0][m][n][i], acc[ai][0][m][n][i + 1]}, b = {acc[ai][1][m][n][i], acc[ai][1][m][n][i + 1]};
                        const f32x2 t = a * (-LOG2E); f32x2 d = {__builtin_amdgcn_exp2f(t.x), __builtin_amdgcn_exp2f(t.y)}; d = d + 1.0f;
                        const f32x2 r = {__builtin_amdgcn_rcpf(d.x), __builtin_amdgcn_rcpf(d.y)}; const f32x2 o = (a * b) * r; h[n * 4 + i] = o.x; h[n * 4 + i + 1] = o.y; }
                u32x4 w; w.x = pk2(h[0], h[1]); w.y = pk2(h[2], h[3]); w.z = pk2(h[4], h[5]); w.w = pk2(h[6], h[7]);
                st16(rowp, w); }
    }
};

template <class Epi, class Sched, bool ALIGN_EPI = false, bool SP2 = false, bool GATHER = false, int BAUX = 0>
__device__ __forceinline__ void gemm_phase(PG8_LAS unsigned char* lds, const Gemm g, const Sched& S, const Epi& E, const int tid_in) {
    int tid_ = tid_in; asm volatile("" : "+v"(tid_));
    const int tid = tid_, wid = __builtin_amdgcn_readfirstlane(tid >> 6), lane = tid & 63, wr = wid >> 2, wc = wid & 3, fr = lane & 15, fq = lane >> 4;
    int K_ = g.K; asm volatile("" : "+s"(K_));
    const int K = K_, nt = K / BK; int ldb_ = g.ldb ? g.ldb : K_; asm volatile("" : "+s"(ldb_)); const int LDB = ldb_;
    unsigned voffA[2], voffB[2]; int gR[2]; unsigned gC[2];
#pragma unroll
    for (int i = 0; i < 2; ++i) { int R, C; stage_rc(tid * 16 + i * 8192, R, C); const int Rb = Epi::PERM ? ((R & ~31) + perm32(R & 31)) : R;
        voffA[i] = (unsigned)(R * g.lda + C) * 2u; voffB[i] = (unsigned)(Rb * LDB + C) * 2u; gR[i] = R; gC[i] = (unsigned)C * 2u; }
    unsigned vC[2][2], vN[2][2];
#define PG8_GIDX(dst, U) do { _Pragma("unroll") for (int h_ = 0; h_ < 2; ++h_) _Pragma("unroll") for (int i_ = 0; i_ < 2; ++i_) \
        dst[h_][i_] = (unsigned)g.gidx[(U).pm * BM + h_ * HALF + gR[i_]] * (unsigned)(g.lda * 2) + gC[i_]; } while (0)
#define PG8_STGA(bufoff, kptr, h, USEN) do { if constexpr (GATHER) { const unsigned vsel_[2] = {(USEN) ? vN[h][0] : vC[h][0], (USEN) ? vN[h][1] : vC[h][1]}; PG8_STAGE(bufoff, kptr, vsel_); } \
        else { PG8_STAGE(bufoff, (kptr) + (h) * hstepA, voffA); } } while (0)
    unsigned ksa_ = g.kstepA ? g.kstepA : (unsigned)(BK * 2), ksb_ = g.kstepB ? g.kstepB : (unsigned)(BK * 2); asm volatile("" : "+s"(ksa_), "+s"(ksb_));
    const size_t kstepA = ksa_, kstepB = ksb_;
    const size_t hstepA = (size_t)HALF * g.lda * 2, hstepB = (size_t)HALF * LDB * 2;
    const size_t tstepA = g.pstepA ? (size_t)g.pstepA : 2 * hstepA, tstepB = g.pstepB ? (size_t)g.pstepB : 2 * hstepB;
    const unsigned ldsw = (unsigned)wid * 1024u;
    const int aoff = lds_byte(wr * 64 + fr, fq * 8), boff = lds_byte(wc * 32 + fr, fq * 8);
#define PG8_SA(b, h) (((b) * 2 + (h)) * HTB)
#define PG8_SB(b, h) ((4 + (b) * 2 + (h)) * HTB)
#define PG8_STAGE(bufoff, gbase, voff) do { _Pragma("unroll") for (int _i = 0; _i < 2; ++_i) \
        __builtin_amdgcn_global_load_lds((const unsigned*)((const char*)(gbase) + (voff)[_i]), (PG8_LAS unsigned*)(lds + (bufoff) + ldsw + _i * 8192), 16, 0, 0); } while (0)
#define PG8_STAGEB(bufoff, gbase, voff) do { _Pragma("unroll") for (int _i = 0; _i < 2; ++_i) \
        __builtin_amdgcn_global_load_lds((const unsigned*)((const char*)(gbase) + (voff)[_i]), (PG8_LAS unsigned*)(lds + (bufoff) + ldsw + _i * 8192), 16, 0, BAUX); } while (0)
#define PG8_LDA(dst, b, h) do { _Pragma("unroll") for (int m = 0; m < 4; ++m) _Pragma("unroll") for (int k = 0; k < 2; ++k) dst[m][k] = *(const PG8_LAS bf16x8*)(lds + PG8_SA(b, h) + aoff + m * 2048 + k * 1024); } while (0)
#define PG8_LDB(dst, b, h) do { _Pragma("unroll") for (int n = 0; n < 2; ++n) _Pragma("unroll") for (int k = 0; k < 2; ++k) dst[n][k] = *(const PG8_LAS bf16x8*)(lds + PG8_SB(b, h) + boff + n * 2048 + k * 1024); } while (0)
#define PG8_MMA(ai, bj, At, Bt) do { __builtin_amdgcn_s_setprio(1); _Pragma("unroll") for (int m = 0; m < 4; ++m) _Pragma("unroll") for (int n = 0; n < 2; ++n) _Pragma("unroll") for (int k = 0; k < 2; ++k) \
        acc[ai][bj][m][n] = __builtin_amdgcn_mfma_f32_16x16x32_bf16(Bt[n][k], At[m][k], acc[ai][bj][m][n], 0, 0, 0); __builtin_amdgcn_s_setprio(0); } while (0)
#define PG8_WAIT_V(n) asm volatile("s_waitcnt vmcnt(" #n ")" ::: "memory")
#define PG8_WAIT_L(n) asm volatile("s_waitcnt lgkmcnt(" #n ")" ::: "memory")
#define PG8_BAR __builtin_amdgcn_s_barrier()
#define PG8_SCHED __builtin_amdgcn_sched_barrier(0)
    Unit cur, nxt; int ui = 0;
    if (!S.next(0, cur)) return;
    f32x4 acc[2][2][4][2];
#pragma unroll
    for (int a = 0; a < 2; ++a)
#pragma unroll
        for (int b = 0; b < 2; ++b)
#pragma unroll
            for (int m = 0; m < 4; ++m)
#pragma unroll
                for (int n = 0; n < 2; ++n) acc[a][b][m][n] = (f32x4){0.f, 0.f, 0.f, 0.f};
    bf16x8 At[4][2], B0[2][2], B1[2][2];
    const char* cA = (const char*)g.A + (GATHER ? (size_t)0 : (size_t)cur.pm * tstepA); const char* cB = (const char*)g.Bt + (size_t)cur.pn * tstepB;
    if constexpr (GATHER) { PG8_GIDX(vC, cur); }
    S.a_ready(cur);
    if constexpr (SP2) {
        PG8_STAGEB(PG8_SB(0, 0), cB, voffB); PG8_STAGEB(PG8_SB(0, 1), cB + hstepB, voffB); PG8_STGA(PG8_SA(0, 0), cA, 0, false); PG8_STGA(PG8_SA(0, 1), cA, 1, false);
        if (wr == 1) PG8_BAR;
        PG8_WAIT_V(2); PG8_BAR;
        PG8_STAGEB(PG8_SB(1, 0), cB + kstepB, voffB); PG8_STGA(PG8_SA(1, 0), cA + kstepA, 0, false); PG8_STAGEB(PG8_SB(1, 1), cB + hstepB + kstepB, voffB);
        PG8_WAIT_V(6); PG8_BAR;
    } else {
        PG8_STAGEB(PG8_SB(0, 0), cB, voffB); PG8_STAGE(PG8_SA(0, 0), cA, voffA); PG8_STAGEB(PG8_SB(0, 1), cB + hstepB, voffB); PG8_STAGE(PG8_SA(0, 1), cA + hstepA, voffA);
        if (wr == 1) PG8_BAR;
        PG8_WAIT_V(4); PG8_BAR;
        PG8_STAGEB(PG8_SB(1, 0), cB + kstepB, voffB); PG8_STAGE(PG8_SA(1, 0), cA + kstepA, voffA); PG8_STAGEB(PG8_SB(1, 1), cB + hstepB + kstepB, voffB);
        PG8_WAIT_V(6); PG8_BAR;
    }
    for (;;) {
        const bool has_next = S.next(ui + 1, nxt);
        const char* nA = (has_next && !GATHER) ? (const char*)g.A + (size_t)nxt.pm * tstepA : cA;
        if constexpr (GATHER) { if (has_next) { PG8_GIDX(vN, nxt); } else { _Pragma("unroll") for (int h_ = 0; h_ < 2; ++h_) { vN[h_][0] = vC[h_][0]; vN[h_][1] = vC[h_][1]; } } } const char* nB = has_next ? (const char*)g.Bt + (size_t)nxt.pn * tstepB : cB;
        for (int t = 0; t < nt; t += 2) {
            const bool last = (t == nt - 2);
            const char* a1 = cA + (size_t)(t + 1) * kstepA;
            const char* a2 = last ? nA : cA + (size_t)(t + 2) * kstepA; const char* b2 = last ? nB : cB + (size_t)(t + 2) * kstepB;
            const char* a3 = a2 + kstepA; const char* b3 = b2 + kstepB;
            if (last && has_next) S.a_ready(nxt);
            if constexpr (SP2) {
            PG8_LDB(B0, 0, 0); PG8_LDB(B1, 0, 1); PG8_SCHED; PG8_LDA(At, 0, 0); PG8_STGA(PG8_SA(1, 1), a1, 1, false);
            PG8_WAIT_V(8); PG8_WAIT_L(0); PG8_BAR; PG8_MMA(0, 0, At, B0); PG8_MMA(0, 1, At, B1); PG8_BAR; PG8_SCHED;
            PG8_LDA(At, 0, 1); PG8_STAGEB(PG8_SB(0, 0), b2, voffB); PG8_STAGEB(PG8_SB(0, 1), b2 + hstepB, voffB); PG8_STGA(PG8_SA(0, 0), a2, 0, last);
            PG8_WAIT_V(8); PG8_WAIT_L(0); PG8_BAR; PG8_MMA(1, 0, At, B0); PG8_MMA(1, 1, At, B1); PG8_BAR; PG8_SCHED;
            PG8_LDB(B0, 1, 0); PG8_LDB(B1, 1, 1); PG8_SCHED; PG8_LDA(At, 1, 0); PG8_STGA(PG8_SA(0, 1), a2, 1, last);
            PG8_WAIT_V(8); PG8_WAIT_L(0); PG8_BAR; PG8_MMA(0, 0, At, B0); PG8_MMA(0, 1, At, B1); PG8_BAR; PG8_SCHED;
            PG8_LDA(At, 1, 1); PG8_STAGEB(PG8_SB(1, 0), b3, voffB); PG8_STAGEB(PG8_SB(1, 1), b3 + hstepB, voffB); PG8_STGA(PG8_SA(1, 0), a3, 0, last);
            PG8_WAIT_V(8); PG8_WAIT_L(0); PG8_BAR; PG8_MMA(1, 0, At, B0); PG8_MMA(1, 1, At, B1); PG8_BAR; PG8_SCHED;
            } else {
            PG8_LDB(B0, 0, 0); PG8_SCHED; PG8_LDA(At, 0, 0); PG8_STAGE(PG8_SA(1, 1), a1 + hstepA, voffA);
            PG8_WAIT_L(8); PG8_BAR; PG8_WAIT_L(0); PG8_MMA(0, 0, At, B0); PG8_BAR; PG8_SCHED;
            PG8_LDB(B1, 0, 1); PG8_STAGEB(PG8_SB(0, 0), b2, voffB);
            PG8_BAR; PG8_WAIT_L(0); PG8_MMA(0, 1, At, B1); PG8_BAR;
            PG8_LDA(At, 0, 1); PG8_STAGE(PG8_SA(0, 0), a2, voffA);
            PG8_BAR; PG8_WAIT_L(0); PG8_MMA(1, 0, At, B0); PG8_BAR; PG8_SCHED;
            PG8_STAGEB(PG8_SB(0, 1), b2 + hstepB, voffB);
            PG8_WAIT_V(6); PG8_BAR; PG8_MMA(1, 1, At, B1); PG8_BAR;
            PG8_LDB(B0, 1, 0); PG8_SCHED; PG8_LDA(At, 1, 0); PG8_STAGE(PG8_SA(0, 1), a2 + hstepA, voffA);
            PG8_WAIT_L(8); PG8_BAR; PG8_WAIT_L(0); PG8_MMA(0, 0, At, B0); PG8_BAR; PG8_SCHED;
            PG8_LDB(B1, 1, 1); PG8_STAGEB(PG8_SB(1, 0), b3, voffB);
            PG8_BAR; PG8_WAIT_L(0); PG8_MMA(0, 1, At, B1); PG8_BAR;
            PG8_LDA(At, 1, 1); PG8_STAGE(PG8_SA(1, 0), a3, voffA);
            PG8_BAR; PG8_WAIT_L(0); PG8_MMA(1, 0, At, B0); PG8_BAR; PG8_SCHED;
            PG8_STAGEB(PG8_SB(1, 1), b3 + hstepB, voffB);
            PG8_WAIT_V(6); PG8_BAR; PG8_MMA(1, 1, At, B1); PG8_BAR;
            }
        }
        if constexpr (ALIGN_EPI) { if (wr == 0) PG8_BAR; }
        if constexpr (!Epi::AFTER_DRAIN) { E(acc, cur, wr, wc, fr, fq); S.done(cur); }
        if (!has_next) break;
#pragma unroll
        for (int a = 0; a < 2; ++a)
#pragma unroll
            for (int b = 0; b < 2; ++b)
#pragma unroll
                for (int m = 0; m < 4; ++m)
#pragma unroll
                    for (int n = 0; n < 2; ++n) acc[a][b][m][n] = (f32x4){0.f, 0.f, 0.f, 0.f};
        cur = nxt; cA = nA; cB = nB; ++ui;
        if constexpr (GATHER) { _Pragma("unroll") for (int h_ = 0; h_ < 2; ++h_) { vC[h_][0] = vN[h_][0]; vC[h_][1] = vN[h_][1]; } }
        if constexpr (ALIGN_EPI) { if (wr == 1) PG8_BAR; }
    }
    PG8_WAIT_V(0);
    if constexpr (!ALIGN_EPI) { if (wr == 0) PG8_BAR; }
    PG8_BAR;
    if constexpr (Epi::AFTER_DRAIN) { E.fused(acc, cur, wr, wc, fr, fq, lds, wid, lane); S.done(cur); }
#undef PG8_SA
#undef PG8_SB
#undef PG8_STAGE
#undef PG8_STAGEB
#undef PG8_STGA
#undef PG8_GIDX
#undef PG8_LDA
#undef PG8_LDB
#undef PG8_MMA
#undef PG8_WAIT_V
#undef PG8_WAIT_L
#undef PG8_BAR
#undef PG8_SCHED
}
}

namespace att {
#define SBAR() __builtin_amdgcn_sched_barrier(0)
__device__ __forceinline__ int crow(int r, int hi) { return (r & 3) + 8 * (r >> 2) + 4 * hi; }
__device__ __forceinline__ unsigned cvtpk(float lo, float hi) { unsigned r; asm volatile("v_cvt_pk_bf16_f32 %0, %1, %2" : "=v"(r) : "v"(lo), "v"(hi)); return r; }

__device__ __forceinline__ void partialSM(f32x16& p0, f32x16& p1, float& mhat, f32x16& negm, float& alpha, const bool first, const float thr) {
  float pmax = p0[0];
#pragma unroll
  for (int r = 1; r < 16; ++r) pmax = fmaxf(pmax, p0[r]);
#pragma unroll
  for (int r = 0; r < 16; ++r) pmax = fmaxf(pmax, p1[r]);
  { auto rr = __builtin_amdgcn_permlane32_swap(__float_as_uint(pmax), __float_as_uint(pmax), false, false);
    pmax = fmaxf(__uint_as_float(rr[0]), __uint_as_float(rr[1])); }
  alpha = 1.f;
  if (__builtin_expect(first || __any(pmax > thr), 0)) {
    const float dl = first ? pmax : fmaxf(pmax, 0.f); mhat += dl;
#pragma unroll
    for (int r = 0; r < 16; ++r) { p0[r] -= dl; p1[r] -= dl; }
#pragma unroll
    for (int r = 0; r < 16; ++r) negm[r] = -mhat;
    asm volatile("" : "+v"(negm));
    alpha = first ? 1.f : __builtin_amdgcn_exp2f(-dl);
  }
#pragma unroll
  for (int r = 0; r < 16; ++r) p0[r] = __builtin_amdgcn_exp2f(p0[r]);
}
__device__ __forceinline__ void finishSM(f32x16& p0, f32x16& p1, float alpha, float& l_reg, bf16x8& pa0, bf16x8& pa1, bf16x8& pa2, bf16x8& pa3) {
#pragma unroll
  for (int r = 0; r < 16; ++r) p1[r] = __builtin_amdgcn_exp2f(p1[r]);
  float ps = 0;
#pragma unroll
  for (int r = 0; r < 16; ++r) ps += p0[r];
#pragma unroll
  for (int r = 0; r < 16; ++r) ps += p1[r];
  { auto rr = __builtin_amdgcn_permlane32_swap(__float_as_uint(ps), __float_as_uint(ps), false, false);
    ps = __uint_as_float(rr[0]) + __uint_as_float(rr[1]); }
  l_reg = l_reg * alpha + ps;
#define PK4(P, BASE, OUT) do { unsigned a0 = cvtpk(P[BASE + 0], P[BASE + 1]), a1 = cvtpk(P[BASE + 2], P[BASE + 3]);   \
    unsigned b0 = cvtpk(P[BASE + 4], P[BASE + 5]), b1 = cvtpk(P[BASE + 6], P[BASE + 7]);                              \
    auto r0 = __builtin_amdgcn_permlane32_swap(a0, b0, false, false); auto r1 = __builtin_amdgcn_permlane32_swap(a1, b1, false, false); \
    v4u w = {r0[0], r1[0], r0[1], r1[1]}; OUT = __builtin_bit_cast(bf16x8, w); } while (0)
  PK4(p0, 0, pa0); PK4(p0, 8, pa1); PK4(p1, 0, pa2); PK4(p1, 8, pa3);
#undef PK4
}
template <int ND, int KS>
__device__ __forceinline__ void qkt(f32x16& p0, f32x16& p1, const char* Ks, const bf16x8* qr, const f32x16& negm, int r32, int hi) {
#pragma unroll
  for (int d0 = 0; d0 < ND; ++d0) { const int cb = (d0 * 16 + hi * 8) * 2;
    const bf16x8 b0 = *reinterpret_cast<const bf16x8*>(Ks + r32 * KS + cb);
    const bf16x8 b1 = *reinterpret_cast<const bf16x8*>(Ks + (32 + r32) * KS + cb);
    p0 = __builtin_amdgcn_mfma_f32_32x32x16_bf16(b0, qr[d0], d0 == 0 ? negm : p0, 0, 0, 0);
    p1 = __builtin_amdgcn_mfma_f32_32x32x16_bf16(b1, qr[d0], d0 == 0 ? negm : p1, 0, 0, 0); }
}
__device__ __forceinline__ int v_st(int k, int c) { const int kk = (k & ~0xC) | ((k & 4) << 1) | ((k & 8) >> 1); return ((kk >> 3) * 2 + (c >> 5)) * 512 + ((kk & 7) * 32 + (c & 31)) * 2; }
__device__ __forceinline__ int v_rd_base(int lane) { return ((lane & 3) << 3) | (((lane >> 2) & 3) << 6) | (((lane >> 4) & 1) << 5) | (((lane >> 5) & 1) << 8); }
constexpr int v_rd_off(int d0, int ks, int half) { return ((2 * ks + half) * 2 + d0) * 512; }
template <int OFF> __device__ __forceinline__ s16x4 tr_read(int vb) {
  s16x4 r; asm volatile("ds_read_b64_tr_b16 %0, %1 offset:%2" : "=&v"(r) : "v"(vb), "i"(OFF) : "memory"); return r;
}
template <int D0> __device__ __forceinline__ void pv_one(f32x16& od, int vb, bf16x8 pa0, bf16x8 pa1, bf16x8 pa2, bf16x8 pa3) {
  const s16x4 l0 = tr_read<v_rd_off(D0, 0, 0)>(vb), h0 = tr_read<v_rd_off(D0, 0, 1)>(vb), l1 = tr_read<v_rd_off(D0, 1, 0)>(vb), h1 = tr_read<v_rd_off(D0, 1, 1)>(vb);
  const s16x4 l2 = tr_read<v_rd_off(D0, 2, 0)>(vb), h2 = tr_read<v_rd_off(D0, 2, 1)>(vb), l3 = tr_read<v_rd_off(D0, 3, 0)>(vb), h3 = tr_read<v_rd_off(D0, 3, 1)>(vb);
  asm volatile("s_waitcnt lgkmcnt(0)" ::: "memory"); SBAR();
#define PK(L, H) (bf16x8){L[0], L[1], L[2], L[3], H[0], H[1], H[2], H[3]}
  od = __builtin_amdgcn_mfma_f32_32x32x16_bf16(pa0, PK(l0, h0), od, 0, 0, 0);
  od = __builtin_amdgcn_mfma_f32_32x32x16_bf16(pa1, PK(l1, h1), od, 0, 0, 0);
  od = __builtin_amdgcn_mfma_f32_32x32x16_bf16(pa2, PK(l2, h2), od, 0, 0, 0);
  od = __builtin_amdgcn_mfma_f32_32x32x16_bf16(pa3, PK(l3, h3), od, 0, 0, 0);
#undef PK
}
__device__ __forceinline__ void pv_d0(f32x16* o, int vb, bf16x8 pa0, bf16x8 pa1, bf16x8 pa2, bf16x8 pa3) {
  pv_one<0>(o[0], vb, pa0, pa1, pa2, pa3); pv_one<1>(o[1], vb, pa0, pa1, pa2, pa3);
}

template <int DK, int LDQ, int LDK1, int LDK2, int LDV>
__device__ __forceinline__ void attn_unit(const bf16* __restrict__ Qb, const bf16* __restrict__ K1, const bf16* __restrict__ K2, const bf16* __restrict__ Vb,
                                          bf16* __restrict__ Ob, const float* ropeq, const int nkeys, char* lds, const int tid_in) {
  constexpr int ND = DK / 16, KS = DK * 2 + 16, SHM_K = 64 * KS, SHM_V = 8192;
  int tid_ = tid_in; asm volatile("" : "+v"(tid_));
  const int tid = tid_, wid = tid >> 6, lane = tid & 63, r32 = lane & 31, hi = lane >> 5;
  char* V_lds = lds; char* K_lds = lds + 2 * SHM_V;
  float* ws = (float*)(lds + 2 * SHM_V + 2 * SHM_K) + wid * 64; float* li_l = ws; float* al_l = ws + 32;
  constexpr float THR = 8.f;
  float mhat = 0.f, l_reg = 0; f32x16 o[2] = {}; bf16x8 qr[ND]; f32x16 negm = {}; asm volatile("" : "+v"(negm));
  const bf16* Qw = Qb + (long)(wid * 32 + r32) * LDQ + hi * 8;
#pragma unroll
  for (int d0 = 0; d0 < ND; ++d0) qr[d0] = *reinterpret_cast<const bf16x8*>(Qw + d0 * 16);
  if (DK == 96 && ropeq != nullptr) {
    const float* cr = ropeq + (size_t)(wid * 32 + r32) * 16 + 4 * hi;
#pragma unroll
    for (int d0 = 4; d0 < ND; ++d0) { const f32x4 c = *(const f32x4*)(cr + (d0 - 4) * 8), s = *(const f32x4*)(cr + 8192 * 16 + (d0 - 4) * 8);
      const v4u w = __builtin_bit_cast(v4u, qr[d0]); v4u o;
      { const float a = bflo(w.x), b = bfhi(w.x); o.x = cvtpk(a * c.x - b * s.x, b * c.x + a * s.x); }
      { const float a = bflo(w.y), b = bfhi(w.y); o.y = cvtpk(a * c.y - b * s.y, b * c.y + a * s.y); }
      { const float a = bflo(w.z), b = bfhi(w.z); o.z = cvtpk(a * c.z - b * s.z, b * c.z + a * s.z); }
      { const float a = bflo(w.w), b = bfhi(w.w); o.w = cvtpk(a * c.w - b * s.w, b * c.w + a * s.w); }
      qr[d0] = __builtin_bit_cast(bf16x8, o); }
  }
  const int sr = tid >> 3, sc = (tid & 7) * 8, vst = v_st(sr, sc), kst = sr * KS + sc * 2;
  const int sr2 = tid >> 2, sc2 = (tid & 3) * 8, kst2 = sr2 * KS + 128 + sc2 * 2;
  const bool has2 = (DK == 96) && (tid < 256);
  const int vb0 = (int)(uintptr_t)V_lds + v_rd_base(lane);
  struct { bf16x8 v, k1, k2; } sr_[2];
#define SLOAD(i, k0) do { sr_[i].v = *reinterpret_cast<const bf16x8*>(&Vb[(long)((k0) + sr) * LDV + sc]); sr_[i].k1 = *reinterpret_cast<const bf16x8*>(&K1[(long)((k0) + sr) * LDK1 + sc]); \
    if (has2) sr_[i].k2 = *reinterpret_cast<const bf16x8*>(&K2[(long)((k0) + sr2) * LDK2 + sc2]); } while (0)
#define SWRITE(b, i) do { *(bf16x8*)(V_lds + (b) * SHM_V + vst) = sr_[i].v; *(bf16x8*)(K_lds + (b) * SHM_K + kst) = sr_[i].k1; \
    if (has2) *(bf16x8*)(K_lds + (b) * SHM_K + kst2) = sr_[i].k2; } while (0)
#define RESC(a) do { if (__any((a) < 1.f)) { if (hi == 0) al_l[r32] = (a); asm volatile("s_waitcnt lgkmcnt(0)" ::: "memory"); \
    _Pragma("unroll") for (int d = 0; d < 2; ++d) _Pragma("unroll") for (int r = 0; r < 16; ++r) o[d][r] *= al_l[crow(r, hi)]; } } while (0)
  f32x16 pA0, pA1, pB0, pB1; float alA, alB; bf16x8 pa0, pa1, pa2, pa3; const int NT = nkeys / 64;
  constexpr int SE = 0, SO = 1;
  SLOAD(SE, 0); asm volatile("s_waitcnt vmcnt(0)" ::: "memory"); SWRITE(0, SE); __syncthreads();
  qkt<ND, KS>(pA0, pA1, K_lds, qr, negm, r32, hi); partialSM(pA0, pA1, mhat, negm, alA, true, THR);
  SLOAD(SO, 64); if (2 < NT) SLOAD(SE, 128);
  SWRITE(1, SO); __syncthreads();
  for (int j = 1; j + 1 < NT; j += 2) {
    SBAR(); qkt<ND, KS>(pB0, pB1, K_lds + SHM_K, qr, negm, r32, hi);
    finishSM(pA0, pA1, alA, l_reg, pa0, pa1, pa2, pa3); SBAR();
    SLOAD(SO, (j + 2) * 64); SBAR();
    pv_d0(o, vb0, pa0, pa1, pa2, pa3); partialSM(pB0, pB1, mhat, negm, alB, false, THR);
    __syncthreads(); SWRITE(0, SE);
    RESC(alB); __syncthreads();
    SBAR(); qkt<ND, KS>(pA0, pA1, K_lds, qr, negm, r32, hi);
    finishSM(pB0, pB1, alB, l_reg, pa0, pa1, pa2, pa3); SBAR();
    if (j + 3 < NT) SLOAD(SE, (j + 3) * 64); SBAR();
    pv_d0(o, vb0 + SHM_V, pa0, pa1, pa2, pa3); partialSM(pA0, pA1, mhat, negm, alA, false, THR);
    __syncthreads(); SWRITE(1, SO);
    RESC(alA); __syncthreads();
  }
  SBAR(); qkt<ND, KS>(pB0, pB1, K_lds + SHM_K, qr, negm, r32, hi);
  finishSM(pA0, pA1, alA, l_reg, pa0, pa1, pa2, pa3); SBAR();
  pv_d0(o, vb0, pa0, pa1, pa2, pa3); partialSM(pB0, pB1, mhat, negm, alB, false, THR);
  __syncthreads(); RESC(alB);
  finishSM(pB0, pB1, alB, l_reg, pa0, pa1, pa2, pa3); SBAR();
  pv_d0(o, vb0 + SHM_V, pa0, pa1, pa2, pa3);
  if (hi == 0) li_l[r32] = l_reg; asm volatile("s_waitcnt lgkmcnt(0)" ::: "memory");
  float rli[16];
#pragma unroll
  for (int r = 0; r < 16; ++r) rli[r] = __builtin_amdgcn_rcpf(li_l[crow(r, hi)]);
  bf16* Ow = Ob + (long)(wid * 32) * OW;
#pragma unroll
  for (int r = 0; r < 16; ++r) { const int orow = crow(r, hi);
#pragma unroll
    for (int d0 = 0; d0 < 2; ++d0) Ow[(long)orow * OW + d0 * 32 + r32] = (bf16)f2bf(o[d0][r] * rli[r]); }
  __syncthreads();
#undef SLOAD
#undef SWRITE
#undef RESC
}
#undef SBAR
}

namespace att2 {
using u32x4 = v4u;
typedef __attribute__((address_space(3))) const char* lds_cptr;
typedef short v4i16_t __attribute__((ext_vector_type(4)));
typedef float f32x2_t __attribute__((ext_vector_type(2))); typedef __bf16 bf16x2_t __attribute__((ext_vector_type(2)));
#define SBAR() __builtin_amdgcn_sched_barrier(0)
__device__ __forceinline__ int crow(int r, int hi) { return (r & 3) + 8 * (r >> 2) + 4 * hi; }
__device__ __forceinline__ void glds16(const void* gbase, unsigned voff, unsigned lds_dst) { unsigned keep;
  asm volatile("s_mov_b32 %0, m0\n\ts_mov_b32 m0, %3\n\ts_nop 0\n\tglobal_load_lds_dwordx4 %1, %2\n\ts_mov_b32 m0, %0" : "=&s"(keep) : "v"(voff), "s"(gbase), "s"(lds_dst) : "memory"); }
__device__ __forceinline__ float max3f(float a, float b, float c) { float r; asm("v_max3_f32 %0, %1, %2, %3" : "=v"(r) : "v"(a), "v"(b), "v"(c)); return r; }
__device__ __forceinline__ float max2f(float a, float b) { float r; asm("v_max_f32_e32 %0, %1, %2" : "=v"(r) : "v"(a), "v"(b)); return r; }
__device__ __forceinline__ float fadd_s(float a, float b) { float r; asm("v_add_f32_e32 %0, %1, %2" : "=v"(r) : "v"(a), "v"(b)); return r; }
__device__ __forceinline__ float fsub_s(float a, float b) { float r; asm("v_sub_f32_e32 %0, %1, %2" : "=v"(r) : "v"(a), "v"(b)); return r; }
__device__ __forceinline__ unsigned cvtpk_s(float lo, float hi) { f32x2_t v = {lo, hi}; bf16x2_t b = __builtin_convertvector(v, bf16x2_t); return __builtin_bit_cast(unsigned, b); }
template <int N> __device__ __forceinline__ void wait_bar() { asm volatile("s_waitcnt vmcnt(%0) lgkmcnt(0)\n\ts_barrier" :: "n"(N) : "memory"); }
template <int ND> __device__ __forceinline__ void qkt(f32x16& p0, f32x16& p1, const char* Kslot, const bf16x8* qr, const f32x16& negm, int r32, int hi) {
  const char* kb = Kslot + hi * 1024 + r32 * 16;
#pragma unroll
  for (int d0 = 0; d0 < ND; ++d0) {
    const bf16x8 b0 = *reinterpret_cast<const bf16x8*>(kb + d0 * 2048);
    const bf16x8 b1 = *reinterpret_cast<const bf16x8*>(kb + d0 * 2048 + 512);
    if (d0 == 0) { p0 = __builtin_amdgcn_mfma_f32_32x32x16_bf16(b0, qr[0], negm, 0, 0, 0); p1 = __builtin_amdgcn_mfma_f32_32x32x16_bf16(b1, qr[0], negm, 0, 0, 0); }
    else { p0 = __builtin_amdgcn_mfma_f32_32x32x16_bf16(b0, qr[d0], p0, 0, 0, 0); p1 = __builtin_amdgcn_mfma_f32_32x32x16_bf16(b1, qr[d0], p1, 0, 0, 0); } }
}
__device__ __forceinline__ void kload2(bf16x8* kf, lds_cptr kp, int j) { kf[2 * j] = *(const LAS bf16x8*)(kp + j * 2048); kf[2 * j + 1] = *(const LAS bf16x8*)(kp + j * 2048 + 512); }
__device__ __forceinline__ s16x4 vtr(lds_cptr p) { return __builtin_bit_cast(s16x4, __builtin_amdgcn_ds_read_tr16_b64_v4i16((LAS v4i16_t*)p)); }
__device__ __forceinline__ float rowmax(const f32x16& p0, const f32x16& p1) {
  float a = max3f(p0[0], p0[1], p1[0]), b = max3f(p0[2], p0[3], p1[1]); a = max3f(a, p1[2], p1[3]);
#pragma unroll
  for (int r = 4; r < 16; r += 4) { a = max3f(a, p0[r], p0[r + 1]); b = max3f(b, p0[r + 2], p0[r + 3]); a = max3f(a, p1[r], p1[r + 1]); b = max3f(b, p1[r + 2], p1[r + 3]); }
  const float m = max2f(a, b);
  auto rr = __builtin_amdgcn_permlane32_swap(__float_as_uint(m), __float_as_uint(m), false, false);
  return max2f(__uint_as_float(rr[0]), __uint_as_float(rr[1]));
}
__device__ __forceinline__ void pv(f32x16* o, int vb, bf16x8 pa0, bf16x8 pa1, bf16x8 pa2, bf16x8 pa3) {
#pragma unroll
  for (int d0 = 0; d0 < 2; ++d0) { s16x4 lo[4], hi[4];
#pragma unroll
    for (int ks = 0; ks < 4; ++ks) {
      asm volatile("ds_read_b64_tr_b16 %0,%1 offset:%c2" : "=&v"(lo[ks]) : "v"(vb), "i"(d0 * 4096 + ks * 1024) : "memory");
      asm volatile("ds_read_b64_tr_b16 %0,%1 offset:%c2" : "=&v"(hi[ks]) : "v"(vb), "i"(d0 * 4096 + ks * 1024 + 512) : "memory"); }
    asm volatile("s_waitcnt lgkmcnt(0)" ::: "memory"); SBAR();
#define PK(k) (bf16x8){lo[k][0], lo[k][1], lo[k][2], lo[k][3], hi[k][0], hi[k][1], hi[k][2], hi[k][3]}
    o[d0] = __builtin_amdgcn_mfma_f32_32x32x16_bf16(pa0, PK(0), o[d0], 0, 0, 0);
    o[d0] = __builtin_amdgcn_mfma_f32_32x32x16_bf16(pa1, PK(1), o[d0], 0, 0, 0);
    o[d0] = __builtin_amdgcn_mfma_f32_32x32x16_bf16(pa2, PK(2), o[d0], 0, 0, 0);
    o[d0] = __builtin_amdgcn_mfma_f32_32x32x16_bf16(pa3, PK(3), o[d0], 0, 0, 0);
#undef PK
  }
}

template <int DK> struct Lay { static constexpr int ND = DK / 16, NC = DK / 8, SLOTK = NC * 1024, SLOTV = 8192, LDS_K = 0, LDS_V = 3 * SLOTK, LDS_WS = LDS_V + 3 * SLOTV, LDS_OST = LDS_WS + 8 * 256, LDS_BYTES = LDS_OST + 8 * 4096, KD = (DK == 96) ? 2 : 1; };

template <int DK, int LDQ, int LDK1, int LDK2, int LDV, int THRL>
__device__ __forceinline__ void attn_unit(const bf16* Qb, const bf16* __restrict__ K1, const bf16* __restrict__ K2, const bf16* __restrict__ Vh, bf16* Ob, const float* ropeq, const int NT, char* shm, const int tid_in, const char* Qn = nullptr, const int qn_pitch = 0, const int qn_lines = 0) {
  using L = Lay<DK>; constexpr int ND = L::ND, SLOTK = L::SLOTK, SLOTV = L::SLOTV, LDS_K = L::LDS_K, LDS_V = L::LDS_V, LDS_WS = L::LDS_WS, LDS_OST = L::LDS_OST, KD = L::KD;
  int tid_ = tid_in; asm volatile("" : "+v"(tid_));
  const int tid = tid_, lane = tid & 63, r32 = lane & 31, hi = lane >> 5; const int wid = __builtin_amdgcn_readfirstlane(tid >> 6);
  const bf16* Qw = Qb + (long)(wid * 32) * LDQ;
  const unsigned lds0 = (unsigned)(uintptr_t)shm;
  float* wsf = (float*)(shm + LDS_WS) + wid * 64;
  const unsigned koff = (unsigned)(lane * LDK1 + wid * 8) * 2u;
  const unsigned koff2 = (unsigned)(lane * LDK2 + (wid & 3) * 8) * 2u;
  const unsigned voffv = (unsigned)((16 * (wid & 3) + (lane >> 2)) * LDV + (wid >> 2) * 32 + (lane & 3) * 8) * 2u;
  const unsigned kdst = lds0 + LDS_K + wid * 1024, kdst2 = lds0 + LDS_K + (8 + (wid & 3)) * 1024, vdst = lds0 + LDS_V + wid * 1024;
#define DMA_K(t, s) do { glds16(K1 + (long)(t) * 64 * LDK1, koff, (unsigned)__builtin_amdgcn_readfirstlane(kdst + (s) * SLOTK)); \
    if (DK == 96) glds16(K2 + (long)(t) * 64 * LDK2, koff2, (unsigned)__builtin_amdgcn_readfirstlane(kdst2 + (s) * SLOTK)); } while (0)
#define DMA_V(t, s) glds16(Vh + (long)(t) * 64 * LDV, voffv, (unsigned)__builtin_amdgcn_readfirstlane(vdst + (s) * SLOTV))
  const int vb0 = (int)(lds0 + LDS_V) + ((lane >> 4) & 1) * 32 + (lane & 3) * 8 + (4 * hi + ((lane & 15) >> 2)) * 64;
  const char* Kbase = shm + LDS_K; bf16x8 kf[12];
  const lds_cptr shm3 = (lds_cptr)shm; const lds_cptr kp0 = shm3 + LDS_K + hi * 1024 + r32 * 16; const lds_cptr vp0 = shm3 + LDS_V + ((lane >> 4) & 1) * 32 + (lane & 3) * 8 + (4 * hi + ((lane & 15) >> 2)) * 64;
  DMA_K(0, 0); DMA_V(0, 0); DMA_K(1, 1);
  bf16x8 qr[6];
#pragma unroll
  for (int d0 = 0; d0 < ND; ++d0) qr[d0] = *reinterpret_cast<const bf16x8*>(&Qw[(long)r32 * LDQ + d0 * 16 + hi * 8]);
  if (DK == 96 && ropeq != nullptr) {
    const float* cr = ropeq + (size_t)(wid * 32 + r32) * 16 + 4 * hi;
#pragma unroll
    for (int d0 = 4; d0 < ND; ++d0) { const f32x4 c = *(const f32x4*)(cr + (d0 - 4) * 8), s = *(const f32x4*)(cr + 8192 * 16 + (d0 - 4) * 8);
      const v4u w = __builtin_bit_cast(v4u, qr[d0]); v4u o;
      { const float a = bflo(w.x), b = bfhi(w.x); o.x = cvtpk_s(a * c.x - b * s.x, b * c.x + a * s.x); }
      { const float a = bflo(w.y), b = bfhi(w.y); o.y = cvtpk_s(a * c.y - b * s.y, b * c.y + a * s.y); }
      { const float a = bflo(w.z), b = bfhi(w.z); o.z = cvtpk_s(a * c.z - b * s.z, b * c.z + a * s.z); }
      { const float a = bflo(w.w), b = bfhi(w.w); o.w = cvtpk_s(a * c.w - b * s.w, b * c.w + a * s.w); }
      qr[d0] = __builtin_bit_cast(bf16x8, o); }
  }
  float mhat = 0.f, l_reg = 0.f; f32x16 o[2]; o[0] = f32x16{}; o[1] = f32x16{}; f32x16 negm = f32x16{}; asm volatile("" : "+v"(negm));
  bool resc = false;
#define START(P0, P1) do { const float rm = rowmax(P0, P1); resc = false; \
    { const float dl = rm; mhat = fadd_s(mhat, dl); \
      _Pragma("unroll") for (int r = 0; r < 16; ++r) { P0[r] = fsub_s(P0[r], dl); P1[r] = fsub_s(P1[r], dl); } \
      _Pragma("unroll") for (int r = 0; r < 16; ++r) negm[r] = -mhat; asm volatile("" : "+v"(negm)); } \
    _Pragma("unroll") for (int r = 0; r < 16; ++r) P0[r] = __builtin_amdgcn_exp2f(P0[r]); } while (0)
#define RESC() do { if (resc) { asm volatile("s_waitcnt lgkmcnt(0)" ::: "memory"); \
      _Pragma("unroll") for (int d_ = 0; d_ < 2; ++d_) _Pragma("unroll") for (int r = 0; r < 16; ++r) o[d_][r] *= wsf[crow(r, hi)]; } } while (0)
  f32x16 pA0, pA1, pB0, pB1;
  int sp = 0, sc = 0, sn = 1;
#define ROT() do { sp = sc; sc = sn; sn = (sn == 2) ? 0 : sn + 1; } while (0)
  DMA_K(2, 2);
  wait_bar<1 + 2 * KD>();
  qkt<ND>(pA0, pA1, Kbase, qr, negm, r32, hi); asm volatile("s_nop 15\n\ts_nop 7" : "+v"(pA0), "+v"(pA1));
  START(pA0, pA1);
  _Pragma("unroll") for (int r = 0; r < 16; ++r) pA1[r] = __builtin_amdgcn_exp2f(pA1[r]);
  wait_bar<0>();
  DMA_K(3, 0); DMA_V(1, 1);
  ROT();
#pragma unroll
  for (int j = 0; j < ND; ++j) kload2(kf, kp0 + sc * SLOTK, j);
  wait_bar<KD + 1>();
  s16x4 vlo[8], vhi[8]; u32x4 pw0, pw1, pw2, pw3;
#define PKW(P, B) cvtpk_s(P[B], P[B + 1])
#define PAF(k) __builtin_bit_cast(bf16x8, pw##k)
#define VFR(i) (bf16x8){vlo[i][0], vlo[i][1], vlo[i][2], vlo[i][3], vhi[i][0], vhi[i][1], vhi[i][2], vhi[i][3]}
#define PIN(x) asm volatile("" : "+v"(x))
#define MX3(a, b, c) __builtin_fmaxf(__builtin_fmaxf((a), (b)), (c))
#define EX(v) __builtin_amdgcn_exp2f(v)
#define GAPB(MF, X, B) do { MF; X[B] = EX(X[B]); X[B + 1] = EX(X[B + 1]); X[B + 2] = EX(X[B + 2]); X[B + 3] = EX(X[B + 3]); PIN(X); SBAR(); } while (0)
#define VRD(i) do { vlo[i] = vtr(vp_ + (((i) >> 2) * 4096 + ((i) & 3) * 1024)); vhi[i] = vtr(vp_ + (((i) >> 2) * 4096 + ((i) & 3) * 1024 + 512)); } while (0)
#define KRD(G, j) do { if (G) { kload2(kf, kp0 + sn * SLOTK, j); SBAR(); } } while (0)
#define MFQ(C, i, d, INIT) C = __builtin_amdgcn_mfma_f32_32x32x16_bf16(kf[i], qr[d], INIT, 0, 0, 0)
#define PHASE_A64(C0, C1, P0, P1) do { \
    VRD(0); SBAR(); float sacc = (P0[0] + P0[1]); \
    MFQ(C0, 0, 0, negm); sacc += P0[2]; sacc += P0[3]; sacc += P0[4]; sacc += P0[5]; PIN(sacc); pw0[0] = PKW(P0, 0); pw0[1] = PKW(P0, 2); PIN(pw0); SBAR(); \
    VRD(4); SBAR(); MFQ(C1, 1, 0, negm); sacc += P0[6]; sacc += P0[7]; sacc += P0[8]; sacc += P0[9]; PIN(sacc); pw0[2] = PKW(P0, 4); pw0[3] = PKW(P0, 6); PIN(pw0); SBAR(); \
    VRD(1); SBAR(); MFQ(C0, 2, 1, C0); sacc += P0[10]; sacc += P0[11]; sacc += P0[12]; sacc += P0[13]; PIN(sacc); pw1[0] = PKW(P0, 8); pw1[1] = PKW(P0, 10); PIN(pw1); SBAR(); \
    VRD(5); SBAR(); MFQ(C1, 3, 1, C1); sacc += P0[14]; sacc += P0[15]; sacc += P1[0]; sacc += P1[1]; PIN(sacc); pw1[2] = PKW(P0, 12); pw1[3] = PKW(P0, 14); PIN(pw1); SBAR(); \
    VRD(2); SBAR(); MFQ(C0, 4, 2, C0); sacc += P1[2]; sacc += P1[3]; sacc += P1[4]; sacc += P1[5]; PIN(sacc); pw2[0] = PKW(P1, 0); pw2[1] = PKW(P1, 2); PIN(pw2); SBAR(); \
    VRD(6); SBAR(); MFQ(C1, 5, 2, C1); sacc += P1[6]; sacc += P1[7]; sacc += P1[8]; sacc += P1[9]; PIN(sacc); pw2[2] = PKW(P1, 4); pw2[3] = PKW(P1, 6); PIN(pw2); SBAR(); \
    VRD(3); SBAR(); MFQ(C0, 6, 3, C0); sacc += P1[10]; sacc += P1[11]; sacc += P1[12]; sacc += P1[13]; PIN(sacc); pw3[0] = PKW(P1, 8); pw3[1] = PKW(P1, 10); PIN(pw3); SBAR(); \
    VRD(7); SBAR(); MFQ(C1, 7, 3, C1); sacc += P1[14]; sacc += P1[15]; PIN(sacc); pw3[2] = PKW(P1, 12); pw3[3] = PKW(P1, 14); PIN(pw3); SBAR(); \
    l_reg += sacc; } while (0)
#define PHASE_A96(C0, C1, P0, P1) do { \
    VRD(0); SBAR(); float sacc = (P0[0] + P0[1]); \
    MFQ(C0, 0, 0, negm); sacc += P0[2]; sacc += P0[3]; sacc += P0[4]; PIN(sacc); pw0[0] = PKW(P0, 0); PIN(pw0); SBAR(); \
    VRD(4); SBAR(); MFQ(C1, 1, 0, negm); sacc += P0[5]; sacc += P0[6]; sacc += P0[7]; PIN(sacc); pw0[1] = PKW(P0, 2); PIN(pw0); SBAR(); \
    VRD(1); SBAR(); MFQ(C0, 2, 1, C0); sacc += P0[8]; sacc += P0[9]; sacc += P0[10]; PIN(sacc); pw0[2] = PKW(P0, 4); PIN(pw0); SBAR(); \
    VRD(5); SBAR(); MFQ(C1, 3, 1, C1); sacc += P0[11]; sacc += P0[12]; sacc += P0[13]; PIN(sacc); pw0[3] = PKW(P0, 6); PIN(pw0); SBAR(); \
    VRD(2); SBAR(); MFQ(C0, 4, 2, C0); sacc += P0[14]; sacc += P0[15]; PIN(sacc); pw1[0] = PKW(P0, 8); PIN(pw1); SBAR(); \
    VRD(6); SBAR(); MFQ(C1, 5, 2, C1); sacc += P1[0]; sacc += P1[1]; PIN(sacc); pw1[1] = PKW(P0, 10); PIN(pw1); SBAR(); \
    VRD(3); SBAR(); MFQ(C0, 6, 3, C0); sacc += P1[2]; sacc += P1[3]; PIN(sacc); pw1[2] = PKW(P0, 12); PIN(pw1); SBAR(); \
    VRD(7); SBAR(); MFQ(C1, 7, 3, C1); sacc += P1[4]; sacc += P1[5]; PIN(sacc); pw1[3] = PKW(P0, 14); PIN(pw1); SBAR(); \
    MFQ(C0, 8, 4, C0); sacc += P1[6]; sacc += P1[7]; sacc += P1[8]; PIN(sacc); pw2[0] = PKW(P1, 0); pw2[1] = PKW(P1, 2); PIN(pw2); SBAR(); \
    MFQ(C1, 9, 4, C1); sacc += P1[9]; sacc += P1[10]; sacc += P1[11]; PIN(sacc); pw2[2] = PKW(P1, 4); pw2[3] = PKW(P1, 6); PIN(pw2); SBAR(); \
    MFQ(C0, 10, 5, C0); sacc += P1[12]; sacc += P1[13]; PIN(sacc); pw3[0] = PKW(P1, 8); pw3[1] = PKW(P1, 10); PIN(pw3); SBAR(); \
    MFQ(C1, 11, 5, C1); sacc += P1[14]; sacc += P1[15]; PIN(sacc); pw3[2] = PKW(P1, 12); pw3[3] = PKW(P1, 14); PIN(pw3); SBAR(); \
    l_reg += sacc; } while (0)
#define STEP(C0, C1, P0, P1, t, GK, GV, GL) do { SBAR(); \
    const lds_cptr vp_ = vp0 + sp * SLOTV; \
    if (DK == 96) PHASE_A96(C0, C1, P0, P1); else PHASE_A64(C0, C1, P0, P1); \
    if (GK) { DMA_K((t) + 3, sc); } if (GV) { DMA_V((t) + 1, sn); } \
    { float a = MX3(C0[0], C0[1], C1[0]), b = MX3(C0[2], C0[3], C1[1]); a = MX3(a, C1[2], C1[3]); \
      _Pragma("unroll") for (int r = 4; r < 16; r += 4) { a = MX3(a, C0[r], C0[r + 1]); b = MX3(b, C0[r + 2], C0[r + 3]); a = MX3(a, C1[r], C1[r + 1]); b = MX3(b, C1[r + 2], C1[r + 3]); } \
      float rm = __builtin_fmaxf(a, b); { auto rr = __builtin_amdgcn_permlane32_swap(__float_as_uint(rm), __float_as_uint(rm), false, false); rm = __builtin_fmaxf(__uint_as_float(rr[0]), __uint_as_float(rr[1])); } \
      resc = false; \
      if (__builtin_expect(__any(rm > (float)THRL), 0)) { const float dl = __builtin_fmaxf(rm, 0.f); mhat += dl; \
        _Pragma("unroll") for (int r = 0; r < 16; ++r) { C0[r] -= dl; C1[r] -= dl; } \
        _Pragma("unroll") for (int r = 0; r < 16; ++r) negm[r] = -mhat; asm volatile("" : "+v"(negm)); \
        const float f = __builtin_amdgcn_exp2f(-dl); l_reg *= f; if (hi == 0) wsf[r32] = f; resc = true; } } \
    SBAR(); \
    GAPB(o[0] = __builtin_amdgcn_mfma_f32_32x32x16_bf16(PAF(0), VFR(0), o[0], 0, 0, 0), C0, 0); \
    KRD(GL && ND == 6, 0); GAPB(o[1] = __builtin_amdgcn_mfma_f32_32x32x16_bf16(PAF(0), VFR(4), o[1], 0, 0, 0), C0, 4); \
    KRD(GL, ND == 6 ? 1 : 0); GAPB(o[0] = __builtin_amdgcn_mfma_f32_32x32x16_bf16(PAF(1), VFR(1), o[0], 0, 0, 0), C0, 8); \
    KRD(GL, ND == 6 ? 2 : 1); GAPB(o[1] = __builtin_amdgcn_mfma_f32_32x32x16_bf16(PAF(1), VFR(5), o[1], 0, 0, 0), C0, 12); \
    KRD(GL, ND == 6 ? 3 : 2); GAPB(o[0] = __builtin_amdgcn_mfma_f32_32x32x16_bf16(PAF(2), VFR(2), o[0], 0, 0, 0), C1, 0); \
    KRD(GL, ND == 6 ? 4 : 3); GAPB(o[1] = __builtin_amdgcn_mfma_f32_32x32x16_bf16(PAF(2), VFR(6), o[1], 0, 0, 0), C1, 4); \
    KRD(GL && ND == 6, 5); GAPB(o[0] = __builtin_amdgcn_mfma_f32_32x32x16_bf16(PAF(3), VFR(3), o[0], 0, 0, 0), C1, 8); \
    GAPB(o[1] = __builtin_amdgcn_mfma_f32_32x32x16_bf16(PAF(3), VFR(7), o[1], 0, 0, 0), C1, 12); \
  } while (0)
  int t = 1;
  for (; t + 5 < NT; t += 2) {
    STEP(pB0, pB1, pA0, pA1, t, true, true, true);     wait_bar<KD + 1>(); RESC(); ROT();
    STEP(pA0, pA1, pB0, pB1, t + 1, true, true, true); wait_bar<KD + 1>(); RESC(); ROT();
  }
#define ENDW(tt) do { if ((tt) + 3 < NT) { wait_bar<KD + 1>(); } else if ((tt) + 2 < NT) { wait_bar<1>(); } else { wait_bar<0>(); } } while (0)
  for (; t + 1 < NT; t += 2) {
    STEP(pB0, pB1, pA0, pA1, t, (t + 3 < NT), (t + 1 < NT), (t + 1 < NT));         ENDW(t);     RESC(); ROT();
    STEP(pA0, pA1, pB0, pB1, t + 1, (t + 4 < NT), (t + 2 < NT), (t + 2 < NT));     ENDW(t + 1); RESC(); ROT();
  }
  STEP(pB0, pB1, pA0, pA1, NT - 1, false, false, false); RESC();
  { float sacc = pB0[0] + pB0[1];
    _Pragma("unroll") for (int r = 2; r < 16; ++r) sacc += pB0[r];
    _Pragma("unroll") for (int r = 0; r < 16; ++r) sacc += pB1[r];
    l_reg += sacc;
    pw0 = (u32x4){PKW(pB0, 0), PKW(pB0, 2), PKW(pB0, 4), PKW(pB0, 6)}; pw1 = (u32x4){PKW(pB0, 8), PKW(pB0, 10), PKW(pB0, 12), PKW(pB0, 14)};
    pw2 = (u32x4){PKW(pB1, 0), PKW(pB1, 2), PKW(pB1, 4), PKW(pB1, 6)}; pw3 = (u32x4){PKW(pB1, 8), PKW(pB1, 10), PKW(pB1, 12), PKW(pB1, 14)};
    SBAR(); pv(o, vb0 + sc * SLOTV, PAF(0), PAF(1), PAF(2), PAF(3)); }
  if (Qn != nullptr && (tid & 1) < qn_lines)
    __builtin_amdgcn_global_load_lds((const unsigned*)(Qn + (long)(tid >> 1) * qn_pitch + (tid & 1) * 128), (__attribute__((address_space(3))) unsigned*)(lds0 + 131072u + (unsigned)wid * 256u), 4, 0, 0);
  { auto rr = __builtin_amdgcn_permlane32_swap(__float_as_uint(l_reg), __float_as_uint(l_reg), false, false); l_reg = __uint_as_float(rr[0]) + __uint_as_float(rr[1]); }
  if (hi == 0) wsf[32 + r32] = l_reg; asm volatile("s_waitcnt lgkmcnt(0)" ::: "memory");
  float rli[16];
#pragma unroll
  for (int r = 0; r < 16; ++r) rli[r] = __builtin_amdgcn_rcpf(wsf[32 + crow(r, hi)]);
  bf16* Ow = Ob + (long)(wid * 32) * OW;
  { bf16* stg = (bf16*)(shm + LDS_OST) + wid * 2048;
#pragma unroll
    for (int r = 0; r < 16; ++r) { const int orow = crow(r, hi);
#pragma unroll
      for (int d0 = 0; d0 < 2; ++d0) stg[orow * 64 + d0 * 32 + r32] = (bf16)f2bf(o[d0][r] * rli[r]); }
    asm volatile("s_waitcnt lgkmcnt(0)" ::: "memory");
#pragma unroll
    for (int i = 0; i < 4; ++i) { const int row = i * 8 + (lane >> 3), ch = lane & 7; const u32x4 v = *(const u32x4*)(stg + row * 64 + ch * 8); *(u32x4*)(Ow + (long)row * OW + ch * 8) = v; } }
  asm volatile("s_waitcnt lgkmcnt(0)\n\ts_barrier" ::: "memory");
#undef DMA_K
#undef DMA_V
#undef START
#undef RESC
#undef ROT
#undef PKW
#undef PAF
#undef VFR
#undef PIN
#undef MX3
#undef EX
#undef GAPB
#undef VRD
#undef KRD
#undef MFQ
#undef PHASE_A64
#undef PHASE_A96
#undef STEP
#undef ENDW
}
#undef SBAR
}

constexpr size_t MiB = 1u << 20;
constexpr size_t WS_CTL = 0, CTL_ZERO_BYTES = 1 * MiB;
constexpr size_t WS_MOD = 1 * MiB;
constexpr size_t WS_ROPE = 2 * MiB;
constexpr size_t WS_AFF = 5 * MiB;
constexpr size_t WS_AFFT = 5 * MiB + 1536 * 1024;
constexpr size_t WS_INV = 8 * MiB;
constexpr size_t WS_ROWIDX = 10 * MiB;
constexpr size_t WS_WIN = 12 * MiB, WS_WUQ = 18 * MiB, WS_WUKV = 19 * MiB, WS_WOUT = 20 * MiB;
constexpr size_t WS_XRES = 24 * MiB;
constexpr size_t WS_H1 = 90 * MiB;
constexpr size_t WS_Z = 123 * MiB;
constexpr size_t WS_QM = 173 * MiB, WS_KVM = 198 * MiB, WS_O = 231 * MiB;
constexpr size_t WS_XG = 256 * MiB;
constexpr size_t WS_HID = 328 * MiB;
constexpr size_t WS_W13 = 520 * MiB, WS_W2 = 856 * MiB, WS_END = 1024 * MiB;
constexpr int CW_BAR = 4096;
constexpr int NPHASE = 28;
constexpr int LDS_BYTES = 147456, MISC_OFF = LDS_BYTES - 256;
constexpr int NWAVES = 8;

#define XB_TMO      128
#define XB_XCNT(j)  (256  + 64 * (j))
#define XB_XSUB(j)  (1280 + 64 * (j))
#define XB_XGEN(j)  (2304 + 64 * (j))
#define XB_TOP      3328
#define XB_TOPGEN   3392
#define XB_LSUB(j)  (3456 + 64 * (j))
#define XB_LGEN(j)  (4480 + 64 * (j))
#define XCD_BAR_WORDS 5504
#define XB_SPIN_CAP (1u << 18)

__device__ __forceinline__ unsigned xb_ld(unsigned* p)              { return __hip_atomic_load(p, __ATOMIC_RELAXED, __HIP_MEMORY_SCOPE_AGENT); }
__device__ __forceinline__ unsigned xb_add(unsigned* p, unsigned v) { return __hip_atomic_fetch_add(p, v, __ATOMIC_RELAXED, __HIP_MEMORY_SCOPE_AGENT); }
__device__ __forceinline__ unsigned xb_xcc_id() { return (unsigned)__builtin_amdgcn_s_getreg((3 << 11) | 20) & 0xFu; }
#define XB_SPIN(cond, bar) do { unsigned _sp = 0; while (cond) { __builtin_amdgcn_s_sleep(1); \
    if ((++_sp & 255u) == 0u) { if (xb_ld(&(bar)[XB_TMO])) break; if (_sp > XB_SPIN_CAP) { atomicAdd(&(bar)[XB_TMO], 1u); break; } } } } while (0)

struct XcdBarrier {
    unsigned* bar; unsigned x;
    volatile LAS unsigned* st;
};

__device__ __forceinline__ XcdBarrier xcd_barrier_post(unsigned* bar, volatile LAS unsigned* st) {
    XcdBarrier b; b.bar = bar; b.x = xb_xcc_id(); b.st = st;
    if (threadIdx.x == 0) st[2] = xb_add(&bar[XB_XCNT(b.x)], 1u);
    return b;
}
__device__ __forceinline__ void xcd_barrier_complete(unsigned* bar, unsigned x, unsigned& nloc, unsigned& nx) {
    const unsigned G = gridDim.x * gridDim.y * gridDim.z;
    unsigned sum, cnt, mine, sp = 0u;
    for (;;) {
        sum = 0u; cnt = 0u; mine = 0u;
#pragma unroll
        for (unsigned j = 0; j < 16; ++j) { const unsigned c = xb_ld(&bar[XB_XCNT(j)]); sum += c; cnt += (c > 0u) ? 1u : 0u; mine = (j == x) ? c : mine; }
        if (sum == G) break;
        __builtin_amdgcn_s_sleep(1);
        if ((++sp & 255u) == 0u) { if (xb_ld(&bar[XB_TMO])) break; if (sp > XB_SPIN_CAP) { atomicAdd(&bar[XB_TMO], 1u); break; } }
    }
    nloc = mine > 0u ? mine : 1u; nx = cnt > 0u ? cnt : 1u;
}

__device__ __forceinline__ void xcd_barrier(const XcdBarrier& b) {
    asm volatile("s_waitcnt vmcnt(0)" ::: "memory");
    __syncthreads();
    if (threadIdx.x == 0) {
        unsigned* bar = b.bar;
        __builtin_amdgcn_s_waitcnt(0);
        unsigned nloc = b.st[0], nx = b.st[1];
        if (nloc == 0u) { xcd_barrier_complete(bar, b.x, nloc, nx); b.st[0] = nloc; b.st[1] = nx; }
        const unsigned old = xb_add(&bar[XB_XSUB(b.x)], 1u);
        const unsigned gen = old / nloc;
        if (old + 1u == (gen + 1u) * nloc) {
            __builtin_amdgcn_fence(__ATOMIC_RELEASE, "agent");
            asm volatile("s_waitcnt vmcnt(0)" ::: "memory");
            const unsigned og = xb_add(&bar[XB_TOP], 1u);
            const unsigned tg = og / nx;
            if (og + 1u == (tg + 1u) * nx) xb_add(&bar[XB_TOPGEN], 1u);
            else XB_SPIN(xb_ld(&bar[XB_TOPGEN]) == tg, bar);
            __builtin_amdgcn_fence(__ATOMIC_ACQUIRE, "agent");
            xb_add(&bar[XB_XGEN(b.x)], 1u);
            asm volatile("s_waitcnt vmcnt(0)" ::: "memory");
        } else {
            XB_SPIN(xb_ld(&bar[XB_XGEN(b.x)]) == gen, bar);
            __builtin_amdgcn_fence(__ATOMIC_ACQUIRE, "agent");
            asm volatile("s_waitcnt vmcnt(0)" ::: "memory");
        }
    }
    __syncthreads();
}

__device__ __forceinline__ bool xcd_grid_regular(const XcdBarrier& b) {
    unsigned n32 = 0u, nz = 0u;
#pragma unroll
    for (unsigned j = 0; j < 16; ++j) { const unsigned c = xb_ld(&b.bar[XB_XCNT(j)]); n32 += (c == 32u) ? 1u : 0u; nz += (c > 0u) ? 1u : 0u; }
    return n32 == 8u && nz == 8u && b.x < 8u;
}
__device__ __forceinline__ void xcd_local_barrier(const XcdBarrier& b) {
    asm volatile("s_waitcnt vmcnt(0)" ::: "memory");
    __syncthreads();
    if (threadIdx.x == 0) {
        unsigned* bar = b.bar;
        __builtin_amdgcn_s_waitcnt(0);
        const unsigned nloc = b.st[0];
        const unsigned old = xb_add(&bar[XB_LSUB(b.x)], 1u);
        const unsigned gen = old / nloc;
        if (old + 1u == (gen + 1u) * nloc) xb_add(&bar[XB_LGEN(b.x)], 1u);
        else XB_SPIN(xb_ld(&bar[XB_LGEN(b.x)]) == gen, bar);
        __builtin_amdgcn_fence(__ATOMIC_ACQUIRE, "agent");
        asm volatile("s_waitcnt vmcnt(0)" ::: "memory");
    }
    __syncthreads();
}

struct Frame {
    LAS unsigned char* lds; volatile LAS unsigned* MISC; unsigned* ctl;
    int tid, lane, wave, vcu, G;
    int reg;
    const float* const* in; float* out; unsigned char* ws;
};
__device__ __forceinline__ const float* gin(const Frame& F, int i) { return (const float*)(const GAS float*)F.in[i]; }
struct Span { int lo, hi, step; };
__device__ __forceinline__ int grp_p0(int g) { return 8 * g + (g < 2 ? g : 2); }
__device__ __forceinline__ int grp_np(int g) { return g < 2 ? 9 : 8; }
__device__ __forceinline__ int grpB_p0(int g) { return 33 * (g >> 2) + ((g & 3) ? 1 + 8 * (g & 3) : 0); }
__device__ __forceinline__ int grpB_np(int g) { return (g & 3) ? 8 : 9; }
__device__ __forceinline__ Span row_span(const Frame& F, int chain) {
    Span s;
    if (F.reg) { const int g = F.vcu >> 5, j = F.vcu & 31; const int lo = chain == 2 ? 2048 * g : 256 * (chain == 1 ? grpB_p0(g) : grp_p0(g)); s.hi = chain == 2 ? lo + 2048 : lo + 256 * (chain == 1 ? grpB_np(g) : grp_np(g));
        s.lo = lo + j * NWAVES + F.wave; s.step = 32 * NWAVES; }
    else { s.lo = F.vcu * NWAVES + F.wave; s.hi = chain == 2 ? NB * SEQ : M; s.step = F.G * NWAVES; }
    return s;
}
enum { I_X = 0, I_C, I_CTX, I_CCTX, I_MODW, I_MODB, I_N1G, I_WIN, I_QNG, I_WUQ, I_KVNG, I_WUKV, I_GQG, I_GKG, I_CVW, I_CVB, I_LNG, I_LNB, I_MOG, I_WOUT, I_N2G, I_RW, I_W1, I_W3, I_W2, I_FG };

__device__ __forceinline__ void sincos_acc(float ang, float& s, float& c) {
    const double x = (double)ang; const double k = __builtin_rint(x * 0.63661977236758134);
    double r = __builtin_fma(-k, 1.5707963267948966, x); r = __builtin_fma(-k, 6.123233995736766e-17, r);
    const double r2 = r * r;
    const double sp = r * (1.0 + r2 * (-1.0 / 6 + r2 * (1.0 / 120 + r2 * (-1.0 / 5040 + r2 * (1.0 / 362880 + r2 * (-1.0 / 39916800 + r2 * (1.0 / 6227020800.0)))))));
    const double cp = 1.0 + r2 * (-0.5 + r2 * (1.0 / 24 + r2 * (-1.0 / 720 + r2 * (1.0 / 40320 + r2 * (-1.0 / 3628800 + r2 * (1.0 / 479001600.0 + r2 * (-1.0 / 87178291200.0)))))));
    const int q = (int)k & 3;
    const double sv = (q == 0) ? sp : (q == 1) ? cp : (q == 2) ? -sp : -cp;
    const double cv = (q == 0) ? cp : (q == 1) ? -sp : (q == 2) ? -cp : sp;
    s = (float)sv; c = (float)cv;
}
template <int NW, class RowMap>
__device__ __forceinline__ void tr_item(const float* W, int N, int k0, int n0, bf16* WT, int ldwt, RowMap rowmap, LAS float* scr, int lane, const float vs = 1.f) {
    constexpr int LPR = NW / 4, RPI = 64 / LPR, NI = 64 / RPI, NO = NW * 8 / 64;
    const int r = lane / LPR, c4 = lane % LPR;
    f32x4 v[NI];
#pragma unroll
    for (int i = 0; i < NI; ++i) v[i] = *(const GAS f32x4*)(W + (size_t)(k0 + i * RPI + r) * N + n0 + 4 * c4);
#pragma unroll
    for (int i = 0; i < NI; ++i) { const int k = i * RPI + r;
#pragma unroll
        for (int j = 0; j < 4; ++j) scr[(4 * c4 + j) * 65 + k] = v[i][j]; }
    LDS_WAIT(); asm volatile("" ::: "memory");
#pragma unroll
    for (int j = 0; j < NO; ++j) { const int n = (lane >> 3) + 8 * j, c = lane & 7; const LAS float* s = scr + n * 65 + 8 * c;
        v4u o; o.x = pk2(s[0] * vs, s[1] * vs); o.y = pk2(s[2] * vs, s[3] * vs); o.z = pk2(s[4] * vs, s[5] * vs); o.w = pk2(s[6] * vs, s[7] * vs);
        *(GAS v4u*)(WT + (size_t)rowmap(n0 + n) * ldwt + k0 + 8 * c) = o; }
    LDS_WAIT(); asm volatile("" ::: "memory");
}
constexpr int NLI = 32256, NMI = 10752;
#ifndef MOE_LSEAM
#define MOE_LSEAM 1
#endif
constexpr int WIN_IN_NB = 116, WIN_IN_IPW = 5, WIN_OUT_NB = 248, WIN_OUT_IPW = 5, WIN_TK0_NB = 192, WIN_TK1_NB = 224, WIN_TK_IPW = 4, WIN_M2_NB = 192, WIN_M2_IPW = 10;
constexpr int N_WIN_IN = WIN_IN_NB * 8 * WIN_IN_IPW, N_WIN_OUT = WIN_OUT_NB * 8 * WIN_OUT_IPW, N_WIN_TK0 = WIN_TK0_NB * 8 * WIN_TK_IPW, N_WIN_TK1 = WIN_TK1_NB * 8 * WIN_TK_IPW, N_WIN_M2 = WIN_M2_NB * 8 * WIN_M2_IPW;
constexpr int WIN_M10_NB = 48, WIN_M11_NB = 128, WIN_M1_IPW = 3, N_WIN_M10 = WIN_M10_NB * 8 * WIN_M1_IPW, N_WIN_M11 = WIN_M11_NB * 8 * WIN_M1_IPW;
constexpr int WIN_AT_NB = 240, WIN_AT_IPW = 1, N_WIN_AT = WIN_AT_NB * 8 * WIN_AT_IPW;
constexpr int PRO_L0 = NLI - N_WIN_IN - N_WIN_AT - N_WIN_OUT - N_WIN_TK0 - N_WIN_M10;
constexpr int PRO_L1 = NLI - N_WIN_M2 - N_WIN_IN - N_WIN_TK1 - N_WIN_M11;
constexpr int BASE_IN0 = PRO_L0, BASE_AT0 = BASE_IN0 + N_WIN_IN, BASE_OUT0 = BASE_AT0 + N_WIN_AT, BASE_TK0 = BASE_OUT0 + N_WIN_OUT, BASE_M10 = BASE_TK0 + N_WIN_TK0;
constexpr int BASE_M2 = PRO_L1, BASE_IN1 = BASE_M2 + N_WIN_M2, BASE_TK1 = BASE_IN1 + N_WIN_IN, BASE_M11 = BASE_TK1 + N_WIN_TK1;
static_assert(BASE_TK0 + N_WIN_TK0 == BASE_M10 && BASE_TK1 + N_WIN_TK1 == BASE_M11 && BASE_TK0 >= 2 * NMI && BASE_TK1 >= 2 * NMI && N_WIN_TK0 / 8 + N_WIN_M10 / 8 <= 1344 && N_WIN_TK1 / 8 + N_WIN_M11 / 8 <= 1344, "the top-k and MOE1 windows are the tail of the w2 tiles");
static_assert(BASE_M10 + N_WIN_M10 == NLI && BASE_M11 + N_WIN_M11 == NLI && PRO_L0 > 0 && PRO_L1 > 0 && BASE_M10 >= 2 * NMI && BASE_M11 >= 2 * NMI, "window partition (the MOE1 windows hold w2 tiles only)");
#ifndef XNT
#define XNT 1
#endif
struct XItem { const float* W; bf16* WT; int N, ldwt, k0, n0, r0, kc; };
__device__ __forceinline__ void xitem_desc(Frame& F, int l, int x, XItem& d) {
    const int mat = x / NMI; int r = x - mat * NMI;
    if (MOE_LSEAM && mat == 2) {
        const int Tt = (l == 0 ? N_WIN_TK0 : N_WIN_TK1) / 8, Tm = (l == 0 ? N_WIN_M10 : N_WIN_M11) / 8, H = 1344 - Tt - Tm; int g, idx;
        if (r < 8 * H) { g = r / H; idx = r - g * H; }
        else if (r < 8 * (H + Tt)) { const int t = r - 8 * H; g = t / Tt; idx = H + t - g * Tt; }
        else { const int t = r - 8 * (H + Tt); g = t / Tm; idx = H + Tt + t - g * Tm; }
        r = g * 1344 + idx; }
    const int e = r / 672, q = r - e * 672, le = l * 16 + e;
    if (mat < 2) { d.W = (mat == 0 ? gin(F, I_W1) : gin(F, I_W3)) + (size_t)le * 1024 * FF; d.N = FF; d.k0 = (q / 42) * 64; d.n0 = (q % 42) * 64;
        const int rr = (d.n0 >> 7) * 256 + mat * 128 + (d.n0 & 127);
        d.WT = (bf16*)(F.ws + WS_W13) + (((size_t)le * 21 + (rr >> 8)) * 16 + (d.k0 >> 6)) * (256 * 64); d.ldwt = 64; d.r0 = rr & 255; d.kc = 0; }
    else { d.W = gin(F, I_W2) + (size_t)le * FF * 1024; d.N = 1024; d.k0 = (q / 16) * 64; d.n0 = (q % 16) * 64;
        d.WT = (bf16*)(F.ws + WS_W2) + (((size_t)le * 4 + (d.n0 >> 8)) * 42 + (d.k0 >> 6)) * (256 * 64); d.ldwt = 64; d.r0 = d.n0 & 255; d.kc = 0; }
}
__device__ __forceinline__ void xitem_load(const XItem& d, f32x4 (&v)[16], int lane) {
    const int r = lane >> 4, c4 = lane & 15; const float* p = d.W + (size_t)(d.k0 + r) * d.N + d.n0 + 4 * c4;
#pragma unroll
    for (int i = 0; i < 16; ++i) v[i] = XNT ? __builtin_nontemporal_load((const GAS f32x4*)(p + (size_t)(4 * i) * d.N)) : *(const GAS f32x4*)(p + (size_t)(4 * i) * d.N);
}
__device__ __forceinline__ void xitem_store(const XItem& d, const f32x4 (&v)[16], LAS float* scr, int lane) {
    const int r = lane >> 4, c4 = lane & 15;
#pragma unroll
    for (int i = 0; i < 16; ++i) { const int k = i * 4 + r;
#pragma unroll
        for (int j = 0; j < 4; ++j) scr[(4 * c4 + j) * 65 + k] = v[i][j]; }
    LDS_WAIT(); asm volatile("" ::: "memory");
#pragma unroll
    for (int j = 0; j < 8; ++j) { const int nn = (lane >> 3) + 8 * j, c = lane & 7; const LAS float* s = scr + nn * 65 + 8 * c;
        const int row = d.r0 + nn;
        v4u o; o.x = pk2(s[0], s[1]); o.y = pk2(s[2], s[3]); o.z = pk2(s[4], s[5]); o.w = pk2(s[6], s[7]);
        if (XNT == 1) __builtin_nontemporal_store(o, (GAS v4u*)(d.WT + (size_t)row * d.ldwt + d.kc + 8 * c)); else *(GAS v4u*)(d.WT + (size_t)row * d.ldwt + d.kc + 8 * c) = o; }
    LDS_WAIT(); asm volatile("" ::: "memory");
}
template <class IdxFn>
__device__ __forceinline__ void conv_stream(Frame& F, int n, IdxFn idx, LAS float* scr, int lane) {
    XItem da, db; f32x4 va[16], vb[16]; int l_, x_;
    if (n > 0) { idx(0, l_, x_); xitem_desc(F, l_, x_, da); xitem_load(da, va, lane); }
    for (int j = 0; j < n; j += 2) {
        const bool hb = j + 1 < n;
        if (hb) { idx(j + 1, l_, x_); xitem_desc(F, l_, x_, db); xitem_load(db, vb, lane); }
        xitem_store(da, va, scr, lane);
        if (hb) { if (j + 2 < n) { idx(j + 2, l_, x_); xitem_desc(F, l_, x_, da); xitem_load(da, va, lane); }
            xitem_store(db, vb, scr, lane); }
    }
}
__device__ __forceinline__ void conv_window_blocked(Frame& F, int l, int base, int rank, int ipw) {
    LAS float* scr = (LAS float*)(F.lds + F.wave * 16640); const int w0 = base + rank * ipw * 8 + F.wave;
    conv_stream(F, ipw, [=](int j, int& ll, int& xx) { ll = l; xx = w0 + j * 8; }, scr, F.lane);
}
__device__ __forceinline__ void conv_window(Frame& F, int l, int base, int rank, int nblk, int ipw) {
    LAS float* scr = (LAS float*)(F.lds + F.wave * 16640); const int w0 = base + rank * 8 + F.wave, st = nblk * 8;
    conv_stream(F, ipw, [=](int j, int& ll, int& xx) { ll = l; xx = w0 + j * st; }, scr, F.lane);
}
__device__ __forceinline__ void ph0(Frame& F) {
    const int tid = F.tid, lane = F.lane;
    const int gw = F.vcu * NWAVES + F.wave, NGW = F.G * NWAVES;
    const int gt = blockIdx.x * 512 + tid, NGT = F.G * 512;
    float* cosM = (float*)(F.ws + WS_ROPE); float* sinM = cosM + 8192 * 16; float* cosG = sinM + 8192 * 16; float* sinG = cosG + 8192 * 32;
    LAS float* scr = (LAS float*)(F.lds + F.wave * 16640);
    constexpr int N_WIN = 2 * 16 * 45, N_WUQ = 2 * 4 * 12, N_WUKV = 2 * 2 * 16, N_WOUT = 2 * 16 * 16;
#ifndef USE_WIN
#define USE_WIN 1
#endif
    const bool win = USE_WIN && (F.G == 256);
    const int n0 = win ? PRO_L0 : NLI, n1 = win ? PRO_L1 : NLI;
    const int NITEMS = n0 + n1 + N_WIN + N_WUQ + N_WUKV + N_WOUT;
    { const int nx = n0 + n1, cnt = (nx - gw + NGW - 1) / NGW;
      conv_stream(F, cnt > 0 ? cnt : 0, [=](int j, int& ll, int& xx) { const int r = gw + j * NGW; ll = r >= n0 ? 1 : 0; xx = r >= n0 ? r - n0 : r; }, scr, lane); }
    for (int it = gw; it < NITEMS - (n0 + n1); it += NGW) {
        int r = it;
        if (r < N_WIN) { const int l = r / 720, q = r % 720, kb = q / 45, nb = q % 45;
            tr_item<32>(gin(F, I_WIN) + (size_t)l * 1024 * 1440, 1440, kb * 64, nb * 32, (bf16*)(F.ws + WS_WIN) + (size_t)l * 1536 * 1024, 1024, [](int n) { return n; }, scr, lane); continue; } r -= N_WIN;
        if (r < N_WOUT) { const int l = r / 256, q = r % 256, kb = q / 16, nb = q % 16;
            tr_item<64>(gin(F, I_WOUT) + (size_t)l * 1024 * 1024, 1024, kb * 64, nb * 64, (bf16*)(F.ws + WS_WOUT) + (size_t)l * 1024 * 1024, 1024, [](int n) { return n; }, scr, lane); continue; } r -= N_WOUT;
        if (r < N_WUQ) { const int l = r / 48, q = r % 48, kb = q / 12, nb = q % 12;
            tr_item<64>(gin(F, I_WUQ) + (size_t)l * 256 * 768, 768, kb * 64, nb * 64, (bf16*)(F.ws + WS_WUQ) + (size_t)l * 768 * 256, 256,
                        [](int n) { const int h = n / 96, j = n % 96; return j < 64 ? n : (j < 80 ? h * 96 + 64 + 2 * (j - 64) : h * 96 + 64 + 2 * (j - 80) + 1); }, scr, lane, C_MLA); continue; } r -= N_WUQ;
        { const int l = r / 32, q = r % 32, kb = q / 16, nb = q % 16;
            tr_item<64>(gin(F, I_WUKV) + (size_t)l * 128 * 1024, 1024, kb * 64, nb * 64, (bf16*)(F.ws + WS_WUKV) + (size_t)l * 1024 * 128, 128, [](int n) { return n; }, scr, lane); }
    }
    __syncthreads();
    for (int i = gt; i < 8192 * 16; i += NGT) { const int t = i >> 4, p = i & 15; const float pos = (p < 8) ? (float)(t >> 6) : (float)(t & 63);
        const float inv = exp2f(-(float)(p & 7) * (13.287712379549449f / 8.f)); float s, c; sincos_acc(pos * inv, s, c); cosM[i] = c; sinM[i] = s; }
    for (int i = gt; i < 8192 * 32; i += NGT) { const int t = i >> 5, p = i & 31; const float pos = (p < 16) ? (float)(t >> 6) : (float)(t & 63);
        const float inv = exp2f(-(float)(p & 15) * (13.287712379549449f / 16.f)); float s, c; sincos_acc(pos * inv, s, c); cosG[i] = c; sinG[i] = s; }
    { bf16* wt = (bf16*)(F.ws + WS_WIN);
      for (int i = gt; i < 2 * 96 * 128; i += NGT) { const int l = i / (96 * 128), r = i % (96 * 128); *(v4u*)(wt + ((size_t)l * 1536 + 1440) * 1024 + (size_t)r * 8) = (v4u){0u, 0u, 0u, 0u}; } }
    { LAS float* sv = (LAS float*)F.lds; LAS f32x4* part = (LAS f32x4*)(F.lds + 12288);
      float* modv = (float*)(F.ws + WS_MOD);
      for (int job = blockIdx.x; job < 256; job += F.G) {
          const int l = job >> 7, grp = job & 127;
          const int kq = (tid < 384) ? tid / 12 : 0, cq = (tid < 384) ? tid % 12 : 0, col = grp * 48 + cq * 4;
          const float* wp = gin(F, I_MODW) + ((size_t)l * 1024 + kq * 32) * 6144 + col;
          f32x4 w[32];
#pragma unroll
          for (int kk = 0; kk < 32; ++kk) w[kk] = *(const f32x4*)(wp + (size_t)kk * 6144);
          float cv[6];
#pragma unroll
          for (int it = 0; it < 6; ++it) { const int i = tid + 512 * it, mv = i >> 10, k = i & 1023; cv[it] = (mv < 2) ? gin(F, I_C)[mv * 1024 + k] : gin(F, I_CCTX)[k]; }
#pragma unroll
          for (int it = 0; it < 6; ++it) sv[tid + 512 * it] = cv[it] * sigmoidf_(cv[it]);
          __syncthreads();
          if (tid < 384) {
              f32x4 a0 = {0.f, 0.f, 0.f, 0.f}, a1 = a0, a2 = a0;
#pragma unroll
              for (int kk = 0; kk < 32; ++kk) { const int k = kq * 32 + kk; a0 += sv[k] * w[kk]; a1 += sv[1024 + k] * w[kk]; a2 += sv[2048 + k] * w[kk]; }
              part[(kq * 12 + cq) * 3 + 0] = a0; part[(kq * 12 + cq) * 3 + 1] = a1; part[(kq * 12 + cq) * 3 + 2] = a2; }
          __syncthreads();
          if (tid < 36) { const int cq2 = tid % 12, mv = tid / 12, col2 = grp * 48 + cq2 * 4; f32x4 s = *(const f32x4*)(gin(F, I_MODB) + l * 6144 + col2);
              for (int kq2 = 0; kq2 < 32; ++kq2) s += part[(kq2 * 12 + cq2) * 3 + mv];
              *(f32x4*)(modv + (size_t)(l * 3 + mv) * 6144 + col2) = s; }
          __syncthreads();
      } }
}

template <int MODE>
__device__ __forceinline__ void norm_phase(Frame& F) {
    const int lane = F.lane; Span sp_; if (MODE == 2) { sp_.lo = F.vcu * NWAVES + F.wave; sp_.hi = M; sp_.step = F.G * NWAVES; } else sp_ = row_span(F, 0);
    const int gw = sp_.lo, NGW = sp_.step, MH = sp_.hi;
    float* xres = (float*)(F.ws + WS_XRES); bf16* xrb = (bf16*)(F.ws + WS_XRES); bf16* h1 = (bf16*)(F.ws + WS_H1);
    const float* modv = (const float*)(F.ws + WS_MOD); const float* aff = (const float*)(F.ws + WS_AFF); const int* inv = (const int*)(F.ws + WS_INV); const bf16* ybuf = (const bf16*)(F.ws + WS_XG);
    const float* xin = gin(F, I_X); const float* cin = gin(F, I_CTX);
#define NP_LOAD(R_, V_, S_, G_) do { const int b_ = (R_) / SB, s_ = (R_) - b_ * SB; \
        const float* src_ = (MODE == 0) ? (s_ < CTX ? cin + ((size_t)b_ * CTX + s_) * DM : xin + ((size_t)b_ * SEQ + (s_ - CTX)) * DM) : xres + (size_t)(R_) * DM; \
        _Pragma("unroll") for (int j = 0; j < 4; ++j) { if (MODE == 0) V_[j] = __builtin_nontemporal_load((const f32x4*)(src_ + 4 * lane + 256 * j)); \
            else if (XRES_BF16) { const v2u w_ = *(const v2u*)(xrb + (size_t)(R_) * DM + 4 * lane + 256 * j); V_[j] = (f32x4){bflo(w_.x), bfhi(w_.x), bflo(w_.y), bfhi(w_.y)}; } \
            else V_[j] = *(const f32x4*)(src_ + 4 * lane + 256 * j); } \
        if (MODE >= 1) { S_ = (lane < 16) ? inv[(size_t)(R_) * 16 + lane] : -1; G_ = (lane < 16) ? aff[(size_t)(R_) * 16 + lane] : 0.f; } } while (0)
#define NP_YREQ(S_, G_, P0_, P1_, PG0_, PG1_, REST_) do { unsigned long long m_ = __ballot((S_) >= 0); PG0_ = 0.f; PG1_ = 0.f; \
        if (m_) { const int e_ = __builtin_ctzll(m_); m_ &= m_ - 1; const int s_ = __builtin_amdgcn_readlane((S_), e_); PG0_ = __builtin_bit_cast(float, __builtin_amdgcn_readlane(__builtin_bit_cast(int, (G_)), e_)); \
            const bf16* y_ = ybuf + ((size_t)e_ * RPE + s_) * DM + 4 * lane; _Pragma("unroll") for (int j = 0; j < 4; ++j) P0_[j] = *(const v2u*)(y_ + 256 * j); } \
        else { _Pragma("unroll") for (int j = 0; j < 4; ++j) P0_[j] = (v2u){0u, 0u}; } \
        if (m_) { const int e_ = __builtin_ctzll(m_); m_ &= m_ - 1; const int s_ = __builtin_amdgcn_readlane((S_), e_); PG1_ = __builtin_bit_cast(float, __builtin_amdgcn_readlane(__builtin_bit_cast(int, (G_)), e_)); \
            const bf16* y_ = ybuf + ((size_t)e_ * RPE + s_) * DM + 4 * lane; _Pragma("unroll") for (int j = 0; j < 4; ++j) P1_[j] = *(const v2u*)(y_ + 256 * j); } \
        else { _Pragma("unroll") for (int j = 0; j < 4; ++j) P1_[j] = (v2u){0u, 0u}; } \
        REST_ = m_; } while (0)
    f32x4 cv[4], n1v[4], n2v[4]; int cs = -1, n1s = -1, n2s = -1; float cg = 0.f, n1g = 0.f, n2g = 0.f;
    v2u cp0[4], cp1[4], np0[4], np1[4]; float cpg0 = 0.f, cpg1 = 0.f, npg0 = 0.f, npg1 = 0.f; unsigned long long crest = 0ull, nrest = 0ull;
    int R = gw;
    if (R < MH) NP_LOAD(R, cv, cs, cg);
    if (R + NGW < MH) NP_LOAD(R + NGW, n1v, n1s, n1g);
    if (MODE >= 1 && R < MH) NP_YREQ(cs, cg, cp0, cp1, cpg0, cpg1, crest);
    f32x4 ngv[4], g2v[4], shv[4], scv[4]; int mvc = -1;
#pragma unroll
    for (int j = 0; j < 4; ++j) ngv[j] = *(const f32x4*)((MODE == 2 ? gin(F, I_FG) : gin(F, I_N1G) + (MODE == 2 ? 0 : MODE) * DM) + 4 * lane + 256 * j);
    for (; R < MH; R += NGW) {
        if (R + 2 * NGW < MH) NP_LOAD(R + 2 * NGW, n2v, n2s, n2g);
        if (MODE >= 1 && R + NGW < MH) NP_YREQ(n1s, n1g, np0, np1, npg0, npg1, nrest);
        const int b = R / SB, s = R - b * SB; const bool isctx = s < CTX; const int mv = isctx ? 2 : b;
        if (!(MODE == 2 && isctx)) {
        if (mv != mvc) { mvc = mv;
#pragma unroll
            for (int j = 0; j < 4; ++j) { const int c = 4 * lane + 256 * j;
                if (MODE >= 1) g2v[j] = *(const f32x4*)(modv + (size_t)((MODE - 1) * 3 + mv) * 6144 + 5120 + c);
                if (MODE <= 1) { const float* mp = modv + (size_t)(MODE * 3 + mv) * 6144; shv[j] = *(const f32x4*)(mp + c); scv[j] = *(const f32x4*)(mp + 1024 + c); } } }
        f32x4 v[4];
#pragma unroll
        for (int j = 0; j < 4; ++j) v[j] = cv[j];
        if (MODE >= 1) {
            f32x4 acc[4];
#pragma unroll
            for (int j = 0; j < 4; ++j) { acc[j] = cpg0 * (f32x4){bflo(cp0[j].x), bfhi(cp0[j].x), bflo(cp0[j].y), bfhi(cp0[j].y)}; acc[j] += cpg1 * (f32x4){bflo(cp1[j].x), bfhi(cp1[j].x), bflo(cp1[j].y), bfhi(cp1[j].y)}; }
            unsigned long long mask = crest;
            while (mask) {
                const int e0 = __builtin_ctzll(mask); mask &= mask - 1; const bool two = mask != 0; const int e1 = two ? __builtin_ctzll(mask) : e0; if (two) mask &= mask - 1;
                const int s0 = __builtin_amdgcn_readlane(cs, e0), s1 = __builtin_amdgcn_readlane(cs, e1);
                const float g0 = __builtin_bit_cast(float, __builtin_amdgcn_readlane(__builtin_bit_cast(int, cg), e0)), g1 = two ? __builtin_bit_cast(float, __builtin_amdgcn_readlane(__builtin_bit_cast(int, cg), e1)) : 0.f;
                const bf16* y0 = ybuf + ((size_t)e0 * RPE + s0) * DM + 4 * lane; const bf16* y1 = ybuf + ((size_t)e1 * RPE + s1) * DM + 4 * lane;
                v2u r0[4], r1[4];
#pragma unroll
                for (int j = 0; j < 4; ++j) { r0[j] = *(const v2u*)(y0 + 256 * j); r1[j] = *(const v2u*)(y1 + 256 * j); }
#pragma unroll
                for (int j = 0; j < 4; ++j) { acc[j] += g0 * (f32x4){bflo(r0[j].x), bfhi(r0[j].x), bflo(r0[j].y), bfhi(r0[j].y)}; acc[j] += g1 * (f32x4){bflo(r1[j].x), bfhi(r1[j].x), bflo(r1[j].y), bfhi(r1[j].y)}; }
            }
#pragma unroll
            for (int j = 0; j < 4; ++j) v[j] += g2v[j] * acc[j];
            if (MODE == 1) {
#pragma unroll
                for (int j = 0; j < 4; ++j) { if (XRES_BF16) { v2u w_; w_.x = pk2(v[j].x, v[j].y); w_.y = pk2(v[j].z, v[j].w); *(v2u*)(xrb + (size_t)R * DM + 4 * lane + 256 * j) = w_; } else *(f32x4*)(xres + (size_t)R * DM + 4 * lane + 256 * j) = v[j]; } }
        }
        float ss = 0.f;
#pragma unroll
        for (int j = 0; j < 4; ++j) ss += (v[j].x * v[j].x + v[j].y * v[j].y) + (v[j].z * v[j].z + v[j].w * v[j].w);
        const float rs = rsqrtf(wave_sum(ss) * (1.f / DM) + EPS);
        if (MODE == 2) {
            float* op = F.out + ((size_t)b * SEQ + (s - CTX)) * DM;
#pragma unroll
            for (int j = 0; j < 4; ++j) __builtin_nontemporal_store(v[j] * rs * ngv[j], (f32x4*)(op + 4 * lane + 256 * j));
        } else {
#pragma unroll
            for (int j = 0; j < 4; ++j) { const int c = 4 * lane + 256 * j; const f32x4 g = ngv[j], sh = shv[j], sc = scv[j];
                const f32x4 h = v[j] * rs * g * (1.f + sc) + sh; v2u o; o.x = pk2(h.x, h.y); o.y = pk2(h.z, h.w); *(v2u*)(h1 + (size_t)R * DM + c) = o; }
        }
        }
#pragma unroll
        for (int j = 0; j < 4; ++j) { cv[j] = n1v[j]; n1v[j] = n2v[j]; cp0[j] = np0[j]; cp1[j] = np1[j]; }
        cs = n1s; cg = n1g; n1s = n2s; n1g = n2g; cpg0 = npg0; cpg1 = npg1; crest = nrest;
    }
#undef NP_LOAD
#undef NP_YREQ
}

struct PrepIn { v2u q; unsigned kv; float kr1, kr2, h1[3], h2[3]; float cm, sm, cg, sg; };
__device__ __forceinline__ void prep_load(Frame& F, int R, PrepIn& I) {
    const bf16* zr = (const bf16*)(F.ws + WS_Z) + (size_t)R * ZW; const int lane = F.lane;
    const int s = R % SB; const bool lat = s >= CTX; const int t = lat ? s - CTX : 0;
    const float* cosM = (const float*)(F.ws + WS_ROPE); const float* sinM = cosM + 8192 * 16; const float* cosG = sinM + 8192 * 16; const float* sinG = cosG + 8192 * 32;
    I.q = *(const v2u*)(zr + ZQ + 4 * lane); I.kv = *(const unsigned*)(zr + ZKV + 2 * lane);
    I.kr1 = bf2f(zr[ZKR + (lane & 15)]); I.kr2 = bf2f(zr[ZKR + 16 + (lane & 15)]);
#pragma unroll
    for (int p = 0; p < 3; ++p) { const bf16* hp = zr + ZGQ + (2 * p + (lane >> 5)) * 64; I.h1[p] = bf2f(hp[lane & 31]); I.h2[p] = bf2f(hp[(lane & 31) + 32]); }
    I.cm = cosM[(size_t)t * 16 + (lane & 15)]; I.sm = sinM[(size_t)t * 16 + (lane & 15)]; I.cg = cosG[(size_t)t * 32 + (lane & 31)]; I.sg = sinG[(size_t)t * 32 + (lane & 31)];
}
struct PrepG { f32x4 qg; f32x2 kvg; float g1[3], g2[3]; };
__device__ __forceinline__ void prep_gammas(Frame& F, int l, PrepG& G) { const int lane = F.lane;
    G.qg = *(const f32x4*)(gin(F, I_QNG) + l * 256 + 4 * lane); G.kvg = *(const f32x2*)(gin(F, I_KVNG) + l * 128 + 2 * lane);
#pragma unroll
    for (int p = 0; p < 3; ++p) { const float* g = (p < 2 ? gin(F, I_GQG) : gin(F, I_GKG)) + l * 64; G.g1[p] = g[lane & 31]; G.g2[p] = g[(lane & 31) + 32]; } }
__device__ __forceinline__ void prep_store(Frame& F, int l, int R, const PrepIn& I, const float ssq, const float sskv, const float (&ssh)[3], const PrepG& G) {
    bf16* zr = (bf16*)(F.ws + WS_Z) + (size_t)R * ZW; const int lane = F.lane;
    const bool lat = (R % SB) >= CTX;
    {
        const float x0 = bflo(I.q.x), x1 = bfhi(I.q.x), x2 = bflo(I.q.y), x3 = bfhi(I.q.y);
        const float rs = rsqrtf(ssq * (1.f / 256) + EPS);
        const f32x4 g = G.qg;
        v2u o; o.x = pk2(x0 * rs * g.x, x1 * rs * g.y); o.y = pk2(x2 * rs * g.z, x3 * rs * g.w); *(v2u*)(zr + ZQ + 4 * lane) = o; }
    {
        const float x0 = bflo(I.kv), x1 = bfhi(I.kv);
        const float rs = rsqrtf(sskv * (1.f / 128) + EPS);
        const f32x2 g = G.kvg;
        *(unsigned*)(zr + ZKV + 2 * lane) = pk2(x0 * rs * g.x, x1 * rs * g.y); }
    {
        const int i = lane & 15; float o1 = I.kr1, o2 = I.kr2;
        if (lat) { o1 = I.kr1 * I.cm - I.kr2 * I.sm; o2 = I.kr2 * I.cm + I.kr1 * I.sm; }
        const unsigned w = pk2(o1, o2);
        if (lane < 16) *(unsigned*)(zr + ZKR + 2 * i) = w; }
#pragma unroll
    for (int p = 0; p < 3; ++p) { const int hh = 2 * p + (lane >> 5), i = lane & 31; bf16* hp = zr + ZGQ + hh * 64;
        const float x1 = I.h1[p], x2 = I.h2[p];
        const float rs = rsqrtf(ssh[p] * (1.f / 64) + EPS);
        const float qs = (p < 2) ? C_GQA : 1.f;
        float y1 = x1 * rs * G.g1[p] * qs, y2 = x2 * rs * G.g2[p] * qs;
        if (lat) { const float a = y1 * I.cg - y2 * I.sg, bb = y2 * I.cg + y1 * I.sg; y1 = a; y2 = bb; }
        hp[i] = (bf16)f2bf(y1); hp[i + 32] = (bf16)f2bf(y2); }
}
__device__ __forceinline__ void prep_quad_load(Frame& F, int R0, int NGW, int MH, PrepIn (&I)[4]) {
#pragma unroll
    for (int u = 0; u < 4; ++u) { const int R = R0 + u * NGW; prep_load(F, R < MH ? R : R0, I[u]); }
}
__device__ __forceinline__ void prep_quad_proc(Frame& F, int l, int R0, int NGW, int MH, const PrepIn (&I)[4], const PrepG& G) {
    float w[8], h[12];
#pragma unroll
    for (int u = 0; u < 4; ++u) { const float a0 = bflo(I[u].q.x), a1 = bfhi(I[u].q.x), a2 = bflo(I[u].q.y), a3 = bfhi(I[u].q.y); w[2 * u] = (a0 * a0 + a1 * a1) + (a2 * a2 + a3 * a3);
        const float k0 = bflo(I[u].kv), k1 = bfhi(I[u].kv); w[2 * u + 1] = k0 * k0 + k1 * k1;
#pragma unroll
        for (int p = 0; p < 3; ++p) h[3 * u + p] = I[u].h1[p] * I[u].h1[p] + I[u].h2[p] * I[u].h2[p]; }
    wave_sum_n<8>(w); half_sum_n<12>(h);
#pragma unroll
    for (int u = 0; u < 4; ++u) { const int R = R0 + u * NGW; if (R < MH) { const float sa[3] = {h[3 * u], h[3 * u + 1], h[3 * u + 2]}; prep_store(F, l, R, I[u], w[2 * u], w[2 * u + 1], sa, G); } }
}
struct ConvIn { v4u av[4], gv[4]; bool ok[4]; };
__device__ __forceinline__ void conv_load(Frame& F, int tile, ConvIn& I) {
    const int tid = F.tid; const int R0 = tile * 32; const int b = R0 / SB, s0 = R0 - b * SB; const bool isctx = s0 < CTX;
    const int seq_lo = b * SB + (isctx ? 0 : CTX), seq_hi = b * SB + (isctx ? CTX : SB);
    const bf16* z = (const bf16*)(F.ws + WS_Z);
#pragma unroll
    for (int j = 0; j < 4; ++j) { const int it = tid + 512 * j; const int rr = it >> 5, c8 = (it & 31) * 8; const int R = R0 - 15 + rr;
        I.ok[j] = (it < 62 * 32) && R >= seq_lo && R < seq_hi; const size_t ro = (size_t)(I.ok[j] ? R : R0) * ZW;
        I.av[j] = *(const v4u*)(z + ro + ZCA + c8); I.gv[j] = *(const v4u*)(z + ro + ZCB + c8); }
}
__device__ __forceinline__ void conv_tile(Frame& F, int l, int tile, const ConvIn& I, int next_tile, ConvIn& N, const float (&w)[31], const float bias, const float (&pv)[12]) {
    const int tid = F.tid, lane = F.lane, wave = F.wave; const int R0 = tile * 32;
    LAS float* U = (LAS float*)F.lds; LAS float* Y = U + 62 * 256;
#pragma unroll
    for (int j = 0; j < 4; ++j) { const int it = tid + 512 * j; if (it < 62 * 32) { const int rr = it >> 5, c8 = (it & 31) * 8;
        f32x4 u0 = {0.f, 0.f, 0.f, 0.f}, u1 = u0;
        if (I.ok[j]) { const v4u a = I.av[j], g = I.gv[j];
            u0.x = bflo(a.x) * sigmoidf_(bflo(g.x)); u0.y = bfhi(a.x) * sigmoidf_(bfhi(g.x)); u0.z = bflo(a.y) * sigmoidf_(bflo(g.y)); u0.w = bfhi(a.y) * sigmoidf_(bfhi(g.y));
            u1.x = bflo(a.z) * sigmoidf_(bflo(g.z)); u1.y = bfhi(a.z) * sigmoidf_(bfhi(g.z)); u1.z = bflo(a.w) * sigmoidf_(bflo(g.w)); u1.w = bfhi(a.w) * sigmoidf_(bfhi(g.w)); }
        *(LAS f32x4*)(U + rr * 256 + c8) = u0; *(LAS f32x4*)(U + rr * 256 + c8 + 4) = u1; } }
    if (next_tile >= 0) conv_load(F, next_tile, N);
    __syncthreads();
    { const int c = tid & 255, hf = tid >> 8;
#pragma unroll
      for (int ch = 0; ch < 2; ++ch) { const int r0 = hf * 16 + ch * 8; float win[38];
#pragma unroll
          for (int q = 0; q < 38; ++q) win[q] = U[(r0 + q) * 256 + c];
#pragma unroll
          for (int o = 0; o < 8; ++o) { float y = bias;
#pragma unroll
              for (int j = 0; j < 31; ++j) y = fmaf(win[o + j], w[j], y);
              Y[(r0 + o) * 256 + c] = y; } } }
    __syncthreads();
    { bf16* cat = (bf16*)(F.ws + WS_H1);
      float y[4][4], red[8];
#pragma unroll
      for (int rr = 0; rr < 4; ++rr) { const int row = wave * 4 + rr; float sm = 0.f, sq = 0.f;
#pragma unroll
          for (int q = 0; q < 4; ++q) { y[rr][q] = Y[row * 256 + lane + 64 * q]; sm += y[rr][q]; sq += y[rr][q] * y[rr][q]; }
          red[rr] = sm; red[4 + rr] = sq; }
      wave_sum_n<8>(red);
      float r2[4];
#pragma unroll
      for (int rr = 0; rr < 4; ++rr) { const float mean = red[rr] * (1.f / 256), var = fmaxf(red[4 + rr] * (1.f / 256) - mean * mean, 0.f); const float rstd = rsqrtf(var + EPS); float s2 = 0.f;
#pragma unroll
          for (int q = 0; q < 4; ++q) { const int c = lane + 64 * q; const float v = (y[rr][q] - mean) * rstd * pv[q] + pv[4 + q]; y[rr][q] = v * sigmoidf_(v); s2 += y[rr][q] * y[rr][q]; }
          r2[rr] = s2; }
      wave_sum_n<4>(r2);
#pragma unroll
      for (int rr = 0; rr < 4; ++rr) { const int row = wave * 4 + rr; const float rs = rsqrtf(r2[rr] * (1.f / 256) + EPS);
#pragma unroll
          for (int q = 0; q < 4; ++q) { const int c = lane + 64 * q; cat[(size_t)(R0 + row) * DM + 768 + c] = (bf16)f2bf(y[rr][q] * rs * pv[8 + q]); } } }
    __syncthreads();
}
__device__ __forceinline__ void prep_phase(Frame& F, int l) {
    const Span sp = row_span(F, 0); PrepG G; prep_gammas(F, l, G);
    PrepIn A[4], B[4]; int R = sp.lo;
    if (R < sp.hi) prep_quad_load(F, R, sp.step, sp.hi, A);
    while (R < sp.hi) {
        const int R1 = R + 4 * sp.step, R2 = R1 + 4 * sp.step;
        if (R1 < sp.hi) prep_quad_load(F, R1, sp.step, sp.hi, B);
        prep_quad_proc(F, l, R, sp.step, sp.hi, A, G);
        if (R1 < sp.hi) { if (R2 < sp.hi) prep_quad_load(F, R2, sp.step, sp.hi, A); prep_quad_proc(F, l, R1, sp.step, sp.hi, B, G); }
        R = R2;
    }
}
__device__ __forceinline__ void convmix_phase(Frame& F, int l) {
    int ntile = (l == 1) ? NB * SEQ / 32 : M / 32;
#define CV_TILE(ti_) ((l == 1) ? ((ti_) / (SEQ / 32)) * (SB / 32) + CTX / 32 + ((ti_) % (SEQ / 32)) : (ti_))
    int ti = F.vcu, st = F.G;
    if (F.reg) { const int g = F.vcu >> 5; const int base = (l == 1) ? 64 * g : 8 * grpB_p0(g); ti = base + (F.vcu & 31); st = 32; ntile = base + ((l == 1) ? 64 : 8 * grpB_np(g)); }
    ConvIn A, B;
    if (ti < ntile) conv_load(F, CV_TILE(ti), A);
    float cw[31]; const float* wp = gin(F, I_CVW) + (size_t)l * 31 * 256 + (F.tid & 255); const float cbias = gin(F, I_CVB)[l * 256 + (F.tid & 255)];
#pragma unroll
    for (int j = 0; j < 31; ++j) cw[j] = wp[j * 256];
    float cpv[12];
#pragma unroll
    for (int q = 0; q < 4; ++q) { const int c = F.lane + 64 * q; cpv[q] = gin(F, I_LNG)[l * 256 + c]; cpv[4 + q] = gin(F, I_LNB)[l * 256 + c]; cpv[8 + q] = gin(F, I_MOG)[l * 1024 + 768 + c]; }
    while (ti < ntile) {
        const int t1 = ti + st, t2 = t1 + st;
        conv_tile(F, l, CV_TILE(ti), A, t1 < ntile ? CV_TILE(t1) : -1, B, cw, cbias, cpv);
        if (t1 < ntile) conv_tile(F, l, CV_TILE(t1), B, t2 < ntile ? CV_TILE(t2) : -1, A, cw, cbias, cpv);
        ti = t2;
    }
#undef CV_TILE
}
#ifndef ATT_TUNED
#define ATT_TUNED 1
#endif
__device__ __forceinline__ void attn_phase(Frame& F, int l, char* ldsg) {
    const bf16* z = (const bf16*)(F.ws + WS_Z); const bf16* qm = (const bf16*)(F.ws + WS_QM); const bf16* kvm = (const bf16*)(F.ws + WS_KVM); bf16* ob = (bf16*)(F.ws + WS_O);
    const float* cosM = (const float*)(F.ws + WS_ROPE);
    const int nctx = (l == 0) ? 16 : 0;
    const int rg = F.vcu >> 5, rj = F.vcu & 31; const bool rctx = F.reg && l == 0 && (rg & 3) == 0;
    const int nctx2 = (l == 0) ? 8 : 0;
    auto mla_u = [&](int k) -> int {
        if (F.reg) { if (k < 2) { const int m = rj + 32 * k; return ((((rg >> 2) * 8 + (m >> 3)) << 5) | ((rg & 3) * 8 + (m & 7))); } return (k == 2 && rctx && rj < 8) ? 512 + (rg >> 2) * 8 + rj : -1; }
        const int u = F.vcu + k * F.G; return u < 512 + nctx ? u : -1; };
    auto gqa_u = [&](int k) -> int {
        if (F.reg) { if (k == 0) return ((((rg >> 2) * 4 + (rj >> 3)) << 5) | ((rg & 3) * 8 + (rj & 7))); return (k == 1 && rctx && rj >= 8 && rj < 12) ? 256 + (rg >> 2) * 4 + (rj - 8) : -1; }
        const int u = F.vcu + k * F.G; return u < 256 + nctx2 ? u : -1; };
    auto mla_q = [&](int u) -> const bf16* { size_t rq; int h; if (u < 512) { const int bh = u >> 5; h = bh & 7; rq = (size_t)(bh >> 3) * SB + CTX + (size_t)(u & 31) * 256; } else { const int v = u - 512; h = v & 7; rq = (size_t)(v >> 3) * SB; } return qm + rq * QW + 96 * h; };
    auto gqa_q = [&](int u) -> const bf16* { size_t rq; int h; if (u < 256) { const int bh = u >> 5; h = bh & 3; rq = (size_t)(bh >> 2) * SB + CTX + (size_t)(u & 31) * 256; } else { const int v = u - 256; h = v & 3; rq = (size_t)(v >> 2) * SB; } return z + rq * ZW + ZGQ + 64 * h; };
    for (int k = 0; ; ++k) {
        const int u = mla_u(k); if (u < 0) break;
        int b, h; size_t rq, rk; int nk;
        if (u < 512) { const int bh = u >> 5, qb = u & 31; b = bh >> 3; h = bh & 7; rk = (size_t)b * SB; rq = rk + CTX + (size_t)qb * 256; nk = SB; }
        else { const int v = u - 512; b = v >> 3; h = v & 7; rk = (size_t)b * SB; rq = rk; nk = CTX; }
        const int un = mla_u(k + 1), ug0 = gqa_u(0);
        const char* qn = un >= 0 ? (const char*)mla_q(un) : (ug0 >= 0 ? (const char*)gqa_q(ug0) : nullptr);
        att2::attn_unit<96, QW, KVW, ZW, KVW, 8>(qm + rq * QW + 96 * h, kvm + rk * KVW + 128 * h, z + rk * ZW + ZKR, kvm + rk * KVW + 128 * h + 64, ob + rq * OW + 64 * h, (u < 512) ? cosM + (size_t)(u & 31) * 256 * 16 : nullptr, nk / 64, ldsg, F.tid,
                                                 qn, un >= 0 ? QW * 2 : ZW * 2, un >= 0 ? 2 : 1);
    }
    for (int k = 0; ; ++k) {
        const int u = gqa_u(k); if (u < 0) break;
        int b, h; size_t rq, rk; int nk;
        if (u < 256) { const int bh = u >> 5, qb = u & 31; b = bh >> 2; h = bh & 3; rk = (size_t)b * SB; rq = rk + CTX + (size_t)qb * 256; nk = SB; }
        else { const int v = u - 256; b = v >> 2; h = v & 3; rk = (size_t)b * SB; rq = rk; nk = CTX; }
        const int un = gqa_u(k + 1);
        att2::attn_unit<64, ZW, ZW, ZW, ZW, 8>(z + rq * ZW + ZGQ + 64 * h, z + rk * ZW + ZGK + 64 * (h >> 1), nullptr, z + rk * ZW + ZGV + 64 * (h >> 1), ob + rq * OW + 512 + 64 * h, nullptr, nk / 64, ldsg, F.tid,
                                               un >= 0 ? (const char*)gqa_q(un) : nullptr, ZW * 2, 1);
    }
}

__device__ __forceinline__ void gnorm_phase(Frame& F, int l) {
    const int lane = F.lane; const Span sp = row_span(F, l == 1 ? 2 : 1); const int gw = sp.lo, NGW = sp.step;
    const bf16* ob = (const bf16*)(F.ws + WS_O); bf16* cat = (bf16*)(F.ws + WS_H1); const float* mg = gin(F, I_MOG) + l * 1024;
    const f32x4 g0 = *(const f32x4*)(mg + 8 * lane), g1 = *(const f32x4*)(mg + 8 * lane + 4), g2 = *(const f32x4*)(mg + 512 + 4 * lane);
    const int nrow = sp.hi;
#define GN_ROW(i_) ((l == 1) ? ((i_) / SEQ) * SB + CTX + ((i_) % SEQ) : (i_))
#define GN_LOAD(I_, A_, C_) do { _Pragma("unroll") for (int u = 0; u < 4; ++u) { const int ii = (I_) + u * NGW; const int Rr = GN_ROW(ii < nrow ? ii : (I_)); \
        A_[u] = *(const v4u*)(ob + (size_t)Rr * OW + 8 * lane); C_[u] = *(const v2u*)(ob + (size_t)Rr * OW + 512 + 4 * lane); } } while (0)
#define GN_PROC(I_, A_, C_) do { _Pragma("unroll") for (int u = 0; u < 4; ++u) { const int ii = (I_) + u * NGW; if (ii < nrow) { const int Rr = GN_ROW(ii); \
            float x[8] = {bflo(A_[u].x), bfhi(A_[u].x), bflo(A_[u].y), bfhi(A_[u].y), bflo(A_[u].z), bfhi(A_[u].z), bflo(A_[u].w), bfhi(A_[u].w)}; float y[4] = {bflo(C_[u].x), bfhi(C_[u].x), bflo(C_[u].y), bfhi(C_[u].y)}; \
            float s1 = 0.f, s2 = 0.f; \
            _Pragma("unroll") for (int k = 0; k < 8; ++k) s1 += x[k] * x[k]; \
            _Pragma("unroll") for (int k = 0; k < 4; ++k) s2 += y[k] * y[k]; \
            const float r1 = rsqrtf(wave_sum(s1) * (1.f / 512) + EPS), r2 = rsqrtf(wave_sum(s2) * (1.f / 256) + EPS); \
            v4u o; o.x = pk2(x[0] * r1 * g0.x, x[1] * r1 * g0.y); o.y = pk2(x[2] * r1 * g0.z, x[3] * r1 * g0.w); o.z = pk2(x[4] * r1 * g1.x, x[5] * r1 * g1.y); o.w = pk2(x[6] * r1 * g1.z, x[7] * r1 * g1.w); \
            *(v4u*)(cat + (size_t)Rr * DM + 8 * lane) = o; \
            v2u p; p.x = pk2(y[0] * r2 * g2.x, y[1] * r2 * g2.y); p.y = pk2(y[2] * r2 * g2.z, y[3] * r2 * g2.w); \
            *(v2u*)(cat + (size_t)Rr * DM + 512 + 4 * lane) = p; } } } while (0)
    v4u aA[4], aB[4]; v2u cA[4], cB[4]; int i = gw;
    if (i < nrow) GN_LOAD(i, aA, cA);
    while (i < nrow) {
        const int i1 = i + 4 * NGW, i2 = i1 + 4 * NGW;
        if (i1 < nrow) GN_LOAD(i1, aB, cB);
        GN_PROC(i, aA, cA);
        if (i1 < nrow) { if (i2 < nrow) GN_LOAD(i2, aA, cA); GN_PROC(i1, aB, cB); }
        i = i2;
    }
#undef GN_LOAD
#undef GN_PROC
#undef GN_ROW
}

#ifndef RT_ROWS
#define RT_ROWS 2
#endif
#ifndef ROUTER_MFMA
#define ROUTER_MFMA 1
#endif
__device__ __forceinline__ void router_phase_mfma(Frame& F, int l) {
    const int tid = F.tid, lane = F.lane; const Span sp = row_span(F, l == 1 ? 2 : 1);
    LAS float* W = (LAS float*)F.lds; LAS float* G2 = W + 16384; LAS float* S2 = G2 + 3072;
    const float* rw = gin(F, I_RW) + (size_t)l * 1024 * 16; const float* n2 = gin(F, I_N2G) + l * DM; const float* modl = (const float*)(F.ws + WS_MOD) + (size_t)l * 3 * 6144;
    const bf16* xrb = (const bf16*)(F.ws + WS_XRES); bf16* h2 = (bf16*)(F.ws + WS_H1); float* aff = (float*)(F.ws + WS_AFF);
    {
        f32x4 wv[8]; float nv[6], scv[6], shv[6];
#pragma unroll
        for (int it = 0; it < 8; ++it) wv[it] = *(const f32x4*)(rw + 4 * (tid + 512 * it));
#pragma unroll
        for (int it = 0; it < 6; ++it) { const int i = tid + 512 * it, mv = i >> 10, k = i & 1023; nv[it] = n2[k]; scv[it] = modl[mv * 6144 + 4096 + k]; shv[it] = modl[mv * 6144 + 3072 + k]; }
#pragma unroll
        for (int it = 0; it < 8; ++it) { const int i = tid + 512 * it, k = i >> 2, e0 = (i & 3) * 4; LAS float* d = W + (((k >> 5) * 4 + ((k >> 3) & 3)) * 16 + e0) * 8 + (k & 7);
            d[0] = wv[it].x; d[8] = wv[it].y; d[16] = wv[it].z; d[24] = wv[it].w; }
#pragma unroll
        for (int it = 0; it < 6; ++it) { const int i = tid + 512 * it; G2[i] = nv[it] * (1.f + scv[it]); S2[i] = shv[it]; }
    }
    __syncthreads();
    const int r = lane & 15, kq = lane >> 4;
    const int gbase = sp.lo - (sp.lo % sp.step); int gw = sp.lo % sp.step;
    if (F.reg) gw = (F.vcu & 31) + 32 * F.wave;
    for (int gi = gw; gbase + gi * 16 < sp.hi; gi += sp.step) {
        const int i0 = gbase + gi * 16; const int R0 = (l == 1) ? (i0 / SEQ) * SB + CTX + (i0 % SEQ) : i0;
        const int b = R0 / SB, s = R0 - b * SB; const int mv = (s < CTX) ? 2 : b;
        const bf16* xp = xrb + (size_t)(R0 + r) * DM + 8 * kq; bf16* hp = h2 + (size_t)(R0 + r) * DM + 8 * kq;
        v4u xv[32];
#pragma unroll
        for (int m = 0; m < 32; ++m) xv[m] = *(const v4u*)(xp + 32 * m);
        float ss = 0.f;
#pragma unroll
        for (int m = 0; m < 32; ++m) { const float a0 = bflo(xv[m].x), a1 = bfhi(xv[m].x), a2 = bflo(xv[m].y), a3 = bfhi(xv[m].y), a4 = bflo(xv[m].z), a5 = bfhi(xv[m].z), a6 = bflo(xv[m].w), a7 = bfhi(xv[m].w);
            ss += ((a0 * a0 + a1 * a1) + (a2 * a2 + a3 * a3)) + ((a4 * a4 + a5 * a5) + (a6 * a6 + a7 * a7)); }
#pragma unroll
        for (int m = 0; m < 32; ++m) asm volatile("" : "+v"(xv[m]));
        ss += sx<16>(ss); ss = sum32(ss);
        const float rs = rsqrtf(ss * (1.f / DM) + EPS);
        f32x4 acc0 = {0.f, 0.f, 0.f, 0.f}, acc1 = acc0;
        const LAS float* gp = G2 + mv * 1024 + 8 * kq; const LAS float* sp2 = S2 + mv * 1024 + 8 * kq; const LAS float* wp = W + (kq * 16 + r) * 8;
#pragma unroll
        for (int m = 0; m < 32; ++m) {
            const f32x4 g0 = *(const LAS f32x4*)(gp + 32 * m), g1 = *(const LAS f32x4*)(gp + 32 * m + 4), s0 = *(const LAS f32x4*)(sp2 + 32 * m), s1 = *(const LAS f32x4*)(sp2 + 32 * m + 4);
            const f32x4 w0 = *(const LAS f32x4*)(wp + m * 512), w1 = *(const LAS f32x4*)(wp + m * 512 + 4);
            const v4u x = xv[m];
            const f32x4 h0 = (f32x4){bflo(x.x), bfhi(x.x), bflo(x.y), bfhi(x.y)} * rs * g0 + s0, h1 = (f32x4){bflo(x.z), bfhi(x.z), bflo(x.w), bfhi(x.w)} * rs * g1 + s1;
            v4u o; o.x = pk2(h0.x, h0.y); o.y = pk2(h0.z, h0.w); o.z = pk2(h1.x, h1.y); o.w = pk2(h1.z, h1.w);
            *(v4u*)(hp + 32 * m) = o;
            acc0 = __builtin_amdgcn_mfma_f32_16x16x4f32(h0.x, w0.x, acc0, 0, 0, 0); acc1 = __builtin_amdgcn_mfma_f32_16x16x4f32(h0.y, w0.y, acc1, 0, 0, 0);
            acc0 = __builtin_amdgcn_mfma_f32_16x16x4f32(h0.z, w0.z, acc0, 0, 0, 0); acc1 = __builtin_amdgcn_mfma_f32_16x16x4f32(h0.w, w0.w, acc1, 0, 0, 0);
            acc0 = __builtin_amdgcn_mfma_f32_16x16x4f32(h1.x, w1.x, acc0, 0, 0, 0); acc1 = __builtin_amdgcn_mfma_f32_16x16x4f32(h1.y, w1.y, acc1, 0, 0, 0);
            acc0 = __builtin_amdgcn_mfma_f32_16x16x4f32(h1.z, w1.z, acc0, 0, 0, 0); acc1 = __builtin_amdgcn_mfma_f32_16x16x4f32(h1.w, w1.w, acc1, 0, 0, 0);
            __builtin_amdgcn_sched_barrier(0);
        }
        const f32x4 lg4 = acc0 + acc1;
        f32x4 pr;
#pragma unroll
        for (int v = 0; v < 4; ++v) { const float lg = lg4[v];
            float mx = lg; mx = fmaxf(mx, sx<1>(mx)); mx = fmaxf(mx, sx<2>(mx)); mx = fmaxf(mx, sx<4>(mx)); mx = fmaxf(mx, sx<8>(mx));
            const float p = __expf(lg - mx); float sum = p;
            sum += sx<1>(sum); sum += sx<2>(sum); sum += sx<4>(sum); sum += sx<8>(sum);
            aff[(size_t)(R0 + 4 * kq + v) * 16 + r] = p / sum; pr[v] = p / sum; }
        *(f32x4*)((float*)(F.ws + WS_AFFT) + (size_t)r * M + R0 + 4 * kq) = pr;
    }
}
__device__ __forceinline__ void router_phase(Frame& F, int l) {
    if (ROUTER_MFMA && XRES_BF16) { router_phase_mfma(F, l); return; }
    constexpr int RT = RT_ROWS;
    const int tid = F.tid, lane = F.lane; const Span sp = row_span(F, l == 1 ? 2 : 1);
    LAS float* W = (LAS float*)F.lds; LAS float* G2 = W + 1024 * 20; LAS float* S2 = G2 + 3072;
    const float* rw = gin(F, I_RW) + (size_t)l * 1024 * 16; const float* n2 = gin(F, I_N2G) + l * DM; const float* modl = (const float*)(F.ws + WS_MOD) + (size_t)l * 3 * 6144;
    const float* xres = (const float*)(F.ws + WS_XRES); bf16* h2 = (bf16*)(F.ws + WS_H1); float* aff = (float*)(F.ws + WS_AFF);
    for (int i = tid; i < 4096; i += 512) *(LAS f32x4*)(W + (i >> 2) * 20 + (i & 3) * 4) = *(const f32x4*)(rw + 4 * i);
    for (int i = tid; i < 3072; i += 512) { const int mv = i >> 10, k = i & 1023; G2[i] = n2[k] * (1.f + modl[mv * 6144 + 4096 + k]); S2[i] = modl[mv * 6144 + 3072 + k]; }
    __syncthreads();
    const int gbase = (sp.lo - (sp.lo % sp.step)) , gw = sp.lo % sp.step;
    for (int gi = gw; gbase + gi * RT < sp.hi; gi += sp.step) {
        const int i0 = gbase + gi * RT; const int R0 = (l == 1) ? (i0 / SEQ) * SB + CTX + (i0 % SEQ) : i0;
        const int b = R0 / SB, s = R0 - b * SB; const int mv = (s < CTX) ? 2 : b;
        const float* xl = xres + (size_t)R0 * DM + lane; const bf16* xlb = (const bf16*)(F.ws + WS_XRES) + (size_t)R0 * DM + lane; bf16* hl = h2 + (size_t)R0 * DM + lane;
        float x[RT][16]; float ss[RT];
#pragma unroll
        for (int u = 0; u < RT; ++u)
#pragma unroll
            for (int q = 0; q < 16; ++q) x[u][q] = XRES_BF16 ? bf2f(xlb[u * DM + 64 * q]) : xl[u * DM + 64 * q];
        float rs[RT];
#pragma unroll
        for (int u = 0; u < RT; ++u) {
            ss[u] = 0.f;
#pragma unroll
            for (int q = 0; q < 16; ++q) ss[u] += x[u][q] * x[u][q];
            asm volatile("" : "+v"(ss[u]));
            rs[u] = rsqrtf(wave_sum(ss[u]) * (1.f / DM) + EPS); }
        float acc[RT][16];
#pragma unroll
        for (int u = 0; u < RT; ++u)
#pragma unroll
            for (int e = 0; e < 16; ++e) acc[u][e] = 0.f;
        f32x4 cw0, cw1, cw2, cw3; float cg, csh;
#define RT_LD(q_, A0, A1, A2, A3, G_, S_) do { const int k_ = lane + 64 * (q_); const LAS f32x4* wp_ = (const LAS f32x4*)(W + k_ * 20); A0 = wp_[0]; A1 = wp_[1]; A2 = wp_[2]; A3 = wp_[3]; G_ = G2[mv * 1024 + k_]; S_ = S2[mv * 1024 + k_]; } while (0)
        RT_LD(0, cw0, cw1, cw2, cw3, cg, csh);
#pragma unroll
        for (int q = 0; q < 16; ++q) { f32x4 nw0 = cw0, nw1 = cw1, nw2 = cw2, nw3 = cw3; float ng = cg, nsh = csh;
            if (q < 15) RT_LD(q + 1, nw0, nw1, nw2, nw3, ng, nsh);
#pragma unroll
            for (int u = 0; u < RT; ++u) { float h = x[u][q] * rs[u] * cg + csh; asm volatile("" : "+v"(h));
                hl[u * DM + 64 * q] = (bf16)f2bf(h);
#define RFMA(A_, W_) asm("v_fmac_f32_e32 %0, %1, %2" : "+v"(A_) : "v"(h), "v"(W_))
                RFMA(acc[u][0], cw0.x); RFMA(acc[u][1], cw0.y); RFMA(acc[u][2], cw0.z); RFMA(acc[u][3], cw0.w);
                RFMA(acc[u][4], cw1.x); RFMA(acc[u][5], cw1.y); RFMA(acc[u][6], cw1.z); RFMA(acc[u][7], cw1.w);
                RFMA(acc[u][8], cw2.x); RFMA(acc[u][9], cw2.y); RFMA(acc[u][10], cw2.z); RFMA(acc[u][11], cw2.w);
                RFMA(acc[u][12], cw3.x); RFMA(acc[u][13], cw3.y); RFMA(acc[u][14], cw3.z); RFMA(acc[u][15], cw3.w); }
#undef RFMA
            cw0 = nw0; cw1 = nw1; cw2 = nw2; cw3 = nw3; cg = ng; csh = nsh;
            __builtin_amdgcn_sched_barrier(0); }
#undef RT_LD
        const int e = ((lane & 1) << 3) | ((lane & 2) << 1) | ((lane & 4) >> 1) | ((lane & 8) >> 3);
#pragma unroll
        for (int u = 0; u < RT; ++u) {
#define RT_STAGE(ST) do { constexpr int half_ = 8 >> (ST); const bool up = (lane >> (ST)) & 1; \
                _Pragma("unroll") for (int j = 0; j < half_; ++j) { const float a = acc[u][j], c = acc[u][j + half_]; const float mine = up ? c : a, other = up ? a : c; acc[u][j] = mine + sx<(1 << (ST))>(other); } } while (0)
            RT_STAGE(0); RT_STAGE(1); RT_STAGE(2); RT_STAGE(3);
#undef RT_STAGE
            float lg = acc[u][0]; lg += sx<16>(lg); lg = sum32(lg);
            float mx = lg;
            mx = fmaxf(mx, sx<1>(mx)); mx = fmaxf(mx, sx<2>(mx)); mx = fmaxf(mx, sx<4>(mx)); mx = fmaxf(mx, sx<8>(mx));
            const float p = __expf(lg - mx); float sum = p;
            sum += sx<1>(sum); sum += sx<2>(sum); sum += sx<4>(sum); sum += sx<8>(sum);
            if (lane < 16) aff[(size_t)(R0 + u) * 16 + e] = p / sum; }
    }
}

template <int N, int KSEL>
__device__ __forceinline__ void topk_list(Frame& F, int R0, int e, int slot0) {
    constexpr int EPT = N >= 512 ? N / 512 : 1;
    LAS unsigned* keys = (LAS unsigned*)F.lds; LAS unsigned* hist = keys + 8192; LAS unsigned* wtot = hist + 256; LAS unsigned* sel = wtot + 16;
    const float* aff = (const float*)(F.ws + WS_AFF); int* inv = (int*)(F.ws + WS_INV); int* rowidx = (int*)(F.ws + WS_ROWIDX);
    const int tid = F.tid, lane = F.lane, wave = F.wave;
    { constexpr int NIT = (N + 511) / 512; unsigned kv[NIT];
#pragma unroll
      for (int it = 0; it < NIT; ++it) { const int i = tid + 512 * it; kv[it] = (i < N) ? __float_as_uint((ROUTER_MFMA && XRES_BF16) ? ((const float*)(F.ws + WS_AFFT))[(size_t)e * M + R0 + i] : aff[(size_t)(R0 + i) * 16 + e]) : 0u; }
#pragma unroll
      for (int it = 0; it < NIT; ++it) { const int i = tid + 512 * it; if (i < N) keys[i] = kv[it]; } }
    unsigned prefix = 0u; unsigned kneed = KSEL;
    for (int pass = 0; pass < 4; ++pass) {
        const int shift = 24 - 8 * pass;
        if (tid < 256) hist[tid] = 0u;
        __syncthreads();
        if (pass == 0) {
            for (int i = tid; i < N; i += 512) { const unsigned d = keys[i] >> 24; unsigned long long todo = __ballot(1);
                while (todo) { const int ln = __builtin_ctzll(todo); const unsigned d0 = __builtin_amdgcn_readlane(d, ln); const unsigned long long m = __ballot(d == d0) & todo;
                    if (lane == ln) (void)__hip_atomic_fetch_add(&hist[d0], (unsigned)__builtin_popcountll(m), __ATOMIC_RELAXED, __HIP_MEMORY_SCOPE_WORKGROUP); todo &= ~m; } }
        } else {
        for (int i = tid; i < N; i += 512) { const unsigned k = keys[i]; const unsigned hiq = (unsigned)((unsigned long long)k >> (shift + 8));
            if (hiq == prefix) (void)__hip_atomic_fetch_add(&hist[(k >> shift) & 255u], 1u, __ATOMIC_RELAXED, __HIP_MEMORY_SCOPE_WORKGROUP); }
        }
        __syncthreads();
        unsigned v = 0u, incl = 0u;
        if (tid < 256) { v = hist[255 - tid]; incl = v;
            incl = wave_scan_incl(incl, lane);
            if (lane == 63) wtot[wave] = incl; }
        __syncthreads();
        if (tid < 256) { unsigned off = 0u; for (int w = 0; w < wave; ++w) off += wtot[w]; incl += off; const unsigned excl = incl - v;
            if (incl >= kneed && excl < kneed) { sel[0] = 255u - (unsigned)tid; sel[1] = kneed - excl; } }
        __syncthreads();
        prefix = (prefix << 8) | sel[0]; kneed = sel[1];
        __syncthreads();
    }
    const unsigned T = prefix; const int cgt = KSEL - (int)kneed;
    unsigned cnt = 0u; const int base = tid * EPT;
    if (base < N) {
#pragma unroll
        for (int q = 0; q < EPT; ++q) { const unsigned k = keys[base + q]; cnt += (k > T) ? 1u : 0u; cnt += (k == T) ? 0x10000u : 0u; } }
    unsigned incl = wave_scan_incl(cnt, lane);
    if (lane == 63) wtot[wave] = incl;
    __syncthreads();
    { unsigned off = 0u; for (int w = 0; w < wave; ++w) off += wtot[w]; incl += off; }
    const unsigned excl = incl - cnt; int pg = (int)(excl & 0xffffu), pe = (int)(excl >> 16);
    if (base < N) {
#pragma unroll
        for (int q = 0; q < EPT; ++q) { const unsigned k = keys[base + q]; int slot = -1;
            if (k > T) slot = pg++; else if (k == T) { if (pe < (int)kneed) slot = cgt + pe; ++pe; }
            const int R = R0 + base + q; inv[(size_t)R * 16 + e] = slot < 0 ? -1 : slot0 + slot;
            if (slot >= 0) rowidx[e * RPE + slot0 + slot] = R; } }
    __syncthreads();
}
__device__ __forceinline__ void topk_phase(Frame& F, int l) {
    int* rowidx = (int*)(F.ws + WS_ROWIDX);
    if (F.reg && MOE_LSEAM) {
        const int g = F.vcu >> 5, j = F.vcu & 31;
        if (l == 0 && j == 8 && F.tid < 384) rowidx[(2 * g + F.tid / 192) * RPE + 2112 + (F.tid % 192)] = 0;
        if (j < 4) { const int b = j >> 1, e = 2 * g + (j & 1); topk_list<SEQ, 1024>(F, b * SB + CTX, e, b * 1024); }
        else if (l == 0 && j < 8) { const int b = (j - 4) >> 1, e = 2 * g + (j & 1); topk_list<CTX, 32>(F, b * SB, e, 2048 + b * 32); }
        return;
    }
    if (l == 0) {
        if (blockIdx.x < 6) { const int i = blockIdx.x * 512 + F.tid; rowidx[(i / 192) * RPE + 2112 + (i % 192)] = 0; } }
    const int njobs = (l == 0) ? 64 : 32;
    for (int job = blockIdx.x; job < njobs; job += F.G) {
        if (job < 32) { const int b = job >> 4, e = job & 15; topk_list<SEQ, 1024>(F, b * SB + CTX, e, b * 1024); }
        else { const int j = job - 32, b = j >> 4, e = j & 15; topk_list<CTX, 32>(F, b * SB, e, 2048 + b * 32); }
    }
}
__device__ __forceinline__ void gather_phase(Frame& F, int l) {
    const int lane = F.lane, gw = F.vcu * NWAVES + F.wave, NGW = F.G * NWAVES; const int nrows = (l == 0) ? 2112 : 2048;
    const int* rowidx = (const int*)(F.ws + WS_ROWIDX); const bf16* h2 = (const bf16*)(F.ws + WS_H1); bf16* xg = (bf16*)(F.ws + WS_XG);
    for (int g = gw; g < NE * nrows; g += NGW) { const int e = g / nrows, slot = g - e * nrows; const int R = rowidx[e * RPE + slot];
        const v4u* src = (const v4u*)(h2 + (size_t)R * DM); v4u* dst = (v4u*)(xg + ((size_t)e * RPE + slot) * DM);
        const v4u a = src[lane], c = src[64 + lane]; dst[lane] = a; dst[64 + lane] = c; }
}
#ifndef MOE_BAUX
#define MOE_BAUX 0
#endif

struct Args { const float* in[26]; float* out; unsigned char* ws; int ph_lo, ph_hi, li, pad; };
__global__ void __launch_bounds__(NWAVES * 64, 2) fwd(Args args) {
    extern __shared__ __attribute__((aligned(16))) unsigned char lds[];
    Frame F;
    F.lds = (LAS unsigned char*)lds; F.MISC = (volatile LAS unsigned*)(F.lds + MISC_OFF);
    F.tid = threadIdx.x; F.lane = F.tid & 63; F.wave = __builtin_amdgcn_readfirstlane(F.tid >> 6);
    const int wv0 = F.wave;
    F.G = gridDim.x; { const int bx = blockIdx.x; F.vcu = (F.G % 8 == 0) ? (bx % 8) * (F.G / 8) + bx / 8 : bx; }
    int vcu0 = F.vcu; F.reg = 0; int reg0 = 0;
    F.ws = (unsigned char*)(GAS unsigned char*)args.ws; F.out = (float*)(GAS float*)args.out; F.ctl = (unsigned*)(GAS unsigned*)(args.ws + WS_CTL);
    F.in = args.in;
    if (F.tid < 64) F.MISC[F.tid] = 0u;
    __syncthreads();
    XcdBarrier bar = xcd_barrier_post(F.ctl + CW_BAR + args.li * XCD_BAR_WORDS, F.MISC + 8);
    const int lo = args.ph_lo, hi = args.ph_hi;
#ifndef PH_EN
#define PH_EN 0xFFFF
#endif
#define IN(k) (lo <= (k) && (k) < hi)
#define INT(k, t) ((((PH_EN) >> (t)) & 1) && IN(k))
#ifndef REP_MASK
#define REP_MASK 0
#endif
#define REPS(t) (1 + (((REP_MASK) >> (t)) & 1))
#define RETID() do { int wq_ = wv0; asm volatile("" : "+s"(wq_)); int ln_; asm volatile("v_mbcnt_lo_u32_b32 %0, -1, 0\n\tv_mbcnt_hi_u32_b32 %0, -1, %0" : "=v"(ln_)); int t_ = wq_ * 64 + ln_; F.tid = t_; F.lane = t_ & 63; F.wave = __builtin_amdgcn_readfirstlane(t_ >> 6); unsigned long long w_ = (unsigned long long)args.ws; asm volatile("" : "+s"(w_)); F.ws = (unsigned char*)(GAS unsigned char*)w_; int v_ = vcu0; asm volatile("" : "+s"(v_)); F.vcu = v_; int r_ = reg0; asm volatile("" : "+s"(r_)); F.reg = r_; } while (0)
#ifndef BAR_REP
#define BAR_REP 1
#endif
#ifndef PROBE_T
#define PROBE_T -1
#endif
#ifndef PROBE_A
#define PROBE_A 8
#endif
#ifndef PROBE_L
#define PROBE_L -1
#endif
#define PH_T0(t) unsigned long long pt0_ = 0; if ((t) == PROBE_T) pt0_ = __builtin_amdgcn_s_memrealtime();
#ifndef PROBE_SELJ
#define PROBE_SELJ 8
#endif
#ifndef PROBE_SEL
#define PROBE_SEL 0
#endif
#define PH_T1(t) do { if ((t) == PROBE_T && (PROBE_L < 0 || PROBE_L == pl_) && (PROBE_SEL == 0 || (((F.vcu & 31) < PROBE_SELJ) == (PROBE_SEL == 1)))) { __syncthreads(); const unsigned long long e_ = __builtin_amdgcn_s_memrealtime(); const unsigned long long w_ = (e_ - pt0_) * PROBE_A; while (__builtin_amdgcn_s_memrealtime() - e_ < w_) __builtin_amdgcn_s_sleep(8); } } while (0)
#define SEAM(k) do { if (IN(k) && IN((k) + 1)) { for (int br = 0; br < BAR_REP; ++br) xcd_barrier(bar); } } while (0)
#ifndef LBAR_REP
#define LBAR_REP 1
#endif
#ifndef LOCAL_SEAMS
#define LOCAL_SEAMS 1
#endif
#define LSEAM(k) do { if (IN(k) && IN((k) + 1)) { if (reg0) { for (int br = 0; br < LBAR_REP; ++br) xcd_local_barrier(bar); } else xcd_barrier(bar); } } while (0)
#define h1 ((bf16*)(F.ws + WS_H1))
#define z ((bf16*)(F.ws + WS_Z))
#define xg ((bf16*)(F.ws + WS_XG))
#define hid ((bf16*)(F.ws + WS_HID))

    int pl_ = 0; (void)pl_;
    if (INT(0, 0)) { PH_T0(0); for (int rep = 0; rep < REPS(0); ++rep) { RETID(); ph0(F); if (REPS(0) > 1) __syncthreads(); } PH_T1(0); SEAM(0); }
    if (LOCAL_SEAMS && IN(0) && IN(1) && F.G == 256) {
        if (threadIdx.x == 0) { const bool rg = xcd_grid_regular(bar); F.MISC[12] = rg ? 1u : 0u; F.MISC[13] = bar.x * 32u + F.MISC[10]; }
        __syncthreads();
        reg0 = __builtin_amdgcn_readfirstlane((int)F.MISC[12]); if (reg0) vcu0 = __builtin_amdgcn_readfirstlane((int)F.MISC[13]);
    }
    for (int l = 0; l < 2; ++l) {
        const int pb = 1 + 13 * l; pl_ = l;
        if (INT(pb + 0, 1)) { PH_T0(1); for (int rep = 0; rep < REPS(1); ++rep) { RETID(); if (l == 0) norm_phase<0>(F); else norm_phase<1>(F); } PH_T1(1); LSEAM(pb + 0); }
        if (INT(pb + 1, 2)) { PH_T0(2); for (int rep = 0; rep < REPS(2); ++rep) { RETID();
            pg8::Gemm g{h1, (const bf16*)(F.ws + WS_WIN) + (size_t)l * 1536 * 1024, 1024, 1024, nullptr}; pg8::GroupOrder S; const int gq = F.vcu >> 5, gj = F.vcu & 31; if (F.reg) S.init(6, grp_p0(gq), grp_np(gq), 32, gj, false); else S.init(6, 0, 66, F.G, F.vcu, false);
            pg8::EpiStore E{z, ZW, 6};
            pg8::gemm_phase<pg8::EpiStore, pg8::GroupOrder, true, true>(F.lds, g, S, E, F.tid);
            if (USE_WIN && rep == 0 && F.G == 256) {
                const int n2 = 6 * grp_np(gq) - 32; const int wr = F.reg ? (gj >= n2 ? (gq < 2 ? 10 * gq : 20 + 16 * (gq - 2)) + gj - n2 : -1) : F.vcu - 140;
                if (wr >= 0) { RETID(); conv_window(F, l, l == 0 ? BASE_IN0 : BASE_IN1, wr, WIN_IN_NB, WIN_IN_IPW); } }
            } PH_T1(2); LSEAM(pb + 1); }
        if (INT(pb + 2, 3)) { PH_T0(3); for (int rep = 0; rep < REPS(3); ++rep) { RETID(); prep_phase(F, l); } PH_T1(3); LSEAM(pb + 2); }
        if (INT(pb + 3, 4)) { PH_T0(4); for (int rep = 0; rep < REPS(4); ++rep) { RETID();
            { pg8::Gemm g{z + ZQ, (const bf16*)(F.ws + WS_WUQ) + (size_t)l * 768 * 256, 256, ZW, nullptr}; pg8::GroupOrder S; const int gq = F.vcu >> 5, gj = F.vcu & 31; if (F.reg) S.init(3, grp_p0(gq), grp_np(gq), 32, (gj + 3 * grp_np(gq)) & 31, false); else S.init(3, 0, 66, F.G, F.G == 256 ? ((F.vcu + 198) & 255) : F.vcu, false);
              pg8::EpiStore E{(bf16*)(F.ws + WS_QM), QW, 3};
              pg8::gemm_phase<pg8::EpiStore, pg8::GroupOrder, true, true>(F.lds, g, S, E, F.tid); }
            RETID();
            { pg8::Gemm g{z + ZKV, (const bf16*)(F.ws + WS_WUKV) + (size_t)l * 1024 * 128, 128, ZW, nullptr}; pg8::GroupOrder S; const int gq = F.vcu >> 5, gj = F.vcu & 31; if (F.reg) S.init(4, grp_p0(gq), grp_np(gq), 32, gj, false); else S.init(4, 0, 66, F.G, F.vcu, false);
              pg8::EpiStore E{(bf16*)(F.ws + WS_KVM), KVW, 4};
              pg8::gemm_phase<pg8::EpiStore, pg8::GroupOrder, true, true>(F.lds, g, S, E, F.tid); }
            } PH_T1(4); if (IN(pb + 3) && IN(pb + 5)) xcd_barrier(bar); }
        if (INT(pb + 5, 6)) { PH_T0(6); for (int rep = 0; rep < REPS(6); ++rep) { RETID(); convmix_phase(F, l); RETID(); attn_phase(F, l, (char*)lds);
            if (USE_WIN && rep == 0 && l == 0 && F.G == 256) {
                const int wr = F.reg ? ((F.vcu & 127) >= 8 ? F.vcu - (F.vcu < 128 ? 8 : 16) : -1) : F.vcu - 16;
                if (wr >= 0) { RETID(); conv_window(F, 0, BASE_AT0, wr, WIN_AT_NB, WIN_AT_IPW); } } } PH_T1(6); LSEAM(pb + 5); }
        if (INT(pb + 6, 7)) { PH_T0(7); for (int rep = 0; rep < REPS(7); ++rep) { RETID(); gnorm_phase(F, l); } PH_T1(7); LSEAM(pb + 6); }
        if (INT(pb + 7, 8)) { PH_T0(8); for (int rep = 0; rep < REPS(8); ++rep) { RETID();
            pg8::Gemm g{h1, (const bf16*)(F.ws + WS_WOUT) + (size_t)l * 1024 * 1024, 1024, 1024, nullptr}; pg8::GroupOrder S; const int gq = F.vcu >> 5, gj = F.vcu & 31; if (F.reg) { if (l == 1) S.init(4, 8 * gq, 8, 32, gj, true); else S.init(4, grpB_p0(gq), grpB_np(gq), 32, gj, false); } else S.init(4, 0, l == 1 ? 64 : 66, F.G, F.vcu, l == 1);
            pg8::EpiRes E{gin(F, I_X), gin(F, I_CTX), (void*)(F.ws + WS_XRES), (const float*)(F.ws + WS_MOD) + (size_t)l * 3 * 6144 + 2048, l};
            pg8::gemm_phase<pg8::EpiRes, pg8::GroupOrder, true, true>(F.lds, g, S, E, F.tid);
            if (USE_WIN && rep == 0 && l == 0 && F.G == 256) {
                const int n2 = 4 * grpB_np(gq) - 32; const int wr = F.reg ? (gj >= n2 ? 32 * gq - 4 * ((gq > 0) + (gq > 4)) + gj - n2 : -1) : F.vcu - 8;
                if (wr >= 0) { RETID(); conv_window(F, 0, BASE_OUT0, wr, WIN_OUT_NB, WIN_OUT_IPW); } }
            } PH_T1(8); LSEAM(pb + 7); }
        if (INT(pb + 8, 9)) { PH_T0(9); for (int rep = 0; rep < REPS(9); ++rep) { RETID(); router_phase(F, l); } PH_T1(9); SEAM(pb + 8); }
        if (INT(pb + 9, 10)) { PH_T0(10); for (int rep = 0; rep < REPS(10); ++rep) { RETID(); topk_phase(F, l);
            if (USE_WIN && rep == 0 && F.G == 256) {
                if (MOE_LSEAM) { const int njg = (l == 0) ? 8 : 4, j = F.vcu & 31; const int wr = F.reg ? (j >= njg ? (F.vcu >> 5) * (32 - njg) + j - njg : -1) : (int)blockIdx.x - 8 * njg;
                    if (wr >= 0) { RETID(); conv_window_blocked(F, l, l == 0 ? BASE_TK0 : BASE_TK1, wr, WIN_TK_IPW); } }
                else { const int nj = (l == 0) ? 64 : 32; if ((int)blockIdx.x >= nj) conv_window(F, l, l == 0 ? BASE_TK0 : BASE_TK1, (int)blockIdx.x - nj, 256 - nj, WIN_TK_IPW); } }
            } PH_T1(10); if (IN(pb + 9) && IN(pb + 11)) { if (MOE_LSEAM && reg0) xcd_local_barrier(bar); else xcd_barrier(bar); } }
        if (INT(pb + 11, 12)) { PH_T0(12); for (int rep = 0; rep < REPS(12); ++rep) { RETID();
            pg8::Gemm g{h1, (const bf16*)(F.ws + WS_W13) + (size_t)l * 16 * 5376 * 1024, 1024, 1024, (const int*)(F.ws + WS_ROWIDX), 64, 0u, 32768u, 0u, 16u * 32768u};         pg8::MoeOrder S; S.init(l == 0 ? 9 : 8, 21, F.G, F.vcu);
            pg8::EpiSwiglu E{hid};
            pg8::gemm_phase<pg8::EpiSwiglu, pg8::MoeOrder, true, true, true, MOE_BAUX>(F.lds, g, S, E, F.tid);
            if (USE_WIN && rep == 0 && F.G == 256) { const int j = F.vcu & 31, j0 = (l == 0) ? 26 : 16;
                if (j >= j0) { RETID(); if (MOE_LSEAM) conv_window_blocked(F, l, l == 0 ? BASE_M10 : BASE_M11, (F.vcu >> 5) * (32 - j0) + j - j0, WIN_M1_IPW); else conv_window(F, l, l == 0 ? BASE_M10 : BASE_M11, (F.vcu >> 5) * (32 - j0) + j - j0, l == 0 ? WIN_M10_NB : WIN_M11_NB, WIN_M1_IPW); } }
            } PH_T1(12); if (MOE_LSEAM) LSEAM(pb + 11); else SEAM(pb + 11); }
        if (INT(pb + 12, 13)) { PH_T0(13); for (int rep = 0; rep < REPS(13); ++rep) { RETID();
            pg8::Gemm g{hid, (const bf16*)(F.ws + WS_W2) + (size_t)l * 16 * 1024 * FF, FF, 64, nullptr, 64, 32768u, 32768u, 42u * 32768u, 42u * 32768u};     pg8::MoeOrder S; S.init(l == 0 ? 9 : 8, 4, F.G, F.vcu);
            pg8::EpiStore E{xg, DM, 4};
#ifndef MOE2_XP
#define MOE2_XP 0
#endif
            pg8::gemm_phase<pg8::EpiStore, pg8::MoeOrder, true, true, false, MOE_BAUX>(F.lds, g, S, E, F.tid);
            if (USE_WIN && rep == 0 && l == 0 && F.G == 256 && (F.vcu & 31) >= 8) { RETID(); conv_window(F, 1, BASE_M2, (F.vcu >> 5) * 24 + (F.vcu & 31) - 8, WIN_M2_NB, WIN_M2_IPW); }
            if (REPS(13) > 1) __syncthreads();
            } PH_T1(13); SEAM(pb + 12); }
    }
    if (INT(27, 14)) { PH_T0(14); for (int rep = 0; rep < REPS(14); ++rep) { RETID(); norm_phase<2>(F); } PH_T1(14); }
#undef h1
#undef z
#undef xg
#undef hid
#undef IN
#undef INT
#undef REPS
#undef SEAM
}

#ifndef MK_MULTI
#define MK_MULTI 0
#endif
extern "C" void kernel_launch(void* const* d_in, const int* in_sizes, int n_in, void* d_out, int out_size, void* d_ws, size_t ws_size, hipStream_t stream) {
    static int grid = 0;
    if (grid == 0) {
        if (n_in != 26 || in_sizes[0] != NB * SEQ * DM || out_size != NB * SEQ * DM || ws_size < WS_END) { fprintf(stderr, "kernel_launch: shape / workspace mismatch (n_in %d, ws %zu)\n", n_in, ws_size); grid = -1; return; }
        int dev = 0, cus = 0, per_cu = 0;
        if (hipGetDevice(&dev) != hipSuccess || hipDeviceGetAttribute(&cus, hipDeviceAttributeMultiprocessorCount, dev) != hipSuccess) { grid = -1; return; }
        if (hipFuncSetAttribute((const void*)fwd, hipFuncAttributeMaxDynamicSharedMemorySize, LDS_BYTES) != hipSuccess) { fprintf(stderr, "kernel_launch: hipFuncSetAttribute failed\n"); grid = -1; return; }
        if (hipOccupancyMaxActiveBlocksPerMultiprocessor(&per_cu, (const void*)fwd, NWAVES * 64, LDS_BYTES) != hipSuccess || per_cu < 1) { fprintf(stderr, "kernel_launch: occupancy query reports %d\n", per_cu); (void)hipGetLastError(); per_cu = 1; }
        grid = cus;
    }
    if (grid < 0) return;
    if (hipMemsetAsync((char*)d_ws + WS_CTL, 0, CTL_ZERO_BYTES, stream) != hipSuccess) return;
    Args a{};
    for (int i = 0; i < 26; ++i) a.in[i] = (const float*)d_in[i];
    a.out = (float*)d_out; a.ws = (unsigned char*)d_ws; a.pad = 0;
#if MK_MULTI
    for (int p = 0; p < NPHASE; ++p) { a.ph_lo = p; a.ph_hi = p + 1; a.li = p; hipLaunchKernelGGL(fwd, dim3(grid), dim3(NWAVES * 64), LDS_BYTES, stream, a); }
#else
    a.ph_lo = 0; a.ph_hi = NPHASE; a.li = 0;
    hipLaunchKernelGGL(fwd, dim3(grid), dim3(NWAVES * 64), LDS_BYTES, stream, a);
#endif
    const hipError_t le = hipPeekAtLastError();
    if (le != hipSuccess) fprintf(stderr, "kernel_launch: launch failed: %s\n", hipGetErrorName(le));
}
```
